# Optimizing an MI355X kernel written in HIP

```python
import math
import jax
import jax.numpy as jnp
from jax import lax
import numpy as np

D_MODEL = 1024
BATCH = 4
SEQ = 8192
DEPTH = 2

CHUNK = 64
HEAD_DIM = 64
SSD_WIDTH = D_MODEL // 2
SSD_HEADS = SSD_WIDTH // HEAD_DIM
SSD_GROUPS = 2
SSD_STATE = 128
SSD_CONV = 4
SSD_CONV_DIM = SSD_WIDTH + 2 * SSD_GROUPS * SSD_STATE
GMLP_WIDTH = D_MODEL // 4
GMLP_GROUPS = GMLP_WIDTH // HEAD_DIM
GMLP_CHUNK = 128
ATT_WIDTH = D_MODEL // 4
ATT_HEADS = ATT_WIDTH // HEAD_DIM
ATT_PREV_CHUNKS = 8
ATT_BAND = (ATT_PREV_CHUNKS + 1) * CHUNK
ATT_MAX_REL = 128
D_MIX = SSD_WIDTH + GMLP_WIDTH + ATT_WIDTH
D_IN = SSD_WIDTH + SSD_CONV_DIM + SSD_HEADS + 2 * GMLP_WIDTH + 3 * ATT_WIDTH
_S1 = SSD_WIDTH
_S2 = _S1 + SSD_CONV_DIM
_S3 = _S2 + SSD_HEADS
_S4 = _S3 + GMLP_WIDTH
_S5 = _S4 + GMLP_WIDTH
IN_SPLITS = (_S1, _S2, _S3, _S4, _S5)
D_FF = 2816
N_EXPERTS = 8
TOP_K = 2
D_FF_EXPERT = 3584
MOE_BLOCK = 512
N_DENSE = (DEPTH + 1) // 2
N_MOE = DEPTH // 2
RMS_EPS = 1e-6
LN_EPS = 1e-5

kernel_name = "hybrid_ssd_gmlp_bandattn_moe_block"


def rms_norm(x, g):
    xf = x.astype(jnp.float32)
    y = xf * lax.rsqrt(jnp.mean(xf * xf, axis=-1, keepdims=True) + RMS_EPS)
    return (y * g.astype(jnp.float32)).astype(x.dtype)


def layer_norm(x, g, b):
    xf = x.astype(jnp.float32)
    mu = jnp.mean(xf, axis=-1, keepdims=True)
    xc = xf - mu
    var = jnp.mean(xc * xc, axis=-1, keepdims=True)
    return (xc * lax.rsqrt(var + LN_EPS) * g.astype(jnp.float32) + b.astype(jnp.float32)).astype(x.dtype)


def segsum(a):
    t = a.shape[-1]
    strict = jnp.tril(jnp.ones((t, t), bool), -1)
    x = jnp.where(strict, a[..., :, None], 0.0)
    x = jnp.cumsum(x, axis=-2)
    return jnp.where(jnp.tril(jnp.ones((t, t), bool)), x, -jnp.inf)


def ssd_mixer(z, xbc, dt_raw, conv_w, conv_b, dt_bias, a_log, d_skip, norm_g):
    f32 = jnp.float32
    b, s, _ = z.shape
    nc = s // CHUNK
    r = SSD_HEADS // SSD_GROUPS
    xbc = lax.conv_general_dilated(xbc, conv_w[:, None, :], (1,), [(SSD_CONV - 1, 0)],
                                   dimension_numbers=('NWC', 'WIO', 'NWC'),
                                   feature_group_count=SSD_CONV_DIM)
    xbc = jax.nn.silu(xbc + conv_b)
    xs, bm, cm = jnp.split(xbc.astype(f32), [SSD_WIDTH, SSD_WIDTH + SSD_GROUPS * SSD_STATE], axis=-1)
    x = xs.reshape(b, nc, CHUNK, SSD_GROUPS, r, HEAD_DIM)
    bm = bm.reshape(b, nc, CHUNK, SSD_GROUPS, SSD_STATE)
    cm = cm.reshape(b, nc, CHUNK, SSD_GROUPS, SSD_STATE)
    dt = jax.nn.softplus(dt_raw.astype(f32) + dt_bias.astype(f32)).reshape(b, nc, CHUNK, SSD_GROUPS, r)
    a = -jnp.exp(a_log.astype(f32)).reshape(SSD_GROUPS, r)
    da = (dt * a).transpose(0, 3, 4, 1, 2)
    xdt = x * dt[..., None]
    a_cs = jnp.cumsum(da, axis=-1)
    decay_in = jnp.exp(segsum(da))
    cb = jnp.einsum('bclgn,bcsgn->bgcls', cm, bm)
    y_diag = jnp.einsum('bgrcls,bcsgrp->bclgrp', cb[:, :, None] * decay_in, xdt)
    decay_to_end = jnp.exp(a_cs[..., -1:] - a_cs).transpose(0, 3, 4, 1, 2)
    states = jnp.einsum('bclgn,bclgrp->bcgrpn', bm, xdt * decay_to_end[..., None])
    states = jnp.concatenate([jnp.zeros_like(states[:, :1]), states], axis=1)
    chunk_decay = jnp.exp(segsum(jnp.pad(a_cs[..., -1], ((0, 0), (0, 0), (0, 0), (1, 0)))))
    states = jnp.einsum('bgrzc,bcgrpn->bzgrpn', chunk_decay, states)[:, :-1]
    decay_from_start = jnp.exp(a_cs).transpose(0, 3, 4, 1, 2)
    y_off = jnp.einsum('bclgn,bcgrpn->bclgrp', cm, states) * decay_from_start[..., None]
    y = y_diag + y_off + x * d_skip.astype(f32).reshape(SSD_GROUPS, r, 1)
    y = y.reshape(b, s, SSD_WIDTH) * jax.nn.silu(z.astype(f32))
    return rms_norm(y, norm_g).astype(z.dtype)


def spatial_gating(u, v, ln_g, ln_b, w_s, b_s):
    b, s, _ = u.shape
    n = s // GMLP_CHUNK
    v = layer_norm(v, ln_g, ln_b).reshape(b, n, GMLP_CHUNK, GMLP_GROUPS, HEAD_DIM)
    w = w_s * jnp.tril(jnp.ones((GMLP_CHUNK, GMLP_CHUNK), w_s.dtype))
    mixed = jnp.einsum('gts,bnsgc->bntgc', w, v) + b_s.T[:, :, None]
    return u * mixed.reshape(b, s, GMLP_WIDTH)


def band_attention(q, k, v, rel_bias):
    b, s, _ = q.shape
    nc = s // CHUNK
    q = q.reshape(b, nc, CHUNK, ATT_HEADS, HEAD_DIM)
    pad = ((0, 0), (ATT_PREV_CHUNKS * CHUNK, 0), (0, 0))
    kp = jnp.pad(k, pad).reshape(b, nc + ATT_PREV_CHUNKS, CHUNK, ATT_HEADS, HEAD_DIM)
    vp = jnp.pad(v, pad).reshape(b, nc + ATT_PREV_CHUNKS, CHUNK, ATT_HEADS, HEAD_DIM)
    kb = jnp.concatenate([kp[:, j:j + nc] for j in range(ATT_PREV_CHUNKS + 1)], axis=2)
    vb = jnp.concatenate([vp[:, j:j + nc] for j in range(ATT_PREV_CHUNKS + 1)], axis=2)
    scores = jnp.einsum('bcqhd,bckhd->bhcqk', q, kb).astype(jnp.float32) * (HEAD_DIM ** -0.5)
    qi = jnp.arange(CHUNK)[:, None]
    ki = jnp.arange(ATT_BAND)[None, :]
    rel = qi - ki + ATT_PREV_CHUNKS * CHUNK
    idx = jnp.clip(rel, -ATT_MAX_REL, ATT_MAX_REL) + ATT_MAX_REL
    bias = rel_bias[:, idx].astype(jnp.float32)
    key_pos = jnp.arange(nc)[:, None] * CHUNK + ki - ATT_PREV_CHUNKS * CHUNK
    valid = key_pos >= 0
    scores = scores + bias[None, :, None]
    scores = jnp.where(valid[None, None, :, None, :], scores, -1e30)
    p = jax.nn.softmax(scores, axis=-1).astype(v.dtype)
    out = jnp.einsum('bhcqk,bckhd->bcqhd', p, vb)
    return out.reshape(b, s, ATT_WIDTH)


def swiglu(x, w_gate, w_up, w_down):
    return (jax.nn.silu(x @ w_gate) * (x @ w_up)) @ w_down


def moe_swiglu(x, router_w, w_gate, w_up, w_down):
    b, s, d = x.shape
    xt = x.reshape(b * s, d)
    n_assign = b * s * TOP_K
    logits = (xt @ router_w).astype(jnp.float32)
    top_logits, top_idx = lax.top_k(logits, TOP_K)
    gates = jax.nn.softmax(top_logits, axis=-1)
    flat_e = top_idx.reshape(-1)
    flat_g = gates.reshape(-1)
    order = jnp.argsort(flat_e)
    sorted_e = flat_e[order]
    counts = jnp.bincount(flat_e, length=N_EXPERTS)
    padded = (counts + MOE_BLOCK - 1) // MOE_BLOCK * MOE_BLOCK
    pad_end = jnp.cumsum(padded)
    pad_start = pad_end - padded
    start = jnp.cumsum(counts) - counts
    dest = pad_start[sorted_e] + jnp.arange(n_assign) - start[sorted_e]
    n_blocks = -(-n_assign // MOE_BLOCK) + N_EXPERTS
    n_rows = n_blocks * MOE_BLOCK
    row_tok = jnp.zeros((n_rows,), jnp.int32).at[dest].set((order // TOP_K).astype(jnp.int32))
    row_gate = jnp.zeros((n_rows,), jnp.float32).at[dest].set(flat_g[order])
    block_first = jnp.arange(n_blocks) * MOE_BLOCK
    block_e = jnp.minimum(jnp.sum(pad_end[None, :] <= block_first[:, None], axis=1), N_EXPERTS - 1)

    def expert_block(args):
        tok, e = args
        xb = xt[tok]
        return swiglu(xb, w_gate[e], w_up[e], w_down[e])

    y = lax.map(expert_block, (row_tok.reshape(n_blocks, MOE_BLOCK), block_e))
    y = y.reshape(n_rows, d) * row_gate[:, None].astype(x.dtype)
    return jnp.zeros_like(xt).at[row_tok].add(y).reshape(b, s, d)


def setup_inputs(seed: int = 0) -> dict:
    key = jax.random.key(seed)
    ks = iter(jax.random.split(key, 40))
    f32 = jnp.float32

    def nrm(shape, scale):
        return scale * jax.random.normal(next(ks), shape, f32)

    def gain(shape):
        return 1.0 + nrm(shape, 0.05)

    dt0 = jnp.exp(jax.random.uniform(next(ks), (DEPTH, SSD_HEADS), f32, math.log(1e-3), math.log(1e-1)))
    return {
        'x': nrm((BATCH, SEQ, D_MODEL), 1.0),
        'mix_pre_norm': gain((DEPTH, D_MODEL)),
        'mix_post_norm': gain((DEPTH, D_MODEL)),
        'ffn_pre_norm': gain((DEPTH, D_MODEL)),
        'ffn_post_norm': gain((DEPTH, D_MODEL)),
        'w_in': nrm((DEPTH, D_MODEL, D_IN), D_MODEL ** -0.5),
        'ssd_conv_w': nrm((DEPTH, SSD_CONV, SSD_CONV_DIM), SSD_CONV ** -0.5),
        'ssd_conv_b': nrm((DEPTH, SSD_CONV_DIM), 0.02),
        'ssd_dt_bias': dt0 + jnp.log(-jnp.expm1(-dt0)),
        'ssd_a_log': jnp.log(jax.random.uniform(next(ks), (DEPTH, SSD_HEADS), f32, 1.0, 16.0)),
        'ssd_d': 1.0 + nrm((DEPTH, SSD_HEADS), 0.1),
        'ssd_norm': gain((DEPTH, SSD_WIDTH)),
        'gmlp_ln_g': gain((DEPTH, GMLP_WIDTH)),
        'gmlp_ln_b': nrm((DEPTH, GMLP_WIDTH), 0.02),
        'gmlp_w_s': nrm((DEPTH, GMLP_GROUPS, GMLP_CHUNK, GMLP_CHUNK), GMLP_CHUNK ** -0.5),
        'gmlp_b_s': 1.0 + nrm((DEPTH, GMLP_GROUPS, GMLP_CHUNK), 0.02),
        'gmlp_out_norm': gain((DEPTH, GMLP_WIDTH)),
        'attn_rel_bias': nrm((DEPTH, ATT_HEADS, 2 * ATT_MAX_REL + 1), 0.2),
        'attn_out_norm': gain((DEPTH, ATT_WIDTH)),
        'w_out': nrm((DEPTH, D_MIX, D_MODEL), D_MIX ** -0.5),
        'ffn_w_gate': nrm((N_DENSE, D_MODEL, D_FF), D_MODEL ** -0.5),
        'ffn_w_up': nrm((N_DENSE, D_MODEL, D_FF), D_MODEL ** -0.5),
        'ffn_w_down': nrm((N_DENSE, D_FF, D_MODEL), D_FF ** -0.5),
        'moe_router': nrm((N_MOE, D_MODEL, N_EXPERTS), D_MODEL ** -0.5),
        'moe_w_gate': nrm((N_MOE, N_EXPERTS, D_MODEL, D_FF_EXPERT), D_MODEL ** -0.5),
        'moe_w_up': nrm((N_MOE, N_EXPERTS, D_MODEL, D_FF_EXPERT), D_MODEL ** -0.5),
        'moe_w_down': nrm((N_MOE, N_EXPERTS, D_FF_EXPERT, D_MODEL), D_FF_EXPERT ** -0.5),
    }


def reference(x, mix_pre_norm, mix_post_norm, ffn_pre_norm, ffn_post_norm, w_in,
              ssd_conv_w, ssd_conv_b, ssd_dt_bias, ssd_a_log, ssd_d, ssd_norm,
              gmlp_ln_g, gmlp_ln_b, gmlp_w_s, gmlp_b_s, gmlp_out_norm,
              attn_rel_bias, attn_out_norm, w_out,
              ffn_w_gate, ffn_w_up, ffn_w_down,
              moe_router, moe_w_gate, moe_w_up, moe_w_down):
    h = x
    for layer in range(DEPTH):
        a = rms_norm(h, mix_pre_norm[layer])
        proj = a @ w_in[layer]
        z, xbc, dt_raw, u, v, qkv = jnp.split(proj, IN_SPLITS, axis=-1)
        q, k, vv = jnp.split(qkv, 3, axis=-1)
        y_ssd = ssd_mixer(z, xbc, dt_raw, ssd_conv_w[layer], ssd_conv_b[layer], ssd_dt_bias[layer],
                          ssd_a_log[layer], ssd_d[layer], ssd_norm[layer])
        y_gmlp = rms_norm(spatial_gating(u, v, gmlp_ln_g[layer], gmlp_ln_b[layer],
                                         gmlp_w_s[layer], gmlp_b_s[layer]), gmlp_out_norm[layer])
        y_att = rms_norm(band_attention(q, k, vv, attn_rel_bias[layer]), attn_out_norm[layer])
        mixed = jnp.concatenate([y_ssd, y_gmlp, y_att], axis=-1) @ w_out[layer]
        h = h + rms_norm(mixed, mix_post_norm[layer])
        f = rms_norm(h, ffn_pre_norm[layer])
        if layer % 2 == 0:
            i = layer // 2
            f = swiglu(f, ffn_w_gate[i], ffn_w_up[i], ffn_w_down[i])
        else:
            i = layer // 2
            f = moe_swiglu(f, moe_router[i], moe_w_gate[i], moe_w_up[i], moe_w_down[i])
        h = h + rms_norm(f, ffn_post_norm[layer])
    return h
```

```cpp
#include <hip/hip_runtime.h>
#include <cstdio>
#include <cstdint>

#ifndef MK_SINGLE
#define MK_SINGLE 0
#endif

namespace pg8 {
#define PG8_LAS __attribute__((address_space(3)))
typedef unsigned short bf16_t;
typedef short bf16x8 __attribute__((ext_vector_type(8)));
typedef float f32x4 __attribute__((ext_vector_type(4)));
typedef unsigned u32x4 __attribute__((ext_vector_type(4)));
constexpr int BM = 256, BK = 64, HALF = 128, HTB = HALF * BK * 2  , STAGE_BYTES = 8 * HTB, NXCD = 8, WGM = 8;

__host__ __device__ __forceinline__ int lds_byte(int r, int c) { const int st = (r >> 4) * 2 + (c >> 5), rr = r & 15, cc = c & 31, ob = rr * 64 + cc * 2; return st * 1024 + (ob ^ (((ob >> 9) & 1) << 5)); }
__host__ __device__ __forceinline__ void stage_rc(int b, int& R, int& C) { const int st = b / 1024, sb = b % 1024, swz = sb ^ (((sb >> 9) & 1) << 5); R = (st >> 1) * 16 + swz / 64; C = (st & 1) * 32 + (swz % 64) / 2; }
__host__ __device__ __forceinline__ int perm32(int rho) { const int n = rho >> 4, i = rho & 15; return 8 * (i >> 2) + 4 * n + (i & 3); }

struct Unit { int pm, pn, om, on; };
struct Gemm { const bf16_t* A; const bf16_t* Bt; int M, N, K; };

__host__ __device__ __forceinline__ bool tile_order(int i, int G, int c, int nM, int nN, int& pm, int& pn) {
    const int nwg = nM * nN; const long L = (long)i * G + c; if (L >= nwg) return false;
    int wgid = (int)L; { const int q = nwg / NXCD, r = nwg % NXCD, xcd = wgid % NXCD, off = wgid / NXCD; wgid = (xcd < r ? xcd * (q + 1) : r * (q + 1) + (xcd - r) * q) + off; }
    const int nig = WGM * nN, gid = wgid / nig, fm = gid * WGM, gsz = (nM - fm) < WGM ? (nM - fm) : WGM;
    pm = fm + ((wgid % nig) % gsz); pn = (wgid % nig) / gsz; return true;
}
struct StaticOrder {
    int nM, nN, G, c;
    __host__ __device__ void init(int M, int N, int G_, int c_) { nM = M / BM; nN = N / BM; G = G_; c = c_; }
    __host__ __device__ bool next(int i, Unit& u) const { int pm, pn; if (!tile_order(i, G, c, nM, nN, pm, pn)) return false; u.pm = pm; u.pn = pn; u.om = pm; u.on = pn; return true; }
    __device__ __forceinline__ void a_ready(const Unit&) const {}
    __device__ __forceinline__ void done(const Unit&) const {}
};
template <bool A_LOCAL, bool O_LOCAL>
struct MoeOrder {
    int t0, nT, nN, G, c; const PG8_LAS int* te;
    __device__ __forceinline__ bool next(int i, Unit& u) const { int pm, pn; if (!tile_order(i, G, c, nT, nN, pm, pn)) return false;
        const int e = __builtin_amdgcn_readfirstlane(te[t0 + pm]);
        u.pm = A_LOCAL ? pm : t0 + pm; u.pn = e * nN + pn; u.om = O_LOCAL ? pm : t0 + pm; u.on = pn; return true; }
    __device__ __forceinline__ void a_ready(const Unit&) const {}
    __device__ __forceinline__ void done(const Unit&) const {}
};

__device__ __forceinline__ unsigned cvt_pk_bf16(float lo, float hi) { unsigned r; asm volatile("v_cvt_pk_bf16_f32 %0, %1, %2" : "=v"(r) : "v"(lo), "v"(hi)); return r; }

struct EpiStore {
    static constexpr bool PERM = true, AFTER_DRAIN = false;
    bf16_t* O; int ldc;
    __device__ __forceinline__ void operator()(const f32x4 (&acc)[2][2][4][2], const Unit& u, int wr, int wc, int fr, int fq) const {
        const int row0 = u.om * BM + wr * 64 + fr; const int col0 = u.on * BM + wc * 32 + 8 * fq;
#pragma unroll
        for (int ai = 0; ai < 2; ++ai)
#pragma unroll
            for (int m = 0; m < 4; ++m) { bf16_t* rowp = O + (size_t)(row0 + ai * HALF + m * 16) * ldc + col0;
#pragma unroll
                for (int bj = 0; bj < 2; ++bj) { const f32x4 v0 = acc[ai][bj][m][0], v1 = acc[ai][bj][m][1];
                    u32x4 w; w.x = cvt_pk_bf16(v0[0], v0[1]); w.y = cvt_pk_bf16(v0[2], v0[3]); w.z = cvt_pk_bf16(v1[0], v1[1]); w.w = cvt_pk_bf16(v1[2], v1[3]);
                    *(u32x4*)(rowp + bj * HALF) = w; } }
    }
};
__device__ __forceinline__ float silu_f(float x) { return x * __builtin_amdgcn_rcpf(1.0f + __expf(-x)); }
struct EpiSwiglu {
    static constexpr bool PERM = true, AFTER_DRAIN = false;
    bf16_t* O; int ldc;
    __device__ __forceinline__ void operator()(const f32x4 (&acc)[2][2][4][2], const Unit& u, int wr, int wc, int fr, int fq) const {
        const int row0 = u.om * BM + wr * 64 + fr; const int col0 = u.on * HALF + wc * 32 + 8 * fq;
#pragma unroll
        for (int ai = 0; ai < 2; ++ai)
#pragma unroll
            for (int m = 0; m < 4; ++m) { bf16_t* rowp = O + (size_t)(row0 + ai * HALF + m * 16) * ldc + col0;
                const f32x4 g0 = acc[ai][0][m][0], g1 = acc[ai][0][m][1], u0 = acc[ai][1][m][0], u1 = acc[ai][1][m][1];
                u32x4 w;
                w.x = cvt_pk_bf16(silu_f(g0[0]) * u0[0], silu_f(g0[1]) * u0[1]); w.y = cvt_pk_bf16(silu_f(g0[2]) * u0[2], silu_f(g0[3]) * u0[3]);
                w.z = cvt_pk_bf16(silu_f(g1[0]) * u1[0], silu_f(g1[1]) * u1[1]); w.w = cvt_pk_bf16(silu_f(g1[2]) * u1[2], silu_f(g1[3]) * u1[3]);
                *(u32x4*)rowp = w; }
    }
};

template <class Epi, class Sched, bool ALIGN_EPI = false, bool SP2 = false>
__device__ __forceinline__ void gemm_phase(PG8_LAS unsigned char* lds, const Gemm g, const Sched& S, const Epi& E) {
    int tid_ = threadIdx.x; asm volatile("" : "+v"(tid_));
    const int tid = tid_, wid = __builtin_amdgcn_readfirstlane(tid >> 6), lane = tid & 63, wr = wid >> 2, wc = wid & 3, fr = lane & 15, fq = lane >> 4;
    const int K = g.K, nt = K / BK;
    unsigned voffA[2], voffB[2];
#pragma unroll
    for (int i = 0; i < 2; ++i) { int R, C; stage_rc(tid * 16 + i * 8192, R, C); const int Rb = Epi::PERM ? ((R & ~31) + perm32(R & 31)) : R;
        voffA[i] = (unsigned)(R * K + C) * 2u; voffB[i] = (unsigned)(Rb * K + C) * 2u; }
    const size_t kstep = (size_t)(BK * 2);
    const size_t hstep = (size_t)HALF * K * 2;
    const size_t tstep = 2 * hstep;
    const unsigned ldsw = (unsigned)wid * 1024u;
    const int aoff = lds_byte(wr * 64 + fr, fq * 8), boff = lds_byte(wc * 32 + fr, fq * 8);
#define PG8_SA(b, h) (((b) * 2 + (h)) * HTB)
#define PG8_SB(b, h) ((4 + (b) * 2 + (h)) * HTB)
#define PG8_STAGE(bufoff, gbase, voff) do { _Pragma("unroll") for (int _i = 0; _i < 2; ++_i) \
        __builtin_amdgcn_global_load_lds((const unsigned*)((const char*)(gbase) + (voff)[_i]), (PG8_LAS unsigned*)(lds + (bufoff) + ldsw + _i * 8192), 16, 0, 0); } while (0)
#define PG8_LDA(dst, b, h) do { _Pragma("unroll") for (int m = 0; m < 4; ++m) _Pragma("unroll") for (int k = 0; k < 2; ++k) dst[m][k] = *(const PG8_LAS bf16x8*)(lds + PG8_SA(b, h) + aoff + m * 2048 + k * 1024); } while (0)
#define PG8_LDB(dst, b, h) do { _Pragma("unroll") for (int n = 0; n < 2; ++n) _Pragma("unroll") for (int k = 0; k < 2; ++k) dst[n][k] = *(const PG8_LAS bf16x8*)(lds + PG8_SB(b, h) + boff + n * 2048 + k * 1024); } while (0)
#define PG8_MMA(ai, bj, At, Bt) do { __builtin_amdgcn_s_setprio(1); _Pragma("unroll") for (int m = 0; m < 4; ++m) _Pragma("unroll") for (int n = 0; n < 2; ++n) _Pragma("unroll") for (int k = 0; k < 2; ++k) \
        acc[ai][bj][m][n] = __builtin_amdgcn_mfma_f32_16x16x32_bf16(Bt[n][k], At[m][k], acc[ai][bj][m][n], 0, 0, 0); __builtin_amdgcn_s_setprio(0); } while (0)
#define PG8_WAIT_V(n) asm volatile("s_waitcnt vmcnt(" #n ")" ::: "memory")
#define PG8_WAIT_L(n) asm volatile("s_waitcnt lgkmcnt(" #n ")" ::: "memory")
#define PG8_BAR __builtin_amdgcn_s_barrier()
#define PG8_SCHED __builtin_amdgcn_sched_barrier(0)
    Unit cur, nxt; int ui = 0;
    if (!S.next(0, cur)) return;
    f32x4 acc[2][2][4][2];
#pragma unroll
    for (int a = 0; a < 2; ++a)
#pragma unroll
        for (int b = 0; b < 2; ++b)
#pragma unroll
            for (int m = 0; m < 4; ++m)
#pragma unroll
                for (int n = 0; n < 2; ++n) acc[a][b][m][n] = (f32x4){0.f, 0.f, 0.f, 0.f};
    bf16x8 At[4][2], B0[2][2], B1[2][2];
    const char* cA = (const char*)g.A + (size_t)cur.pm * tstep; const char* cB = (const char*)g.Bt + (size_t)cur.pn * tstep;
    S.a_ready(cur);
    if constexpr (SP2) {
        PG8_STAGE(PG8_SB(0, 0), cB, voffB); PG8_STAGE(PG8_SB(0, 1), cB + hstep, voffB); PG8_STAGE(PG8_SA(0, 0), cA, voffA); PG8_STAGE(PG8_SA(0, 1), cA + hstep, voffA);
        if (wr == 1) PG8_BAR;
        PG8_WAIT_V(2); PG8_BAR;
        PG8_STAGE(PG8_SB(1, 0), cB + kstep, voffB); PG8_STAGE(PG8_SA(1, 0), cA + kstep, voffA); PG8_STAGE(PG8_SB(1, 1), cB + hstep + kstep, voffB);
        PG8_WAIT_V(6); PG8_BAR;
    } else {
        PG8_STAGE(PG8_SB(0, 0), cB, voffB); PG8_STAGE(PG8_SA(0, 0), cA, voffA); PG8_STAGE(PG8_SB(0, 1), cB + hstep, voffB); PG8_STAGE(PG8_SA(0, 1), cA + hstep, voffA);
        if (wr == 1) PG8_BAR;
        PG8_WAIT_V(4); PG8_BAR;
        PG8_STAGE(PG8_SB(1, 0), cB + kstep, voffB); PG8_STAGE(PG8_SA(1, 0), cA + kstep, voffA); PG8_STAGE(PG8_SB(1, 1), cB + hstep + kstep, voffB);
        PG8_WAIT_V(6); PG8_BAR;
    }
    for (;;) {
        const bool has_next = S.next(ui + 1, nxt);
        const char* nA = has_next ? (const char*)g.A + (size_t)nxt.pm * tstep : cA; const char* nB = has_next ? (const char*)g.Bt + (size_t)nxt.pn * tstep : cB;
        for (int t = 0; t < nt; t += 2) {
            const bool last = (t == nt - 2);
            const char* a1 = cA + (size_t)(t + 1) * kstep;
            const char* a2 = last ? nA : cA + (size_t)(t + 2) * kstep; const char* b2 = last ? nB : cB + (size_t)(t + 2) * kstep;
            const char* a3 = a2 + kstep; const char* b3 = b2 + kstep;
            if (last && has_next) S.a_ready(nxt);
            if constexpr (SP2) {
            PG8_LDB(B0, 0, 0); PG8_LDB(B1, 0, 1); PG8_SCHED; PG8_LDA(At, 0, 0); PG8_STAGE(PG8_SA(1, 1), a1 + hstep, voffA);
            PG8_WAIT_V(8); PG8_WAIT_L(0); PG8_BAR; PG8_MMA(0, 0, At, B0); PG8_MMA(0, 1, At, B1); PG8_BAR; PG8_SCHED;
            PG8_LDA(At, 0, 1); PG8_STAGE(PG8_SB(0, 0), b2, voffB); PG8_STAGE(PG8_SB(0, 1), b2 + hstep, voffB); PG8_STAGE(PG8_SA(0, 0), a2, voffA);
            PG8_WAIT_V(8); PG8_WAIT_L(0); PG8_BAR; PG8_MMA(1, 0, At, B0); PG8_MMA(1, 1, At, B1); PG8_BAR; PG8_SCHED;
            PG8_LDB(B0, 1, 0); PG8_LDB(B1, 1, 1); PG8_SCHED; PG8_LDA(At, 1, 0); PG8_STAGE(PG8_SA(0, 1), a2 + hstep, voffA);
            PG8_WAIT_V(8); PG8_WAIT_L(0); PG8_BAR; PG8_MMA(0, 0, At, B0); PG8_MMA(0, 1, At, B1); PG8_BAR; PG8_SCHED;
            PG8_LDA(At, 1, 1); PG8_STAGE(PG8_SB(1, 0), b3, voffB); PG8_STAGE(PG8_SB(1, 1), b3 + hstep, voffB); PG8_STAGE(PG8_SA(1, 0), a3, voffA);
            PG8_WAIT_V(8); PG8_WAIT_L(0); PG8_BAR; PG8_MMA(1, 0, At, B0); PG8_MMA(1, 1, At, B1); PG8_BAR; PG8_SCHED;
            } else {
            PG8_LDB(B0, 0, 0); PG8_SCHED; PG8_LDA(At, 0, 0); PG8_STAGE(PG8_SA(1, 1), a1 + hstep, voffA);
            PG8_WAIT_L(8); PG8_BAR; PG8_WAIT_L(0); PG8_MMA(0, 0, At, B0); PG8_BAR; PG8_SCHED;
            PG8_LDB(B1, 0, 1); PG8_STAGE(PG8_SB(0, 0), b2, voffB);
            PG8_BAR; PG8_WAIT_L(0); PG8_MMA(0, 1, At, B1); PG8_BAR;
            PG8_LDA(At, 0, 1); PG8_STAGE(PG8_SA(0, 0), a2, voffA);
            PG8_BAR; PG8_WAIT_L(0); PG8_MMA(1, 0, At, B0); PG8_BAR; PG8_SCHED;
            PG8_STAGE(PG8_SB(0, 1), b2 + hstep, voffB);
            PG8_WAIT_V(6); PG8_BAR; PG8_MMA(1, 1, At, B1); PG8_BAR;
            PG8_LDB(B0, 1, 0); PG8_SCHED; PG8_LDA(At, 1, 0); PG8_STAGE(PG8_SA(0, 1), a2 + hstep, voffA);
            PG8_WAIT_L(8); PG8_BAR; PG8_WAIT_L(0); PG8_MMA(0, 0, At, B0); PG8_BAR; PG8_SCHED;
            PG8_LDB(B1, 1, 1); PG8_STAGE(PG8_SB(1, 0), b3, voffB);
            PG8_BAR; PG8_WAIT_L(0); PG8_MMA(0, 1, At, B1); PG8_BAR;
            PG8_LDA(At, 1, 1); PG8_STAGE(PG8_SA(1, 0), a3, voffA);
            PG8_BAR; PG8_WAIT_L(0); PG8_MMA(1, 0, At, B0); PG8_BAR; PG8_SCHED;
            PG8_STAGE(PG8_SB(1, 1), b3 + hstep, voffB);
            PG8_WAIT_V(6); PG8_BAR; PG8_MMA(1, 1, At, B1); PG8_BAR;
            }
        }
        if constexpr (ALIGN_EPI) { if (wr == 0) PG8_BAR; }
        if constexpr (!Epi::AFTER_DRAIN) { E(acc, cur, wr, wc, fr, fq); S.done(cur); }
        if (!has_next) break;
#pragma unroll
        for (int a = 0; a < 2; ++a)
#pragma unroll
            for (int b = 0; b < 2; ++b)
#pragma unroll
                for (int m = 0; m < 4; ++m)
#pragma unroll
                    for (int n = 0; n < 2; ++n) acc[a][b][m][n] = (f32x4){0.f, 0.f, 0.f, 0.f};
        cur = nxt; cA = nA; cB = nB; ++ui;
        if constexpr (ALIGN_EPI) { if (wr == 1) PG8_BAR; }
    }
    PG8_WAIT_V(0);
    if constexpr (!ALIGN_EPI) { if (wr == 0) PG8_BAR; }
    PG8_BAR;
    if constexpr (Epi::AFTER_DRAIN) { E.fused(acc, cur, wr, wc, fr, fq, lds, wid, lane); S.done(cur); }
#undef PG8_SA
#undef PG8_SB
#undef PG8_STAGE
#undef PG8_LDA
#undef PG8_LDB
#undef PG8_MMA
#undef PG8_WAIT_V
#undef PG8_WAIT_L
#undef PG8_BAR
#undef PG8_SCHED
}
}

#define GAS __attribute__((address_space(1)))
#define LAS __attribute__((address_space(3)))
typedef unsigned short bf16;
typedef unsigned v4u __attribute__((ext_vector_type(4)));
typedef unsigned v2u __attribute__((ext_vector_type(2)));
typedef float f32x4 __attribute__((ext_vector_type(4)));
typedef float f32x2 __attribute__((ext_vector_type(2)));
typedef short bf16x8 __attribute__((ext_vector_type(8)));
typedef short v4i16 __attribute__((ext_vector_type(4)));
typedef GAS unsigned gu32;
#define RLX_AGENT __ATOMIC_RELAXED, __HIP_MEMORY_SCOPE_AGENT
#define LDS_WAIT() asm volatile("s_waitcnt lgkmcnt(0)" ::: "memory")
#define VM_WAIT() asm volatile("s_waitcnt vmcnt(0)" ::: "memory")
__device__ __forceinline__ unsigned pk2(float lo, float hi) { return pg8::cvt_pk_bf16(lo, hi); }
__device__ __forceinline__ float bflo(unsigned u) { return __uint_as_float(u << 16); }
__device__ __forceinline__ float bfhi(unsigned u) { return __uint_as_float(u & 0xffff0000u); }
__device__ __forceinline__ float wave_sum(float v) {
#pragma unroll
    for (int o = 1; o < 64; o <<= 1) v += __shfl_xor(v, o);
    return v;
}
__device__ __forceinline__ f32x4 mfma16(bf16x8 a, bf16x8 b, f32x4 c) { return __builtin_amdgcn_mfma_f32_16x16x32_bf16(a, b, c, 0, 0, 0); }
__device__ __forceinline__ v4i16 trrd(LAS unsigned char* p) { return __builtin_amdgcn_ds_read_tr16_b64_v4i16((LAS v4i16*)p); }
__device__ __forceinline__ bf16x8 cat8(v4i16 lo, v4i16 hi) { return (bf16x8){lo[0], lo[1], lo[2], lo[3], hi[0], hi[1], hi[2], hi[3]}; }
__device__ __forceinline__ bf16x8 pack8(float a0, float a1, float a2, float a3, float a4, float a5, float a6, float a7) {
    v4u w; w.x = pk2(a0, a1); w.y = pk2(a2, a3); w.z = pk2(a4, a5); w.w = pk2(a6, a7); return __builtin_bit_cast(bf16x8, w); }
__device__ __forceinline__ float silu(float x) { return x * __builtin_amdgcn_rcpf(1.0f + __expf(-x)); }

#define XB_TMO      128
#define XB_XCNT(j)  (256  + 64 * (j))
#define XB_XSUB(j)  (1280 + 64 * (j))
#define XB_XGEN(j)  (2304 + 64 * (j))
#define XB_TOP      3328
#define XB_TOPGEN   3392
#define XCD_BAR_WORDS 3456
#define XB_SPIN_CAP (1u << 18)

__device__ __forceinline__ unsigned xb_ld(unsigned* p)              { return __hip_atomic_load(p, __ATOMIC_RELAXED, __HIP_MEMORY_SCOPE_AGENT); }
__device__ __forceinline__ unsigned xb_add(unsigned* p, unsigned v) { return __hip_atomic_fetch_add(p, v, __ATOMIC_RELAXED, __HIP_MEMORY_SCOPE_AGENT); }
__device__ __forceinline__ unsigned xb_xcc_id() { return (unsigned)__builtin_amdgcn_s_getreg((3 << 11) | 20) & 0xFu; }
#define XB_SPIN(cond, bar) do { unsigned _sp = 0; while (cond) { __builtin_amdgcn_s_sleep(1); \
    if ((++_sp & 255u) == 0u) { if (xb_ld(&(bar)[XB_TMO])) break; if (_sp > XB_SPIN_CAP) { atomicAdd(&(bar)[XB_TMO], 1u); break; } } } } while (0)

struct XcdBarrier {
    unsigned* bar; unsigned x;
    volatile LAS unsigned* st;
};

__device__ __forceinline__ XcdBarrier xcd_barrier_post(unsigned* bar, volatile LAS unsigned* st) {
    XcdBarrier b; b.bar = bar; b.x = xb_xcc_id(); b.st = st;
    if (threadIdx.x == 0) (void)xb_add(&bar[XB_XCNT(b.x)], 1u);
    return b;
}
__device__ __forceinline__ void xcd_barrier_complete(unsigned* bar, unsigned x, unsigned& nloc, unsigned& nx) {
    const unsigned G = gridDim.x * gridDim.y * gridDim.z;
    unsigned sum, cnt, mine, sp = 0u;
    for (;;) {
        sum = 0u; cnt = 0u; mine = 0u;
#pragma unroll
        for (unsigned j = 0; j < 16; ++j) { const unsigned c = xb_ld(&bar[XB_XCNT(j)]); sum += c; cnt += (c > 0u) ? 1u : 0u; mine = (j == x) ? c : mine; }
        if (sum == G) break;
        __builtin_amdgcn_s_sleep(1);
        if ((++sp & 255u) == 0u) { if (xb_ld(&bar[XB_TMO])) break; if (sp > XB_SPIN_CAP) { atomicAdd(&bar[XB_TMO], 1u); break; } }
    }
    nloc = mine > 0u ? mine : 1u; nx = cnt > 0u ? cnt : 1u;
}

__device__ __forceinline__ void xcd_barrier(const XcdBarrier& b) {
    asm volatile("s_waitcnt vmcnt(0)" ::: "memory");
    __syncthreads();
    if (threadIdx.x == 0) {
        unsigned* bar = b.bar;
        __builtin_amdgcn_s_waitcnt(0);
        unsigned nloc = b.st[0], nx = b.st[1];
        if (nloc == 0u) { xcd_barrier_complete(bar, b.x, nloc, nx); b.st[0] = nloc; b.st[1] = nx; }
        const unsigned old = xb_add(&bar[XB_XSUB(b.x)], 1u);
        const unsigned gen = old / nloc;
        if (old + 1u == (gen + 1u) * nloc) {
            __builtin_amdgcn_fence(__ATOMIC_RELEASE, "agent");
            asm volatile("s_waitcnt vmcnt(0)" ::: "memory");
            const unsigned og = xb_add(&bar[XB_TOP], 1u);
            const unsigned tg = og / nx;
            if (og + 1u == (tg + 1u) * nx) xb_add(&bar[XB_TOPGEN], 1u);
            else XB_SPIN(xb_ld(&bar[XB_TOPGEN]) == tg, bar);
            __builtin_amdgcn_fence(__ATOMIC_ACQUIRE, "agent");
            xb_add(&bar[XB_XGEN(b.x)], 1u);
            asm volatile("s_waitcnt vmcnt(0)" ::: "memory");
        } else {
            XB_SPIN(xb_ld(&bar[XB_XGEN(b.x)]) == gen, bar);
            __builtin_amdgcn_fence(__ATOMIC_ACQUIRE, "agent");
            asm volatile("s_waitcnt vmcnt(0)" ::: "memory");
        }
    }
    __syncthreads();
}

constexpr int NWAVES = 8, NTHR = 512;
constexpr int D = 1024, SEQ = 8192, NBATCH = 4, M = NBATCH * SEQ, NCHUNK = SEQ / 64;
constexpr int DIN = 2824, PN = 2816;
constexpr int PC_Z = 0, PC_XBC = 512, PC_U = 1536, PC_V = 1792, PC_Q = 2048, PC_K = 2304, PC_VV = 2560;
constexpr int DFF = 2816, DFFE = 3584, NEXP = 8;
constexpr int MOE_CH = 88, MOE_MAXT = 264;
constexpr int NIN = 27;
constexpr size_t MiB = 1u << 20;
constexpr size_t WS_CTL = 0, CTL_ZERO_BYTES = 65536;
constexpr size_t WS_AEND = 65536, WS_WGCNT = 98304;
constexpr size_t WS_DTRAW = 1 * MiB, WS_TOKE = 2 * MiB, WS_TOKG = 2 * MiB + 262144, WS_POS = 2 * MiB + 524288;
constexpr size_t WS_WIN = 4 * MiB, WS_WOUT = 15 * MiB, WS_WGU = 19 * MiB, WS_WD = 30 * MiB;
constexpr size_t WS_A1 = 36 * MiB, WS_XBCC = 36 * MiB;
constexpr size_t WS_PROJ = 100 * MiB, WS_MIXED = 100 * MiB, WS_H1 = 100 * MiB;
constexpr size_t WS_ST = 276 * MiB, WS_FOUT = 276 * MiB;
constexpr size_t WS_Y = 404 * MiB;
constexpr size_t WS_HM = 36 * MiB, WS_XS = 190 * MiB, WS_MWGU = 322 * MiB, WS_MWD = 434 * MiB, WS_END = 490 * MiB;
constexpr int CW_BAR = 4096;
constexpr int LDS_BYTES = 163840, LDSCTL_OFF = 147456;
constexpr int CTL_MISC = LDSCTL_OFF, CTL_CNT = LDSCTL_OFF + 128, CTL_TE = LDSCTL_OFF + 512;

struct Args { const float* in[NIN]; float* out; unsigned char* ws; int ph_lo, ph_hi; };

struct Frame {
    LAS unsigned char* lds;
    int tid, lane, wave, vcu, G;
};
__device__ __forceinline__ bool fresh(Frame& F) { int t_ = threadIdx.x; asm volatile("" : "+v"(t_)); F.tid = t_; F.lane = t_ & 63; F.wave = __builtin_amdgcn_readfirstlane(t_ >> 6); return true; }

__device__ __forceinline__ void cvt_item(const float* W, int N, int k0, int n0, bf16* WT, int K, int row0, LAS float* scr, int lane) {
#pragma unroll 8
    for (int i = 0; i < 32; ++i) { const int kk = 2 * i + (lane >> 5); scr[kk * 33 + (lane & 31)] = W[(size_t)(k0 + kk) * N + n0 + (lane & 31)]; }
    LDS_WAIT(); asm volatile("" ::: "memory");
    const int c = lane & 7;
#pragma unroll
    for (int j = 0; j < 4; ++j) { const int n = (lane >> 3) + 8 * j; const LAS float* s = scr + (8 * c) * 33 + n;
        v4u o; o.x = pk2(s[0 * 33], s[1 * 33]); o.y = pk2(s[2 * 33], s[3 * 33]); o.z = pk2(s[4 * 33], s[5 * 33]); o.w = pk2(s[6 * 33], s[7 * 33]);
        *(GAS v4u*)(WT + (size_t)(row0 + n) * K + k0 + 8 * c) = o; }
    LDS_WAIT(); asm volatile("" ::: "memory");
}
__device__ __forceinline__ void cvt_small_weights(Frame& F, const Args& A) {
    LAS float* scr = (LAS float*)(F.lds + F.wave * 16384);
    const int gw = F.vcu * NWAVES + F.wave, NGW = F.G * NWAVES;
    bf16* WIN = (bf16*)(A.ws + WS_WIN); bf16* WOUT = (bf16*)(A.ws + WS_WOUT); bf16* WGU = (bf16*)(A.ws + WS_WGU); bf16* WD = (bf16*)(A.ws + WS_WD);
    constexpr int NI = 2816 + 1024 + 2816 + 1408;
    for (int it = gw; it < NI; it += NGW) {
        int r = it;
        if (r < 2816) { const int L = r / 1408; r %= 1408; const int kb = r / 88, nb = r % 88; const int ns = 32 * nb + (32 * nb >= 1536 ? 8 : 0);
            cvt_item(A.in[5] + (size_t)L * D * DIN, DIN, 64 * kb, ns, WIN + (size_t)L * PN * D, D, 32 * nb, scr, F.lane); continue; }
        r -= 2816;
        if (r < 1024) { const int L = r / 512; r %= 512; const int kb = r / 32, nb = r % 32;
            cvt_item(A.in[19] + (size_t)L * D * D, D, 64 * kb, 32 * nb, WOUT + (size_t)L * D * D, D, 32 * nb, scr, F.lane); continue; }
        r -= 1024;
        if (r < 2816) { const int up = r / 1408; r %= 1408; const int kb = r / 88, nb = r % 88;
            cvt_item(up ? A.in[21] : A.in[20], DFF, 64 * kb, 32 * nb, WGU, D, 256 * (nb >> 2) + 32 * (nb & 3) + 128 * up, scr, F.lane); continue; }
        r -= 2816;
        { const int kb = r / 32, nb = r % 32; cvt_item(A.in[22], D, 64 * kb, 32 * nb, WD, DFF, 32 * nb, scr, F.lane); }
    }
}
__device__ __forceinline__ void cvt_moe_weights(Frame& F, const Args& A) {
    LAS float* scr = (LAS float*)(F.lds + 32768 + F.wave * 8704);
    const int gw = F.vcu * NWAVES + F.wave, NGW = F.G * NWAVES;
    bf16* MWGU = (bf16*)(A.ws + WS_MWGU); bf16* MWD = (bf16*)(A.ws + WS_MWD);
    constexpr int NI = 3 * 14336;
    for (int it = gw; it < NI; it += NGW) {
        int r = it;
        if (r < 28672) { const int up = r / 14336; r %= 14336; const int e = r / 1792; r %= 1792; const int kb = r / 112, nb = r % 112;
            cvt_item((up ? A.in[25] : A.in[24]) + (size_t)e * D * DFFE, DFFE, 64 * kb, 32 * nb, MWGU + (size_t)e * 7168 * D, D, 256 * (nb >> 2) + 32 * (nb & 3) + 128 * up, scr, F.lane); continue; }
        r -= 28672;
        { const int e = r / 1792; r %= 1792; const int kb = r / 32, nb = r % 32;
          cvt_item(A.in[26] + (size_t)e * DFFE * D, D, 64 * kb, 32 * nb, MWD + (size_t)e * D * DFFE, DFFE, 32 * nb, scr, F.lane); }
    }
}

struct RowArgs {
    const float* hsrc; float* hdst;
    int branch;
    const bf16* ybuf; const float* gpost;
    const float* gpre; bf16* a1;
    int proj;
    const float* w8; int w8ld;
};
__device__ __forceinline__ void row_phase(Frame& F, const Args& A, const RowArgs& R) {
    LAS float* W8T = (LAS float*)F.lds;
    LAS int* cnt = (LAS int*)(F.lds + CTL_CNT);
    const int lane = F.lane;
    if (R.proj) { for (int idx = F.tid; idx < 8192; idx += NTHR) { const int e = idx & 7, k = idx >> 3; W8T[e * 1024 + k] = R.w8[(size_t)k * R.w8ld + e]; } }
    if (R.proj == 2 && F.tid < 8) cnt[F.tid] = 0;
    __syncthreads();
    f32x4 gpo[4], gpr[4];
#pragma unroll
    for (int j = 0; j < 4; ++j) { gpo[j] = R.branch ? *(const f32x4*)(R.gpost + 4 * lane + 256 * j) : (f32x4){0.f, 0.f, 0.f, 0.f}; gpr[j] = R.gpre ? *(const f32x4*)(R.gpre + 4 * lane + 256 * j) : (f32x4){0.f, 0.f, 0.f, 0.f}; }
    float* DTRAW = (float*)(A.ws + WS_DTRAW); int* TOKE = (int*)(A.ws + WS_TOKE); float* TOKG = (float*)(A.ws + WS_TOKG); const int* POS = (const int*)(A.ws + WS_POS);
    const int gw = F.vcu * NWAVES + F.wave, NGW = F.G * NWAVES;
    for (int m = gw; m < M; m += NGW) {
        f32x4 v[4];
#pragma unroll
        for (int j = 0; j < 4; ++j) v[j] = *(const f32x4*)(R.hsrc + (size_t)m * D + 4 * lane + 256 * j);
        if (R.branch) {
            f32x4 y[4];
            if (R.branch == 1) {
#pragma unroll
                for (int j = 0; j < 4; ++j) { const v2u raw = *(const v2u*)(R.ybuf + (size_t)m * D + 4 * lane + 256 * j); y[j] = (f32x4){bflo(raw.x), bfhi(raw.x), bflo(raw.y), bfhi(raw.y)}; }
            } else {
                const int p0 = POS[2 * m], p1 = POS[2 * m + 1]; const float g0 = TOKG[2 * m], g1 = TOKG[2 * m + 1];
#pragma unroll
                for (int j = 0; j < 4; ++j) { const v2u r0 = *(const v2u*)(R.ybuf + (size_t)p0 * D + 4 * lane + 256 * j); const v2u r1 = *(const v2u*)(R.ybuf + (size_t)p1 * D + 4 * lane + 256 * j);
                    y[j] = (f32x4){g0 * bflo(r0.x) + g1 * bflo(r1.x), g0 * bfhi(r0.x) + g1 * bfhi(r1.x), g0 * bflo(r0.y) + g1 * bflo(r1.y), g0 * bfhi(r0.y) + g1 * bfhi(r1.y)}; }
            }
            float ss = 0.f;
#pragma unroll
            for (int j = 0; j < 4; ++j) ss += (y[j].x * y[j].x + y[j].y * y[j].y) + (y[j].z * y[j].z + y[j].w * y[j].w);
            const float sc = 1.0f / sqrtf(wave_sum(ss) * (1.0f / D) + 1e-6f);
#pragma unroll
            for (int j = 0; j < 4; ++j) v[j] = v[j] + y[j] * sc * gpo[j];
        }
        if (R.hdst) {
#pragma unroll
            for (int j = 0; j < 4; ++j) *(f32x4*)(R.hdst + (size_t)m * D + 4 * lane + 256 * j) = v[j];
        }
        if (R.gpre) {
            float ss = 0.f;
#pragma unroll
            for (int j = 0; j < 4; ++j) ss += (v[j].x * v[j].x + v[j].y * v[j].y) + (v[j].z * v[j].z + v[j].w * v[j].w);
            const float sc = 1.0f / sqrtf(wave_sum(ss) * (1.0f / D) + 1e-6f);
#pragma unroll
            for (int j = 0; j < 4; ++j) { v[j] = v[j] * sc * gpr[j]; v2u o; o.x = pk2(v[j].x, v[j].y); o.y = pk2(v[j].z, v[j].w); *(v2u*)(R.a1 + (size_t)m * D + 4 * lane + 256 * j) = o; }
            if (R.proj) {
                float p[8];
#pragma unroll
                for (int e = 0; e < 8; ++e) { float s = 0.f;
#pragma unroll
                    for (int j = 0; j < 4; ++j) { const f32x4 w = *(const LAS f32x4*)(W8T + e * 1024 + 4 * lane + 256 * j); s += (v[j].x * w.x + v[j].y * w.y) + (v[j].z * w.z + v[j].w * w.w); }
                    p[e] = wave_sum(s); }
                if (R.proj == 1) {
                    float mine = p[0];
#pragma unroll
                    for (int e = 1; e < 8; ++e) mine = (lane == e) ? p[e] : mine;
                    if (lane < 8) DTRAW[(size_t)m * 8 + lane] = mine;
                } else {
                    float best = p[0]; int bi = 0;
#pragma unroll
                    for (int e = 1; e < 8; ++e) if (p[e] > best) { best = p[e]; bi = e; }
                    float sb = -3.0e38f; int si = 0;
#pragma unroll
                    for (int e = 0; e < 8; ++e) if (e != bi && p[e] > sb) { sb = p[e]; si = e; }
                    const float g0 = 1.0f / (1.0f + expf(sb - best)), g1 = 1.0f - g0;
                    if (lane == 0) { TOKE[2 * m] = bi; TOKE[2 * m + 1] = si; TOKG[2 * m] = g0; TOKG[2 * m + 1] = g1;
                        __hip_atomic_fetch_add(cnt + bi, 1, __ATOMIC_RELAXED, __HIP_MEMORY_SCOPE_WORKGROUP); __hip_atomic_fetch_add(cnt + si, 1, __ATOMIC_RELAXED, __HIP_MEMORY_SCOPE_WORKGROUP); }
                }
            }
        }
    }
    if (R.proj == 2) { __syncthreads(); if (F.tid < 8) ((int*)(A.ws + WS_WGCNT))[F.vcu * 8 + F.tid] = cnt[F.tid]; }
    __syncthreads();
}

__device__ __forceinline__ void moe_tables(Frame& F, const Args& A) {
    LAS int* c = (LAS int*)(F.lds + CTL_CNT); LAS int* te = (LAS int*)(F.lds + CTL_TE);
    if (F.tid < 40) c[F.tid] = 0;
    __syncthreads();
    const int* WGCNT = (const int*)(A.ws + WS_WGCNT);
    for (int idx = F.tid; idx < F.G * 8; idx += NTHR) { const int wg = idx >> 3, e = idx & 7; const int v = WGCNT[idx];
        __hip_atomic_fetch_add(c + e, v, __ATOMIC_RELAXED, __HIP_MEMORY_SCOPE_WORKGROUP); if (wg < F.vcu) __hip_atomic_fetch_add(c + 8 + e, v, __ATOMIC_RELAXED, __HIP_MEMORY_SCOPE_WORKGROUP); }
    __syncthreads();
    if (F.tid == 0) { int t = 0; for (int e = 0; e < 8; ++e) { c[16 + e] = t * 256; const int n = (c[e] + 255) >> 8; for (int j = 0; j < n && t + j < MOE_MAXT; ++j) te[t + j] = e; t += n; } c[32] = t < MOE_MAXT ? t : MOE_MAXT; }
    __syncthreads();
}
__device__ __forceinline__ void moe_gather(Frame& F, const Args& A) {
    LAS int* c = (LAS int*)(F.lds + CTL_CNT);
    const int* TOKE = (const int*)(A.ws + WS_TOKE); int* POS = (int*)(A.ws + WS_POS);
    const bf16* A1 = (const bf16*)(A.ws + WS_A1); bf16* XS = (bf16*)(A.ws + WS_XS);
    const int gw = F.vcu * NWAVES + F.wave, NGW = F.G * NWAVES, lane = F.lane;
    for (int m = gw; m < M; m += NGW) {
        int d0 = 0, d1 = 0;
        if (lane == 0) { const int e0 = TOKE[2 * m], e1 = TOKE[2 * m + 1];
            d0 = c[16 + e0] + c[8 + e0] + __hip_atomic_fetch_add(c + 24 + e0, 1, __ATOMIC_RELAXED, __HIP_MEMORY_SCOPE_WORKGROUP);
            d1 = c[16 + e1] + c[8 + e1] + __hip_atomic_fetch_add(c + 24 + e1, 1, __ATOMIC_RELAXED, __HIP_MEMORY_SCOPE_WORKGROUP);
            POS[2 * m] = d0; POS[2 * m + 1] = d1; }
        d0 = __builtin_amdgcn_readfirstlane(d0); d1 = __builtin_amdgcn_readfirstlane(d1);
        const v4u r0 = *(const v4u*)(A1 + (size_t)m * D + 8 * lane), r1 = *(const v4u*)(A1 + (size_t)m * D + 512 + 8 * lane);
        *(v4u*)(XS + (size_t)d0 * D + 8 * lane) = r0; *(v4u*)(XS + (size_t)d0 * D + 512 + 8 * lane) = r1;
        *(v4u*)(XS + (size_t)d1 * D + 8 * lane) = r0; *(v4u*)(XS + (size_t)d1 * D + 512 + 8 * lane) = r1;
    }
    __syncthreads();
}

__device__ __forceinline__ void gmlp_unit(Frame& F, const Args& A, int L, int nb) {
    LAS unsigned char* Ls = F.lds; const int lane = F.lane, w = F.wave, fr = lane & 15, q4 = lane >> 4;
    const size_t m0 = (size_t)nb * 128;
    const bf16* P = (const bf16*)(A.ws + WS_PROJ); bf16* Y = (bf16*)(A.ws + WS_Y);
    { const f32x4 g4 = *(const f32x4*)(A.in[12] + L * 256 + 4 * lane), b4 = *(const f32x4*)(A.in[13] + L * 256 + 4 * lane);
#pragma unroll 2
      for (int i = 0; i < 16; ++i) { const int r = 16 * w + i;
        const v2u raw = *(const v2u*)(P + (m0 + r) * PN + PC_V + 4 * lane);
        f32x4 v = (f32x4){bflo(raw.x), bfhi(raw.x), bflo(raw.y), bfhi(raw.y)};
        const float mu = wave_sum((v.x + v.y) + (v.z + v.w)) * (1.0f / 256.0f);
        v = v - mu;
        const float var = wave_sum((v.x * v.x + v.y * v.y) + (v.z * v.z + v.w * v.w)) * (1.0f / 256.0f);
        const float rstd = 1.0f / sqrtf(var + 1e-5f);
        v = v * rstd * g4 + b4;
        v2u o; o.x = pk2(v.x, v.y); o.y = pk2(v.z, v.w);
        *(LAS v2u*)(Ls + r * 544 + lane * 8) = o; } }
    __syncthreads();
    const int g = w & 3;
    f32x4 acc[4][4];
    const float* Wg = A.in[14] + (size_t)(L * 4 + g) * 128 * 128;
    const float* bsg = A.in[15] + (size_t)(L * 4 + g) * 128;
#pragma unroll
    for (int pi = 0; pi < 4; ++pi) {
        const int it = (w >> 2) == 0 ? (pi == 0 ? 0 : pi == 1 ? 7 : pi == 2 ? 1 : 6) : (pi == 0 ? 2 : pi == 1 ? 5 : pi == 2 ? 3 : 4);
#pragma unroll
        for (int ct = 0; ct < 4; ++ct) acc[pi][ct] = (f32x4){0.f, 0.f, 0.f, 0.f};
        const int t = 16 * it + fr, nks = (it >> 1) + 1;
        for (int ks = 0; ks < nks; ++ks) {
            const int sA = 32 * ks + 4 * q4, sB = sA + 16;
            const f32x4 wa = *(const f32x4*)(Wg + t * 128 + sA), wb = *(const f32x4*)(Wg + t * 128 + sB);
            const bf16x8 xf = pack8(sA + 0 <= t ? wa.x : 0.f, sA + 1 <= t ? wa.y : 0.f, sA + 2 <= t ? wa.z : 0.f, sA + 3 <= t ? wa.w : 0.f,
                                    sB + 0 <= t ? wb.x : 0.f, sB + 1 <= t ? wb.y : 0.f, sB + 2 <= t ? wb.z : 0.f, sB + 3 <= t ? wb.w : 0.f);
#pragma unroll
            for (int ct = 0; ct < 4; ++ct) { const int col = g * 64 + ct * 16 + 4 * (lane & 3);
                const v4i16 lo = trrd(Ls + (sA + (fr >> 2)) * 544 + col * 2), hi = trrd(Ls + (sB + (fr >> 2)) * 544 + col * 2);
                acc[pi][ct] = mfma16(xf, cat8(lo, hi), acc[pi][ct]); }
        }
#pragma unroll
        for (int r = 0; r < 4; ++r) { const float bs = bsg[16 * it + 4 * q4 + r];
#pragma unroll
            for (int ct = 0; ct < 4; ++ct) acc[pi][ct][r] += bs; }
    }
    __syncthreads();
#pragma unroll
    for (int pi = 0; pi < 4; ++pi) {
        const int it = (w >> 2) == 0 ? (pi == 0 ? 0 : pi == 1 ? 7 : pi == 2 ? 1 : 6) : (pi == 0 ? 2 : pi == 1 ? 5 : pi == 2 ? 3 : 4);
#pragma unroll
        for (int ct = 0; ct < 4; ++ct)
#pragma unroll
            for (int r = 0; r < 4; ++r) *(LAS float*)(Ls + (16 * it + 4 * q4 + r) * 1040 + (g * 64 + ct * 16 + fr) * 4) = acc[pi][ct][r];
    }
    __syncthreads();
    { const f32x4 gn = *(const f32x4*)(A.in[16] + L * 256 + 4 * lane);
#pragma unroll 2
      for (int i = 0; i < 16; ++i) { const int r = 16 * w + i;
        const f32x4 mx = *(const LAS f32x4*)(Ls + r * 1040 + lane * 16);
        const v2u raw = *(const v2u*)(P + (m0 + r) * PN + PC_U + 4 * lane);
        f32x4 v = (f32x4){bflo(raw.x), bfhi(raw.x), bflo(raw.y), bfhi(raw.y)} * mx;
        const float ss = wave_sum((v.x * v.x + v.y * v.y) + (v.z * v.z + v.w * v.w)) * (1.0f / 256.0f);
        v = v * (1.0f / sqrtf(ss + 1e-6f)) * gn;
        v2u o; o.x = pk2(v.x, v.y); o.y = pk2(v.z, v.w);
        *(v2u*)(Y + (m0 + r) * D + 512 + 4 * lane) = o; } }
    __syncthreads();
}

__device__ __forceinline__ void attn_unit(Frame& F, const Args& A, int L, int bc) {
    LAS unsigned char* Ls = F.lds; const int lane = F.lane, w = F.wave, fr = lane & 15, q4 = lane >> 4;
    const int b = bc >> 7, c = bc & 127; const size_t m0 = (size_t)b * SEQ + (size_t)c * 64;
    const bf16* P = (const bf16*)(A.ws + WS_PROJ); bf16* Y = (bf16*)(A.ws + WS_Y);
    const int h = w >> 1, qh = w & 1;
    LAS unsigned char* Vb = Ls + w * 10240;
    const float* bias = A.in[17] + (size_t)(L * 4 + h) * 257;
    bf16x8 qf[2][2];
#pragma unroll
    for (int qb = 0; qb < 2; ++qb)
#pragma unroll
        for (int ks = 0; ks < 2; ++ks) qf[qb][ks] = *(const bf16x8*)(P + (m0 + 32 * qh + 16 * qb + fr) * PN + PC_Q + h * 64 + 32 * ks + 8 * q4);
    f32x4 o[4][2];
#pragma unroll
    for (int dt = 0; dt < 4; ++dt) { o[dt][0] = (f32x4){0.f, 0.f, 0.f, 0.f}; o[dt][1] = (f32x4){0.f, 0.f, 0.f, 0.f}; }
    float mrun[2] = {-1e30f, -1e30f}, lrun[2] = {0.f, 0.f};
    const int jmin = c >= 8 ? 0 : 8 - c;
    for (int j = jmin; j <= 8; ++j) {
        const size_t kr0 = m0 - (size_t)(8 - j) * 64;
#pragma unroll
        for (int i = 0; i < 8; ++i) { const int row = i * 8 + (lane >> 3), ch = lane & 7;
            const v4u v = *(const v4u*)(P + (kr0 + row) * PN + PC_VV + h * 64 + ch * 8); *(LAS v4u*)(Vb + row * 160 + ch * 16) = v; }
        f32x4 st[4][2];
#pragma unroll
        for (int kt = 0; kt < 4; ++kt) { st[kt][0] = (f32x4){0.f, 0.f, 0.f, 0.f}; st[kt][1] = (f32x4){0.f, 0.f, 0.f, 0.f};
#pragma unroll
            for (int ks = 0; ks < 2; ++ks) { const bf16x8 kf = *(const bf16x8*)(P + (kr0 + 16 * kt + fr) * PN + PC_K + h * 64 + 32 * ks + 8 * q4);
                st[kt][0] = mfma16(kf, qf[0][ks], st[kt][0]); st[kt][1] = mfma16(kf, qf[1][ks], st[kt][1]); } }
#pragma unroll
        for (int qb = 0; qb < 2; ++qb) {
            const int qpos = 32 * qh + 16 * qb + fr; float mx = -1e30f;
#pragma unroll
            for (int kt = 0; kt < 4; ++kt)
#pragma unroll
                for (int r = 0; r < 4; ++r) { const int key = 16 * kt + 4 * q4 + r; int rel = 512 - 64 * j + qpos - key; rel = rel < -128 ? -128 : (rel > 128 ? 128 : rel);
                    const float s = st[kt][qb][r] * 0.125f + bias[rel + 128]; st[kt][qb][r] = s; mx = fmaxf(mx, s); }
            mx = fmaxf(mx, __shfl_xor(mx, 16)); mx = fmaxf(mx, __shfl_xor(mx, 32));
            const float mnew = fmaxf(mrun[qb], mx), alpha = __expf(mrun[qb] - mnew); mrun[qb] = mnew;
            float rs = 0.f;
#pragma unroll
            for (int kt = 0; kt < 4; ++kt)
#pragma unroll
                for (int r = 0; r < 4; ++r) { const float p = __expf(st[kt][qb][r] - mnew); st[kt][qb][r] = p; rs += p; }
            rs += __shfl_xor(rs, 16); rs += __shfl_xor(rs, 32);
            lrun[qb] = lrun[qb] * alpha + rs;
#pragma unroll
            for (int dt = 0; dt < 4; ++dt) o[dt][qb] = o[dt][qb] * alpha;
        }
#pragma unroll
        for (int kk = 0; kk < 2; ++kk) {
            const bf16x8 y0 = pack8(st[2 * kk][0][0], st[2 * kk][0][1], st[2 * kk][0][2], st[2 * kk][0][3], st[2 * kk + 1][0][0], st[2 * kk + 1][0][1], st[2 * kk + 1][0][2], st[2 * kk + 1][0][3]);
            const bf16x8 y1 = pack8(st[2 * kk][1][0], st[2 * kk][1][1], st[2 * kk][1][2], st[2 * kk][1][3], st[2 * kk + 1][1][0], st[2 * kk + 1][1][1], st[2 * kk + 1][1][2], st[2 * kk + 1][1][3]);
            const int rowA = 32 * kk + 4 * q4 + (fr >> 2), rowB = rowA + 16;
#pragma unroll
            for (int dt = 0; dt < 4; ++dt) { const int cb = (16 * dt + 4 * (lane & 3)) * 2;
                const bf16x8 xf = cat8(trrd(Vb + rowA * 160 + cb), trrd(Vb + rowB * 160 + cb));
                o[dt][0] = mfma16(xf, y0, o[dt][0]); o[dt][1] = mfma16(xf, y1, o[dt][1]); }
        }
    }
    const float il0 = 1.0f / lrun[0], il1 = 1.0f / lrun[1];
    __syncthreads();
#pragma unroll
    for (int dt = 0; dt < 4; ++dt) {
        *(LAS f32x4*)(Ls + (32 * qh + fr) * 1040 + (h * 64 + 16 * dt + 4 * q4) * 4) = o[dt][0] * il0;
        *(LAS f32x4*)(Ls + (32 * qh + 16 + fr) * 1040 + (h * 64 + 16 * dt + 4 * q4) * 4) = o[dt][1] * il1; }
    __syncthreads();
    { const f32x4 gn = *(const f32x4*)(A.in[18] + L * 256 + 4 * lane);
#pragma unroll 2
      for (int i = 0; i < 8; ++i) { const int r = 8 * w + i;
        f32x4 v = *(const LAS f32x4*)(Ls + r * 1040 + lane * 16);
        const float ss = wave_sum((v.x * v.x + v.y * v.y) + (v.z * v.z + v.w * v.w)) * (1.0f / 256.0f);
        v = v * (1.0f / sqrtf(ss + 1e-6f)) * gn;
        v2u ov; ov.x = pk2(v.x, v.y); ov.y = pk2(v.z, v.w);
        *(v2u*)(Y + (m0 + r) * D + 768 + 4 * lane) = ov; } }
    __syncthreads();
}

__device__ __forceinline__ void ssd_prepass(Frame& F, const Args& A, int L, size_t m0, LAS float* dtl, LAS float* acs, LAS float* tmp) {
    const float* DTRAW = (const float*)(A.ws + WS_DTRAW);
    { const int l = F.tid >> 3, h = F.tid & 7;
      const float x = DTRAW[(m0 + l) * 8 + h] + A.in[8][L * 8 + h];
      const float dt = x > 20.f ? x : log1pf(expf(x));
      dtl[l * 8 + h] = dt; tmp[l * 8 + h] = -dt * expf(A.in[9][L * 8 + h]); }
    __syncthreads();
    if (F.tid < 8) { float run = 0.f;
#pragma unroll 1
      for (int l = 0; l < 64; ++l) { run += tmp[l * 8 + F.tid]; acs[l * 8 + F.tid] = run; } }
    __syncthreads();
}
__device__ __forceinline__ void ssd1_unit(Frame& F, const Args& A, int L, int bc) {
    LAS unsigned char* Ls = F.lds; const int lane = F.lane, w = F.wave, fr = lane & 15, q4 = lane >> 4;
    const int b = bc >> 7, c = bc & 127; const size_t m0 = (size_t)b * SEQ + (size_t)c * 64;
    const bf16* P = (const bf16*)(A.ws + WS_PROJ); bf16* XBCC = (bf16*)(A.ws + WS_XBCC); float* ST = (float*)(A.ws + WS_ST); float* AEND = (float*)(A.ws + WS_AEND);
    LAS unsigned char* XI = Ls; LAS unsigned char* BI = Ls + 67584;
    LAS float* dtl = (LAS float*)(Ls + 102400); LAS float* acs = (LAS float*)(Ls + 104448); LAS float* tmp = (LAS float*)(Ls + 106496);
    ssd_prepass(F, A, L, m0, dtl, acs, tmp);
    if (F.tid < 8) AEND[(size_t)bc * 8 + F.tid] = acs[63 * 8 + F.tid];
    { const int cg = F.tid & 127, tg = F.tid >> 7, ch0 = 8 * cg;
      float wk[4][8], bs[8];
#pragma unroll
      for (int k = 0; k < 4; ++k) { const f32x4 a = *(const f32x4*)(A.in[6] + (size_t)(L * 4 + k) * 1024 + ch0), bq = *(const f32x4*)(A.in[6] + (size_t)(L * 4 + k) * 1024 + ch0 + 4);
          wk[k][0] = a.x; wk[k][1] = a.y; wk[k][2] = a.z; wk[k][3] = a.w; wk[k][4] = bq.x; wk[k][5] = bq.y; wk[k][6] = bq.z; wk[k][7] = bq.w; }
      { const f32x4 a = *(const f32x4*)(A.in[7] + (size_t)L * 1024 + ch0), bq = *(const f32x4*)(A.in[7] + (size_t)L * 1024 + ch0 + 4);
          bs[0] = a.x; bs[1] = a.y; bs[2] = a.z; bs[3] = a.w; bs[4] = bq.x; bs[5] = bq.y; bs[6] = bq.z; bs[7] = bq.w; }
      const int hh = cg >> 3;
#pragma unroll 1
      for (int hf = 0; hf < 2; ++hf) {
      v4u raw[11];
#pragma unroll
      for (int tt = 0; tt < 11; ++tt) { const int lp = 16 * tg + 8 * hf - 3 + tt; const bool ok = (c * 64 + lp) >= 0;
          raw[tt] = ok ? *(const v4u*)(P + (size_t)((long)m0 + lp) * PN + PC_XBC + ch0) : (v4u){0u, 0u, 0u, 0u}; }
#pragma unroll
      for (int t = 0; t < 8; ++t) { const int l = 16 * tg + 8 * hf + t;
          float y[8];
#pragma unroll
          for (int e = 0; e < 8; ++e) y[e] = bs[e];
#pragma unroll
          for (int k = 0; k < 4; ++k) { const v4u rw = raw[t + k];
              y[0] += wk[k][0] * bflo(rw.x); y[1] += wk[k][1] * bfhi(rw.x); y[2] += wk[k][2] * bflo(rw.y); y[3] += wk[k][3] * bfhi(rw.y);
              y[4] += wk[k][4] * bflo(rw.z); y[5] += wk[k][5] * bfhi(rw.z); y[6] += wk[k][6] * bflo(rw.w); y[7] += wk[k][7] * bfhi(rw.w); }
#pragma unroll
          for (int e = 0; e < 8; ++e) y[e] = silu(y[e]);
          v4u o; o.x = pk2(y[0], y[1]); o.y = pk2(y[2], y[3]); o.z = pk2(y[4], y[5]); o.w = pk2(y[6], y[7]);
          *(v4u*)(XBCC + (m0 + l) * 1024 + ch0) = o;
          if (cg < 64) { const float sc = dtl[l * 8 + hh] * __expf(acs[63 * 8 + hh] - acs[l * 8 + hh]);
              v4u os; os.x = pk2(y[0] * sc, y[1] * sc); os.y = pk2(y[2] * sc, y[3] * sc); os.z = pk2(y[4] * sc, y[5] * sc); os.w = pk2(y[6] * sc, y[7] * sc);
              *(LAS v4u*)(XI + l * 1056 + ch0 * 2) = os; }
          else if (cg < 96) *(LAS v4u*)(BI + l * 544 + (ch0 - 512) * 2) = o;
      } } }
    __syncthreads();
    { const int h = w, gi = h >> 2;
      float* STh = ST + ((size_t)bc * 8 + h) * 8192;
#pragma unroll 1
      for (int nh = 0; nh < 2; ++nh) {
      f32x4 acc[4][4];
#pragma unroll
      for (int nt = 0; nt < 4; ++nt)
#pragma unroll
          for (int pt = 0; pt < 4; ++pt) acc[nt][pt] = (f32x4){0.f, 0.f, 0.f, 0.f};
#pragma unroll
      for (int ks = 0; ks < 2; ++ks) {
          const int rowA = 32 * ks + 4 * q4 + (fr >> 2), rowB = rowA + 16;
          bf16x8 yf[4];
#pragma unroll
          for (int pt = 0; pt < 4; ++pt) { const int cb = (h * 64 + 16 * pt + 4 * (lane & 3)) * 2; yf[pt] = cat8(trrd(XI + rowA * 1056 + cb), trrd(XI + rowB * 1056 + cb)); }
#pragma unroll
          for (int nt = 0; nt < 4; ++nt) { const int cb = (gi * 128 + 64 * nh + 16 * nt + 4 * (lane & 3)) * 2;
              const bf16x8 xf = cat8(trrd(BI + rowA * 544 + cb), trrd(BI + rowB * 544 + cb));
#pragma unroll
              for (int pt = 0; pt < 4; ++pt) acc[nt][pt] = mfma16(xf, yf[pt], acc[nt][pt]); }
      }
#pragma unroll
      for (int nt = 0; nt < 4; ++nt)
#pragma unroll
          for (int pt = 0; pt < 4; ++pt) *(f32x4*)(STh + (16 * pt + fr) * 128 + 64 * nh + 16 * nt + 4 * q4) = acc[nt][pt];
      }
    }
    __syncthreads();
}
__device__ __forceinline__ void ssd_scan(Frame& F, const Args& A) {
    float* ST = (float*)(A.ws + WS_ST); const float* AEND = (const float*)(A.ws + WS_AEND);
    for (int it = F.vcu * NTHR + F.tid; it < 32 * 4096; it += F.G * NTHR) {
        const int bh = it >> 12, b = bh >> 3, h = bh & 7, e = (it & 4095) * 2;
        float* base = ST + ((size_t)(b * NCHUNK) * 8 + h) * 8192 + e;
        f32x2 s = (f32x2){0.f, 0.f};
        for (int c0 = 0; c0 < NCHUNK; c0 += 8) {
            f32x2 v[8]; float dec[8];
#pragma unroll
            for (int i = 0; i < 8; ++i) { v[i] = *(const f32x2*)(base + (size_t)(c0 + i) * 65536); dec[i] = __expf(AEND[(size_t)(b * NCHUNK + c0 + i) * 8 + h]); }
#pragma unroll
            for (int i = 0; i < 8; ++i) { *(f32x2*)(base + (size_t)(c0 + i) * 65536) = s; s = s * dec[i] + v[i]; }
        }
    }
}
__device__ __forceinline__ void ssd3_unit(Frame& F, const Args& A, int L, int bc) {
    LAS unsigned char* Ls = F.lds; const int lane = F.lane, w = F.wave, fr = lane & 15, q4 = lane >> 4;
    const int b = bc >> 7, c = bc & 127; const size_t m0 = (size_t)b * SEQ + (size_t)c * 64;
    const bf16* P = (const bf16*)(A.ws + WS_PROJ); const bf16* XBCC = (const bf16*)(A.ws + WS_XBCC); const float* ST = (const float*)(A.ws + WS_ST); bf16* Y = (bf16*)(A.ws + WS_Y);
    LAS unsigned char* XI = Ls; LAS unsigned char* BI = Ls + 67584; LAS unsigned char* CI = Ls + 102400;
    LAS float* dtl = (LAS float*)(Ls + 137216); LAS float* acs = (LAS float*)(Ls + 139264); LAS float* tmp = (LAS float*)(Ls + 141312);
    ssd_prepass(F, A, L, m0, dtl, acs, tmp);
#pragma unroll 4
    for (int i = 0; i < 16; ++i) { const int pc = F.tid + NTHR * i, row = pc >> 7, cg = pc & 127;
        const v4u v = *(const v4u*)(XBCC + (m0 + row) * 1024 + 8 * cg);
        LAS unsigned char* dst = cg < 64 ? XI + row * 1056 + cg * 16 : (cg < 96 ? BI + row * 544 + (cg - 64) * 16 : CI + row * 544 + (cg - 96) * 16);
        *(LAS v4u*)dst = v; }
    __syncthreads();
    const int h = w, gi = h >> 2;
    f32x4 acc[4][4];
#pragma unroll
    for (int lt = 0; lt < 4; ++lt)
#pragma unroll
        for (int pt = 0; pt < 4; ++pt) acc[lt][pt] = (f32x4){0.f, 0.f, 0.f, 0.f};
    { const float* Sh = ST + ((size_t)bc * 8 + h) * 8192;
#pragma unroll 1
      for (int kn = 0; kn < 4; ++kn) {
          bf16x8 yf[4];
#pragma unroll
          for (int pt = 0; pt < 4; ++pt) { const f32x4 s0 = *(const f32x4*)(Sh + (16 * pt + fr) * 128 + 32 * kn + 8 * q4), s1 = *(const f32x4*)(Sh + (16 * pt + fr) * 128 + 32 * kn + 8 * q4 + 4);
              yf[pt] = pack8(s0.x, s0.y, s0.z, s0.w, s1.x, s1.y, s1.z, s1.w); }
#pragma unroll
          for (int lt = 0; lt < 4; ++lt) { const bf16x8 xf = *(const LAS bf16x8*)(CI + (16 * lt + fr) * 544 + (gi * 128 + 32 * kn + 8 * q4) * 2);
#pragma unroll
              for (int pt = 0; pt < 4; ++pt) acc[lt][pt] = mfma16(xf, yf[pt], acc[lt][pt]); }
      }
#pragma unroll
      for (int lt = 0; lt < 4; ++lt)
#pragma unroll
          for (int r = 0; r < 4; ++r) { const float sc = __expf(acs[(16 * lt + 4 * q4 + r) * 8 + h]);
#pragma unroll
              for (int pt = 0; pt < 4; ++pt) acc[lt][pt][r] *= sc; }
    }
#pragma unroll
    for (int lt = 0; lt < 4; ++lt) {
#pragma unroll
        for (int ksp = 0; ksp <= (lt >> 1); ++ksp) {
            __builtin_amdgcn_sched_barrier(0);
            const bool hasb = (2 * ksp + 1) <= lt;
            f32x4 d0a = (f32x4){0.f, 0.f, 0.f, 0.f}, d0b = (f32x4){0.f, 0.f, 0.f, 0.f};
#pragma unroll
            for (int kn = 0; kn < 4; ++kn) { const int cb = (gi * 128 + 32 * kn + 8 * q4) * 2;
                const bf16x8 cf = *(const LAS bf16x8*)(CI + (16 * lt + fr) * 544 + cb);
                const bf16x8 ba = *(const LAS bf16x8*)(BI + (32 * ksp + fr) * 544 + cb); d0a = mfma16(ba, cf, d0a);
                if (hasb) { const bf16x8 bb = *(const LAS bf16x8*)(BI + (32 * ksp + 16 + fr) * 544 + cb); d0b = mfma16(bb, cf, d0b); } }
            const int l = 16 * lt + fr; const float al = acs[l * 8 + h];
            float ga[4], gb[4];
#pragma unroll
            for (int r = 0; r < 4; ++r) { const int sa = 32 * ksp + 4 * q4 + r, sb = sa + 16;
                ga[r] = sa <= l ? d0a[r] * __expf(al - acs[sa * 8 + h]) * dtl[sa * 8 + h] : 0.f;
                gb[r] = (hasb && sb <= l) ? d0b[r] * __expf(al - acs[sb * 8 + h]) * dtl[sb * 8 + h] : 0.f; }
            const bf16x8 xf = pack8(ga[0], ga[1], ga[2], ga[3], gb[0], gb[1], gb[2], gb[3]);
            const int rowA = 32 * ksp + 4 * q4 + (fr >> 2), rowB = rowA + 16;
#pragma unroll
            for (int pt = 0; pt < 4; ++pt) { const int cb = (h * 64 + 16 * pt + 4 * (lane & 3)) * 2;
                acc[lt][pt] = mfma16(xf, cat8(trrd(XI + rowA * 1056 + cb), trrd(XI + rowB * 1056 + cb)), acc[lt][pt]); }
        }
    }
    { const float dsk = A.in[10][L * 8 + h];
#pragma unroll
      for (int lt = 0; lt < 4; ++lt)
#pragma unroll
          for (int pt = 0; pt < 4; ++pt)
#pragma unroll
              for (int r = 0; r < 4; ++r) { const unsigned short xv = *(const LAS unsigned short*)(XI + (16 * lt + 4 * q4 + r) * 1056 + (h * 64 + 16 * pt + fr) * 2);
                  acc[lt][pt][r] += dsk * __uint_as_float((unsigned)xv << 16); } }
    __syncthreads();
#pragma unroll
    for (int lt = 0; lt < 4; ++lt)
#pragma unroll
        for (int pt = 0; pt < 4; ++pt)
#pragma unroll
            for (int r = 0; r < 4; ++r) *(LAS float*)(Ls + (16 * lt + 4 * q4 + r) * 2112 + (h * 64 + 16 * pt + fr) * 4) = acc[lt][pt][r];
    __syncthreads();
    { const f32x4 g0 = *(const f32x4*)(A.in[11] + L * 512 + 8 * lane), g1 = *(const f32x4*)(A.in[11] + L * 512 + 8 * lane + 4);
#pragma unroll 2
      for (int i = 0; i < 8; ++i) { const int r = 8 * w + i;
        f32x4 v0 = *(const LAS f32x4*)(Ls + r * 2112 + lane * 32), v1 = *(const LAS f32x4*)(Ls + r * 2112 + lane * 32 + 16);
        const v4u z = *(const v4u*)(P + (m0 + r) * PN + PC_Z + 8 * lane);
        v0 = v0 * (f32x4){silu(bflo(z.x)), silu(bfhi(z.x)), silu(bflo(z.y)), silu(bfhi(z.y))};
        v1 = v1 * (f32x4){silu(bflo(z.z)), silu(bfhi(z.z)), silu(bflo(z.w)), silu(bfhi(z.w))};
        const float ss = wave_sum((v0.x * v0.x + v0.y * v0.y) + (v0.z * v0.z + v0.w * v0.w) + (v1.x * v1.x + v1.y * v1.y) + (v1.z * v1.z + v1.w * v1.w)) * (1.0f / 512.0f);
        const float sc = 1.0f / sqrtf(ss + 1e-6f);
        v0 = v0 * sc * g0; v1 = v1 * sc * g1;
        v4u ov; ov.x = pk2(v0.x, v0.y); ov.y = pk2(v0.z, v0.w); ov.z = pk2(v1.x, v1.y); ov.w = pk2(v1.z, v1.w);
        *(v4u*)(Y + (m0 + r) * D + 8 * lane) = ov; } }
    __syncthreads();
}

constexpr int NPHASE = 31;
__global__ void __launch_bounds__(NTHR, 2) fwd_kernel(Args args) {
    extern __shared__ __attribute__((aligned(16))) unsigned char lds[];
    Frame F;
    F.lds = (LAS unsigned char*)lds;
    F.tid = threadIdx.x; F.lane = F.tid & 63; F.wave = __builtin_amdgcn_readfirstlane(F.tid >> 6);
    F.G = gridDim.x; { const int bx = blockIdx.x; F.vcu = (F.G % 8 == 0) ? (bx % 8) * (F.G / 8) + bx / 8 : bx; }
    gu32* ctl = (gu32*)(args.ws + WS_CTL);
    for (int u = F.tid; u < (LDS_BYTES - LDSCTL_OFF) / 4; u += NTHR) ((LAS unsigned*)(F.lds + LDSCTL_OFF))[u] = 0u;
    __syncthreads();
    XcdBarrier bar; bar.bar = (unsigned*)(ctl + CW_BAR); bar.x = 0; bar.st = nullptr;
    const int lo = args.ph_lo, hi = args.ph_hi;
    if (hi - lo > 1) bar = xcd_barrier_post((unsigned*)(ctl + CW_BAR), (volatile LAS unsigned*)(F.lds + CTL_MISC) + 8);
#define IN(k) ((lo <= (k) && (k) < hi) && fresh(F))
#define SEAM(k) do { if ((k) + 1 < hi) xcd_barrier(bar); } while (0)
    unsigned char* ws = args.ws;
    bf16* A1 = (bf16*)(ws + WS_A1); bf16* PROJ = (bf16*)(ws + WS_PROJ); bf16* Yb = (bf16*)(ws + WS_Y); bf16* MIXED = (bf16*)(ws + WS_MIXED);
    const int bid = (int)blockIdx.x;

    if (IN(0)) {
        cvt_small_weights(F, args);
        __syncthreads();
        RowArgs R{args.in[0], nullptr, 0, nullptr, nullptr, args.in[1], A1, 1, args.in[5] + 1536, DIN};
        row_phase(F, args, R);
        SEAM(0);
    }
    for (int L = 0; L < 2; ++L) {
        const int pb = 1 + 16 * L;
        if (IN(pb + 0)) {
            pg8::Gemm g{A1, (const bf16*)(ws + WS_WIN) + (size_t)L * PN * D, M, PN, D}; pg8::StaticOrder S; S.init(M, PN, F.G, bid);
            pg8::EpiStore E{PROJ, PN};
            pg8::gemm_phase<pg8::EpiStore, pg8::StaticOrder, true, true>(F.lds, g, S, E);
            SEAM(pb + 0);
        }
        if (IN(pb + 1)) {
            #ifndef NO_SSD1
            for (int u = F.vcu; u < NBATCH * NCHUNK; u += F.G) ssd1_unit(F, args, L, u);
#endif
            #ifndef NO_ATTN
            for (int u = F.vcu; u < NBATCH * NCHUNK; u += F.G) attn_unit(F, args, L, u);
#endif
            #ifndef NO_GMLP
            for (int u = F.vcu; u < M / 128; u += F.G) gmlp_unit(F, args, L, u);
#endif
            SEAM(pb + 1);
        }
        #ifndef NO_SCAN
        if (IN(pb + 2)) { ssd_scan(F, args); SEAM(pb + 2); }
#endif
        #ifndef NO_SSD3
        if (IN(pb + 3)) { for (int u = F.vcu; u < NBATCH * NCHUNK; u += F.G) ssd3_unit(F, args, L, u); SEAM(pb + 3); }
#endif
        if (IN(pb + 4)) {
            pg8::Gemm g{Yb, (const bf16*)(ws + WS_WOUT) + (size_t)L * D * D, M, D, D}; pg8::StaticOrder S; S.init(M, D, F.G, bid);
            pg8::EpiStore E{MIXED, D};
            pg8::gemm_phase<pg8::EpiStore, pg8::StaticOrder, true, true>(F.lds, g, S, E);
            SEAM(pb + 4);
        }
        if (IN(pb + 5)) {
            RowArgs R{L == 0 ? args.in[0] : args.out, args.out, 1, MIXED, args.in[2] + L * D, args.in[3] + L * D, A1, L == 1 ? 2 : 0, args.in[23], 8};
            row_phase(F, args, R);
            if (L == 1) cvt_moe_weights(F, args);
            SEAM(pb + 5);
        }
        if (L == 0) {
            if (IN(pb + 6)) {
                pg8::Gemm g{A1, (const bf16*)(ws + WS_WGU), M, 2 * DFF, D}; pg8::StaticOrder S; S.init(M, 2 * DFF, F.G, bid);
                pg8::EpiSwiglu E{(bf16*)(ws + WS_H1), DFF};
                pg8::gemm_phase<pg8::EpiSwiglu, pg8::StaticOrder, true, true>(F.lds, g, S, E);
                SEAM(pb + 6);
            }
            if (IN(pb + 7)) {
                pg8::Gemm g{(const bf16*)(ws + WS_H1), (const bf16*)(ws + WS_WD), M, D, DFF}; pg8::StaticOrder S; S.init(M, D, F.G, bid);
                pg8::EpiStore E{(bf16*)(ws + WS_FOUT), D};
                pg8::gemm_phase<pg8::EpiStore, pg8::StaticOrder, true, true>(F.lds, g, S, E);
                SEAM(pb + 7);
            }
            if (IN(pb + 8)) {
                RowArgs R{args.out, args.out, 1, (const bf16*)(ws + WS_FOUT), args.in[4], args.in[1] + D, A1, 1, args.in[5] + (size_t)D * DIN + 1536, DIN};
                row_phase(F, args, R);
                SEAM(pb + 8);
            }
        } else {
            if (IN(pb + 6)) { moe_tables(F, args); moe_gather(F, args); SEAM(pb + 6); }
            for (int k = 0; k < 3; ++k) {
                if (IN(pb + 7 + 2 * k)) {
                    moe_tables(F, args);
                    const int nT = *(LAS int*)(F.lds + CTL_CNT + 32 * 4); int nk = nT - MOE_CH * k; nk = nk < 0 ? 0 : (nk > MOE_CH ? MOE_CH : nk);
                    pg8::Gemm g{(const bf16*)(ws + WS_XS), (const bf16*)(ws + WS_MWGU), 0, 0, D};
                    pg8::MoeOrder<false, true> S{MOE_CH * k, nk, 28, F.G, bid, (const LAS int*)(F.lds + CTL_TE)};
                    pg8::EpiSwiglu E{(bf16*)(ws + WS_HM), DFFE};
                    pg8::gemm_phase<pg8::EpiSwiglu, pg8::MoeOrder<false, true>, true, true>(F.lds, g, S, E);
                    SEAM(pb + 7 + 2 * k);
                }
                if (IN(pb + 8 + 2 * k)) {
                    moe_tables(F, args);
                    const int nT = *(LAS int*)(F.lds + CTL_CNT + 32 * 4); int nk = nT - MOE_CH * k; nk = nk < 0 ? 0 : (nk > MOE_CH ? MOE_CH : nk);
                    pg8::Gemm g{(const bf16*)(ws + WS_HM), (const bf16*)(ws + WS_MWD), 0, 0, DFFE};
                    pg8::MoeOrder<true, false> S{MOE_CH * k, nk, 4, F.G, bid, (const LAS int*)(F.lds + CTL_TE)};
                    pg8::EpiStore E{(bf16*)(ws + WS_XS), D};
                    pg8::gemm_phase<pg8::EpiStore, pg8::MoeOrder<true, false>, true, true>(F.lds, g, S, E);
                    SEAM(pb + 8 + 2 * k);
                }
            }
            if (IN(pb + 13)) {
                RowArgs R{args.out, args.out, 2, (const bf16*)(ws + WS_XS), args.in[4] + D, nullptr, nullptr, 0, nullptr, 0};
                row_phase(F, args, R);
            }
        }
    }
#undef IN
#undef SEAM
}

extern "C" void kernel_launch(void* const* d_in, const int* in_sizes, int n_in, void* d_out, int out_size, void* d_ws, size_t ws_size, hipStream_t stream) {
    static int grid = 0;
    if (grid == 0) {
        if (n_in != NIN || out_size != M * D || ws_size < WS_END) { fprintf(stderr, "kernel_launch: unexpected shapes (n_in %d, out %d, ws %zu)\n", n_in, out_size, ws_size); grid = -1; return; }
        int dev = 0, cus = 0;
        if (hipGetDevice(&dev) != hipSuccess || hipDeviceGetAttribute(&cus, hipDeviceAttributeMultiprocessorCount, dev) != hipSuccess) { grid = -1; return; }
        if (hipFuncSetAttribute((const void*)fwd_kernel, hipFuncAttributeMaxDynamicSharedMemorySize, LDS_BYTES) != hipSuccess) { fprintf(stderr, "kernel_launch: hipFuncSetAttribute failed\n"); grid = -1; return; }
        int per_cu = 0;
        if (hipOccupancyMaxActiveBlocksPerMultiprocessor(&per_cu, (const void*)fwd_kernel, NTHR, LDS_BYTES) != hipSuccess || per_cu < 1) fprintf(stderr, "kernel_launch: occupancy query says %d\n", per_cu);
        (void)hipGetLastError();
        grid = cus > 256 ? 256 : cus;
    }
    if (grid < 0) return;
    (void)hipMemsetAsync((char*)d_ws + WS_CTL, 0, CTL_ZERO_BYTES, stream);
    Args a{};
    for (int i = 0; i < NIN; ++i) a.in[i] = (const float*)d_in[i];
    a.out = (float*)d_out; a.ws = (unsigned char*)d_ws;
#if MK_SINGLE
    a.ph_lo = 0; a.ph_hi = NPHASE;
    hipLaunchKernelGGL(fwd_kernel, dim3(grid), dim3(NTHR), LDS_BYTES, stream, a);
#else
    static const int phases[] = {0, 1, 2, 3, 4, 5, 6, 7, 8, 9, 17, 18, 19, 20, 21, 22, 23, 24, 25, 26, 27, 28, 29, 30};
    for (unsigned i = 0; i < sizeof(phases) / sizeof(phases[0]); ++i) { a.ph_lo = phases[i]; a.ph_hi = phases[i] + 1; hipLaunchKernelGGL(fwd_kernel, dim3(grid), dim3(NTHR), LDS_BYTES, stream, a); }
#endif
}
```

```cpp
#include <hip/hip_runtime.h>
#include <cstdio>
#include <cstdint>

#ifndef MK_SINGLE
#define MK_SINGLE 1
#endif

namespace pg8 {
#define PG8_LAS __attribute__((address_space(3)))
typedef unsigned short bf16_t;
typedef short bf16x8 __attribute__((ext_vector_type(8)));
typedef float f32x4 __attribute__((ext_vector_type(4)));
typedef unsigned u32x4 __attribute__((ext_vector_type(4)));
constexpr int BM = 256, BK = 64, HALF = 128, HTB = HALF * BK * 2  , STAGE_BYTES = 8 * HTB, NXCD = 8, WGM = 8;

__host__ __device__ __forceinline__ int lds_byte(int r, int c) { const int st = (r >> 4) * 2 + (c >> 5), rr = r & 15, cc = c & 31, ob = rr * 64 + cc * 2; return st * 1024 + (ob ^ (((ob >> 9) & 1) << 5)); }
__host__ __device__ __forceinline__ void stage_rc(int b, int& R, int& C) { const int st = b / 1024, sb = b % 1024, swz = sb ^ (((sb >> 9) & 1) << 5); R = (st >> 1) * 16 + swz / 64; C = (st & 1) * 32 + (swz % 64) / 2; }
__host__ __device__ __forceinline__ int perm32(int rho) { const int n = rho >> 4, i = rho & 15; return 8 * (i >> 2) + 4 * n + (i & 3); }

struct Unit { int pm, pn, om, on; };
struct Gemm { const bf16_t* A; const bf16_t* Bt; int M, N, K; };

__host__ __device__ __forceinline__ bool tile_order(int i, int G, int c, int nM, int nN, int& pm, int& pn) {
    const int nwg = nM * nN; const long L = (long)i * G + c; if (L >= nwg) return false;
    int wgid = (int)L; { const int q = nwg / NXCD, r = nwg % NXCD, xcd = wgid % NXCD, off = wgid / NXCD; wgid = (xcd < r ? xcd * (q + 1) : r * (q + 1) + (xcd - r) * q) + off; }
    const int nig = WGM * nN, gid = wgid / nig, fm = gid * WGM, gsz = (nM - fm) < WGM ? (nM - fm) : WGM;
    pm = fm + ((wgid % nig) % gsz); pn = (wgid % nig) / gsz; return true;
}
struct StaticOrder {
    int nM, nN, G, c;
    __host__ __device__ void init(int M, int N, int G_, int c_) { nM = M / BM; nN = N / BM; G = G_; c = c_; }
    __host__ __device__ bool next(int i, Unit& u) const { int pm, pn; if (!tile_order(i, G, c, nM, nN, pm, pn)) return false; u.pm = pm; u.pn = pn; u.om = pm; u.on = pn; return true; }
    __device__ __forceinline__ void a_ready(const Unit&) const {}
    __device__ __forceinline__ void done(const Unit&) const {}
};
template <bool A_LOCAL, bool O_LOCAL>
struct MoeOrder {
    int t0, nT, nN, G, c; const PG8_LAS int* te;
    __device__ __forceinline__ bool next(int i, Unit& u) const { int pm, pn; if (!tile_order(i, G, c, nT, nN, pm, pn)) return false;
        const int e = __builtin_amdgcn_readfirstlane(te[t0 + pm]);
        u.pm = A_LOCAL ? pm : t0 + pm; u.pn = e * nN + pn; u.om = O_LOCAL ? pm : t0 + pm; u.on = pn; return true; }
    __device__ __forceinline__ void a_ready(const Unit&) const {}
    __device__ __forceinline__ void done(const Unit&) const {}
};

__device__ __forceinline__ unsigned cvt_pk_bf16(float lo, float hi) { unsigned r; asm volatile("v_cvt_pk_bf16_f32 %0, %1, %2" : "=v"(r) : "v"(lo), "v"(hi)); return r; }

struct EpiStore {
    static constexpr bool PERM = true, AFTER_DRAIN = false;
    bf16_t* O; int ldc;
    __device__ __forceinline__ void operator()(const f32x4 (&acc)[2][2][4][2], const Unit& u, int wr, int wc, int fr, int fq) const {
        const int row0 = u.om * BM + wr * 64 + fr; const int col0 = u.on * BM + wc * 32 + 8 * fq;
#pragma unroll
        for (int ai = 0; ai < 2; ++ai)
#pragma unroll
            for (int m = 0; m < 4; ++m) { bf16_t* rowp = O + (size_t)(row0 + ai * HALF + m * 16) * ldc + col0;
#pragma unroll
                for (int bj = 0; bj < 2; ++bj) { const f32x4 v0 = acc[ai][bj][m][0], v1 = acc[ai][bj][m][1];
                    u32x4 w; w.x = cvt_pk_bf16(v0[0], v0[1]); w.y = cvt_pk_bf16(v0[2], v0[3]); w.z = cvt_pk_bf16(v1[0], v1[1]); w.w = cvt_pk_bf16(v1[2], v1[3]);
                    *(u32x4*)(rowp + bj * HALF) = w; } }
    }
};
__device__ __forceinline__ float silu_f(float x) { return x * __builtin_amdgcn_rcpf(1.0f + __expf(-x)); }
struct EpiSwiglu {
    static constexpr bool PERM = true, AFTER_DRAIN = false;
    bf16_t* O; int ldc;
    __device__ __forceinline__ void operator()(const f32x4 (&acc)[2][2][4][2], const Unit& u, int wr, int wc, int fr, int fq) const {
        const int row0 = u.om * BM + wr * 64 + fr; const int col0 = u.on * HALF + wc * 32 + 8 * fq;
#pragma unroll
        for (int ai = 0; ai < 2; ++ai)
#pragma unroll
            for (int m = 0; m < 4; ++m) { bf16_t* rowp = O + (size_t)(row0 + ai * HALF + m * 16) * ldc + col0;
                const f32x4 g0 = acc[ai][0][m][0], g1 = acc[ai][0][m][1], u0 = acc[ai][1][m][0], u1 = acc[ai][1][m][1];
                u32x4 w;
                w.x = cvt_pk_bf16(silu_f(g0[0]) * u0[0], silu_f(g0[1]) * u0[1]); w.y = cvt_pk_bf16(silu_f(g0[2]) * u0[2], silu_f(g0[3]) * u0[3]);
                w.z = cvt_pk_bf16(silu_f(g1[0]) * u1[0], silu_f(g1[1]) * u1[1]); w.w = cvt_pk_bf16(silu_f(g1[2]) * u1[2], silu_f(g1[3]) * u1[3]);
                *(u32x4*)rowp = w; }
    }
};

template <class Epi, class Sched, bool ALIGN_EPI = false, bool SP2 = false>
__device__ __forceinline__ void gemm_phase(PG8_LAS unsigned char* lds, const Gemm g, const Sched& S, const Epi& E) {
    int tid_ = threadIdx.x; asm volatile("" : "+v"(tid_));
    const int tid = tid_, wid = __builtin_amdgcn_readfirstlane(tid >> 6), lane = tid & 63, wr = wid >> 2, wc = wid & 3, fr = lane & 15, fq = lane >> 4;
    const int K = g.K, nt = K / BK;
    unsigned voffA[2], voffB[2];
#pragma unroll
    for (int i = 0; i < 2; ++i) { int R, C; stage_rc(tid * 16 + i * 8192, R, C); const int Rb = Epi::PERM ? ((R & ~31) + perm32(R & 31)) : R;
        voffA[i] = (unsigned)(R * K + C) * 2u; voffB[i] = (unsigned)(Rb * K + C) * 2u; }
    const size_t kstep = (size_t)(BK * 2);
    const size_t hstep = (size_t)HALF * K * 2;
    const size_t tstep = 2 * hstep;
    const unsigned ldsw = (unsigned)wid * 1024u;
    const int aoff = lds_byte(wr * 64 + fr, fq * 8), boff = lds_byte(wc * 32 + fr, fq * 8);
#define PG8_SA(b, h) (((b) * 2 + (h)) * HTB)
#define PG8_SB(b, h) ((4 + (b) * 2 + (h)) * HTB)
#define PG8_STAGE(bufoff, gbase, voff) do { _Pragma("unroll") for (int _i = 0; _i < 2; ++_i) \
        __builtin_amdgcn_global_load_lds((const unsigned*)((const char*)(gbase) + (voff)[_i]), (PG8_LAS unsigned*)(lds + (bufoff) + ldsw + _i * 8192), 16, 0, 0); } while (0)
#define PG8_LDA(dst, b, h) do { _Pragma("unroll") for (int m = 0; m < 4; ++m) _Pragma("unroll") for (int k = 0; k < 2; ++k) dst[m][k] = *(const PG8_LAS bf16x8*)(lds + PG8_SA(b, h) + aoff + m * 2048 + k * 1024); } while (0)
#define PG8_LDB(dst, b, h) do { _Pragma("unroll") for (int n = 0; n < 2; ++n) _Pragma("unroll") for (int k = 0; k < 2; ++k) dst[n][k] = *(const PG8_LAS bf16x8*)(lds + PG8_SB(b, h) + boff + n * 2048 + k * 1024); } while (0)
#define PG8_MMA(ai, bj, At, Bt) do { __builtin_amdgcn_s_setprio(1); _Pragma("unroll") for (int m = 0; m < 4; ++m) _Pragma("unroll") for (int n = 0; n < 2; ++n) _Pragma("unroll") for (int k = 0; k < 2; ++k) \
        acc[ai][bj][m][n] = __builtin_amdgcn_mfma_f32_16x16x32_bf16(Bt[n][k], At[m][k], acc[ai][bj][m][n], 0, 0, 0); __builtin_amdgcn_s_setprio(0); } while (0)
#define PG8_WAIT_V(n) asm volatile("s_waitcnt vmcnt(" #n ")" ::: "memory")
#define PG8_WAIT_L(n) asm volatile("s_waitcnt lgkmcnt(" #n ")" ::: "memory")
#define PG8_BAR __builtin_amdgcn_s_barrier()
#define PG8_SCHED __builtin_amdgcn_sched_barrier(0)
    Unit cur, nxt; int ui = 0;
    if (!S.next(0, cur)) return;
    f32x4 acc[2][2][4][2];
#pragma unroll
    for (int a = 0; a < 2; ++a)
#pragma unroll
        for (int b = 0; b < 2; ++b)
#pragma unroll
            for (int m = 0; m < 4; ++m)
#pragma unroll
                for (int n = 0; n < 2; ++n) acc[a][b][m][n] = (f32x4){0.f, 0.f, 0.f, 0.f};
    bf16x8 At[4][2], B0[2][2], B1[2][2];
    const char* cA = (const char*)g.A + (size_t)cur.pm * tstep; const char* cB = (const char*)g.Bt + (size_t)cur.pn * tstep;
    S.a_ready(cur);
    if constexpr (SP2) {
        PG8_STAGE(PG8_SB(0, 0), cB, voffB); PG8_STAGE(PG8_SB(0, 1), cB + hstep, voffB); PG8_STAGE(PG8_SA(0, 0), cA, voffA); PG8_STAGE(PG8_SA(0, 1), cA + hstep, voffA);
        if (wr == 1) PG8_BAR;
        PG8_WAIT_V(2); PG8_BAR;
        PG8_STAGE(PG8_SB(1, 0), cB + kstep, voffB); PG8_STAGE(PG8_SA(1, 0), cA + kstep, voffA); PG8_STAGE(PG8_SB(1, 1), cB + hstep + kstep, voffB);
        PG8_WAIT_V(6); PG8_BAR;
    } else {
        PG8_STAGE(PG8_SB(0, 0), cB, voffB); PG8_STAGE(PG8_SA(0, 0), cA, voffA); PG8_STAGE(PG8_SB(0, 1), cB + hstep, voffB); PG8_STAGE(PG8_SA(0, 1), cA + hstep, voffA);
        if (wr == 1) PG8_BAR;
        PG8_WAIT_V(4); PG8_BAR;
        PG8_STAGE(PG8_SB(1, 0), cB + kstep, voffB); PG8_STAGE(PG8_SA(1, 0), cA + kstep, voffA); PG8_STAGE(PG8_SB(1, 1), cB + hstep + kstep, voffB);
        PG8_WAIT_V(6); PG8_BAR;
    }
    for (;;) {
        const bool has_next = S.next(ui + 1, nxt);
        const char* nA = has_next ? (const char*)g.A + (size_t)nxt.pm * tstep : cA; const char* nB = has_next ? (const char*)g.Bt + (size_t)nxt.pn * tstep : cB;
        for (int t = 0; t < nt; t += 2) {
            const bool last = (t == nt - 2);
            const char* a1 = cA + (size_t)(t + 1) * kstep;
            const char* a2 = last ? nA : cA + (size_t)(t + 2) * kstep; const char* b2 = last ? nB : cB + (size_t)(t + 2) * kstep;
            const char* a3 = a2 + kstep; const char* b3 = b2 + kstep;
            if (last && has_next) S.a_ready(nxt);
            if constexpr (SP2) {
            PG8_LDB(B0, 0, 0); PG8_LDB(B1, 0, 1); PG8_SCHED; PG8_LDA(At, 0, 0); PG8_STAGE(PG8_SA(1, 1), a1 + hstep, voffA);
            PG8_WAIT_V(8); PG8_WAIT_L(0); PG8_BAR; PG8_MMA(0, 0, At, B0); PG8_MMA(0, 1, At, B1); PG8_BAR; PG8_SCHED;
            PG8_LDA(At, 0, 1); PG8_STAGE(PG8_SB(0, 0), b2, voffB); PG8_STAGE(PG8_SB(0, 1), b2 + hstep, voffB); PG8_STAGE(PG8_SA(0, 0), a2, voffA);
            PG8_WAIT_V(8); PG8_WAIT_L(0); PG8_BAR; PG8_MMA(1, 0, At, B0); PG8_MMA(1, 1, At, B1); PG8_BAR; PG8_SCHED;
            PG8_LDB(B0, 1, 0); PG8_LDB(B1, 1, 1); PG8_SCHED; PG8_LDA(At, 1, 0); PG8_STAGE(PG8_SA(0, 1), a2 + hstep, voffA);
            PG8_WAIT_V(8); PG8_WAIT_L(0); PG8_BAR; PG8_MMA(0, 0, At, B0); PG8_MMA(0, 1, At, B1); PG8_BAR; PG8_SCHED;
            PG8_LDA(At, 1, 1); PG8_STAGE(PG8_SB(1, 0), b3, voffB); PG8_STAGE(PG8_SB(1, 1), b3 + hstep, voffB); PG8_STAGE(PG8_SA(1, 0), a3, voffA);
            PG8_WAIT_V(8); PG8_WAIT_L(0); PG8_BAR; PG8_MMA(1, 0, At, B0); PG8_MMA(1, 1, At, B1); PG8_BAR; PG8_SCHED;
            } else {
            PG8_LDB(B0, 0, 0); PG8_SCHED; PG8_LDA(At, 0, 0); PG8_STAGE(PG8_SA(1, 1), a1 + hstep, voffA);
            PG8_WAIT_L(8); PG8_BAR; PG8_WAIT_L(0); PG8_MMA(0, 0, At, B0); PG8_BAR; PG8_SCHED;
            PG8_LDB(B1, 0, 1); PG8_STAGE(PG8_SB(0, 0), b2, voffB);
            PG8_BAR; PG8_WAIT_L(0); PG8_MMA(0, 1, At, B1); PG8_BAR;
            PG8_LDA(At, 0, 1); PG8_STAGE(PG8_SA(0, 0), a2, voffA);
            PG8_BAR; PG8_WAIT_L(0); PG8_MMA(1, 0, At, B0); PG8_BAR; PG8_SCHED;
            PG8_STAGE(PG8_SB(0, 1), b2 + hstep, voffB);
            PG8_WAIT_V(6); PG8_BAR; PG8_MMA(1, 1, At, B1); PG8_BAR;
            PG8_LDB(B0, 1, 0); PG8_SCHED; PG8_LDA(At, 1, 0); PG8_STAGE(PG8_SA(0, 1), a2 + hstep, voffA);
            PG8_WAIT_L(8); PG8_BAR; PG8_WAIT_L(0); PG8_MMA(0, 0, At, B0); PG8_BAR; PG8_SCHED;
            PG8_LDB(B1, 1, 1); PG8_STAGE(PG8_SB(1, 0), b3, voffB);
            PG8_BAR; PG8_WAIT_L(0); PG8_MMA(0, 1, At, B1); PG8_BAR;
            PG8_LDA(At, 1, 1); PG8_STAGE(PG8_SA(1, 0), a3, voffA);
            PG8_BAR; PG8_WAIT_L(0); PG8_MMA(1, 0, At, B0); PG8_BAR; PG8_SCHED;
            PG8_STAGE(PG8_SB(1, 1), b3 + hstep, voffB);
            PG8_WAIT_V(6); PG8_BAR; PG8_MMA(1, 1, At, B1); PG8_BAR;
            }
        }
        if constexpr (ALIGN_EPI) { if (wr == 0) PG8_BAR; }
        if constexpr (!Epi::AFTER_DRAIN) { E(acc, cur, wr, wc, fr, fq); S.done(cur); }
        if (!has_next) break;
#pragma unroll
        for (int a = 0; a < 2; ++a)
#pragma unroll
            for (int b = 0; b < 2; ++b)
#pragma unroll
                for (int m = 0; m < 4; ++m)
#pragma unroll
                    for (int n = 0; n < 2; ++n) acc[a][b][m][n] = (f32x4){0.f, 0.f, 0.f, 0.f};
        cur = nxt; cA = nA; cB = nB; ++ui;
        if constexpr (ALIGN_EPI) { if (wr == 1) PG8_BAR; }
    }
    PG8_WAIT_V(0);
    if constexpr (!ALIGN_EPI) { if (wr == 0) PG8_BAR; }
    PG8_BAR;
    if constexpr (Epi::AFTER_DRAIN) { E.fused(acc, cur, wr, wc, fr, fq, lds, wid, lane); S.done(cur); }
#undef PG8_SA
#undef PG8_SB
#undef PG8_STAGE
#undef PG8_LDA
#undef PG8_LDB
#undef PG8_MMA
#undef PG8_WAIT_V
#undef PG8_WAIT_L
#undef PG8_BAR
#undef PG8_SCHED
}
}

#define GAS __attribute__((address_space(1)))
#define LAS __attribute__((address_space(3)))
typedef unsigned short bf16;
typedef unsigned v4u __attribute__((ext_vector_type(4)));
typedef unsigned v2u __attribute__((ext_vector_type(2)));
typedef float f32x4 __attribute__((ext_vector_type(4)));
typedef float f32x2 __attribute__((ext_vector_type(2)));
typedef short bf16x8 __attribute__((ext_vector_type(8)));
typedef short v4i16 __attribute__((ext_vector_type(4)));
typedef GAS unsigned gu32;
#define RLX_AGENT __ATOMIC_RELAXED, __HIP_MEMORY_SCOPE_AGENT
#define LDS_WAIT() asm volatile("s_waitcnt lgkmcnt(0)" ::: "memory")
#define VM_WAIT() asm volatile("s_waitcnt vmcnt(0)" ::: "memory")
__device__ __forceinline__ unsigned pk2(float lo, float hi) { return pg8::cvt_pk_bf16(lo, hi); }
__device__ __forceinline__ float bflo(unsigned u) { return __uint_as_float(u << 16); }
__device__ __forceinline__ float bfhi(unsigned u) { return __uint_as_float(u & 0xffff0000u); }
__device__ __forceinline__ float wave_sum(float v) {
#pragma unroll
    for (int o = 1; o < 64; o <<= 1) v += __shfl_xor(v, o);
    return v;
}
__device__ __forceinline__ f32x4 mfma16(bf16x8 a, bf16x8 b, f32x4 c) { return __builtin_amdgcn_mfma_f32_16x16x32_bf16(a, b, c, 0, 0, 0); }
__device__ __forceinline__ v4i16 trrd(LAS unsigned char* p) { return __builtin_amdgcn_ds_read_tr16_b64_v4i16((LAS v4i16*)p); }
__device__ __forceinline__ bf16x8 cat8(v4i16 lo, v4i16 hi) { return (bf16x8){lo[0], lo[1], lo[2], lo[3], hi[0], hi[1], hi[2], hi[3]}; }
__device__ __forceinline__ bf16x8 pack8(float a0, float a1, float a2, float a3, float a4, float a5, float a6, float a7) {
    v4u w; w.x = pk2(a0, a1); w.y = pk2(a2, a3); w.z = pk2(a4, a5); w.w = pk2(a6, a7); return __builtin_bit_cast(bf16x8, w); }
__device__ __forceinline__ float silu(float x) { return x * __builtin_amdgcn_rcpf(1.0f + __expf(-x)); }

#define XB_TMO      128
#define XB_XCNT(j)  (256  + 64 * (j))
#define XB_XSUB(j)  (1280 + 64 * (j))
#define XB_XGEN(j)  (2304 + 64 * (j))
#define XB_TOP      3328
#define XB_TOPGEN   3392
#define XCD_BAR_WORDS 3456
#define XB_SPIN_CAP (1u << 18)

__device__ __forceinline__ unsigned xb_ld(unsigned* p)              { return __hip_atomic_load(p, __ATOMIC_RELAXED, __HIP_MEMORY_SCOPE_AGENT); }
__device__ __forceinline__ unsigned xb_add(unsigned* p, unsigned v) { return __hip_atomic_fetch_add(p, v, __ATOMIC_RELAXED, __HIP_MEMORY_SCOPE_AGENT); }
__device__ __forceinline__ unsigned xb_xcc_id() { return (unsigned)__builtin_amdgcn_s_getreg((3 << 11) | 20) & 0xFu; }
#define XB_SPIN(cond, bar) do { unsigned _sp = 0; while (cond) { __builtin_amdgcn_s_sleep(1); \
    if ((++_sp & 255u) == 0u) { if (xb_ld(&(bar)[XB_TMO])) break; if (_sp > XB_SPIN_CAP) { atomicAdd(&(bar)[XB_TMO], 1u); break; } } } } while (0)

struct XcdBarrier {
    unsigned* bar; unsigned x;
    volatile LAS unsigned* st;
};

__device__ __forceinline__ XcdBarrier xcd_barrier_post(unsigned* bar, volatile LAS unsigned* st) {
    XcdBarrier b; b.bar = bar; b.x = xb_xcc_id(); b.st = st;
    if (threadIdx.x == 0) (void)xb_add(&bar[XB_XCNT(b.x)], 1u);
    return b;
}
__device__ __forceinline__ void xcd_barrier_complete(unsigned* bar, unsigned x, unsigned& nloc, unsigned& nx) {
    const unsigned G = gridDim.x * gridDim.y * gridDim.z;
    unsigned sum, cnt, mine, sp = 0u;
    for (;;) {
        sum = 0u; cnt = 0u; mine = 0u;
#pragma unroll
        for (unsigned j = 0; j < 16; ++j) { const unsigned c = xb_ld(&bar[XB_XCNT(j)]); sum += c; cnt += (c > 0u) ? 1u : 0u; mine = (j == x) ? c : mine; }
        if (sum == G) break;
        __builtin_amdgcn_s_sleep(1);
        if ((++sp & 255u) == 0u) { if (xb_ld(&bar[XB_TMO])) break; if (sp > XB_SPIN_CAP) { atomicAdd(&bar[XB_TMO], 1u); break; } }
    }
    nloc = mine > 0u ? mine : 1u; nx = cnt > 0u ? cnt : 1u;
}

__device__ __forceinline__ void xcd_barrier(const XcdBarrier& b) {
    asm volatile("s_waitcnt vmcnt(0)" ::: "memory");
    __syncthreads();
    if (threadIdx.x == 0) {
        unsigned* bar = b.bar;
        __builtin_amdgcn_s_waitcnt(0);
        unsigned nloc = b.st[0], nx = b.st[1];
        if (nloc == 0u) { xcd_barrier_complete(bar, b.x, nloc, nx); b.st[0] = nloc; b.st[1] = nx; }
        const unsigned old = xb_add(&bar[XB_XSUB(b.x)], 1u);
        const unsigned gen = old / nloc;
        if (old + 1u == (gen + 1u) * nloc) {
            __builtin_amdgcn_fence(__ATOMIC_RELEASE, "agent");
            asm volatile("s_waitcnt vmcnt(0)" ::: "memory");
            const unsigned og = xb_add(&bar[XB_TOP], 1u);
            const unsigned tg = og / nx;
            if (og + 1u == (tg + 1u) * nx) xb_add(&bar[XB_TOPGEN], 1u);
            else XB_SPIN(xb_ld(&bar[XB_TOPGEN]) == tg, bar);
            __builtin_amdgcn_fence(__ATOMIC_ACQUIRE, "agent");
            xb_add(&bar[XB_XGEN(b.x)], 1u);
            asm volatile("s_waitcnt vmcnt(0)" ::: "memory");
        } else {
            XB_SPIN(xb_ld(&bar[XB_XGEN(b.x)]) == gen, bar);
            __builtin_amdgcn_fence(__ATOMIC_ACQUIRE, "agent");
            asm volatile("s_waitcnt vmcnt(0)" ::: "memory");
        }
    }
    __syncthreads();
}

constexpr int NWAVES = 8, NTHR = 512;
constexpr int D = 1024, SEQ = 8192, NBATCH = 4, M = NBATCH * SEQ, NCHUNK = SEQ / 64;
constexpr int DIN = 2824, PN = 2816;
constexpr int PC_Z = 0, PC_XBC = 512, PC_U = 1536, PC_V = 1792, PC_Q = 2048, PC_K = 2304, PC_VV = 2560;
constexpr int DFF = 2816, DFFE = 3584, NEXP = 8;
constexpr int MOE_CH = 88, MOE_MAXT = 264;
constexpr int NIN = 27;
constexpr size_t MiB = 1u << 20;
constexpr size_t WS_CTL = 0, CTL_ZERO_BYTES = 65536;
constexpr size_t WS_AEND = 65536, WS_WGCNT = 98304;
constexpr size_t WS_DTRAW = 1 * MiB, WS_TOKE = 2 * MiB, WS_TOKG = 2 * MiB + 262144, WS_POS = 2 * MiB + 524288;
constexpr size_t WS_WIN = 4 * MiB, WS_WOUT = 15 * MiB, WS_WGU = 19 * MiB, WS_WD = 30 * MiB;
constexpr size_t WS_A1 = 36 * MiB, WS_XBCC = 36 * MiB;
constexpr size_t WS_PROJ = 100 * MiB, WS_MIXED = 100 * MiB, WS_H1 = 100 * MiB;
constexpr size_t WS_ST = 276 * MiB, WS_FOUT = 276 * MiB;
constexpr size_t WS_Y = 404 * MiB;
constexpr size_t WS_HM = 36 * MiB, WS_XS = 190 * MiB, WS_MWGU = 322 * MiB, WS_MWD = 434 * MiB, WS_END = 490 * MiB;
constexpr int CW_BAR = 4096;
constexpr int LDS_BYTES = 163840, LDSCTL_OFF = 147456;
constexpr int CTL_MISC = LDSCTL_OFF, CTL_CNT = LDSCTL_OFF + 128, CTL_TE = LDSCTL_OFF + 512;

struct Args { const float* in[NIN]; float* out; unsigned char* ws; int ph_lo, ph_hi; };

struct Frame {
    LAS unsigned char* lds;
    int tid, lane, wave, vcu, G;
};
__device__ __forceinline__ bool fresh(Frame& F) { int t_ = threadIdx.x; asm volatile("" : "+v"(t_)); F.tid = t_; F.lane = t_ & 63; F.wave = __builtin_amdgcn_readfirstlane(t_ >> 6); return true; }

__device__ __forceinline__ void cvt_item(const float* W, int N, int k0, int n0, bf16* WT, int K, int row0, LAS float* scr, int lane) {
#pragma unroll 8
    for (int i = 0; i < 32; ++i) { const int kk = 2 * i + (lane >> 5); scr[kk * 33 + (lane & 31)] = W[(size_t)(k0 + kk) * N + n0 + (lane & 31)]; }
    LDS_WAIT(); asm volatile("" ::: "memory");
    const int c = lane & 7;
#pragma unroll
    for (int j = 0; j < 4; ++j) { const int n = (lane >> 3) + 8 * j; const LAS float* s = scr + (8 * c) * 33 + n;
        v4u o; o.x = pk2(s[0 * 33], s[1 * 33]); o.y = pk2(s[2 * 33], s[3 * 33]); o.z = pk2(s[4 * 33], s[5 * 33]); o.w = pk2(s[6 * 33], s[7 * 33]);
        *(GAS v4u*)(WT + (size_t)(row0 + n) * K + k0 + 8 * c) = o; }
    LDS_WAIT(); asm volatile("" ::: "memory");
}
__device__ __forceinline__ void cvt_small_weights(Frame& F, const Args& A) {
    LAS float* scr = (LAS float*)(F.lds + F.wave * 16384);
    const int gw = F.vcu * NWAVES + F.wave, NGW = F.G * NWAVES;
    bf16* WIN = (bf16*)(A.ws + WS_WIN); bf16* WOUT = (bf16*)(A.ws + WS_WOUT); bf16* WGU = (bf16*)(A.ws + WS_WGU); bf16* WD = (bf16*)(A.ws + WS_WD);
    constexpr int NI = 2816 + 1024 + 2816 + 1408;
    for (int it = gw; it < NI; it += NGW) {
        int r = it;
        if (r < 2816) { const int L = r / 1408; r %= 1408; const int kb = r / 88, nb = r % 88; const int ns = 32 * nb + (32 * nb >= 1536 ? 8 : 0);
            cvt_item(A.in[5] + (size_t)L * D * DIN, DIN, 64 * kb, ns, WIN + (size_t)L * PN * D, D, 32 * nb, scr, F.lane); continue; }
        r -= 2816;
        if (r < 1024) { const int L = r / 512; r %= 512; const int kb = r / 32, nb = r % 32;
            cvt_item(A.in[19] + (size_t)L * D * D, D, 64 * kb, 32 * nb, WOUT + (size_t)L * D * D, D, 32 * nb, scr, F.lane); continue; }
        r -= 1024;
        if (r < 2816) { const int up = r / 1408; r %= 1408; const int kb = r / 88, nb = r % 88;
            cvt_item(up ? A.in[21] : A.in[20], DFF, 64 * kb, 32 * nb, WGU, D, 256 * (nb >> 2) + 32 * (nb & 3) + 128 * up, scr, F.lane); continue; }
        r -= 2816;
        { const int kb = r / 32, nb = r % 32; cvt_item(A.in[22], D, 64 * kb, 32 * nb, WD, DFF, 32 * nb, scr, F.lane); }
    }
}
__device__ __forceinline__ void cvt_moe_weights(Frame& F, const Args& A) {
    LAS float* scr = (LAS float*)(F.lds + 32768 + F.wave * 8704);
    const int gw = F.vcu * NWAVES + F.wave, NGW = F.G * NWAVES;
    bf16* MWGU = (bf16*)(A.ws + WS_MWGU); bf16* MWD = (bf16*)(A.ws + WS_MWD);
    constexpr int NI = 3 * 14336;
    for (int it = gw; it < NI; it += NGW) {
        int r = it;
        if (r < 28672) { const int up = r / 14336; r %= 14336; const int e = r / 1792; r %= 1792; const int kb = r / 112, nb = r % 112;
            cvt_item((up ? A.in[25] : A.in[24]) + (size_t)e * D * DFFE, DFFE, 64 * kb, 32 * nb, MWGU + (size_t)e * 7168 * D, D, 256 * (nb >> 2) + 32 * (nb & 3) + 128 * up, scr, F.lane); continue; }
        r -= 28672;
        { const int e = r / 1792; r %= 1792; const int kb = r / 32, nb = r % 32;
          cvt_item(A.in[26] + (size_t)e * DFFE * D, D, 64 * kb, 32 * nb, MWD + (size_t)e * D * DFFE, DFFE, 32 * nb, scr, F.lane); }
    }
}

struct RowArgs {
    const float* hsrc; float* hdst;
    int branch;
    const bf16* ybuf; const float* gpost;
    const float* gpre; bf16* a1;
    int proj;
    const float* w8; int w8ld;
};
__device__ __forceinline__ void row_phase(Frame& F, const Args& A, const RowArgs& R) {
    LAS float* W8T = (LAS float*)F.lds;
    LAS int* cnt = (LAS int*)(F.lds + CTL_CNT);
    const int lane = F.lane;
    if (R.proj) { for (int idx = F.tid; idx < 8192; idx += NTHR) { const int e = idx & 7, k = idx >> 3; W8T[e * 1024 + k] = R.w8[(size_t)k * R.w8ld + e]; } }
    if (R.proj == 2 && F.tid < 8) cnt[F.tid] = 0;
    __syncthreads();
    f32x4 gpo[4], gpr[4];
#pragma unroll
    for (int j = 0; j < 4; ++j) { gpo[j] = R.branch ? *(const f32x4*)(R.gpost + 4 * lane + 256 * j) : (f32x4){0.f, 0.f, 0.f, 0.f}; gpr[j] = R.gpre ? *(const f32x4*)(R.gpre + 4 * lane + 256 * j) : (f32x4){0.f, 0.f, 0.f, 0.f}; }
    float* DTRAW = (float*)(A.ws + WS_DTRAW); int* TOKE = (int*)(A.ws + WS_TOKE); float* TOKG = (float*)(A.ws + WS_TOKG); const int* POS = (const int*)(A.ws + WS_POS);
    const int gw = F.vcu * NWAVES + F.wave, NGW = F.G * NWAVES;
    for (int m = gw; m < M; m += NGW) {
        f32x4 v[4];
#pragma unroll
        for (int j = 0; j < 4; ++j) v[j] = *(const f32x4*)(R.hsrc + (size_t)m * D + 4 * lane + 256 * j);
        if (R.branch) {
            f32x4 y[4];
            if (R.branch == 1) {
#pragma unroll
                for (int j = 0; j < 4; ++j) { const v2u raw = *(const v2u*)(R.ybuf + (size_t)m * D + 4 * lane + 256 * j); y[j] = (f32x4){bflo(raw.x), bfhi(raw.x), bflo(raw.y), bfhi(raw.y)}; }
            } else {
                const int p0 = POS[2 * m], p1 = POS[2 * m + 1]; const float g0 = TOKG[2 * m], g1 = TOKG[2 * m + 1];
#pragma unroll
                for (int j = 0; j < 4; ++j) { const v2u r0 = *(const v2u*)(R.ybuf + (size_t)p0 * D + 4 * lane + 256 * j); const v2u r1 = *(const v2u*)(R.ybuf + (size_t)p1 * D + 4 * lane + 256 * j);
                    y[j] = (f32x4){g0 * bflo(r0.x) + g1 * bflo(r1.x), g0 * bfhi(r0.x) + g1 * bfhi(r1.x), g0 * bflo(r0.y) + g1 * bflo(r1.y), g0 * bfhi(r0.y) + g1 * bfhi(r1.y)}; }
            }
            float ss = 0.f;
#pragma unroll
            for (int j = 0; j < 4; ++j) ss += (y[j].x * y[j].x + y[j].y * y[j].y) + (y[j].z * y[j].z + y[j].w * y[j].w);
            const float sc = 1.0f / sqrtf(wave_sum(ss) * (1.0f / D) + 1e-6f);
#pragma unroll
            for (int j = 0; j < 4; ++j) v[j] = v[j] + y[j] * sc * gpo[j];
        }
        if (R.hdst) {
#pragma unroll
            for (int j = 0; j < 4; ++j) *(f32x4*)(R.hdst + (size_t)m * D + 4 * lane + 256 * j) = v[j];
        }
        if (R.gpre) {
            float ss = 0.f;
#pragma unroll
            for (int j = 0; j < 4; ++j) ss += (v[j].x * v[j].x + v[j].y * v[j].y) + (v[j].z * v[j].z + v[j].w * v[j].w);
            const float sc = 1.0f / sqrtf(wave_sum(ss) * (1.0f / D) + 1e-6f);
#pragma unroll
            for (int j = 0; j < 4; ++j) { v[j] = v[j] * sc * gpr[j]; v2u o; o.x = pk2(v[j].x, v[j].y); o.y = pk2(v[j].z, v[j].w); *(v2u*)(R.a1 + (size_t)m * D + 4 * lane + 256 * j) = o; }
            if (R.proj) {
                float p[8];
#pragma unroll
                for (int e = 0; e < 8; ++e) { float s = 0.f;
#pragma unroll
                    for (int j = 0; j < 4; ++j) { const f32x4 w = *(const LAS f32x4*)(W8T + e * 1024 + 4 * lane + 256 * j); s += (v[j].x * w.x + v[j].y * w.y) + (v[j].z * w.z + v[j].w * w.w); }
                    p[e] = wave_sum(s); }
                if (R.proj == 1) {
                    float mine = p[0];
#pragma unroll
                    for (int e = 1; e < 8; ++e) mine = (lane == e) ? p[e] : mine;
                    if (lane < 8) DTRAW[(size_t)m * 8 + lane] = mine;
                } else {
                    float best = p[0]; int bi = 0;
#pragma unroll
                    for (int e = 1; e < 8; ++e) if (p[e] > best) { best = p[e]; bi = e; }
                    float sb = -3.0e38f; int si = 0;
#pragma unroll
                    for (int e = 0; e < 8; ++e) if (e != bi && p[e] > sb) { sb = p[e]; si = e; }
                    const float g0 = 1.0f / (1.0f + expf(sb - best)), g1 = 1.0f - g0;
                    if (lane == 0) { TOKE[2 * m] = bi; TOKE[2 * m + 1] = si; TOKG[2 * m] = g0; TOKG[2 * m + 1] = g1;
                        __hip_atomic_fetch_add(cnt + bi, 1, __ATOMIC_RELAXED, __HIP_MEMORY_SCOPE_WORKGROUP); __hip_atomic_fetch_add(cnt + si, 1, __ATOMIC_RELAXED, __HIP_MEMORY_SCOPE_WORKGROUP); }
                }
            }
        }
    }
    if (R.proj == 2) { __syncthreads(); if (F.tid < 8) ((int*)(A.ws + WS_WGCNT))[F.vcu * 8 + F.tid] = cnt[F.tid]; }
    __syncthreads();
}

__device__ __forceinline__ void moe_tables(Frame& F, const Args& A) {
    LAS int* c = (LAS int*)(F.lds + CTL_CNT); LAS int* te = (LAS int*)(F.lds + CTL_TE);
    if (F.tid < 40) c[F.tid] = 0;
    __syncthreads();
    const int* WGCNT = (const int*)(A.ws + WS_WGCNT);
    for (int idx = F.tid; idx < F.G * 8; idx += NTHR) { const int wg = idx >> 3, e = idx & 7; const int v = WGCNT[idx];
        __hip_atomic_fetch_add(c + e, v, __ATOMIC_RELAXED, __HIP_MEMORY_SCOPE_WORKGROUP); if (wg < F.vcu) __hip_atomic_fetch_add(c + 8 + e, v, __ATOMIC_RELAXED, __HIP_MEMORY_SCOPE_WORKGROUP); }
    __syncthreads();
    if (F.tid == 0) { int t = 0; for (int e = 0; e < 8; ++e) { c[16 + e] = t * 256; const int n = (c[e] + 255) >> 8; for (int j = 0; j < n && t + j < MOE_MAXT; ++j) te[t + j] = e; t += n; } c[32] = t < MOE_MAXT ? t : MOE_MAXT; }
    __syncthreads();
}
__device__ __forceinline__ void moe_gather(Frame& F, const Args& A) {
    LAS int* c = (LAS int*)(F.lds + CTL_CNT);
    const int* TOKE = (const int*)(A.ws + WS_TOKE); int* POS = (int*)(A.ws + WS_POS);
    const bf16* A1 = (const bf16*)(A.ws + WS_A1); bf16* XS = (bf16*)(A.ws + WS_XS);
    const int gw = F.vcu * NWAVES + F.wave, NGW = F.G * NWAVES, lane = F.lane;
    for (int m = gw; m < M; m += NGW) {
        int d0 = 0, d1 = 0;
        if (lane == 0) { const int e0 = TOKE[2 * m], e1 = TOKE[2 * m + 1];
            d0 = c[16 + e0] + c[8 + e0] + __hip_atomic_fetch_add(c + 24 + e0, 1, __ATOMIC_RELAXED, __HIP_MEMORY_SCOPE_WORKGROUP);
            d1 = c[16 + e1] + c[8 + e1] + __hip_atomic_fetch_add(c + 24 + e1, 1, __ATOMIC_RELAXED, __HIP_MEMORY_SCOPE_WORKGROUP);
            POS[2 * m] = d0; POS[2 * m + 1] = d1; }
        d0 = __builtin_amdgcn_readfirstlane(d0); d1 = __builtin_amdgcn_readfirstlane(d1);
        const v4u r0 = *(const v4u*)(A1 + (size_t)m * D + 8 * lane), r1 = *(const v4u*)(A1 + (size_t)m * D + 512 + 8 * lane);
        *(v4u*)(XS + (size_t)d0 * D + 8 * lane) = r0; *(v4u*)(XS + (size_t)d0 * D + 512 + 8 * lane) = r1;
        *(v4u*)(XS + (size_t)d1 * D + 8 * lane) = r0; *(v4u*)(XS + (size_t)d1 * D + 512 + 8 * lane) = r1;
    }
    __syncthreads();
}

__device__ __forceinline__ void gmlp_unit(Frame& F, const Args& A, int L, int nb) {
    LAS unsigned char* Ls = F.lds; const int lane = F.lane, w = F.wave, fr = lane & 15, q4 = lane >> 4;
    const size_t m0 = (size_t)nb * 128;
    const bf16* P = (const bf16*)(A.ws + WS_PROJ); bf16* Y = (bf16*)(A.ws + WS_Y);
    { const f32x4 g4 = *(const f32x4*)(A.in[12] + L * 256 + 4 * lane), b4 = *(const f32x4*)(A.in[13] + L * 256 + 4 * lane);
#pragma unroll 2
      for (int i = 0; i < 16; ++i) { const int r = 16 * w + i;
        const v2u raw = *(const v2u*)(P + (m0 + r) * PN + PC_V + 4 * lane);
        f32x4 v = (f32x4){bflo(raw.x), bfhi(raw.x), bflo(raw.y), bfhi(raw.y)};
        const float mu = wave_sum((v.x + v.y) + (v.z + v.w)) * (1.0f / 256.0f);
        v = v - mu;
        const float var = wave_sum((v.x * v.x + v.y * v.y) + (v.z * v.z + v.w * v.w)) * (1.0f / 256.0f);
        const float rstd = 1.0f / sqrtf(var + 1e-5f);
        v = v * rstd * g4 + b4;
        v2u o; o.x = pk2(v.x, v.y); o.y = pk2(v.z, v.w);
        *(LAS v2u*)(Ls + r * 544 + lane * 8) = o; } }
    __syncthreads();
    const int g = w & 3;
    f32x4 acc[4][4];
    const float* Wg = A.in[14] + (size_t)(L * 4 + g) * 128 * 128;
    const float* bsg = A.in[15] + (size_t)(L * 4 + g) * 128;
#pragma unroll
    for (int pi = 0; pi < 4; ++pi) {
        const int it = (w >> 2) == 0 ? (pi == 0 ? 0 : pi == 1 ? 7 : pi == 2 ? 1 : 6) : (pi == 0 ? 2 : pi == 1 ? 5 : pi == 2 ? 3 : 4);
#pragma unroll
        for (int ct = 0; ct < 4; ++ct) acc[pi][ct] = (f32x4){0.f, 0.f, 0.f, 0.f};
        const int t = 16 * it + fr, nks = (it >> 1) + 1;
        for (int ks = 0; ks < nks; ++ks) {
            const int sA = 32 * ks + 4 * q4, sB = sA + 16;
            const f32x4 wa = *(const f32x4*)(Wg + t * 128 + sA), wb = *(const f32x4*)(Wg + t * 128 + sB);
            const bf16x8 xf = pack8(sA + 0 <= t ? wa.x : 0.f, sA + 1 <= t ? wa.y : 0.f, sA + 2 <= t ? wa.z : 0.f, sA + 3 <= t ? wa.w : 0.f,
                                    sB + 0 <= t ? wb.x : 0.f, sB + 1 <= t ? wb.y : 0.f, sB + 2 <= t ? wb.z : 0.f, sB + 3 <= t ? wb.w : 0.f);
#pragma unroll
            for (int ct = 0; ct < 4; ++ct) { const int col = g * 64 + ct * 16 + 4 * (lane & 3);
                const v4i16 lo = trrd(Ls + (sA + (fr >> 2)) * 544 + col * 2), hi = trrd(Ls + (sB + (fr >> 2)) * 544 + col * 2);
                acc[pi][ct] = mfma16(xf, cat8(lo, hi), acc[pi][ct]); }
        }
#pragma unroll
        for (int r = 0; r < 4; ++r) { const float bs = bsg[16 * it + 4 * q4 + r];
#pragma unroll
            for (int ct = 0; ct < 4; ++ct) acc[pi][ct][r] += bs; }
    }
    __syncthreads();
#pragma unroll
    for (int pi = 0; pi < 4; ++pi) {
        const int it = (w >> 2) == 0 ? (pi == 0 ? 0 : pi == 1 ? 7 : pi == 2 ? 1 : 6) : (pi == 0 ? 2 : pi == 1 ? 5 : pi == 2 ? 3 : 4);
#pragma unroll
        for (int ct = 0; ct < 4; ++ct)
#pragma unroll
            for (int r = 0; r < 4; ++r) *(LAS float*)(Ls + (16 * it + 4 * q4 + r) * 1040 + (g * 64 + ct * 16 + fr) * 4) = acc[pi][ct][r];
    }
    __syncthreads();
    { const f32x4 gn = *(const f32x4*)(A.in[16] + L * 256 + 4 * lane);
#pragma unroll 2
      for (int i = 0; i < 16; ++i) { const int r = 16 * w + i;
        const f32x4 mx = *(const LAS f32x4*)(Ls + r * 1040 + lane * 16);
        const v2u raw = *(const v2u*)(P + (m0 + r) * PN + PC_U + 4 * lane);
        f32x4 v = (f32x4){bflo(raw.x), bfhi(raw.x), bflo(raw.y), bfhi(raw.y)} * mx;
        const float ss = wave_sum((v.x * v.x + v.y * v.y) + (v.z * v.z + v.w * v.w)) * (1.0f / 256.0f);
        v = v * (1.0f / sqrtf(ss + 1e-6f)) * gn;
        v2u o; o.x = pk2(v.x, v.y); o.y = pk2(v.z, v.w);
        *(v2u*)(Y + (m0 + r) * D + 512 + 4 * lane) = o; } }
    __syncthreads();
}

__device__ __forceinline__ void attn_unit(Frame& F, const Args& A, int L, int bc) {
    LAS unsigned char* Ls = F.lds; const int lane = F.lane, w = F.wave, fr = lane & 15, q4 = lane >> 4;
    const int b = bc >> 7, c = bc & 127; const size_t m0 = (size_t)b * SEQ + (size_t)c * 64;
    const bf16* P = (const bf16*)(A.ws + WS_PROJ); bf16* Y = (bf16*)(A.ws + WS_Y);
    const int h = w >> 1, qh = w & 1;
    LAS unsigned char* Vb = Ls + w * 10240;
    const float* bias = A.in[17] + (size_t)(L * 4 + h) * 257;
    bf16x8 qf[2][2];
#pragma unroll
    for (int qb = 0; qb < 2; ++qb)
#pragma unroll
        for (int ks = 0; ks < 2; ++ks) qf[qb][ks] = *(const bf16x8*)(P + (m0 + 32 * qh + 16 * qb + fr) * PN + PC_Q + h * 64 + 32 * ks + 8 * q4);
    f32x4 o[4][2];
#pragma unroll
    for (int dt = 0; dt < 4; ++dt) { o[dt][0] = (f32x4){0.f, 0.f, 0.f, 0.f}; o[dt][1] = (f32x4){0.f, 0.f, 0.f, 0.f}; }
    float mrun[2] = {-1e30f, -1e30f}, lrun[2] = {0.f, 0.f};
    const int jmin = c >= 8 ? 0 : 8 - c;
    for (int j = jmin; j <= 8; ++j) {
        const size_t kr0 = m0 - (size_t)(8 - j) * 64;
#pragma unroll
        for (int i = 0; i < 8; ++i) { const int row = i * 8 + (lane >> 3), ch = lane & 7;
            const v4u v = *(const v4u*)(P + (kr0 + row) * PN + PC_VV + h * 64 + ch * 8); *(LAS v4u*)(Vb + row * 160 + ch * 16) = v; }
        f32x4 st[4][2];
#pragma unroll
        for (int kt = 0; kt < 4; ++kt) { st[kt][0] = (f32x4){0.f, 0.f, 0.f, 0.f}; st[kt][1] = (f32x4){0.f, 0.f, 0.f, 0.f};
#pragma unroll
            for (int ks = 0; ks < 2; ++ks) { const bf16x8 kf = *(const bf16x8*)(P + (kr0 + 16 * kt + fr) * PN + PC_K + h * 64 + 32 * ks + 8 * q4);
                st[kt][0] = mfma16(kf, qf[0][ks], st[kt][0]); st[kt][1] = mfma16(kf, qf[1][ks], st[kt][1]); } }
#pragma unroll
        for (int qb = 0; qb < 2; ++qb) {
            const int qpos = 32 * qh + 16 * qb + fr; float mx = -1e30f;
#pragma unroll
            for (int kt = 0; kt < 4; ++kt)
#pragma unroll
                for (int r = 0; r < 4; ++r) { const int key = 16 * kt + 4 * q4 + r; int rel = 512 - 64 * j + qpos - key; rel = rel < -128 ? -128 : (rel > 128 ? 128 : rel);
                    const float s = st[kt][qb][r] * 0.125f + bias[rel + 128]; st[kt][qb][r] = s; mx = fmaxf(mx, s); }
            mx = fmaxf(mx, __shfl_xor(mx, 16)); mx = fmaxf(mx, __shfl_xor(mx, 32));
            const float mnew = fmaxf(mrun[qb], mx), alpha = __expf(mrun[qb] - mnew); mrun[qb] = mnew;
            float rs = 0.f;
#pragma unroll
            for (int kt = 0; kt < 4; ++kt)
#pragma unroll
                for (int r = 0; r < 4; ++r) { const float p = __expf(st[kt][qb][r] - mnew); st[kt][qb][r] = p; rs += p; }
            rs += __shfl_xor(rs, 16); rs += __shfl_xor(rs, 32);
            lrun[qb] = lrun[qb] * alpha + rs;
#pragma unroll
            for (int dt = 0; dt < 4; ++dt) o[dt][qb] = o[dt][qb] * alpha;
        }
#pragma unroll
        for (int kk = 0; kk < 2; ++kk) {
            const bf16x8 y0 = pack8(st[2 * kk][0][0], st[2 * kk][0][1], st[2 * kk][0][2], st[2 * kk][0][3], st[2 * kk + 1][0][0], st[2 * kk + 1][0][1], st[2 * kk + 1][0][2], st[2 * kk + 1][0][3]);
            const bf16x8 y1 = pack8(st[2 * kk][1][0], st[2 * kk][1][1], st[2 * kk][1][2], st[2 * kk][1][3], st[2 * kk + 1][1][0], st[2 * kk + 1][1][1], st[2 * kk + 1][1][2], st[2 * kk + 1][1][3]);
            const int rowA = 32 * kk + 4 * q4 + (fr >> 2), rowB = rowA + 16;
#pragma unroll
            for (int dt = 0; dt < 4; ++dt) { const int cb = (16 * dt + 4 * (lane & 3)) * 2;
                const bf16x8 xf = cat8(trrd(Vb + rowA * 160 + cb), trrd(Vb + rowB * 160 + cb));
                o[dt][0] = mfma16(xf, y0, o[dt][0]); o[dt][1] = mfma16(xf, y1, o[dt][1]); }
        }
    }
    const float il0 = 1.0f / lrun[0], il1 = 1.0f / lrun[1];
    __syncthreads();
#pragma unroll
    for (int dt = 0; dt < 4; ++dt) {
        *(LAS f32x4*)(Ls + (32 * qh + fr) * 1040 + (h * 64 + 16 * dt + 4 * q4) * 4) = o[dt][0] * il0;
        *(LAS f32x4*)(Ls + (32 * qh + 16 + fr) * 1040 + (h * 64 + 16 * dt + 4 * q4) * 4) = o[dt][1] * il1; }
    __syncthreads();
    { const f32x4 gn = *(const f32x4*)(A.in[18] + L * 256 + 4 * lane);
#pragma unroll 2
      for (int i = 0; i < 8; ++i) { const int r = 8 * w + i;
        f32x4 v = *(const LAS f32x4*)(Ls + r * 1040 + lane * 16);
        const float ss = wave_sum((v.x * v.x + v.y * v.y) + (v.z * v.z + v.w * v.w)) * (1.0f / 256.0f);
        v = v * (1.0f / sqrtf(ss + 1e-6f)) * gn;
        v2u ov; ov.x = pk2(v.x, v.y); ov.y = pk2(v.z, v.w);
        *(v2u*)(Y + (m0 + r) * D + 768 + 4 * lane) = ov; } }
    __syncthreads();
}

__device__ __forceinline__ void ssd_prepass(Frame& F, const Args& A, int L, size_t m0, LAS float* dtl, LAS float* acs, LAS float* tmp) {
    const float* DTRAW = (const float*)(A.ws + WS_DTRAW);
    { const int l = F.tid >> 3, h = F.tid & 7;
      const float x = DTRAW[(m0 + l) * 8 + h] + A.in[8][L * 8 + h];
      const float dt = x > 20.f ? x : log1pf(expf(x));
      dtl[l * 8 + h] = dt; tmp[l * 8 + h] = -dt * expf(A.in[9][L * 8 + h]); }
    __syncthreads();
    if (F.tid < 8) { float run = 0.f;
#pragma unroll 1
      for (int l = 0; l < 64; ++l) { run += tmp[l * 8 + F.tid]; acs[l * 8 + F.tid] = run; } }
    __syncthreads();
}
__device__ __forceinline__ void ssd1_unit(Frame& F, const Args& A, int L, int bc) {
    LAS unsigned char* Ls = F.lds; const int lane = F.lane, w = F.wave, fr = lane & 15, q4 = lane >> 4;
    const int b = bc >> 7, c = bc & 127; const size_t m0 = (size_t)b * SEQ + (size_t)c * 64;
    const bf16* P = (const bf16*)(A.ws + WS_PROJ); bf16* XBCC = (bf16*)(A.ws + WS_XBCC); float* ST = (float*)(A.ws + WS_ST); float* AEND = (float*)(A.ws + WS_AEND);
    LAS unsigned char* XI = Ls; LAS unsigned char* BI = Ls + 67584;
    LAS float* dtl = (LAS float*)(Ls + 102400); LAS float* acs = (LAS float*)(Ls + 104448); LAS float* tmp = (LAS float*)(Ls + 106496);
    ssd_prepass(F, A, L, m0, dtl, acs, tmp);
    if (F.tid < 8) AEND[(size_t)bc * 8 + F.tid] = acs[63 * 8 + F.tid];
    { const int cg = F.tid & 127, tg = F.tid >> 7, ch0 = 8 * cg;
      float wk[4][8], bs[8];
#pragma unroll
      for (int k = 0; k < 4; ++k) { const f32x4 a = *(const f32x4*)(A.in[6] + (size_t)(L * 4 + k) * 1024 + ch0), bq = *(const f32x4*)(A.in[6] + (size_t)(L * 4 + k) * 1024 + ch0 + 4);
          wk[k][0] = a.x; wk[k][1] = a.y; wk[k][2] = a.z; wk[k][3] = a.w; wk[k][4] = bq.x; wk[k][5] = bq.y; wk[k][6] = bq.z; wk[k][7] = bq.w; }
      { const f32x4 a = *(const f32x4*)(A.in[7] + (size_t)L * 1024 + ch0), bq = *(const f32x4*)(A.in[7] + (size_t)L * 1024 + ch0 + 4);
          bs[0] = a.x; bs[1] = a.y; bs[2] = a.z; bs[3] = a.w; bs[4] = bq.x; bs[5] = bq.y; bs[6] = bq.z; bs[7] = bq.w; }
      const int hh = cg >> 3;
#pragma unroll 1
      for (int hf = 0; hf < 2; ++hf) {
      v4u raw[11];
#pragma unroll
      for (int tt = 0; tt < 11; ++tt) { const int lp = 16 * tg + 8 * hf - 3 + tt; const bool ok = (c * 64 + lp) >= 0;
          raw[tt] = ok ? *(const v4u*)(P + (size_t)((long)m0 + lp) * PN + PC_XBC + ch0) : (v4u){0u, 0u, 0u, 0u}; }
#pragma unroll
      for (int t = 0; t < 8; ++t) { const int l = 16 * tg + 8 * hf + t;
          float y[8];
#pragma unroll
          for (int e = 0; e < 8; ++e) y[e] = bs[e];
#pragma unroll
          for (int k = 0; k < 4; ++k) { const v4u rw = raw[t + k];
              y[0] += wk[k][0] * bflo(rw.x); y[1] += wk[k][1] * bfhi(rw.x); y[2] += wk[k][2] * bflo(rw.y); y[3] += wk[k][3] * bfhi(rw.y);
              y[4] += wk[k][4] * bflo(rw.z); y[5] += wk[k][5] * bfhi(rw.z); y[6] += wk[k][6] * bflo(rw.w); y[7] += wk[k][7] * bfhi(rw.w); }
#pragma unroll
          for (int e = 0; e < 8; ++e) y[e] = silu(y[e]);
          v4u o; o.x = pk2(y[0], y[1]); o.y = pk2(y[2], y[3]); o.z = pk2(y[4], y[5]); o.w = pk2(y[6], y[7]);
          *(v4u*)(XBCC + (m0 + l) * 1024 + ch0) = o;
          if (cg < 64) { const float sc = dtl[l * 8 + hh] * __expf(acs[63 * 8 + hh] - acs[l * 8 + hh]);
              v4u os; os.x = pk2(y[0] * sc, y[1] * sc); os.y = pk2(y[2] * sc, y[3] * sc); os.z = pk2(y[4] * sc, y[5] * sc); os.w = pk2(y[6] * sc, y[7] * sc);
              *(LAS v4u*)(XI + l * 1056 + ch0 * 2) = os; }
          else if (cg < 96) *(LAS v4u*)(BI + l * 544 + (ch0 - 512) * 2) = o;
      } } }
    __syncthreads();
    { const int h = w, gi = h >> 2;
      float* STh = ST + ((size_t)bc * 8 + h) * 8192;
#pragma unroll 1
      for (int nh = 0; nh < 2; ++nh) {
      f32x4 acc[4][4];
#pragma unroll
      for (int nt = 0; nt < 4; ++nt)
#pragma unroll
          for (int pt = 0; pt < 4; ++pt) acc[nt][pt] = (f32x4){0.f, 0.f, 0.f, 0.f};
#pragma unroll
      for (int ks = 0; ks < 2; ++ks) {
          const int rowA = 32 * ks + 4 * q4 + (fr >> 2), rowB = rowA + 16;
          bf16x8 yf[4];
#pragma unroll
          for (int pt = 0; pt < 4; ++pt) { const int cb = (h * 64 + 16 * pt + 4 * (lane & 3)) * 2; yf[pt] = cat8(trrd(XI + rowA * 1056 + cb), trrd(XI + rowB * 1056 + cb)); }
#pragma unroll
          for (int nt = 0; nt < 4; ++nt) { const int cb = (gi * 128 + 64 * nh + 16 * nt + 4 * (lane & 3)) * 2;
              const bf16x8 xf = cat8(trrd(BI + rowA * 544 + cb), trrd(BI + rowB * 544 + cb));
#pragma unroll
              for (int pt = 0; pt < 4; ++pt) acc[nt][pt] = mfma16(xf, yf[pt], acc[nt][pt]); }
      }
#pragma unroll
      for (int nt = 0; nt < 4; ++nt)
#pragma unroll
          for (int pt = 0; pt < 4; ++pt) *(f32x4*)(STh + (16 * pt + fr) * 128 + 64 * nh + 16 * nt + 4 * q4) = acc[nt][pt];
      }
    }
    __syncthreads();
}
__device__ __forceinline__ void ssd_scan(Frame& F, const Args& A) {
    float* ST = (float*)(A.ws + WS_ST); const float* AEND = (const float*)(A.ws + WS_AEND);
    for (int it = F.vcu * NTHR + F.tid; it < 32 * 4096; it += F.G * NTHR) {
        const int bh = it >> 12, b = bh >> 3, h = bh & 7, e = (it & 4095) * 2;
        float* base = ST + ((size_t)(b * NCHUNK) * 8 + h) * 8192 + e;
        f32x2 s = (f32x2){0.f, 0.f};
        for (int c0 = 0; c0 < NCHUNK; c0 += 8) {
            f32x2 v[8]; float dec[8];
#pragma unroll
            for (int i = 0; i < 8; ++i) { v[i] = *(const f32x2*)(base + (size_t)(c0 + i) * 65536); dec[i] = __expf(AEND[(size_t)(b * NCHUNK + c0 + i) * 8 + h]); }
#pragma unroll
            for (int i = 0; i < 8; ++i) { *(f32x2*)(base + (size_t)(c0 + i) * 65536) = s; s = s * dec[i] + v[i]; }
        }
    }
}
__device__ __forceinline__ void ssd3_unit(Frame& F, const Args& A, int L, int bc) {
    LAS unsigned char* Ls = F.lds; const int lane = F.lane, w = F.wave, fr = lane & 15, q4 = lane >> 4;
    const int b = bc >> 7, c = bc & 127; const size_t m0 = (size_t)b * SEQ + (size_t)c * 64;
    const bf16* P = (const bf16*)(A.ws + WS_PROJ); const bf16* XBCC = (const bf16*)(A.ws + WS_XBCC); const float* ST = (const float*)(A.ws + WS_ST); bf16* Y = (bf16*)(A.ws + WS_Y);
    LAS unsigned char* XI = Ls; LAS unsigned char* BI = Ls + 67584; LAS unsigned char* CI = Ls + 102400;
    LAS float* dtl = (LAS float*)(Ls + 137216); LAS float* acs = (LAS float*)(Ls + 139264); LAS float* tmp = (LAS float*)(Ls + 141312);
    ssd_prepass(F, A, L, m0, dtl, acs, tmp);
#pragma unroll 4
    for (int i = 0; i < 16; ++i) { const int pc = F.tid + NTHR * i, row = pc >> 7, cg = pc & 127;
        const v4u v = *(const v4u*)(XBCC + (m0 + row) * 1024 + 8 * cg);
        LAS unsigned char* dst = cg < 64 ? XI + row * 1056 + cg * 16 : (cg < 96 ? BI + row * 544 + (cg - 64) * 16 : CI + row * 544 + (cg - 96) * 16);
        *(LAS v4u*)dst = v; }
    __syncthreads();
    const int h = w, gi = h >> 2;
    f32x4 acc[4][4];
#pragma unroll
    for (int lt = 0; lt < 4; ++lt)
#pragma unroll
        for (int pt = 0; pt < 4; ++pt) acc[lt][pt] = (f32x4){0.f, 0.f, 0.f, 0.f};
    { const float* Sh = ST + ((size_t)bc * 8 + h) * 8192;
#pragma unroll 1
      for (int kn = 0; kn < 4; ++kn) {
          bf16x8 yf[4];
#pragma unroll
          for (int pt = 0; pt < 4; ++pt) { const f32x4 s0 = *(const f32x4*)(Sh + (16 * pt + fr) * 128 + 32 * kn + 8 * q4), s1 = *(const f32x4*)(Sh + (16 * pt + fr) * 128 + 32 * kn + 8 * q4 + 4);
              yf[pt] = pack8(s0.x, s0.y, s0.z, s0.w, s1.x, s1.y, s1.z, s1.w); }
#pragma unroll
          for (int lt = 0; lt < 4; ++lt) { const bf16x8 xf = *(const LAS bf16x8*)(CI + (16 * lt + fr) * 544 + (gi * 128 + 32 * kn + 8 * q4) * 2);
#pragma unroll
              for (int pt = 0; pt < 4; ++pt) acc[lt][pt] = mfma16(xf, yf[pt], acc[lt][pt]); }
      }
#pragma unroll
      for (int lt = 0; lt < 4; ++lt)
#pragma unroll
          for (int r = 0; r < 4; ++r) { const float sc = __expf(acs[(16 * lt + 4 * q4 + r) * 8 + h]);
#pragma unroll
              for (int pt = 0; pt < 4; ++pt) acc[lt][pt][r] *= sc; }
    }
#pragma unroll
    for (int lt = 0; lt < 4; ++lt) {
#pragma unroll
        for (int ksp = 0; ksp <= (lt >> 1); ++ksp) {
            __builtin_amdgcn_sched_barrier(0);
            const bool hasb = (2 * ksp + 1) <= lt;
            f32x4 d0a = (f32x4){0.f, 0.f, 0.f, 0.f}, d0b = (f32x4){0.f, 0.f, 0.f, 0.f};
#pragma unroll
            for (int kn = 0; kn < 4; ++kn) { const int cb = (gi * 128 + 32 * kn + 8 * q4) * 2;
                const bf16x8 cf = *(const LAS bf16x8*)(CI + (16 * lt + fr) * 544 + cb);
                const bf16x8 ba = *(const LAS bf16x8*)(BI + (32 * ksp + fr) * 544 + cb); d0a = mfma16(ba, cf, d0a);
                if (hasb) { const bf16x8 bb = *(const LAS bf16x8*)(BI + (32 * ksp + 16 + fr) * 544 + cb); d0b = mfma16(bb, cf, d0b); } }
            const int l = 16 * lt + fr; const float al = acs[l * 8 + h];
            float ga[4], gb[4];
#pragma unroll
            for (int r = 0; r < 4; ++r) { const int sa = 32 * ksp + 4 * q4 + r, sb = sa + 16;
                ga[r] = sa <= l ? d0a[r] * __expf(al - acs[sa * 8 + h]) * dtl[sa * 8 + h] : 0.f;
                gb[r] = (hasb && sb <= l) ? d0b[r] * __expf(al - acs[sb * 8 + h]) * dtl[sb * 8 + h] : 0.f; }
            const bf16x8 xf = pack8(ga[0], ga[1], ga[2], ga[3], gb[0], gb[1], gb[2], gb[3]);
            const int rowA = 32 * ksp + 4 * q4 + (fr >> 2), rowB = rowA + 16;
#pragma unroll
            for (int pt = 0; pt < 4; ++pt) { const int cb = (h * 64 + 16 * pt + 4 * (lane & 3)) * 2;
                acc[lt][pt] = mfma16(xf, cat8(trrd(XI + rowA * 1056 + cb), trrd(XI + rowB * 1056 + cb)), acc[lt][pt]); }
        }
    }
    { const float dsk = A.in[10][L * 8 + h];
#pragma unroll
      for (int lt = 0; lt < 4; ++lt)
#pragma unroll
          for (int pt = 0; pt < 4; ++pt)
#pragma unroll
              for (int r = 0; r < 4; ++r) { const unsigned short xv = *(const LAS unsigned short*)(XI + (16 * lt + 4 * q4 + r) * 1056 + (h * 64 + 16 * pt + fr) * 2);
                  acc[lt][pt][r] += dsk * __uint_as_float((unsigned)xv << 16); } }
    __syncthreads();
#pragma unroll
    for (int lt = 0; lt < 4; ++lt)
#pragma unroll
        for (int pt = 0; pt < 4; ++pt)
#pragma unroll
            for (int r = 0; r < 4; ++r) *(LAS float*)(Ls + (16 * lt + 4 * q4 + r) * 2112 + (h * 64 + 16 * pt + fr) * 4) = acc[lt][pt][r];
    __syncthreads();
    { const f32x4 g0 = *(const f32x4*)(A.in[11] + L * 512 + 8 * lane), g1 = *(const f32x4*)(A.in[11] + L * 512 + 8 * lane + 4);
#pragma unroll 2
      for (int i = 0; i < 8; ++i) { const int r = 8 * w + i;
        f32x4 v0 = *(const LAS f32x4*)(Ls + r * 2112 + lane * 32), v1 = *(const LAS f32x4*)(Ls + r * 2112 + lane * 32 + 16);
        const v4u z = *(const v4u*)(P + (m0 + r) * PN + PC_Z + 8 * lane);
        v0 = v0 * (f32x4){silu(bflo(z.x)), silu(bfhi(z.x)), silu(bflo(z.y)), silu(bfhi(z.y))};
        v1 = v1 * (f32x4){silu(bflo(z.z)), silu(bfhi(z.z)), silu(bflo(z.w)), silu(bfhi(z.w))};
        const float ss = wave_sum((v0.x * v0.x + v0.y * v0.y) + (v0.z * v0.z + v0.w * v0.w) + (v1.x * v1.x + v1.y * v1.y) + (v1.z * v1.z + v1.w * v1.w)) * (1.0f / 512.0f);
        const float sc = 1.0f / sqrtf(ss + 1e-6f);
        v0 = v0 * sc * g0; v1 = v1 * sc * g1;
        v4u ov; ov.x = pk2(v0.x, v0.y); ov.y = pk2(v0.z, v0.w); ov.z = pk2(v1.x, v1.y); ov.w = pk2(v1.z, v1.w);
        *(v4u*)(Y + (m0 + r) * D + 8 * lane) = ov; } }
    __syncthreads();
}

constexpr int NPHASE = 31;
__global__ void __launch_bounds__(NTHR, 2) fwd_kernel(Args args) {
    extern __shared__ __attribute__((aligned(16))) unsigned char lds[];
    Frame F;
    F.lds = (LAS unsigned char*)lds;
    F.tid = threadIdx.x; F.lane = F.tid & 63; F.wave = __builtin_amdgcn_readfirstlane(F.tid >> 6);
    F.G = gridDim.x; { const int bx = blockIdx.x; F.vcu = (F.G % 8 == 0) ? (bx % 8) * (F.G / 8) + bx / 8 : bx; }
    gu32* ctl = (gu32*)(args.ws + WS_CTL);
    for (int u = F.tid; u < (LDS_BYTES - LDSCTL_OFF) / 4; u += NTHR) ((LAS unsigned*)(F.lds + LDSCTL_OFF))[u] = 0u;
    __syncthreads();
    XcdBarrier bar; bar.bar = (unsigned*)(ctl + CW_BAR); bar.x = 0; bar.st = nullptr;
    const int lo = args.ph_lo, hi = args.ph_hi;
    if (hi - lo > 1) bar = xcd_barrier_post((unsigned*)(ctl + CW_BAR), (volatile LAS unsigned*)(F.lds + CTL_MISC) + 8);
#define IN(k) ((lo <= (k) && (k) < hi) && fresh(F))
#define SEAM(k) do { if ((k) + 1 < hi) xcd_barrier(bar); } while (0)
    unsigned char* ws = args.ws;
    bf16* A1 = (bf16*)(ws + WS_A1); bf16* PROJ = (bf16*)(ws + WS_PROJ); bf16* Yb = (bf16*)(ws + WS_Y); bf16* MIXED = (bf16*)(ws + WS_MIXED);
    const int bid = (int)blockIdx.x;

    if (IN(0)) {
        cvt_small_weights(F, args);
        __syncthreads();
        RowArgs R{args.in[0], nullptr, 0, nullptr, nullptr, args.in[1], A1, 1, args.in[5] + 1536, DIN};
        row_phase(F, args, R);
        SEAM(0);
    }
    for (int L = 0; L < 2; ++L) {
        const int pb = 1 + 16 * L;
        if (IN(pb + 0)) {
            pg8::Gemm g{A1, (const bf16*)(ws + WS_WIN) + (size_t)L * PN * D, M, PN, D}; pg8::StaticOrder S; S.init(M, PN, F.G, bid);
            pg8::EpiStore E{PROJ, PN};
            pg8::gemm_phase<pg8::EpiStore, pg8::StaticOrder, true, true>(F.lds, g, S, E);
            SEAM(pb + 0);
        }
        if (IN(pb + 1)) {
            #ifndef NO_SSD1
            for (int u = F.vcu; u < NBATCH * NCHUNK; u += F.G) ssd1_unit(F, args, L, u);
#endif
            #ifndef NO_ATTN
            for (int u = F.vcu; u < NBATCH * NCHUNK; u += F.G) attn_unit(F, args, L, u);
#endif
            #ifndef NO_GMLP
            for (int u = F.vcu; u < M / 128; u += F.G) gmlp_unit(F, args, L, u);
#endif
            SEAM(pb + 1);
        }
        #ifndef NO_SCAN
        if (IN(pb + 2)) { ssd_scan(F, args); SEAM(pb + 2); }
#endif
        #ifndef NO_SSD3
        if (IN(pb + 3)) { for (int u = F.vcu; u < NBATCH * NCHUNK; u += F.G) ssd3_unit(F, args, L, u); SEAM(pb + 3); }
#endif
        if (IN(pb + 4)) {
            pg8::Gemm g{Yb, (const bf16*)(ws + WS_WOUT) + (size_t)L * D * D, M, D, D}; pg8::StaticOrder S; S.init(M, D, F.G, bid);
            pg8::EpiStore E{MIXED, D};
            pg8::gemm_phase<pg8::EpiStore, pg8::StaticOrder, true, true>(F.lds, g, S, E);
            SEAM(pb + 4);
        }
        if (IN(pb + 5)) {
            RowArgs R{L == 0 ? args.in[0] : args.out, args.out, 1, MIXED, args.in[2] + L * D, args.in[3] + L * D, A1, L == 1 ? 2 : 0, args.in[23], 8};
            row_phase(F, args, R);
            if (L == 1) cvt_moe_weights(F, args);
            SEAM(pb + 5);
        }
        if (L == 0) {
            if (IN(pb + 6)) {
                pg8::Gemm g{A1, (const bf16*)(ws + WS_WGU), M, 2 * DFF, D}; pg8::StaticOrder S; S.init(M, 2 * DFF, F.G, bid);
                pg8::EpiSwiglu E{(bf16*)(ws + WS_H1), DFF};
                pg8::gemm_phase<pg8::EpiSwiglu, pg8::StaticOrder, true, true>(F.lds, g, S, E);
                SEAM(pb + 6);
            }
            if (IN(pb + 7)) {
                pg8::Gemm g{(const bf16*)(ws + WS_H1), (const bf16*)(ws + WS_WD), M, D, DFF}; pg8::StaticOrder S; S.init(M, D, F.G, bid);
                pg8::EpiStore E{(bf16*)(ws + WS_FOUT), D};
                pg8::gemm_phase<pg8::EpiStore, pg8::StaticOrder, true, true>(F.lds, g, S, E);
                SEAM(pb + 7);
            }
            if (IN(pb + 8)) {
                RowArgs R{args.out, args.out, 1, (const bf16*)(ws + WS_FOUT), args.in[4], args.in[1] + D, A1, 1, args.in[5] + (size_t)D * DIN + 1536, DIN};
                row_phase(F, args, R);
                SEAM(pb + 8);
            }
        } else {
            if (IN(pb + 6)) { moe_tables(F, args); moe_gather(F, args); SEAM(pb + 6); }
            for (int k = 0; k < 3; ++k) {
                if (IN(pb + 7 + 2 * k)) {
                    moe_tables(F, args);
                    const int nT = *(LAS int*)(F.lds + CTL_CNT + 32 * 4); int nk = nT - MOE_CH * k; nk = nk < 0 ? 0 : (nk > MOE_CH ? MOE_CH : nk);
                    pg8::Gemm g{(const bf16*)(ws + WS_XS), (const bf16*)(ws + WS_MWGU), 0, 0, D};
                    pg8::MoeOrder<false, true> S{MOE_CH * k, nk, 28, F.G, bid, (const LAS int*)(F.lds + CTL_TE)};
                    pg8::EpiSwiglu E{(bf16*)(ws + WS_HM), DFFE};
                    pg8::gemm_phase<pg8::EpiSwiglu, pg8::MoeOrder<false, true>, true, true>(F.lds, g, S, E);
                    SEAM(pb + 7 + 2 * k);
                }
                if (IN(pb + 8 + 2 * k)) {
                    moe_tables(F, args);
                    const int nT = *(LAS int*)(F.lds + CTL_CNT + 32 * 4); int nk = nT - MOE_CH * k; nk = nk < 0 ? 0 : (nk > MOE_CH ? MOE_CH : nk);
                    pg8::Gemm g{(const bf16*)(ws + WS_HM), (const bf16*)(ws + WS_MWD), 0, 0, DFFE};
                    pg8::MoeOrder<true, false> S{MOE_CH * k, nk, 4, F.G, bid, (const LAS int*)(F.lds + CTL_TE)};
                    pg8::EpiStore E{(bf16*)(ws + WS_XS), D};
                    pg8::gemm_phase<pg8::EpiStore, pg8::MoeOrder<true, false>, true, true>(F.lds, g, S, E);
                    SEAM(pb + 8 + 2 * k);
                }
            }
            if (IN(pb + 13)) {
                RowArgs R{args.out, args.out, 2, (const bf16*)(ws + WS_XS), args.in[4] + D, nullptr, nullptr, 0, nullptr, 0};
                row_phase(F, args, R);
            }
        }
    }
#undef IN
#undef SEAM
}

extern "C" void kernel_launch(void* const* d_in, const int* in_sizes, int n_in, void* d_out, int out_size, void* d_ws, size_t ws_size, hipStream_t stream) {
    static int grid = 0;
    if (grid == 0) {
        if (n_in != NIN || out_size != M * D || ws_size < WS_END) { fprintf(stderr, "kernel_launch: unexpected shapes (n_in %d, out %d, ws %zu)\n", n_in, out_size, ws_size); grid = -1; return; }
        int dev = 0, cus = 0;
        if (hipGetDevice(&dev) != hipSuccess || hipDeviceGetAttribute(&cus, hipDeviceAttributeMultiprocessorCount, dev) != hipSuccess) { grid = -1; return; }
        if (hipFuncSetAttribute((const void*)fwd_kernel, hipFuncAttributeMaxDynamicSharedMemorySize, LDS_BYTES) != hipSuccess) { fprintf(stderr, "kernel_launch: hipFuncSetAttribute failed\n"); grid = -1; return; }
        int per_cu = 0;
        if (hipOccupancyMaxActiveBlocksPerMultiprocessor(&per_cu, (const void*)fwd_kernel, NTHR, LDS_BYTES) != hipSuccess || per_cu < 1) fprintf(stderr, "kernel_launch: occupancy query says %d\n", per_cu);
        (void)hipGetLastError();
        grid = cus > 256 ? 256 : cus;
    }
    if (grid < 0) return;
    (void)hipMemsetAsync((char*)d_ws + WS_CTL, 0, CTL_ZERO_BYTES, stream);
    Args a{};
    for (int i = 0; i < NIN; ++i) a.in[i] = (const float*)d_in[i];
    a.out = (float*)d_out; a.ws = (unsigned char*)d_ws;
#if MK_SINGLE
    a.ph_lo = 0; a.ph_hi = NPHASE;
    hipLaunchKernelGGL(fwd_kernel, dim3(grid), dim3(NTHR), LDS_BYTES, stream, a);
#else
    static const int phases[] = {0, 1, 2, 3, 4, 5, 6, 7, 8, 9, 17, 18, 19, 20, 21, 22, 23, 24, 25, 26, 27, 28, 29, 30};
    for (unsigned i = 0; i < sizeof(phases) / sizeof(phases[0]); ++i) { a.ph_lo = phases[i]; a.ph_hi = phases[i] + 1; hipLaunchKernelGGL(fwd_kernel, dim3(grid), dim3(NTHR), LDS_BYTES, stream, a); }
#endif
}
```

```cpp
#include <hip/hip_runtime.h>
#include <cstdio>
#include <cstdint>

#ifndef MK_SINGLE
#define MK_SINGLE 1
#endif

namespace pg8 {
#define PG8_LAS __attribute__((address_space(3)))
typedef unsigned short bf16_t;
typedef short bf16x8 __attribute__((ext_vector_type(8)));
typedef float f32x4 __attribute__((ext_vector_type(4)));
typedef unsigned u32x4 __attribute__((ext_vector_type(4)));
constexpr int BM = 256, BK = 64, HALF = 128, HTB = HALF * BK * 2  , STAGE_BYTES = 8 * HTB, NXCD = 8, WGM = 8;

__host__ __device__ __forceinline__ int lds_byte(int r, int c) { const int st = (r >> 4) * 2 + (c >> 5), rr = r & 15, cc = c & 31, ob = rr * 64 + cc * 2; return st * 1024 + (ob ^ (((ob >> 9) & 1) << 5)); }
__host__ __device__ __forceinline__ void stage_rc(int b, int& R, int& C) { const int st = b / 1024, sb = b % 1024, swz = sb ^ (((sb >> 9) & 1) << 5); R = (st >> 1) * 16 + swz / 64; C = (st & 1) * 32 + (swz % 64) / 2; }
__host__ __device__ __forceinline__ int perm32(int rho) { const int n = rho >> 4, i = rho & 15; return 8 * (i >> 2) + 4 * n + (i & 3); }

struct Unit { int pm, pn, om, on; };
struct Gemm { const bf16_t* A; const bf16_t* Bt; int M, N, K; };

__host__ __device__ __forceinline__ bool tile_order(int i, int G, int c, int nM, int nN, int& pm, int& pn) {
    const int nwg = nM * nN; const long L = (long)i * G + c; if (L >= nwg) return false;
    int wgid = (int)L; { const int q = nwg / NXCD, r = nwg % NXCD, xcd = wgid % NXCD, off = wgid / NXCD; wgid = (xcd < r ? xcd * (q + 1) : r * (q + 1) + (xcd - r) * q) + off; }
    const int nig = WGM * nN, gid = wgid / nig, fm = gid * WGM, gsz = (nM - fm) < WGM ? (nM - fm) : WGM;
    pm = fm + ((wgid % nig) % gsz); pn = (wgid % nig) / gsz; return true;
}
struct StaticOrder {
    int nM, nN, G, c;
    __host__ __device__ void init(int M, int N, int G_, int c_) { nM = M / BM; nN = N / BM; G = G_; c = c_; }
    __host__ __device__ bool next(int i, Unit& u) const { int pm, pn; if (!tile_order(i, G, c, nM, nN, pm, pn)) return false; u.pm = pm; u.pn = pn; u.om = pm; u.on = pn; return true; }
    __device__ __forceinline__ void a_ready(const Unit&) const {}
    __device__ __forceinline__ void done(const Unit&) const {}
};
template <bool A_LOCAL, bool O_LOCAL>
struct MoeOrder {
    int t0, nT, nN, G, c; const PG8_LAS int* te;
    __device__ __forceinline__ bool next(int i, Unit& u) const { int pm, pn; if (!tile_order(i, G, c, nT, nN, pm, pn)) return false;
        const int e = __builtin_amdgcn_readfirstlane(te[t0 + pm]);
        u.pm = A_LOCAL ? pm : t0 + pm; u.pn = e * nN + pn; u.om = O_LOCAL ? pm : t0 + pm; u.on = pn; return true; }
    __device__ __forceinline__ void a_ready(const Unit&) const {}
    __device__ __forceinline__ void done(const Unit&) const {}
};

__device__ __forceinline__ unsigned cvt_pk_bf16(float lo, float hi) { unsigned r; asm volatile("v_cvt_pk_bf16_f32 %0, %1, %2" : "=v"(r) : "v"(lo), "v"(hi)); return r; }

struct EpiStore {
    static constexpr bool PERM = true, AFTER_DRAIN = false;
    bf16_t* O; int ldc;
    __device__ __forceinline__ void operator()(const f32x4 (&acc)[2][2][4][2], const Unit& u, int wr, int wc, int fr, int fq) const {
        const int row0 = u.om * BM + wr * 64 + fr; const int col0 = u.on * BM + wc * 32 + 8 * fq;
#pragma unroll
        for (int ai = 0; ai < 2; ++ai)
#pragma unroll
            for (int m = 0; m < 4; ++m) { bf16_t* rowp = O + (size_t)(row0 + ai * HALF + m * 16) * ldc + col0;
#pragma unroll
                for (int bj = 0; bj < 2; ++bj) { const f32x4 v0 = acc[ai][bj][m][0], v1 = acc[ai][bj][m][1];
                    u32x4 w; w.x = cvt_pk_bf16(v0[0], v0[1]); w.y = cvt_pk_bf16(v0[2], v0[3]); w.z = cvt_pk_bf16(v1[0], v1[1]); w.w = cvt_pk_bf16(v1[2], v1[3]);
                    *(u32x4*)(rowp + bj * HALF) = w; } }
    }
};
__device__ __forceinline__ float silu_f(float x) { return x * __builtin_amdgcn_rcpf(1.0f + __expf(-x)); }
struct EpiSwiglu {
    static constexpr bool PERM = true, AFTER_DRAIN = false;
    bf16_t* O; int ldc;
    __device__ __forceinline__ void operator()(const f32x4 (&acc)[2][2][4][2], const Unit& u, int wr, int wc, int fr, int fq) const {
        const int row0 = u.om * BM + wr * 64 + fr; const int col0 = u.on * HALF + wc * 32 + 8 * fq;
#pragma unroll
        for (int ai = 0; ai < 2; ++ai)
#pragma unroll
            for (int m = 0; m < 4; ++m) { bf16_t* rowp = O + (size_t)(row0 + ai * HALF + m * 16) * ldc + col0;
                const f32x4 g0 = acc[ai][0][m][0], g1 = acc[ai][0][m][1], u0 = acc[ai][1][m][0], u1 = acc[ai][1][m][1];
                u32x4 w;
                w.x = cvt_pk_bf16(silu_f(g0[0]) * u0[0], silu_f(g0[1]) * u0[1]); w.y = cvt_pk_bf16(silu_f(g0[2]) * u0[2], silu_f(g0[3]) * u0[3]);
                w.z = cvt_pk_bf16(silu_f(g1[0]) * u1[0], silu_f(g1[1]) * u1[1]); w.w = cvt_pk_bf16(silu_f(g1[2]) * u1[2], silu_f(g1[3]) * u1[3]);
                *(u32x4*)rowp = w; }
    }
};

template <class Epi, class Sched, bool ALIGN_EPI = false, bool SP2 = false>
__device__ __forceinline__ void gemm_phase(PG8_LAS unsigned char* lds, const Gemm g, const Sched& S, const Epi& E) {
    int tid_ = threadIdx.x; asm volatile("" : "+v"(tid_));
    const int tid = tid_, wid = __builtin_amdgcn_readfirstlane(tid >> 6), lane = tid & 63, wr = wid >> 2, wc = wid & 3, fr = lane & 15, fq = lane >> 4;
    const int K = g.K, nt = K / BK;
    unsigned voffA[2], voffB[2];
#pragma unroll
    for (int i = 0; i < 2; ++i) { int R, C; stage_rc(tid * 16 + i * 8192, R, C); const int Rb = Epi::PERM ? ((R & ~31) + perm32(R & 31)) : R;
        voffA[i] = (unsigned)(R * K + C) * 2u; voffB[i] = (unsigned)(Rb * K + C) * 2u; }
    const size_t kstep = (size_t)(BK * 2);
    const size_t hstep = (size_t)HALF * K * 2;
    const size_t tstep = 2 * hstep;
    const unsigned ldsw = (unsigned)wid * 1024u;
    const int aoff = lds_byte(wr * 64 + fr, fq * 8), boff = lds_byte(wc * 32 + fr, fq * 8);
#define PG8_SA(b, h) (((b) * 2 + (h)) * HTB)
#define PG8_SB(b, h) ((4 + (b) * 2 + (h)) * HTB)
#define PG8_STAGE(bufoff, gbase, voff) do { _Pragma("unroll") for (int _i = 0; _i < 2; ++_i) \
        __builtin_amdgcn_global_load_lds((const unsigned*)((const char*)(gbase) + (voff)[_i]), (PG8_LAS unsigned*)(lds + (bufoff) + ldsw + _i * 8192), 16, 0, 0); } while (0)
#define PG8_LDA(dst, b, h) do { _Pragma("unroll") for (int m = 0; m < 4; ++m) _Pragma("unroll") for (int k = 0; k < 2; ++k) dst[m][k] = *(const PG8_LAS bf16x8*)(lds + PG8_SA(b, h) + aoff + m * 2048 + k * 1024); } while (0)
#define PG8_LDB(dst, b, h) do { _Pragma("unroll") for (int n = 0; n < 2; ++n) _Pragma("unroll") for (int k = 0; k < 2; ++k) dst[n][k] = *(const PG8_LAS bf16x8*)(lds + PG8_SB(b, h) + boff + n * 2048 + k * 1024); } while (0)
#define PG8_MMA(ai, bj, At, Bt) do { __builtin_amdgcn_s_setprio(1); _Pragma("unroll") for (int m = 0; m < 4; ++m) _Pragma("unroll") for (int n = 0; n < 2; ++n) _Pragma("unroll") for (int k = 0; k < 2; ++k) \
        acc[ai][bj][m][n] = __builtin_amdgcn_mfma_f32_16x16x32_bf16(Bt[n][k], At[m][k], acc[ai][bj][m][n], 0, 0, 0); __builtin_amdgcn_s_setprio(0); } while (0)
#define PG8_WAIT_V(n) asm volatile("s_waitcnt vmcnt(" #n ")" ::: "memory")
#define PG8_WAIT_L(n) asm volatile("s_waitcnt lgkmcnt(" #n ")" ::: "memory")
#define PG8_BAR __builtin_amdgcn_s_barrier()
#define PG8_SCHED __builtin_amdgcn_sched_barrier(0)
    Unit cur, nxt; int ui = 0;
    if (!S.next(0, cur)) return;
    f32x4 acc[2][2][4][2];
#pragma unroll
    for (int a = 0; a < 2; ++a)
#pragma unroll
        for (int b = 0; b < 2; ++b)
#pragma unroll
            for (int m = 0; m < 4; ++m)
#pragma unroll
                for (int n = 0; n < 2; ++n) acc[a][b][m][n] = (f32x4){0.f, 0.f, 0.f, 0.f};
    bf16x8 At[4][2], B0[2][2], B1[2][2];
    const char* cA = (const char*)g.A + (size_t)cur.pm * tstep; const char* cB = (const char*)g.Bt + (size_t)cur.pn * tstep;
    S.a_ready(cur);
    if constexpr (SP2) {
        PG8_STAGE(PG8_SB(0, 0), cB, voffB); PG8_STAGE(PG8_SB(0, 1), cB + hstep, voffB); PG8_STAGE(PG8_SA(0, 0), cA, voffA); PG8_STAGE(PG8_SA(0, 1), cA + hstep, voffA);
        if (wr == 1) PG8_BAR;
        PG8_WAIT_V(2); PG8_BAR;
        PG8_STAGE(PG8_SB(1, 0), cB + kstep, voffB); PG8_STAGE(PG8_SA(1, 0), cA + kstep, voffA); PG8_STAGE(PG8_SB(1, 1), cB + hstep + kstep, voffB);
        PG8_WAIT_V(6); PG8_BAR;
    } else {
        PG8_STAGE(PG8_SB(0, 0), cB, voffB); PG8_STAGE(PG8_SA(0, 0), cA, voffA); PG8_STAGE(PG8_SB(0, 1), cB + hstep, voffB); PG8_STAGE(PG8_SA(0, 1), cA + hstep, voffA);
        if (wr == 1) PG8_BAR;
        PG8_WAIT_V(4); PG8_BAR;
        PG8_STAGE(PG8_SB(1, 0), cB + kstep, voffB); PG8_STAGE(PG8_SA(1, 0), cA + kstep, voffA); PG8_STAGE(PG8_SB(1, 1), cB + hstep + kstep, voffB);
        PG8_WAIT_V(6); PG8_BAR;
    }
    for (;;) {
        const bool has_next = S.next(ui + 1, nxt);
        const char* nA = has_next ? (const char*)g.A + (size_t)nxt.pm * tstep : cA; const char* nB = has_next ? (const char*)g.Bt + (size_t)nxt.pn * tstep : cB;
        for (int t = 0; t < nt; t += 2) {
            const bool last = (t == nt - 2);
            const char* a1 = cA + (size_t)(t + 1) * kstep;
            const char* a2 = last ? nA : cA + (size_t)(t + 2) * kstep; const char* b2 = last ? nB : cB + (size_t)(t + 2) * kstep;
            const char* a3 = a2 + kstep; const char* b3 = b2 + kstep;
            if (last && has_next) S.a_ready(nxt);
            if constexpr (SP2) {
            PG8_LDB(B0, 0, 0); PG8_LDB(B1, 0, 1); PG8_SCHED; PG8_LDA(At, 0, 0); PG8_STAGE(PG8_SA(1, 1), a1 + hstep, voffA);
            PG8_WAIT_V(8); PG8_WAIT_L(0); PG8_BAR; PG8_MMA(0, 0, At, B0); PG8_MMA(0, 1, At, B1); PG8_BAR; PG8_SCHED;
            PG8_LDA(At, 0, 1); PG8_STAGE(PG8_SB(0, 0), b2, voffB); PG8_STAGE(PG8_SB(0, 1), b2 + hstep, voffB); PG8_STAGE(PG8_SA(0, 0), a2, voffA);
            PG8_WAIT_V(8); PG8_WAIT_L(0); PG8_BAR; PG8_MMA(1, 0, At, B0); PG8_MMA(1, 1, At, B1); PG8_BAR; PG8_SCHED;
            PG8_LDB(B0, 1, 0); PG8_LDB(B1, 1, 1); PG8_SCHED; PG8_LDA(At, 1, 0); PG8_STAGE(PG8_SA(0, 1), a2 + hstep, voffA);
            PG8_WAIT_V(8); PG8_WAIT_L(0); PG8_BAR; PG8_MMA(0, 0, At, B0); PG8_MMA(0, 1, At, B1); PG8_BAR; PG8_SCHED;
            PG8_LDA(At, 1, 1); PG8_STAGE(PG8_SB(1, 0), b3, voffB); PG8_STAGE(PG8_SB(1, 1), b3 + hstep, voffB); PG8_STAGE(PG8_SA(1, 0), a3, voffA);
            PG8_WAIT_V(8); PG8_WAIT_L(0); PG8_BAR; PG8_MMA(1, 0, At, B0); PG8_MMA(1, 1, At, B1); PG8_BAR; PG8_SCHED;
            } else {
            PG8_LDB(B0, 0, 0); PG8_SCHED; PG8_LDA(At, 0, 0); PG8_STAGE(PG8_SA(1, 1), a1 + hstep, voffA);
            PG8_WAIT_L(8); PG8_BAR; PG8_WAIT_L(0); PG8_MMA(0, 0, At, B0); PG8_BAR; PG8_SCHED;
            PG8_LDB(B1, 0, 1); PG8_STAGE(PG8_SB(0, 0), b2, voffB);
            PG8_BAR; PG8_WAIT_L(0); PG8_MMA(0, 1, At, B1); PG8_BAR;
            PG8_LDA(At, 0, 1); PG8_STAGE(PG8_SA(0, 0), a2, voffA);
            PG8_BAR; PG8_WAIT_L(0); PG8_MMA(1, 0, At, B0); PG8_BAR; PG8_SCHED;
            PG8_STAGE(PG8_SB(0, 1), b2 + hstep, voffB);
            PG8_WAIT_V(6); PG8_BAR; PG8_MMA(1, 1, At, B1); PG8_BAR;
            PG8_LDB(B0, 1, 0); PG8_SCHED; PG8_LDA(At, 1, 0); PG8_STAGE(PG8_SA(0, 1), a2 + hstep, voffA);
            PG8_WAIT_L(8); PG8_BAR; PG8_WAIT_L(0); PG8_MMA(0, 0, At, B0); PG8_BAR; PG8_SCHED;
            PG8_LDB(B1, 1, 1); PG8_STAGE(PG8_SB(1, 0), b3, voffB);
            PG8_BAR; PG8_WAIT_L(0); PG8_MMA(0, 1, At, B1); PG8_BAR;
            PG8_LDA(At, 1, 1); PG8_STAGE(PG8_SA(1, 0), a3, voffA);
            PG8_BAR; PG8_WAIT_L(0); PG8_MMA(1, 0, At, B0); PG8_BAR; PG8_SCHED;
            PG8_STAGE(PG8_SB(1, 1), b3 + hstep, voffB);
            PG8_WAIT_V(6); PG8_BAR; PG8_MMA(1, 1, At, B1); PG8_BAR;
            }
        }
        if constexpr (ALIGN_EPI) { if (wr == 0) PG8_BAR; }
        if constexpr (!Epi::AFTER_DRAIN) { E(acc, cur, wr, wc, fr, fq); S.done(cur); }
        if (!has_next) break;
#pragma unroll
        for (int a = 0; a < 2; ++a)
#pragma unroll
            for (int b = 0; b < 2; ++b)
#pragma unroll
                for (int m = 0; m < 4; ++m)
#pragma unroll
                    for (int n = 0; n < 2; ++n) acc[a][b][m][n] = (f32x4){0.f, 0.f, 0.f, 0.f};
        cur = nxt; cA = nA; cB = nB; ++ui;
        if constexpr (ALIGN_EPI) { if (wr == 1) PG8_BAR; }
    }
    PG8_WAIT_V(0);
    if constexpr (!ALIGN_EPI) { if (wr == 0) PG8_BAR; }
    PG8_BAR;
    if constexpr (Epi::AFTER_DRAIN) { E.fused(acc, cur, wr, wc, fr, fq, lds, wid, lane); S.done(cur); }
#undef PG8_SA
#undef PG8_SB
#undef PG8_STAGE
#undef PG8_LDA
#undef PG8_LDB
#undef PG8_MMA
#undef PG8_WAIT_V
#undef PG8_WAIT_L
#undef PG8_BAR
#undef PG8_SCHED
}
}

#define GAS __attribute__((address_space(1)))
#define LAS __attribute__((address_space(3)))
typedef unsigned short bf16;
typedef unsigned v4u __attribute__((ext_vector_type(4)));
typedef unsigned v2u __attribute__((ext_vector_type(2)));
typedef float f32x4 __attribute__((ext_vector_type(4)));
typedef float f32x2 __attribute__((ext_vector_type(2)));
typedef short bf16x8 __attribute__((ext_vector_type(8)));
typedef short v4i16 __attribute__((ext_vector_type(4)));
typedef GAS unsigned gu32;
#define RLX_AGENT __ATOMIC_RELAXED, __HIP_MEMORY_SCOPE_AGENT
#define LDS_WAIT() asm volatile("s_waitcnt lgkmcnt(0)" ::: "memory")
#define VM_WAIT() asm volatile("s_waitcnt vmcnt(0)" ::: "memory")
__device__ __forceinline__ unsigned pk2(float lo, float hi) { return pg8::cvt_pk_bf16(lo, hi); }
__device__ __forceinline__ float bflo(unsigned u) { return __uint_as_float(u << 16); }
__device__ __forceinline__ float bfhi(unsigned u) { return __uint_as_float(u & 0xffff0000u); }
__device__ __forceinline__ float wave_sum(float v) {
#pragma unroll
    for (int o = 1; o < 64; o <<= 1) v += __shfl_xor(v, o);
    return v;
}
__device__ __forceinline__ f32x4 mfma16(bf16x8 a, bf16x8 b, f32x4 c) { return __builtin_amdgcn_mfma_f32_16x16x32_bf16(a, b, c, 0, 0, 0); }
__device__ __forceinline__ v4i16 trrd(LAS unsigned char* p) { return __builtin_amdgcn_ds_read_tr16_b64_v4i16((LAS v4i16*)p); }
__device__ __forceinline__ bf16x8 cat8(v4i16 lo, v4i16 hi) { return (bf16x8){lo[0], lo[1], lo[2], lo[3], hi[0], hi[1], hi[2], hi[3]}; }
__device__ __forceinline__ bf16x8 pack8(float a0, float a1, float a2, float a3, float a4, float a5, float a6, float a7) {
    v4u w; w.x = pk2(a0, a1); w.y = pk2(a2, a3); w.z = pk2(a4, a5); w.w = pk2(a6, a7); return __builtin_bit_cast(bf16x8, w); }
__device__ __forceinline__ float silu(float x) { return x * __builtin_amdgcn_rcpf(1.0f + __expf(-x)); }

#define XB_TMO      128
#define XB_XCNT(j)  (256  + 64 * (j))
#define XB_XSUB(j)  (1280 + 64 * (j))
#define XB_XGEN(j)  (2304 + 64 * (j))
#define XB_TOP      3328
#define XB_TOPGEN   3392
#define XCD_BAR_WORDS 3456
#define XB_SPIN_CAP (1u << 18)

__device__ __forceinline__ unsigned xb_ld(unsigned* p)              { return __hip_atomic_load(p, __ATOMIC_RELAXED, __HIP_MEMORY_SCOPE_AGENT); }
__device__ __forceinline__ unsigned xb_add(unsigned* p, unsigned v) { return __hip_atomic_fetch_add(p, v, __ATOMIC_RELAXED, __HIP_MEMORY_SCOPE_AGENT); }
__device__ __forceinline__ unsigned xb_xcc_id() { return (unsigned)__builtin_amdgcn_s_getreg((3 << 11) | 20) & 0xFu; }
#define XB_SPIN(cond, bar) do { unsigned _sp = 0; while (cond) { __builtin_amdgcn_s_sleep(1); \
    if ((++_sp & 255u) == 0u) { if (xb_ld(&(bar)[XB_TMO])) break; if (_sp > XB_SPIN_CAP) { atomicAdd(&(bar)[XB_TMO], 1u); break; } } } } while (0)

struct XcdBarrier {
    unsigned* bar; unsigned x;
    volatile LAS unsigned* st;
};

__device__ __forceinline__ XcdBarrier xcd_barrier_post(unsigned* bar, volatile LAS unsigned* st) {
    XcdBarrier b; b.bar = bar; b.x = xb_xcc_id(); b.st = st;
    if (threadIdx.x == 0) (void)xb_add(&bar[XB_XCNT(b.x)], 1u);
    return b;
}
__device__ __forceinline__ void xcd_barrier_complete(unsigned* bar, unsigned x, unsigned& nloc, unsigned& nx) {
    const unsigned G = gridDim.x * gridDim.y * gridDim.z;
    unsigned sum, cnt, mine, sp = 0u;
    for (;;) {
        sum = 0u; cnt = 0u; mine = 0u;
#pragma unroll
        for (unsigned j = 0; j < 16; ++j) { const unsigned c = xb_ld(&bar[XB_XCNT(j)]); sum += c; cnt += (c > 0u) ? 1u : 0u; mine = (j == x) ? c : mine; }
        if (sum == G) break;
        __builtin_amdgcn_s_sleep(1);
        if ((++sp & 255u) == 0u) { if (xb_ld(&bar[XB_TMO])) break; if (sp > XB_SPIN_CAP) { atomicAdd(&bar[XB_TMO], 1u); break; } }
    }
    nloc = mine > 0u ? mine : 1u; nx = cnt > 0u ? cnt : 1u;
}

__device__ __forceinline__ void xcd_barrier(const XcdBarrier& b) {
    asm volatile("s_waitcnt vmcnt(0)" ::: "memory");
    __syncthreads();
    if (threadIdx.x == 0) {
        unsigned* bar = b.bar;
        __builtin_amdgcn_s_waitcnt(0);
        unsigned nloc = b.st[0], nx = b.st[1];
        if (nloc == 0u) { xcd_barrier_complete(bar, b.x, nloc, nx); b.st[0] = nloc; b.st[1] = nx; }
        const unsigned old = xb_add(&bar[XB_XSUB(b.x)], 1u);
        const unsigned gen = old / nloc;
        if (old + 1u == (gen + 1u) * nloc) {
            __builtin_amdgcn_fence(__ATOMIC_RELEASE, "agent");
            asm volatile("s_waitcnt vmcnt(0)" ::: "memory");
            const unsigned og = xb_add(&bar[XB_TOP], 1u);
            const unsigned tg = og / nx;
            if (og + 1u == (tg + 1u) * nx) xb_add(&bar[XB_TOPGEN], 1u);
            else XB_SPIN(xb_ld(&bar[XB_TOPGEN]) == tg, bar);
            __builtin_amdgcn_fence(__ATOMIC_ACQUIRE, "agent");
            xb_add(&bar[XB_XGEN(b.x)], 1u);
            asm volatile("s_waitcnt vmcnt(0)" ::: "memory");
        } else {
            XB_SPIN(xb_ld(&bar[XB_XGEN(b.x)]) == gen, bar);
            __builtin_amdgcn_fence(__ATOMIC_ACQUIRE, "agent");
            asm volatile("s_waitcnt vmcnt(0)" ::: "memory");
        }
    }
    __syncthreads();
}

constexpr int NWAVES = 8, NTHR = 512;
constexpr int D = 1024, SEQ = 8192, NBATCH = 4, M = NBATCH * SEQ, NCHUNK = SEQ / 64;
constexpr int DIN = 2824, PN = 2816;
constexpr int PC_Z = 0, PC_XBC = 512, PC_U = 1536, PC_V = 1792, PC_Q = 2048, PC_K = 2304, PC_VV = 2560;
constexpr int DFF = 2816, DFFE = 3584, NEXP = 8;
constexpr int MOE_CH = 64, MOE_NCH = 4, MOE_MAXT = 264;
constexpr int NIN = 27;
constexpr size_t MiB = 1u << 20;
constexpr size_t WS_CTL = 0, CTL_ZERO_BYTES = 65536;
constexpr size_t WS_AEND = 65536, WS_WGCNT = 98304;
constexpr size_t WS_DTRAW = 1 * MiB, WS_TOKE = 2 * MiB, WS_TOKG = 2 * MiB + 262144, WS_POS = 2 * MiB + 524288;
constexpr size_t WS_WIN = 4 * MiB, WS_WOUT = 15 * MiB, WS_WGU = 19 * MiB, WS_WD = 30 * MiB;
constexpr size_t WS_A1 = 36 * MiB, WS_XBCC = 36 * MiB;
constexpr size_t WS_PROJ = 100 * MiB, WS_MIXED = 100 * MiB, WS_H1 = 100 * MiB;
constexpr size_t WS_ST = 276 * MiB, WS_FOUT = 276 * MiB;
constexpr size_t WS_Y = 404 * MiB;
constexpr size_t WS_HM = 36 * MiB, WS_XS = 190 * MiB, WS_MWGU = 322 * MiB, WS_MWD = 434 * MiB, WS_END = 490 * MiB;
constexpr int CW_BAR = 4096;
constexpr int LDS_BYTES = 163840, LDSCTL_OFF = 147456;
constexpr int CTL_MISC = LDSCTL_OFF, CTL_CNT = LDSCTL_OFF + 128, CTL_TE = LDSCTL_OFF + 512;

#ifndef PROBE_DUP
#define PROBE_DUP 0
#endif
#define REP(n) for (int rep_ = 0; rep_ < (((PROBE_DUP >> (n)) & 1) ? 2 : 1); ++rep_)
struct Args { const float* in[NIN]; float* out; unsigned char* ws; int ph_lo, ph_hi; };

struct Frame {
    LAS unsigned char* lds;
    int tid, lane, wave, vcu, G;
};
__device__ __forceinline__ bool fresh(Frame& F) { int t_ = threadIdx.x; asm volatile("" : "+v"(t_)); F.tid = t_; F.lane = t_ & 63; F.wave = __builtin_amdgcn_readfirstlane(t_ >> 6); return true; }

__device__ __forceinline__ void cvt_task(const float* W, int N, int k0, int n0, bf16* WT, int K, int row0, int lane) {
    const float* s = W + (size_t)k0 * N + n0 + lane;
    bf16* d = WT + (size_t)(row0 + lane) * K + k0;
#pragma unroll
    for (int hb = 0; hb < 2; ++hb) {
        float v[32];
#pragma unroll
        for (int j = 0; j < 32; ++j) v[j] = s[(size_t)(32 * hb + j) * N];
#pragma unroll
        for (int q = 0; q < 4; ++q) { v4u o; o.x = pk2(v[8 * q], v[8 * q + 1]); o.y = pk2(v[8 * q + 2], v[8 * q + 3]); o.z = pk2(v[8 * q + 4], v[8 * q + 5]); o.w = pk2(v[8 * q + 6], v[8 * q + 7]);
            *(GAS v4u*)(d + 32 * hb + 8 * q) = o; }
    }
}
__device__ __forceinline__ void cvt_small_weights(Frame& F, const Args& A) {
    const int gw = F.vcu * NWAVES + F.wave, NGW = F.G * NWAVES;
    bf16* WIN = (bf16*)(A.ws + WS_WIN); bf16* WOUT = (bf16*)(A.ws + WS_WOUT); bf16* WGU = (bf16*)(A.ws + WS_WGU); bf16* WD = (bf16*)(A.ws + WS_WD);
    constexpr int NI = 1408 + 512 + 1408 + 704;
    for (int it = gw; it < NI; it += NGW) {
        int r = it;
        if (r < 1408) { const int L = r / 704; r %= 704; const int kb = r / 44, nb = r % 44; const int ns = 64 * nb + (64 * nb >= 1536 ? 8 : 0);
            cvt_task(A.in[5] + (size_t)L * D * DIN, DIN, 64 * kb, ns, WIN + (size_t)L * PN * D, D, 64 * nb, F.lane); continue; }
        r -= 1408;
        if (r < 512) { const int L = r / 256; r %= 256; const int kb = r / 16, nb = r % 16;
            cvt_task(A.in[19] + (size_t)L * D * D, D, 64 * kb, 64 * nb, WOUT + (size_t)L * D * D, D, 64 * nb, F.lane); continue; }
        r -= 512;
        if (r < 1408) { const int up = r / 704; r %= 704; const int kb = r / 44, nb = r % 44;
            cvt_task(up ? A.in[21] : A.in[20], DFF, 64 * kb, 64 * nb, WGU, D, 256 * (nb >> 1) + 64 * (nb & 1) + 128 * up, F.lane); continue; }
        r -= 1408;
        { const int kb = r / 16, nb = r % 16; cvt_task(A.in[22], D, 64 * kb, 64 * nb, WD, DFF, 64 * nb, F.lane); }
    }
}
__device__ __forceinline__ void cvt_moe_weights(Frame& F, const Args& A) {
    const int gw = F.vcu * NWAVES + F.wave, NGW = F.G * NWAVES;
    bf16* MWGU = (bf16*)(A.ws + WS_MWGU); bf16* MWD = (bf16*)(A.ws + WS_MWD);
    constexpr int NI = 14336 + 7168;
    for (int it = gw; it < NI; it += NGW) {
        int r = it;
        if (r < 14336) { const int ue = r / 896; r %= 896; const int up = ue >> 3, e = ue & 7; const int kb = r / 56, nb = r % 56;
            cvt_task((up ? A.in[25] : A.in[24]) + (size_t)e * D * DFFE, DFFE, 64 * kb, 64 * nb, MWGU + (size_t)e * 7168 * D, D, 256 * (nb >> 1) + 64 * (nb & 1) + 128 * up, F.lane); continue; }
        r -= 14336;
        { const int e = r / 896; r %= 896; const int kb = r / 16, nb = r % 16;
          cvt_task(A.in[26] + (size_t)e * DFFE * D, D, 64 * kb, 64 * nb, MWD + (size_t)e * D * DFFE, DFFE, 64 * nb, F.lane); }
    }
}

struct RowArgs {
    const float* hsrc; float* hdst;
    int branch;
    const bf16* ybuf; const float* gpost;
    const float* gpre; bf16* a1;
    int proj;
    const float* w8; int w8ld;
};
__device__ __forceinline__ void row_phase(Frame& F, const Args& A, const RowArgs& R) {
    LAS float* W8T = (LAS float*)F.lds;
    LAS int* cnt = (LAS int*)(F.lds + CTL_CNT);
    const int lane = F.lane;
    if (R.proj) { for (int idx = F.tid; idx < 8192; idx += NTHR) { const int e = idx & 7, k = idx >> 3; W8T[e * 1024 + k] = R.w8[(size_t)k * R.w8ld + e]; } }
    if (R.proj == 2 && F.tid < 8) cnt[F.tid] = 0;
    __syncthreads();
    f32x4 gpo[4], gpr[4];
#pragma unroll
    for (int j = 0; j < 4; ++j) { gpo[j] = R.branch ? *(const f32x4*)(R.gpost + 4 * lane + 256 * j) : (f32x4){0.f, 0.f, 0.f, 0.f}; gpr[j] = R.gpre ? *(const f32x4*)(R.gpre + 4 * lane + 256 * j) : (f32x4){0.f, 0.f, 0.f, 0.f}; }
    float* DTRAW = (float*)(A.ws + WS_DTRAW); int* TOKE = (int*)(A.ws + WS_TOKE); float* TOKG = (float*)(A.ws + WS_TOKG); const int* POS = (const int*)(A.ws + WS_POS);
    const int gw = F.vcu * NWAVES + F.wave, NGW = F.G * NWAVES;
    for (int m = gw; m < M; m += NGW) {
        f32x4 v[4];
#pragma unroll
        for (int j = 0; j < 4; ++j) v[j] = *(const f32x4*)(R.hsrc + (size_t)m * D + 4 * lane + 256 * j);
        if (R.branch) {
            f32x4 y[4];
            if (R.branch == 1) {
#pragma unroll
                for (int j = 0; j < 4; ++j) { const v2u raw = *(const v2u*)(R.ybuf + (size_t)m * D + 4 * lane + 256 * j); y[j] = (f32x4){bflo(raw.x), bfhi(raw.x), bflo(raw.y), bfhi(raw.y)}; }
            } else {
                const int p0 = POS[2 * m], p1 = POS[2 * m + 1]; const float g0 = TOKG[2 * m], g1 = TOKG[2 * m + 1];
#pragma unroll
                for (int j = 0; j < 4; ++j) { const v2u r0 = *(const v2u*)(R.ybuf + (size_t)p0 * D + 4 * lane + 256 * j); const v2u r1 = *(const v2u*)(R.ybuf + (size_t)p1 * D + 4 * lane + 256 * j);
                    y[j] = (f32x4){g0 * bflo(r0.x) + g1 * bflo(r1.x), g0 * bfhi(r0.x) + g1 * bfhi(r1.x), g0 * bflo(r0.y) + g1 * bflo(r1.y), g0 * bfhi(r0.y) + g1 * bfhi(r1.y)}; }
            }
            float ss = 0.f;
#pragma unroll
            for (int j = 0; j < 4; ++j) ss += (y[j].x * y[j].x + y[j].y * y[j].y) + (y[j].z * y[j].z + y[j].w * y[j].w);
            const float sc = 1.0f / sqrtf(wave_sum(ss) * (1.0f / D) + 1e-6f);
#pragma unroll
            for (int j = 0; j < 4; ++j) v[j] = v[j] + y[j] * sc * gpo[j];
        }
        if (R.hdst) {
#pragma unroll
            for (int j = 0; j < 4; ++j) *(f32x4*)(R.hdst + (size_t)m * D + 4 * lane + 256 * j) = v[j];
        }
        if (R.gpre) {
            float ss = 0.f;
#pragma unroll
            for (int j = 0; j < 4; ++j) ss += (v[j].x * v[j].x + v[j].y * v[j].y) + (v[j].z * v[j].z + v[j].w * v[j].w);
            const float sc = 1.0f / sqrtf(wave_sum(ss) * (1.0f / D) + 1e-6f);
#pragma unroll
            for (int j = 0; j < 4; ++j) { v[j] = v[j] * sc * gpr[j]; v2u o; o.x = pk2(v[j].x, v[j].y); o.y = pk2(v[j].z, v[j].w); *(v2u*)(R.a1 + (size_t)m * D + 4 * lane + 256 * j) = o; }
            if (R.proj) {
                float p[8];
#pragma unroll
                for (int e = 0; e < 8; ++e) { float s = 0.f;
#pragma unroll
                    for (int j = 0; j < 4; ++j) { const f32x4 w = *(const LAS f32x4*)(W8T + e * 1024 + 4 * lane + 256 * j); s += (v[j].x * w.x + v[j].y * w.y) + (v[j].z * w.z + v[j].w * w.w); }
                    p[e] = wave_sum(s); }
                if (R.proj == 1) {
                    float mine = p[0];
#pragma unroll
                    for (int e = 1; e < 8; ++e) mine = (lane == e) ? p[e] : mine;
                    if (lane < 8) DTRAW[(size_t)m * 8 + lane] = mine;
                } else {
                    float best = p[0]; int bi = 0;
#pragma unroll
                    for (int e = 1; e < 8; ++e) if (p[e] > best) { best = p[e]; bi = e; }
                    float sb = -3.0e38f; int si = 0;
#pragma unroll
                    for (int e = 0; e < 8; ++e) if (e != bi && p[e] > sb) { sb = p[e]; si = e; }
                    const float g0 = 1.0f / (1.0f + expf(sb - best)), g1 = 1.0f - g0;
                    if (lane == 0) { TOKE[2 * m] = bi; TOKE[2 * m + 1] = si; TOKG[2 * m] = g0; TOKG[2 * m + 1] = g1;
                        __hip_atomic_fetch_add(cnt + bi, 1, __ATOMIC_RELAXED, __HIP_MEMORY_SCOPE_WORKGROUP); __hip_atomic_fetch_add(cnt + si, 1, __ATOMIC_RELAXED, __HIP_MEMORY_SCOPE_WORKGROUP); }
                }
            }
        }
    }
    if (R.proj == 2) { __syncthreads(); if (F.tid < 8) ((int*)(A.ws + WS_WGCNT))[F.vcu * 8 + F.tid] = cnt[F.tid]; }
    __syncthreads();
}

__device__ __forceinline__ void moe_tables(Frame& F, const Args& A) {
    LAS int* c = (LAS int*)(F.lds + CTL_CNT); LAS int* te = (LAS int*)(F.lds + CTL_TE);
    if (F.tid < 40) c[F.tid] = 0;
    __syncthreads();
    const int* WGCNT = (const int*)(A.ws + WS_WGCNT);
    for (int idx = F.tid; idx < F.G * 8; idx += NTHR) { const int wg = idx >> 3, e = idx & 7; const int v = WGCNT[idx];
        __hip_atomic_fetch_add(c + e, v, __ATOMIC_RELAXED, __HIP_MEMORY_SCOPE_WORKGROUP); if (wg < F.vcu) __hip_atomic_fetch_add(c + 8 + e, v, __ATOMIC_RELAXED, __HIP_MEMORY_SCOPE_WORKGROUP); }
    __syncthreads();
    if (F.tid == 0) { int t = 0; for (int e = 0; e < 8; ++e) { c[16 + e] = t * 256; const int n = (c[e] + 255) >> 8; for (int j = 0; j < n && t + j < MOE_MAXT; ++j) te[t + j] = e; t += n; } c[32] = t < MOE_MAXT ? t : MOE_MAXT; }
    __syncthreads();
}
__device__ __forceinline__ void moe_gather(Frame& F, const Args& A) {
    LAS int* c = (LAS int*)(F.lds + CTL_CNT);
    const int* TOKE = (const int*)(A.ws + WS_TOKE); int* POS = (int*)(A.ws + WS_POS);
    const bf16* A1 = (const bf16*)(A.ws + WS_A1); bf16* XS = (bf16*)(A.ws + WS_XS);
    const int gw = F.vcu * NWAVES + F.wave, NGW = F.G * NWAVES, lane = F.lane;
    for (int m = gw; m < M; m += NGW) {
        int d0 = 0, d1 = 0;
        if (lane == 0) { const int e0 = TOKE[2 * m], e1 = TOKE[2 * m + 1];
            d0 = c[16 + e0] + c[8 + e0] + __hip_atomic_fetch_add(c + 24 + e0, 1, __ATOMIC_RELAXED, __HIP_MEMORY_SCOPE_WORKGROUP);
            d1 = c[16 + e1] + c[8 + e1] + __hip_atomic_fetch_add(c + 24 + e1, 1, __ATOMIC_RELAXED, __HIP_MEMORY_SCOPE_WORKGROUP);
            POS[2 * m] = d0; POS[2 * m + 1] = d1; }
        d0 = __builtin_amdgcn_readfirstlane(d0); d1 = __builtin_amdgcn_readfirstlane(d1);
        const v4u r0 = *(const v4u*)(A1 + (size_t)m * D + 8 * lane), r1 = *(const v4u*)(A1 + (size_t)m * D + 512 + 8 * lane);
        *(v4u*)(XS + (size_t)d0 * D + 8 * lane) = r0; *(v4u*)(XS + (size_t)d0 * D + 512 + 8 * lane) = r1;
        *(v4u*)(XS + (size_t)d1 * D + 8 * lane) = r0; *(v4u*)(XS + (size_t)d1 * D + 512 + 8 * lane) = r1;
    }
    __syncthreads();
}

__device__ __forceinline__ void gmlp_unit(Frame& F, const Args& A, int L, int nb) {
    LAS unsigned char* Ls = F.lds; const int lane = F.lane, w = F.wave, fr = lane & 15, q4 = lane >> 4;
    const size_t m0 = (size_t)nb * 128;
    const bf16* P = (const bf16*)(A.ws + WS_PROJ); bf16* Y = (bf16*)(A.ws + WS_Y);
    { const f32x4 g4 = *(const f32x4*)(A.in[12] + L * 256 + 4 * lane), b4 = *(const f32x4*)(A.in[13] + L * 256 + 4 * lane);
#pragma unroll 2
      for (int i = 0; i < 16; ++i) { const int r = 16 * w + i;
        const v2u raw = *(const v2u*)(P + (m0 + r) * PN + PC_V + 4 * lane);
        f32x4 v = (f32x4){bflo(raw.x), bfhi(raw.x), bflo(raw.y), bfhi(raw.y)};
        const float mu = wave_sum((v.x + v.y) + (v.z + v.w)) * (1.0f / 256.0f);
        v = v - mu;
        const float var = wave_sum((v.x * v.x + v.y * v.y) + (v.z * v.z + v.w * v.w)) * (1.0f / 256.0f);
        const float rstd = 1.0f / sqrtf(var + 1e-5f);
        v = v * rstd * g4 + b4;
        v2u o; o.x = pk2(v.x, v.y); o.y = pk2(v.z, v.w);
        *(LAS v2u*)(Ls + r * 544 + lane * 8) = o; } }
    __syncthreads();
    const int g = w & 3;
    f32x4 acc[4][4];
    const float* Wg = A.in[14] + (size_t)(L * 4 + g) * 128 * 128;
    const float* bsg = A.in[15] + (size_t)(L * 4 + g) * 128;
#pragma unroll
    for (int pi = 0; pi < 4; ++pi) {
        const int it = (w >> 2) == 0 ? (pi == 0 ? 0 : pi == 1 ? 7 : pi == 2 ? 1 : 6) : (pi == 0 ? 2 : pi == 1 ? 5 : pi == 2 ? 3 : 4);
#pragma unroll
        for (int ct = 0; ct < 4; ++ct) acc[pi][ct] = (f32x4){0.f, 0.f, 0.f, 0.f};
        const int t = 16 * it + fr, nks = (it >> 1) + 1;
        for (int ks = 0; ks < nks; ++ks) {
            const int sA = 32 * ks + 4 * q4, sB = sA + 16;
            const f32x4 wa = *(const f32x4*)(Wg + t * 128 + sA), wb = *(const f32x4*)(Wg + t * 128 + sB);
            const bf16x8 xf = pack8(sA + 0 <= t ? wa.x : 0.f, sA + 1 <= t ? wa.y : 0.f, sA + 2 <= t ? wa.z : 0.f, sA + 3 <= t ? wa.w : 0.f,
                                    sB + 0 <= t ? wb.x : 0.f, sB + 1 <= t ? wb.y : 0.f, sB + 2 <= t ? wb.z : 0.f, sB + 3 <= t ? wb.w : 0.f);
#pragma unroll
            for (int ct = 0; ct < 4; ++ct) { const int col = g * 64 + ct * 16 + 4 * (lane & 3);
                const v4i16 lo = trrd(Ls + (sA + (fr >> 2)) * 544 + col * 2), hi = trrd(Ls + (sB + (fr >> 2)) * 544 + col * 2);
                acc[pi][ct] = mfma16(xf, cat8(lo, hi), acc[pi][ct]); }
        }
#pragma unroll
        for (int r = 0; r < 4; ++r) { const float bs = bsg[16 * it + 4 * q4 + r];
#pragma unroll
            for (int ct = 0; ct < 4; ++ct) acc[pi][ct][r] += bs; }
    }
    __syncthreads();
#pragma unroll
    for (int pi = 0; pi < 4; ++pi) {
        const int it = (w >> 2) == 0 ? (pi == 0 ? 0 : pi == 1 ? 7 : pi == 2 ? 1 : 6) : (pi == 0 ? 2 : pi == 1 ? 5 : pi == 2 ? 3 : 4);
#pragma unroll
        for (int ct = 0; ct < 4; ++ct)
#pragma unroll
            for (int r = 0; r < 4; ++r) *(LAS float*)(Ls + (16 * it + 4 * q4 + r) * 1040 + (g * 64 + ct * 16 + fr) * 4) = acc[pi][ct][r];
    }
    __syncthreads();
    { const f32x4 gn = *(const f32x4*)(A.in[16] + L * 256 + 4 * lane);
#pragma unroll 2
      for (int i = 0; i < 16; ++i) { const int r = 16 * w + i;
        const f32x4 mx = *(const LAS f32x4*)(Ls + r * 1040 + lane * 16);
        const v2u raw = *(const v2u*)(P + (m0 + r) * PN + PC_U + 4 * lane);
        f32x4 v = (f32x4){bflo(raw.x), bfhi(raw.x), bflo(raw.y), bfhi(raw.y)} * mx;
        const float ss = wave_sum((v.x * v.x + v.y * v.y) + (v.z * v.z + v.w * v.w)) * (1.0f / 256.0f);
        v = v * (1.0f / sqrtf(ss + 1e-6f)) * gn;
        v2u o; o.x = pk2(v.x, v.y); o.y = pk2(v.z, v.w);
        *(v2u*)(Y + (m0 + r) * D + 512 + 4 * lane) = o; } }
    __syncthreads();
}

__device__ __forceinline__ void attn_unit(Frame& F, const Args& A, int L, int bc) {
    LAS unsigned char* Ls = F.lds; const int lane = F.lane, w = F.wave, fr = lane & 15, q4 = lane >> 4;
    const int b = bc >> 7, c = bc & 127; const size_t m0 = (size_t)b * SEQ + (size_t)c * 64;
    const bf16* P = (const bf16*)(A.ws + WS_PROJ); bf16* Y = (bf16*)(A.ws + WS_Y);
    const int h = w >> 1, qh = w & 1;
    LAS unsigned char* Vb = Ls + w * 10240;
    const float* bias = A.in[17] + (size_t)(L * 4 + h) * 257;
    bf16x8 qf[2][2];
#pragma unroll
    for (int qb = 0; qb < 2; ++qb)
#pragma unroll
        for (int ks = 0; ks < 2; ++ks) qf[qb][ks] = *(const bf16x8*)(P + (m0 + 32 * qh + 16 * qb + fr) * PN + PC_Q + h * 64 + 32 * ks + 8 * q4);
    f32x4 o[4][2];
#pragma unroll
    for (int dt = 0; dt < 4; ++dt) { o[dt][0] = (f32x4){0.f, 0.f, 0.f, 0.f}; o[dt][1] = (f32x4){0.f, 0.f, 0.f, 0.f}; }
    float mrun[2] = {-1e30f, -1e30f}, lrun[2] = {0.f, 0.f};
    const int jmin = c >= 8 ? 0 : 8 - c;
    for (int j = jmin; j <= 8; ++j) {
        const size_t kr0 = m0 - (size_t)(8 - j) * 64;
#pragma unroll
        for (int i = 0; i < 8; ++i) { const int row = i * 8 + (lane >> 3), ch = lane & 7;
            const v4u v = *(const v4u*)(P + (kr0 + row) * PN + PC_VV + h * 64 + ch * 8); *(LAS v4u*)(Vb + row * 160 + ch * 16) = v; }
        f32x4 st[4][2];
#pragma unroll
        for (int kt = 0; kt < 4; ++kt) { st[kt][0] = (f32x4){0.f, 0.f, 0.f, 0.f}; st[kt][1] = (f32x4){0.f, 0.f, 0.f, 0.f};
#pragma unroll
            for (int ks = 0; ks < 2; ++ks) { const bf16x8 kf = *(const bf16x8*)(P + (kr0 + 16 * kt + fr) * PN + PC_K + h * 64 + 32 * ks + 8 * q4);
                st[kt][0] = mfma16(kf, qf[0][ks], st[kt][0]); st[kt][1] = mfma16(kf, qf[1][ks], st[kt][1]); } }
#pragma unroll
        for (int qb = 0; qb < 2; ++qb) {
            const int qpos = 32 * qh + 16 * qb + fr; float mx = -1e30f;
#pragma unroll
            for (int kt = 0; kt < 4; ++kt)
#pragma unroll
                for (int r = 0; r < 4; ++r) { const int key = 16 * kt + 4 * q4 + r; int rel = 512 - 64 * j + qpos - key; rel = rel < -128 ? -128 : (rel > 128 ? 128 : rel);
                    const float s = st[kt][qb][r] * 0.125f + bias[rel + 128]; st[kt][qb][r] = s; mx = fmaxf(mx, s); }
            mx = fmaxf(mx, __shfl_xor(mx, 16)); mx = fmaxf(mx, __shfl_xor(mx, 32));
            const float mnew = fmaxf(mrun[qb], mx), alpha = __expf(mrun[qb] - mnew); mrun[qb] = mnew;
            float rs = 0.f;
#pragma unroll
            for (int kt = 0; kt < 4; ++kt)
#pragma unroll
                for (int r = 0; r < 4; ++r) { const float p = __expf(st[kt][qb][r] - mnew); st[kt][qb][r] = p; rs += p; }
            rs += __shfl_xor(rs, 16); rs += __shfl_xor(rs, 32);
            lrun[qb] = lrun[qb] * alpha + rs;
#pragma unroll
            for (int dt = 0; dt < 4; ++dt) o[dt][qb] = o[dt][qb] * alpha;
        }
#pragma unroll
        for (int kk = 0; kk < 2; ++kk) {
            const bf16x8 y0 = pack8(st[2 * kk][0][0], st[2 * kk][0][1], st[2 * kk][0][2], st[2 * kk][0][3], st[2 * kk + 1][0][0], st[2 * kk + 1][0][1], st[2 * kk + 1][0][2], st[2 * kk + 1][0][3]);
            const bf16x8 y1 = pack8(st[2 * kk][1][0], st[2 * kk][1][1], st[2 * kk][1][2], st[2 * kk][1][3], st[2 * kk + 1][1][0], st[2 * kk + 1][1][1], st[2 * kk + 1][1][2], st[2 * kk + 1][1][3]);
            const int rowA = 32 * kk + 4 * q4 + (fr >> 2), rowB = rowA + 16;
#pragma unroll
            for (int dt = 0; dt < 4; ++dt) { const int cb = (16 * dt + 4 * (lane & 3)) * 2;
                const bf16x8 xf = cat8(trrd(Vb + rowA * 160 + cb), trrd(Vb + rowB * 160 + cb));
                o[dt][0] = mfma16(xf, y0, o[dt][0]); o[dt][1] = mfma16(xf, y1, o[dt][1]); }
        }
    }
    const float il0 = 1.0f / lrun[0], il1 = 1.0f / lrun[1];
    __syncthreads();
#pragma unroll
    for (int dt = 0; dt < 4; ++dt) {
        *(LAS f32x4*)(Ls + (32 * qh + fr) * 1040 + (h * 64 + 16 * dt + 4 * q4) * 4) = o[dt][0] * il0;
        *(LAS f32x4*)(Ls + (32 * qh + 16 + fr) * 1040 + (h * 64 + 16 * dt + 4 * q4) * 4) = o[dt][1] * il1; }
    __syncthreads();
    { const f32x4 gn = *(const f32x4*)(A.in[18] + L * 256 + 4 * lane);
#pragma unroll 2
      for (int i = 0; i < 8; ++i) { const int r = 8 * w + i;
        f32x4 v = *(const LAS f32x4*)(Ls + r * 1040 + lane * 16);
        const float ss = wave_sum((v.x * v.x + v.y * v.y) + (v.z * v.z + v.w * v.w)) * (1.0f / 256.0f);
        v = v * (1.0f / sqrtf(ss + 1e-6f)) * gn;
        v2u ov; ov.x = pk2(v.x, v.y); ov.y = pk2(v.z, v.w);
        *(v2u*)(Y + (m0 + r) * D + 768 + 4 * lane) = ov; } }
    __syncthreads();
}

__device__ __forceinline__ void ssd_prepass(Frame& F, const Args& A, int L, size_t m0, LAS float* dtl, LAS float* acs) {
    const float* DTRAW = (const float*)(A.ws + WS_DTRAW);
    if (F.wave == 0) { const int l = F.lane;
        const f32x4 r0 = *(const f32x4*)(DTRAW + (m0 + l) * 8), r1 = *(const f32x4*)(DTRAW + (m0 + l) * 8 + 4);
        const float raw[8] = {r0.x, r0.y, r0.z, r0.w, r1.x, r1.y, r1.z, r1.w};
#pragma unroll
        for (int h = 0; h < 8; ++h) { const float x = raw[h] + A.in[8][L * 8 + h];
            const float dt = x > 20.f ? x : log1pf(expf(x));
            float s = -dt * expf(A.in[9][L * 8 + h]);
#pragma unroll
            for (int o = 1; o < 64; o <<= 1) { const float t = __shfl_up(s, o); s += (l >= o) ? t : 0.f; }
            dtl[l * 8 + h] = dt; acs[l * 8 + h] = s; } }
    __syncthreads();
}
__device__ __forceinline__ void ssd1_unit(Frame& F, const Args& A, int L, int bc) {
    LAS unsigned char* Ls = F.lds; const int lane = F.lane, w = F.wave, fr = lane & 15, q4 = lane >> 4;
    const int b = bc >> 7, c = bc & 127; const size_t m0 = (size_t)b * SEQ + (size_t)c * 64;
    const bf16* P = (const bf16*)(A.ws + WS_PROJ); bf16* XBCC = (bf16*)(A.ws + WS_XBCC); bf16* ST = (bf16*)(A.ws + WS_ST); float* AEND = (float*)(A.ws + WS_AEND);
    LAS unsigned char* XI = Ls; LAS unsigned char* BI = Ls + 67584;
    LAS float* dtl = (LAS float*)(Ls + 102400); LAS float* acs = (LAS float*)(Ls + 104448);
    ssd_prepass(F, A, L, m0, dtl, acs);
    if (F.tid < 8) AEND[(size_t)bc * 8 + F.tid] = acs[63 * 8 + F.tid];
    { const int cg = F.tid & 127, tg = F.tid >> 7, ch0 = 8 * cg;
      float wk[4][8], bs[8];
#pragma unroll
      for (int k = 0; k < 4; ++k) { const f32x4 a = *(const f32x4*)(A.in[6] + (size_t)(L * 4 + k) * 1024 + ch0), bq = *(const f32x4*)(A.in[6] + (size_t)(L * 4 + k) * 1024 + ch0 + 4);
          wk[k][0] = a.x; wk[k][1] = a.y; wk[k][2] = a.z; wk[k][3] = a.w; wk[k][4] = bq.x; wk[k][5] = bq.y; wk[k][6] = bq.z; wk[k][7] = bq.w; }
      { const f32x4 a = *(const f32x4*)(A.in[7] + (size_t)L * 1024 + ch0), bq = *(const f32x4*)(A.in[7] + (size_t)L * 1024 + ch0 + 4);
          bs[0] = a.x; bs[1] = a.y; bs[2] = a.z; bs[3] = a.w; bs[4] = bq.x; bs[5] = bq.y; bs[6] = bq.z; bs[7] = bq.w; }
      const int hh = cg >> 3;
#pragma unroll 1
      for (int hf = 0; hf < 2; ++hf) {
      v4u raw[11];
#pragma unroll
      for (int tt = 0; tt < 11; ++tt) { const int lp = 16 * tg + 8 * hf - 3 + tt; const bool ok = (c * 64 + lp) >= 0;
          raw[tt] = ok ? *(const v4u*)(P + (size_t)((long)m0 + lp) * PN + PC_XBC + ch0) : (v4u){0u, 0u, 0u, 0u}; }
#pragma unroll
      for (int t = 0; t < 8; ++t) { const int l = 16 * tg + 8 * hf + t;
          float y[8];
#pragma unroll
          for (int e = 0; e < 8; ++e) y[e] = bs[e];
#pragma unroll
          for (int k = 0; k < 4; ++k) { const v4u rw = raw[t + k];
              y[0] += wk[k][0] * bflo(rw.x); y[1] += wk[k][1] * bfhi(rw.x); y[2] += wk[k][2] * bflo(rw.y); y[3] += wk[k][3] * bfhi(rw.y);
              y[4] += wk[k][4] * bflo(rw.z); y[5] += wk[k][5] * bfhi(rw.z); y[6] += wk[k][6] * bflo(rw.w); y[7] += wk[k][7] * bfhi(rw.w); }
#pragma unroll
          for (int e = 0; e < 8; ++e) y[e] = silu(y[e]);
          v4u o; o.x = pk2(y[0], y[1]); o.y = pk2(y[2], y[3]); o.z = pk2(y[4], y[5]); o.w = pk2(y[6], y[7]);
          *(v4u*)(XBCC + (m0 + l) * 1024 + ch0) = o;
          if (cg < 64) { const float sc = dtl[l * 8 + hh] * __expf(acs[63 * 8 + hh] - acs[l * 8 + hh]);
              v4u os; os.x = pk2(y[0] * sc, y[1] * sc); os.y = pk2(y[2] * sc, y[3] * sc); os.z = pk2(y[4] * sc, y[5] * sc); os.w = pk2(y[6] * sc, y[7] * sc);
              *(LAS v4u*)(XI + l * 1056 + ch0 * 2) = os; }
          else if (cg < 96) *(LAS v4u*)(BI + l * 544 + (ch0 - 512) * 2) = o;
      } } }
    __syncthreads();
    { const int h = w, gi = h >> 2;
      bf16* STh = ST + ((size_t)bc * 8 + h) * 8192;
#pragma unroll 1
      for (int nh = 0; nh < 2; ++nh) {
      f32x4 acc[4][4];
#pragma unroll
      for (int nt = 0; nt < 4; ++nt)
#pragma unroll
          for (int pt = 0; pt < 4; ++pt) acc[nt][pt] = (f32x4){0.f, 0.f, 0.f, 0.f};
#pragma unroll
      for (int ks = 0; ks < 2; ++ks) {
          const int rowA = 32 * ks + 4 * q4 + (fr >> 2), rowB = rowA + 16;
          bf16x8 yf[4];
#pragma unroll
          for (int pt = 0; pt < 4; ++pt) { const int cb = (h * 64 + 16 * pt + 4 * (lane & 3)) * 2; yf[pt] = cat8(trrd(XI + rowA * 1056 + cb), trrd(XI + rowB * 1056 + cb)); }
#pragma unroll
          for (int nt = 0; nt < 4; ++nt) { const int cb = (gi * 128 + 64 * nh + 16 * nt + 4 * (lane & 3)) * 2;
              const bf16x8 xf = cat8(trrd(BI + rowA * 544 + cb), trrd(BI + rowB * 544 + cb));
#pragma unroll
              for (int pt = 0; pt < 4; ++pt) acc[nt][pt] = mfma16(xf, yf[pt], acc[nt][pt]); }
      }
#pragma unroll
      for (int nt = 0; nt < 4; ++nt)
#pragma unroll
          for (int pt = 0; pt < 4; ++pt) { v2u o; o.x = pk2(acc[nt][pt][0], acc[nt][pt][1]); o.y = pk2(acc[nt][pt][2], acc[nt][pt][3]); *(v2u*)(STh + (16 * pt + fr) * 128 + 64 * nh + 16 * nt + 4 * q4) = o; }
      }
    }
    __syncthreads();
}
__device__ __forceinline__ void ssd_scan(Frame& F, const Args& A) {
    unsigned* ST = (unsigned*)(A.ws + WS_ST); const float* AEND = (const float*)(A.ws + WS_AEND);
    for (int it = F.vcu * NTHR + F.tid; it < 32 * 4096; it += F.G * NTHR) {
        const int bh = it >> 12, b = bh >> 3, h = bh & 7, e = (it & 4095);
        unsigned* base = ST + ((size_t)(b * NCHUNK) * 8 + h) * 4096 + e;
        float s0 = 0.f, s1 = 0.f;
        for (int c0 = 0; c0 < NCHUNK; c0 += 16) {
            unsigned v[16]; float dec[16];
#pragma unroll
            for (int i = 0; i < 16; ++i) { v[i] = base[(size_t)(c0 + i) * 32768]; dec[i] = __expf(AEND[(size_t)(b * NCHUNK + c0 + i) * 8 + h]); }
#pragma unroll
            for (int i = 0; i < 16; ++i) { base[(size_t)(c0 + i) * 32768] = pk2(s0, s1); s0 = s0 * dec[i] + bflo(v[i]); s1 = s1 * dec[i] + bfhi(v[i]); }
        }
    }
}
__device__ __forceinline__ void ssd3_unit(Frame& F, const Args& A, int L, int bc) {
    LAS unsigned char* Ls = F.lds; const int lane = F.lane, w = F.wave, fr = lane & 15, q4 = lane >> 4;
    const int b = bc >> 7, c = bc & 127; const size_t m0 = (size_t)b * SEQ + (size_t)c * 64;
    const bf16* P = (const bf16*)(A.ws + WS_PROJ); const bf16* XBCC = (const bf16*)(A.ws + WS_XBCC); const bf16* ST = (const bf16*)(A.ws + WS_ST); bf16* Y = (bf16*)(A.ws + WS_Y);
    LAS unsigned char* XI = Ls; LAS unsigned char* BI = Ls + 67584; LAS unsigned char* CI = Ls + 102400;
    LAS float* dtl = (LAS float*)(Ls + 137216); LAS float* acs = (LAS float*)(Ls + 139264);
    ssd_prepass(F, A, L, m0, dtl, acs);
#pragma unroll 4
    for (int i = 0; i < 16; ++i) { const int pc = F.tid + NTHR * i, row = pc >> 7, cg = pc & 127;
        const v4u v = *(const v4u*)(XBCC + (m0 + row) * 1024 + 8 * cg);
        LAS unsigned char* dst = cg < 64 ? XI + row * 1056 + cg * 16 : (cg < 96 ? BI + row * 544 + (cg - 64) * 16 : CI + row * 544 + (cg - 96) * 16);
        *(LAS v4u*)dst = v; }
    __syncthreads();
    const int h = w, gi = h >> 2;
    f32x4 acc[4][4];
#pragma unroll
    for (int lt = 0; lt < 4; ++lt)
#pragma unroll
        for (int pt = 0; pt < 4; ++pt) acc[lt][pt] = (f32x4){0.f, 0.f, 0.f, 0.f};
    { const bf16* Sh = ST + ((size_t)bc * 8 + h) * 8192;
#pragma unroll 1
      for (int kn = 0; kn < 4; ++kn) {
          bf16x8 yf[4];
#pragma unroll
          for (int pt = 0; pt < 4; ++pt) yf[pt] = *(const bf16x8*)(Sh + (16 * pt + fr) * 128 + 32 * kn + 8 * q4);
#pragma unroll
          for (int lt = 0; lt < 4; ++lt) { const bf16x8 xf = *(const LAS bf16x8*)(CI + (16 * lt + fr) * 544 + (gi * 128 + 32 * kn + 8 * q4) * 2);
#pragma unroll
              for (int pt = 0; pt < 4; ++pt) acc[lt][pt] = mfma16(xf, yf[pt], acc[lt][pt]); }
      }
#pragma unroll
      for (int lt = 0; lt < 4; ++lt)
#pragma unroll
          for (int r = 0; r < 4; ++r) { const float sc = __expf(acs[(16 * lt + 4 * q4 + r) * 8 + h]);
#pragma unroll
              for (int pt = 0; pt < 4; ++pt) acc[lt][pt][r] *= sc; }
    }
#pragma unroll
    for (int lt = 0; lt < 4; ++lt) {
#pragma unroll
        for (int ksp = 0; ksp <= (lt >> 1); ++ksp) {
            __builtin_amdgcn_sched_barrier(0);
            const bool hasb = (2 * ksp + 1) <= lt;
            f32x4 d0a = (f32x4){0.f, 0.f, 0.f, 0.f}, d0b = (f32x4){0.f, 0.f, 0.f, 0.f};
#pragma unroll
            for (int kn = 0; kn < 4; ++kn) { const int cb = (gi * 128 + 32 * kn + 8 * q4) * 2;
                const bf16x8 cf = *(const LAS bf16x8*)(CI + (16 * lt + fr) * 544 + cb);
                const bf16x8 ba = *(const LAS bf16x8*)(BI + (32 * ksp + fr) * 544 + cb); d0a = mfma16(ba, cf, d0a);
                if (hasb) { const bf16x8 bb = *(const LAS bf16x8*)(BI + (32 * ksp + 16 + fr) * 544 + cb); d0b = mfma16(bb, cf, d0b); } }
            const int l = 16 * lt + fr; const float al = acs[l * 8 + h];
            float ga[4], gb[4];
#pragma unroll
            for (int r = 0; r < 4; ++r) { const int sa = 32 * ksp + 4 * q4 + r, sb = sa + 16;
                ga[r] = sa <= l ? d0a[r] * __expf(al - acs[sa * 8 + h]) * dtl[sa * 8 + h] : 0.f;
                gb[r] = (hasb && sb <= l) ? d0b[r] * __expf(al - acs[sb * 8 + h]) * dtl[sb * 8 + h] : 0.f; }
            const bf16x8 xf = pack8(ga[0], ga[1], ga[2], ga[3], gb[0], gb[1], gb[2], gb[3]);
            const int rowA = 32 * ksp + 4 * q4 + (fr >> 2), rowB = rowA + 16;
#pragma unroll
            for (int pt = 0; pt < 4; ++pt) { const int cb = (h * 64 + 16 * pt + 4 * (lane & 3)) * 2;
                acc[lt][pt] = mfma16(xf, cat8(trrd(XI + rowA * 1056 + cb), trrd(XI + rowB * 1056 + cb)), acc[lt][pt]); }
        }
    }
    { const float dsk = A.in[10][L * 8 + h];
#pragma unroll
      for (int lt = 0; lt < 4; ++lt)
#pragma unroll
          for (int pt = 0; pt < 4; ++pt)
#pragma unroll
              for (int r = 0; r < 4; ++r) { const unsigned short xv = *(const LAS unsigned short*)(XI + (16 * lt + 4 * q4 + r) * 1056 + (h * 64 + 16 * pt + fr) * 2);
                  acc[lt][pt][r] += dsk * __uint_as_float((unsigned)xv << 16); } }
    __syncthreads();
#pragma unroll
    for (int lt = 0; lt < 4; ++lt)
#pragma unroll
        for (int pt = 0; pt < 4; ++pt)
#pragma unroll
            for (int r = 0; r < 4; ++r) *(LAS float*)(Ls + (16 * lt + 4 * q4 + r) * 2112 + (h * 64 + 16 * pt + fr) * 4) = acc[lt][pt][r];
    __syncthreads();
    { const f32x4 g0 = *(const f32x4*)(A.in[11] + L * 512 + 8 * lane), g1 = *(const f32x4*)(A.in[11] + L * 512 + 8 * lane + 4);
#pragma unroll 2
      for (int i = 0; i < 8; ++i) { const int r = 8 * w + i;
        f32x4 v0 = *(const LAS f32x4*)(Ls + r * 2112 + lane * 32), v1 = *(const LAS f32x4*)(Ls + r * 2112 + lane * 32 + 16);
        const v4u z = *(const v4u*)(P + (m0 + r) * PN + PC_Z + 8 * lane);
        v0 = v0 * (f32x4){silu(bflo(z.x)), silu(bfhi(z.x)), silu(bflo(z.y)), silu(bfhi(z.y))};
        v1 = v1 * (f32x4){silu(bflo(z.z)), silu(bfhi(z.z)), silu(bflo(z.w)), silu(bfhi(z.w))};
        const float ss = wave_sum((v0.x * v0.x + v0.y * v0.y) + (v0.z * v0.z + v0.w * v0.w) + (v1.x * v1.x + v1.y * v1.y) + (v1.z * v1.z + v1.w * v1.w)) * (1.0f / 512.0f);
        const float sc = 1.0f / sqrtf(ss + 1e-6f);
        v0 = v0 * sc * g0; v1 = v1 * sc * g1;
        v4u ov; ov.x = pk2(v0.x, v0.y); ov.y = pk2(v0.z, v0.w); ov.z = pk2(v1.x, v1.y); ov.w = pk2(v1.z, v1.w);
        *(v4u*)(Y + (m0 + r) * D + 8 * lane) = ov; } }
    __syncthreads();
}

constexpr int NPHASE = 1 + 16 + 7 + 2 * MOE_NCH + 1;
__global__ void __launch_bounds__(NTHR, 2) fwd_kernel(Args args) {
    extern __shared__ __attribute__((aligned(16))) unsigned char lds[];
    Frame F;
    F.lds = (LAS unsigned char*)lds;
    F.tid = threadIdx.x; F.lane = F.tid & 63; F.wave = __builtin_amdgcn_readfirstlane(F.tid >> 6);
    F.G = gridDim.x; { const int bx = blockIdx.x; F.vcu = (F.G % 8 == 0) ? (bx % 8) * (F.G / 8) + bx / 8 : bx; }
    gu32* ctl = (gu32*)(args.ws + WS_CTL);
    for (int u = F.tid; u < (LDS_BYTES - LDSCTL_OFF) / 4; u += NTHR) ((LAS unsigned*)(F.lds + LDSCTL_OFF))[u] = 0u;
    __syncthreads();
    XcdBarrier bar; bar.bar = (unsigned*)(ctl + CW_BAR); bar.x = 0; bar.st = nullptr;
    const int lo = args.ph_lo, hi = args.ph_hi;
    if (hi - lo > 1) bar = xcd_barrier_post((unsigned*)(ctl + CW_BAR), (volatile LAS unsigned*)(F.lds + CTL_MISC) + 8);
#define IN(k) ((lo <= (k) && (k) < hi) && fresh(F))
#define SEAM(k) do { if ((k) + 1 < hi) { REP(12) xcd_barrier(bar); } } while (0)
    unsigned char* ws = args.ws;
    bf16* A1 = (bf16*)(ws + WS_A1); bf16* PROJ = (bf16*)(ws + WS_PROJ); bf16* Yb = (bf16*)(ws + WS_Y); bf16* MIXED = (bf16*)(ws + WS_MIXED);
    const int bid = (int)blockIdx.x;

    if (IN(0)) {
        REP(10) { cvt_small_weights(F, args);
        __syncthreads(); }
        RowArgs R{args.in[0], nullptr, 0, nullptr, nullptr, args.in[1], A1, 1, args.in[5] + 1536, DIN};
        REP(9) row_phase(F, args, R);
        SEAM(0);
    }
    for (int L = 0; L < 2; ++L) {
        const int pb = 1 + 16 * L;
        if (IN(pb + 0)) {
            pg8::Gemm g{A1, (const bf16*)(ws + WS_WIN) + (size_t)L * PN * D, M, PN, D}; pg8::StaticOrder S; S.init(M, PN, F.G, bid);
            pg8::EpiStore E{PROJ, PN};
            REP(5) pg8::gemm_phase<pg8::EpiStore, pg8::StaticOrder, true, true>(F.lds, g, S, E);
            SEAM(pb + 0);
        }
        if (IN(pb + 1)) {
                        REP(0) for (int u = F.vcu; u < NBATCH * NCHUNK; u += F.G) ssd1_unit(F, args, L, u);
                        REP(1) for (int u = F.vcu; u < NBATCH * NCHUNK; u += F.G) attn_unit(F, args, L, u);
                        REP(2) for (int u = F.vcu; u < M / 128; u += F.G) gmlp_unit(F, args, L, u);
            SEAM(pb + 1);
        }
                if (IN(pb + 2)) { ssd_scan(F, args); SEAM(pb + 2); }
                if (IN(pb + 3)) { REP(3) for (int u = F.vcu; u < NBATCH * NCHUNK; u += F.G) ssd3_unit(F, args, L, u); SEAM(pb + 3); }
        if (IN(pb + 4)) {
            pg8::Gemm g{Yb, (const bf16*)(ws + WS_WOUT) + (size_t)L * D * D, M, D, D}; pg8::StaticOrder S; S.init(M, D, F.G, bid);
            pg8::EpiStore E{MIXED, D};
            REP(5) pg8::gemm_phase<pg8::EpiStore, pg8::StaticOrder, true, true>(F.lds, g, S, E);
            SEAM(pb + 4);
        }
        if (IN(pb + 5)) {
            RowArgs R{L == 0 ? args.in[0] : args.out, args.out, 1, MIXED, args.in[2] + L * D, args.in[3] + L * D, A1, L == 1 ? 2 : 0, args.in[23], 8};
            if (L == 0) { REP(8) row_phase(F, args, R); } else row_phase(F, args, R);
            if (L == 1) REP(4) cvt_moe_weights(F, args);
            SEAM(pb + 5);
        }
        if (L == 0) {
            if (IN(pb + 6)) {
                pg8::Gemm g{A1, (const bf16*)(ws + WS_WGU), M, 2 * DFF, D}; pg8::StaticOrder S; S.init(M, 2 * DFF, F.G, bid);
                pg8::EpiSwiglu E{(bf16*)(ws + WS_H1), DFF};
                REP(6) pg8::gemm_phase<pg8::EpiSwiglu, pg8::StaticOrder, true, true>(F.lds, g, S, E);
                SEAM(pb + 6);
            }
            if (IN(pb + 7)) {
                pg8::Gemm g{(const bf16*)(ws + WS_H1), (const bf16*)(ws + WS_WD), M, D, DFF}; pg8::StaticOrder S; S.init(M, D, F.G, bid);
                pg8::EpiStore E{(bf16*)(ws + WS_FOUT), D};
                REP(6) pg8::gemm_phase<pg8::EpiStore, pg8::StaticOrder, true, true>(F.lds, g, S, E);
                SEAM(pb + 7);
            }
            if (IN(pb + 8)) {
                RowArgs R{args.out, args.out, 1, (const bf16*)(ws + WS_FOUT), args.in[4], args.in[1] + D, A1, 1, args.in[5] + (size_t)D * DIN + 1536, DIN};
                row_phase(F, args, R);
                SEAM(pb + 8);
            }
        } else {
            if (IN(pb + 6)) { REP(11) { moe_tables(F, args); moe_gather(F, args); } SEAM(pb + 6); }
            for (int k = 0; k < MOE_NCH; ++k) {
                if (IN(pb + 7 + 2 * k)) {
                    moe_tables(F, args);
                    const int nT = *(LAS int*)(F.lds + CTL_CNT + 32 * 4); int nk = nT - MOE_CH * k; nk = nk < 0 ? 0 : ((k < MOE_NCH - 1 && nk > MOE_CH) ? MOE_CH : nk);
                    pg8::Gemm g{(const bf16*)(ws + WS_XS), (const bf16*)(ws + WS_MWGU), 0, 0, D};
                    pg8::MoeOrder<false, true> S{MOE_CH * k, nk, 28, F.G, bid, (const LAS int*)(F.lds + CTL_TE)};
                    pg8::EpiSwiglu E{(bf16*)(ws + WS_HM), DFFE};
                    REP(7) pg8::gemm_phase<pg8::EpiSwiglu, pg8::MoeOrder<false, true>, true, true>(F.lds, g, S, E);
                    SEAM(pb + 7 + 2 * k);
                }
                if (IN(pb + 8 + 2 * k)) {
                    moe_tables(F, args);
                    const int nT = *(LAS int*)(F.lds + CTL_CNT + 32 * 4); int nk = nT - MOE_CH * k; nk = nk < 0 ? 0 : ((k < MOE_NCH - 1 && nk > MOE_CH) ? MOE_CH : nk);
                    pg8::Gemm g{(const bf16*)(ws + WS_HM), (const bf16*)(ws + WS_MWD), 0, 0, DFFE};
                    pg8::MoeOrder<true, false> S{MOE_CH * k, nk, 4, F.G, bid, (const LAS int*)(F.lds + CTL_TE)};
                    pg8::EpiStore E{(bf16*)(ws + WS_XS), D};
                    REP(7) pg8::gemm_phase<pg8::EpiStore, pg8::MoeOrder<true, false>, true, true>(F.lds, g, S, E);
                    SEAM(pb + 8 + 2 * k);
                }
            }
            if (IN(pb + 7 + 2 * MOE_NCH)) {
                RowArgs R{args.out, args.out, 2, (const bf16*)(ws + WS_XS), args.in[4] + D, nullptr, nullptr, 0, nullptr, 0};
                row_phase(F, args, R);
            }
        }
    }
#undef IN
#undef SEAM
}

extern "C" void kernel_launch(void* const* d_in, const int* in_sizes, int n_in, void* d_out, int out_size, void* d_ws, size_t ws_size, hipStream_t stream) {
    static int grid = 0;
    if (grid == 0) {
        if (n_in != NIN || out_size != M * D || ws_size < WS_END) { fprintf(stderr, "kernel_launch: unexpected shapes (n_in %d, out %d, ws %zu)\n", n_in, out_size, ws_size); grid = -1; return; }
        int dev = 0, cus = 0;
        if (hipGetDevice(&dev) != hipSuccess || hipDeviceGetAttribute(&cus, hipDeviceAttributeMultiprocessorCount, dev) != hipSuccess) { grid = -1; return; }
        if (hipFuncSetAttribute((const void*)fwd_kernel, hipFuncAttributeMaxDynamicSharedMemorySize, LDS_BYTES) != hipSuccess) { fprintf(stderr, "kernel_launch: hipFuncSetAttribute failed\n"); grid = -1; return; }
        int per_cu = 0;
        if (hipOccupancyMaxActiveBlocksPerMultiprocessor(&per_cu, (const void*)fwd_kernel, NTHR, LDS_BYTES) != hipSuccess || per_cu < 1) fprintf(stderr, "kernel_launch: occupancy query says %d\n", per_cu);
        (void)hipGetLastError();
        grid = cus > 256 ? 256 : cus;
    }
    if (grid < 0) return;
    (void)hipMemsetAsync((char*)d_ws + WS_CTL, 0, CTL_ZERO_BYTES, stream);
    Args a{};
    for (int i = 0; i < NIN; ++i) a.in[i] = (const float*)d_in[i];
    a.out = (float*)d_out; a.ws = (unsigned char*)d_ws;
#if MK_SINGLE
    a.ph_lo = 0; a.ph_hi = NPHASE;
    hipLaunchKernelGGL(fwd_kernel, dim3(grid), dim3(NTHR), LDS_BYTES, stream, a);
#else
    for (int ph = 0; ph < NPHASE; ++ph) { if (ph >= 10 && ph < 17) continue; a.ph_lo = ph; a.ph_hi = ph + 1; hipLaunchKernelGGL(fwd_kernel, dim3(grid), dim3(NTHR), LDS_BYTES, stream, a); }
#endif
}
```

```cpp
#include <hip/hip_runtime.h>
#include <cstdio>
#include <cstdint>

#ifndef MK_SINGLE
#define MK_SINGLE 1
#endif

namespace pg8 {
#define PG8_LAS __attribute__((address_space(3)))
typedef unsigned short bf16_t;
typedef short bf16x8 __attribute__((ext_vector_type(8)));
typedef float f32x4 __attribute__((ext_vector_type(4)));
typedef unsigned u32x4 __attribute__((ext_vector_type(4)));
constexpr int BM = 256, BK = 64, HALF = 128, HTB = HALF * BK * 2  , STAGE_BYTES = 8 * HTB, NXCD = 8, WGM = 8;

__host__ __device__ __forceinline__ int lds_byte(int r, int c) { const int st = (r >> 4) * 2 + (c >> 5), rr = r & 15, cc = c & 31, ob = rr * 64 + cc * 2; return st * 1024 + (ob ^ (((ob >> 9) & 1) << 5)); }
__host__ __device__ __forceinline__ void stage_rc(int b, int& R, int& C) { const int st = b / 1024, sb = b % 1024, swz = sb ^ (((sb >> 9) & 1) << 5); R = (st >> 1) * 16 + swz / 64; C = (st & 1) * 32 + (swz % 64) / 2; }
__host__ __device__ __forceinline__ int perm32(int rho) { const int n = rho >> 4, i = rho & 15; return 8 * (i >> 2) + 4 * n + (i & 3); }

struct Unit { int pm, pn, om, on; };
struct Gemm { const bf16_t* A; const bf16_t* Bt; int M, N, K; };

__host__ __device__ __forceinline__ bool tile_order(int i, int G, int c, int nM, int nN, int& pm, int& pn) {
    const int nwg = nM * nN; const long L = (long)i * G + c; if (L >= nwg) return false;
    int wgid = (int)L; { const int q = nwg / NXCD, r = nwg % NXCD, xcd = wgid % NXCD, off = wgid / NXCD; wgid = (xcd < r ? xcd * (q + 1) : r * (q + 1) + (xcd - r) * q) + off; }
    const int nig = WGM * nN, gid = wgid / nig, fm = gid * WGM, gsz = (nM - fm) < WGM ? (nM - fm) : WGM;
    pm = fm + ((wgid % nig) % gsz); pn = (wgid % nig) / gsz; return true;
}
struct StaticOrder {
    int nM, nN, G, c;
    __host__ __device__ void init(int M, int N, int G_, int c_) { nM = M / BM; nN = N / BM; G = G_; c = c_; }
    __host__ __device__ bool next(int i, Unit& u) const { int pm, pn; if (!tile_order(i, G, c, nM, nN, pm, pn)) return false; u.pm = pm; u.pn = pn; u.om = pm; u.on = pn; return true; }
    __device__ __forceinline__ void a_ready(const Unit&) const {}
    __device__ __forceinline__ void done(const Unit&) const {}
};
template <bool A_LOCAL, bool O_LOCAL>
struct MoeOrder {
    int t0, nT, nN, G, c; const PG8_LAS int* te;
    __device__ __forceinline__ bool next(int i, Unit& u) const { int pm, pn; if (!tile_order(i, G, c, nT, nN, pm, pn)) return false;
        const int e = __builtin_amdgcn_readfirstlane(te[t0 + pm]);
        u.pm = A_LOCAL ? pm : t0 + pm; u.pn = e * nN + pn; u.om = O_LOCAL ? pm : t0 + pm; u.on = pn; return true; }
    __device__ __forceinline__ void a_ready(const Unit&) const {}
    __device__ __forceinline__ void done(const Unit&) const {}
};

__device__ __forceinline__ unsigned cvt_pk_bf16(float lo, float hi) { unsigned r; asm volatile("v_cvt_pk_bf16_f32 %0, %1, %2" : "=v"(r) : "v"(lo), "v"(hi)); return r; }

typedef int v8i32 __attribute__((ext_vector_type(8)));
__device__ __forceinline__ v8i32 cat16(bf16x8 lo, bf16x8 hi) { const u32x4 a = __builtin_bit_cast(u32x4, lo), b = __builtin_bit_cast(u32x4, hi); return (v8i32){(int)a.x, (int)a.y, (int)a.z, (int)a.w, (int)b.x, (int)b.y, (int)b.z, (int)b.w}; }
__device__ __forceinline__ float clamp448(float x) { return __builtin_fminf(__builtin_fmaxf(x, -448.0f), 448.0f); }
__device__ __forceinline__ unsigned pack_fp8x4(float a, float b, float c, float d) {
    int r = 0; r = __builtin_amdgcn_cvt_pk_fp8_f32(clamp448(a), clamp448(b), r, false); r = __builtin_amdgcn_cvt_pk_fp8_f32(clamp448(c), clamp448(d), r, true); return (unsigned)r; }
struct EpiStore {
    static constexpr bool PERM = true, AFTER_DRAIN = false;
    bf16_t* O; int ldc; float scale;
    __device__ __forceinline__ void operator()(const f32x4 (&acc)[2][2][4][2], const Unit& u, int wr, int wc, int fr, int fq) const {
        const int row0 = u.om * BM + wr * 64 + fr; const int col0 = u.on * BM + wc * 32 + 8 * fq;
#pragma unroll
        for (int ai = 0; ai < 2; ++ai)
#pragma unroll
            for (int m = 0; m < 4; ++m) { bf16_t* rowp = O + (size_t)(row0 + ai * HALF + m * 16) * ldc + col0;
#pragma unroll
                for (int bj = 0; bj < 2; ++bj) { const f32x4 v0 = acc[ai][bj][m][0] * scale, v1 = acc[ai][bj][m][1] * scale;
                    u32x4 w; w.x = cvt_pk_bf16(v0[0], v0[1]); w.y = cvt_pk_bf16(v0[2], v0[3]); w.z = cvt_pk_bf16(v1[0], v1[1]); w.w = cvt_pk_bf16(v1[2], v1[3]);
                    *(u32x4*)(rowp + bj * HALF) = w; } }
    }
};
__device__ __forceinline__ float silu_f(float x) { return x * __builtin_amdgcn_rcpf(1.0f + __expf(-x)); }
struct EpiSwiglu {
    static constexpr bool PERM = true, AFTER_DRAIN = false;
    bf16_t* O; int ldc;
    __device__ __forceinline__ void operator()(const f32x4 (&acc)[2][2][4][2], const Unit& u, int wr, int wc, int fr, int fq) const {
        const int row0 = u.om * BM + wr * 64 + fr; const int col0 = u.on * HALF + wc * 32 + 8 * fq;
#pragma unroll
        for (int ai = 0; ai < 2; ++ai)
#pragma unroll
            for (int m = 0; m < 4; ++m) { bf16_t* rowp = O + (size_t)(row0 + ai * HALF + m * 16) * ldc + col0;
                const f32x4 g0 = acc[ai][0][m][0], g1 = acc[ai][0][m][1], u0 = acc[ai][1][m][0], u1 = acc[ai][1][m][1];
                u32x4 w;
                w.x = cvt_pk_bf16(silu_f(g0[0]) * u0[0], silu_f(g0[1]) * u0[1]); w.y = cvt_pk_bf16(silu_f(g0[2]) * u0[2], silu_f(g0[3]) * u0[3]);
                w.z = cvt_pk_bf16(silu_f(g1[0]) * u1[0], silu_f(g1[1]) * u1[1]); w.w = cvt_pk_bf16(silu_f(g1[2]) * u1[2], silu_f(g1[3]) * u1[3]);
                *(u32x4*)rowp = w; }
    }
};

struct EpiSwiglu8 {
    static constexpr bool PERM = true, AFTER_DRAIN = false;
    unsigned char* O; int ldc; float in_scale, out_scale;
    __device__ __forceinline__ void operator()(const f32x4 (&acc)[2][2][4][2], const Unit& u, int wr, int wc, int fr, int fq) const {
        const int row0 = u.om * BM + wr * 64 + fr; const int col0 = u.on * HALF + wc * 32 + 8 * fq;
#pragma unroll
        for (int ai = 0; ai < 2; ++ai)
#pragma unroll
            for (int m = 0; m < 4; ++m) { unsigned char* rowp = O + (size_t)(row0 + ai * HALF + m * 16) * ldc + col0;
                const f32x4 g0 = acc[ai][0][m][0] * in_scale, g1 = acc[ai][0][m][1] * in_scale, u0 = acc[ai][1][m][0] * (in_scale * out_scale), u1 = acc[ai][1][m][1] * (in_scale * out_scale);
                typedef unsigned u32x2 __attribute__((ext_vector_type(2)));
                u32x2 w;
                w.x = pack_fp8x4(silu_f(g0[0]) * u0[0], silu_f(g0[1]) * u0[1], silu_f(g0[2]) * u0[2], silu_f(g0[3]) * u0[3]);
                w.y = pack_fp8x4(silu_f(g1[0]) * u1[0], silu_f(g1[1]) * u1[1], silu_f(g1[2]) * u1[2], silu_f(g1[3]) * u1[3]);
                *(u32x2*)rowp = w; }
    }
};

template <class Epi, class Sched, bool ALIGN_EPI = false, bool SP2 = false, bool FP8 = false>
__device__ __forceinline__ void gemm_phase(PG8_LAS unsigned char* lds, const Gemm g, const Sched& S, const Epi& E) {
    int tid_ = threadIdx.x; asm volatile("" : "+v"(tid_));
    const int tid = tid_, wid = __builtin_amdgcn_readfirstlane(tid >> 6), lane = tid & 63, wr = wid >> 2, wc = wid & 3, fr = lane & 15, fq = lane >> 4;
    int K_ = g.K; asm volatile("" : "+s"(K_));
    const int K = K_, nt = K / BK;
    unsigned voffA[2], voffB[2];
#pragma unroll
    for (int i = 0; i < 2; ++i) { int R, C; stage_rc(tid * 16 + i * 8192, R, C); const int Rb = Epi::PERM ? ((R & ~31) + perm32(R & 31)) : R;
        voffA[i] = (unsigned)(R * K + C) * 2u; voffB[i] = (unsigned)(Rb * K + C) * 2u; }
    const size_t kstep = (size_t)(BK * 2);
    const size_t hstep = (size_t)HALF * K * 2;
    const size_t tstep = 2 * hstep;
    const unsigned ldsw = (unsigned)wid * 1024u;
    const int aoff = lds_byte(wr * 64 + fr, fq * 8), boff = lds_byte(wc * 32 + fr, fq * 8);
#define PG8_SA(b, h) (((b) * 2 + (h)) * HTB)
#define PG8_SB(b, h) ((4 + (b) * 2 + (h)) * HTB)
#define PG8_STAGE(bufoff, gbase, voff) do { _Pragma("unroll") for (int _i = 0; _i < 2; ++_i) \
        __builtin_amdgcn_global_load_lds((const unsigned*)((const char*)(gbase) + (voff)[_i]), (PG8_LAS unsigned*)(lds + (bufoff) + ldsw + _i * 8192), 16, 0, 0); } while (0)
#define PG8_LDA(dst, dst8, b, h) do { _Pragma("unroll") for (int m = 0; m < 4; ++m) { \
        if constexpr (FP8) dst8[m] = cat16(*(const PG8_LAS bf16x8*)(lds + PG8_SA(b, h) + aoff + m * 2048), *(const PG8_LAS bf16x8*)(lds + PG8_SA(b, h) + aoff + m * 2048 + 1024)); \
        else { _Pragma("unroll") for (int k = 0; k < 2; ++k) dst[m][k] = *(const PG8_LAS bf16x8*)(lds + PG8_SA(b, h) + aoff + m * 2048 + k * 1024); } } } while (0)
#define PG8_LDB(dst, dst8, b, h) do { _Pragma("unroll") for (int n = 0; n < 2; ++n) { \
        if constexpr (FP8) dst8[n] = cat16(*(const PG8_LAS bf16x8*)(lds + PG8_SB(b, h) + boff + n * 2048), *(const PG8_LAS bf16x8*)(lds + PG8_SB(b, h) + boff + n * 2048 + 1024)); \
        else { _Pragma("unroll") for (int k = 0; k < 2; ++k) dst[n][k] = *(const PG8_LAS bf16x8*)(lds + PG8_SB(b, h) + boff + n * 2048 + k * 1024); } } } while (0)
#define PG8_MMA(ai, bj, At, At8, Bt, Bt8) do { __builtin_amdgcn_s_setprio(1); _Pragma("unroll") for (int m = 0; m < 4; ++m) _Pragma("unroll") for (int n = 0; n < 2; ++n) { \
        if constexpr (FP8) { asm volatile("v_mfma_f32_16x16x128_f8f6f4 %0, %1, %2, %0" : "+v"(acc[ai][bj][m][n]) : "v"(Bt8[n]), "v"(At8[m])); } \
        else { _Pragma("unroll") for (int k = 0; k < 2; ++k) acc[ai][bj][m][n] = __builtin_amdgcn_mfma_f32_16x16x32_bf16(Bt[n][k], At[m][k], acc[ai][bj][m][n], 0, 0, 0); } } __builtin_amdgcn_s_setprio(0); } while (0)
#define PG8_WAIT_V(n) asm volatile("s_waitcnt vmcnt(" #n ")" ::: "memory")
#define PG8_WAIT_L(n) asm volatile("s_waitcnt lgkmcnt(" #n ")" ::: "memory")
#define PG8_BAR __builtin_amdgcn_s_barrier()
#define PG8_SCHED __builtin_amdgcn_sched_barrier(0)
    Unit cur, nxt; int ui = 0;
    if (!S.next(0, cur)) return;
    f32x4 acc[2][2][4][2];
#pragma unroll
    for (int a = 0; a < 2; ++a)
#pragma unroll
        for (int b = 0; b < 2; ++b)
#pragma unroll
            for (int m = 0; m < 4; ++m)
#pragma unroll
                for (int n = 0; n < 2; ++n) acc[a][b][m][n] = (f32x4){0.f, 0.f, 0.f, 0.f};
    bf16x8 At[4][2], B0[2][2], B1[2][2]; v8i32 At8[4], B08[2], B18[2];
    const char* cA = (const char*)g.A + (size_t)cur.pm * tstep; const char* cB = (const char*)g.Bt + (size_t)cur.pn * tstep;
    S.a_ready(cur);
    if constexpr (SP2) {
        PG8_STAGE(PG8_SB(0, 0), cB, voffB); PG8_STAGE(PG8_SB(0, 1), cB + hstep, voffB); PG8_STAGE(PG8_SA(0, 0), cA, voffA); PG8_STAGE(PG8_SA(0, 1), cA + hstep, voffA);
        if (wr == 1) PG8_BAR;
        PG8_WAIT_V(2); PG8_BAR;
        PG8_STAGE(PG8_SB(1, 0), cB + kstep, voffB); PG8_STAGE(PG8_SA(1, 0), cA + kstep, voffA); PG8_STAGE(PG8_SB(1, 1), cB + hstep + kstep, voffB);
        PG8_WAIT_V(6); PG8_BAR;
    } else {
        PG8_STAGE(PG8_SB(0, 0), cB, voffB); PG8_STAGE(PG8_SA(0, 0), cA, voffA); PG8_STAGE(PG8_SB(0, 1), cB + hstep, voffB); PG8_STAGE(PG8_SA(0, 1), cA + hstep, voffA);
        if (wr == 1) PG8_BAR;
        PG8_WAIT_V(4); PG8_BAR;
        PG8_STAGE(PG8_SB(1, 0), cB + kstep, voffB); PG8_STAGE(PG8_SA(1, 0), cA + kstep, voffA); PG8_STAGE(PG8_SB(1, 1), cB + hstep + kstep, voffB);
        PG8_WAIT_V(6); PG8_BAR;
    }
    for (;;) {
        const bool has_next = S.next(ui + 1, nxt);
        const char* nA = has_next ? (const char*)g.A + (size_t)nxt.pm * tstep : cA; const char* nB = has_next ? (const char*)g.Bt + (size_t)nxt.pn * tstep : cB;
#pragma unroll 1
        for (int t = 0; t < nt; t += 2) {
            const bool last = (t == nt - 2);
            const char* a1 = cA + (size_t)(t + 1) * kstep;
            const char* a2 = last ? nA : cA + (size_t)(t + 2) * kstep; const char* b2 = last ? nB : cB + (size_t)(t + 2) * kstep;
            const char* a3 = a2 + kstep; const char* b3 = b2 + kstep;
            if (last && has_next) S.a_ready(nxt);
            if constexpr (SP2) {
            PG8_LDB(B0, B08, 0, 0); PG8_LDB(B1, B18, 0, 1); PG8_SCHED; PG8_LDA(At, At8, 0, 0); PG8_STAGE(PG8_SA(1, 1), a1 + hstep, voffA);
            PG8_WAIT_V(8); PG8_WAIT_L(0); PG8_BAR; PG8_MMA(0, 0, At, At8, B0, B08); PG8_MMA(0, 1, At, At8, B1, B18); PG8_BAR; PG8_SCHED;
            PG8_LDA(At, At8, 0, 1); PG8_STAGE(PG8_SB(0, 0), b2, voffB); PG8_STAGE(PG8_SB(0, 1), b2 + hstep, voffB); PG8_STAGE(PG8_SA(0, 0), a2, voffA);
            PG8_WAIT_V(8); PG8_WAIT_L(0); PG8_BAR; PG8_MMA(1, 0, At, At8, B0, B08); PG8_MMA(1, 1, At, At8, B1, B18); PG8_BAR; PG8_SCHED;
            PG8_LDB(B0, B08, 1, 0); PG8_LDB(B1, B18, 1, 1); PG8_SCHED; PG8_LDA(At, At8, 1, 0); PG8_STAGE(PG8_SA(0, 1), a2 + hstep, voffA);
            PG8_WAIT_V(8); PG8_WAIT_L(0); PG8_BAR; PG8_MMA(0, 0, At, At8, B0, B08); PG8_MMA(0, 1, At, At8, B1, B18); PG8_BAR; PG8_SCHED;
            PG8_LDA(At, At8, 1, 1); PG8_STAGE(PG8_SB(1, 0), b3, voffB); PG8_STAGE(PG8_SB(1, 1), b3 + hstep, voffB); PG8_STAGE(PG8_SA(1, 0), a3, voffA);
            PG8_WAIT_V(8); PG8_WAIT_L(0); PG8_BAR; PG8_MMA(1, 0, At, At8, B0, B08); PG8_MMA(1, 1, At, At8, B1, B18); PG8_BAR; PG8_SCHED;
            } else {
            PG8_LDB(B0, B08, 0, 0); PG8_SCHED; PG8_LDA(At, At8, 0, 0); PG8_STAGE(PG8_SA(1, 1), a1 + hstep, voffA);
            PG8_WAIT_L(8); PG8_BAR; PG8_WAIT_L(0); PG8_MMA(0, 0, At, At8, B0, B08); PG8_BAR; PG8_SCHED;
            PG8_LDB(B1, B18, 0, 1); PG8_STAGE(PG8_SB(0, 0), b2, voffB);
            PG8_BAR; PG8_WAIT_L(0); PG8_MMA(0, 1, At, At8, B1, B18); PG8_BAR;
            PG8_LDA(At, At8, 0, 1); PG8_STAGE(PG8_SA(0, 0), a2, voffA);
            PG8_BAR; PG8_WAIT_L(0); PG8_MMA(1, 0, At, At8, B0, B08); PG8_BAR; PG8_SCHED;
            PG8_STAGE(PG8_SB(0, 1), b2 + hstep, voffB);
            PG8_WAIT_V(6); PG8_BAR; PG8_MMA(1, 1, At, At8, B1, B18); PG8_BAR;
            PG8_LDB(B0, B08, 1, 0); PG8_SCHED; PG8_LDA(At, At8, 1, 0); PG8_STAGE(PG8_SA(0, 1), a2 + hstep, voffA);
            PG8_WAIT_L(8); PG8_BAR; PG8_WAIT_L(0); PG8_MMA(0, 0, At, At8, B0, B08); PG8_BAR; PG8_SCHED;
            PG8_LDB(B1, B18, 1, 1); PG8_STAGE(PG8_SB(1, 0), b3, voffB);
            PG8_BAR; PG8_WAIT_L(0); PG8_MMA(0, 1, At, At8, B1, B18); PG8_BAR;
            PG8_LDA(At, At8, 1, 1); PG8_STAGE(PG8_SA(1, 0), a3, voffA);
            PG8_BAR; PG8_WAIT_L(0); PG8_MMA(1, 0, At, At8, B0, B08); PG8_BAR; PG8_SCHED;
            PG8_STAGE(PG8_SB(1, 1), b3 + hstep, voffB);
            PG8_WAIT_V(6); PG8_BAR; PG8_MMA(1, 1, At, At8, B1, B18); PG8_BAR;
            }
        }
        if constexpr (FP8) asm volatile("s_nop 15\n\ts_nop 15" ::: "memory");
        if constexpr (ALIGN_EPI) { if (wr == 0) PG8_BAR; }
        if constexpr (!Epi::AFTER_DRAIN) { E(acc, cur, wr, wc, fr, fq); S.done(cur); }
        if (!has_next) break;
#pragma unroll
        for (int a = 0; a < 2; ++a)
#pragma unroll
            for (int b = 0; b < 2; ++b)
#pragma unroll
                for (int m = 0; m < 4; ++m)
#pragma unroll
                    for (int n = 0; n < 2; ++n) acc[a][b][m][n] = (f32x4){0.f, 0.f, 0.f, 0.f};
        cur = nxt; cA = nA; cB = nB; ++ui;
        if constexpr (ALIGN_EPI) { if (wr == 1) PG8_BAR; }
    }
    PG8_WAIT_V(0);
    if constexpr (!ALIGN_EPI) { if (wr == 0) PG8_BAR; }
    PG8_BAR;
    if constexpr (Epi::AFTER_DRAIN) { E.fused(acc, cur, wr, wc, fr, fq, lds, wid, lane); S.done(cur); }
#undef PG8_SA
#undef PG8_SB
#undef PG8_STAGE
#undef PG8_LDA
#undef PG8_LDB
#undef PG8_MMA
#undef PG8_WAIT_V
#undef PG8_WAIT_L
#undef PG8_BAR
#undef PG8_SCHED
}
}

#define GAS __attribute__((address_space(1)))
#define LAS __attribute__((address_space(3)))
typedef unsigned short bf16;
typedef unsigned v4u __attribute__((ext_vector_type(4)));
typedef unsigned v2u __attribute__((ext_vector_type(2)));
typedef float f32x4 __attribute__((ext_vector_type(4)));
typedef float f32x2 __attribute__((ext_vector_type(2)));
typedef short bf16x8 __attribute__((ext_vector_type(8)));
typedef short v4i16 __attribute__((ext_vector_type(4)));
typedef GAS unsigned gu32;
#define RLX_AGENT __ATOMIC_RELAXED, __HIP_MEMORY_SCOPE_AGENT
#define LDS_WAIT() asm volatile("s_waitcnt lgkmcnt(0)" ::: "memory")
#define VM_WAIT() asm volatile("s_waitcnt vmcnt(0)" ::: "memory")
__device__ __forceinline__ unsigned pk2(float lo, float hi) { return pg8::cvt_pk_bf16(lo, hi); }
__device__ __forceinline__ float bflo(unsigned u) { return __uint_as_float(u << 16); }
__device__ __forceinline__ float bfhi(unsigned u) { return __uint_as_float(u & 0xffff0000u); }
__device__ __forceinline__ float wave_sum(float v) {
#pragma unroll
    for (int o = 1; o < 64; o <<= 1) v += __shfl_xor(v, o);
    return v;
}
__device__ __forceinline__ f32x4 mfma16(bf16x8 a, bf16x8 b, f32x4 c) { return __builtin_amdgcn_mfma_f32_16x16x32_bf16(a, b, c, 0, 0, 0); }
__device__ __forceinline__ v4i16 trrd(LAS unsigned char* p) { return __builtin_amdgcn_ds_read_tr16_b64_v4i16((LAS v4i16*)p); }
__device__ __forceinline__ bf16x8 cat8(v4i16 lo, v4i16 hi) { return (bf16x8){lo[0], lo[1], lo[2], lo[3], hi[0], hi[1], hi[2], hi[3]}; }
__device__ __forceinline__ bf16x8 pack8(float a0, float a1, float a2, float a3, float a4, float a5, float a6, float a7) {
    v4u w; w.x = pk2(a0, a1); w.y = pk2(a2, a3); w.z = pk2(a4, a5); w.w = pk2(a6, a7); return __builtin_bit_cast(bf16x8, w); }
__device__ __forceinline__ float silu(float x) { return x * __builtin_amdgcn_rcpf(1.0f + __expf(-x)); }

#define XB_TMO      128
#define XB_XCNT(j)  (256  + 64 * (j))
#define XB_XSUB(j)  (1280 + 64 * (j))
#define XB_XGEN(j)  (2304 + 64 * (j))
#define XB_TOP      3328
#define XB_TOPGEN   3392
#define XCD_BAR_WORDS 3456
#define XB_SPIN_CAP (1u << 18)

__device__ __forceinline__ unsigned xb_ld(unsigned* p)              { return __hip_atomic_load(p, __ATOMIC_RELAXED, __HIP_MEMORY_SCOPE_AGENT); }
__device__ __forceinline__ unsigned xb_add(unsigned* p, unsigned v) { return __hip_atomic_fetch_add(p, v, __ATOMIC_RELAXED, __HIP_MEMORY_SCOPE_AGENT); }
__device__ __forceinline__ unsigned xb_xcc_id() { return (unsigned)__builtin_amdgcn_s_getreg((3 << 11) | 20) & 0xFu; }
#define XB_SPIN(cond, bar) do { unsigned _sp = 0; while (cond) { __builtin_amdgcn_s_sleep(1); \
    if ((++_sp & 255u) == 0u) { if (xb_ld(&(bar)[XB_TMO])) break; if (_sp > XB_SPIN_CAP) { atomicAdd(&(bar)[XB_TMO], 1u); break; } } } } while (0)

struct XcdBarrier {
    unsigned* bar; unsigned x;
    volatile LAS unsigned* st;
};

__device__ __forceinline__ XcdBarrier xcd_barrier_post(unsigned* bar, volatile LAS unsigned* st) {
    XcdBarrier b; b.bar = bar; b.x = xb_xcc_id(); b.st = st;
    if (threadIdx.x == 0) (void)xb_add(&bar[XB_XCNT(b.x)], 1u);
    return b;
}
__device__ __forceinline__ void xcd_barrier_complete(unsigned* bar, unsigned x, unsigned& nloc, unsigned& nx) {
    const unsigned G = gridDim.x * gridDim.y * gridDim.z;
    unsigned sum, cnt, mine, sp = 0u;
    for (;;) {
        sum = 0u; cnt = 0u; mine = 0u;
#pragma unroll
        for (unsigned j = 0; j < 16; ++j) { const unsigned c = xb_ld(&bar[XB_XCNT(j)]); sum += c; cnt += (c > 0u) ? 1u : 0u; mine = (j == x) ? c : mine; }
        if (sum == G) break;
        __builtin_amdgcn_s_sleep(1);
        if ((++sp & 255u) == 0u) { if (xb_ld(&bar[XB_TMO])) break; if (sp > XB_SPIN_CAP) { atomicAdd(&bar[XB_TMO], 1u); break; } }
    }
    nloc = mine > 0u ? mine : 1u; nx = cnt > 0u ? cnt : 1u;
}

__device__ __forceinline__ void xcd_barrier(const XcdBarrier& b) {
    asm volatile("s_waitcnt vmcnt(0)" ::: "memory");
    __syncthreads();
    if (threadIdx.x == 0) {
        unsigned* bar = b.bar;
        __builtin_amdgcn_s_waitcnt(0);
        unsigned nloc = b.st[0], nx = b.st[1];
        if (nloc == 0u) { xcd_barrier_complete(bar, b.x, nloc, nx); b.st[0] = nloc; b.st[1] = nx; }
        const unsigned old = xb_add(&bar[XB_XSUB(b.x)], 1u);
        const unsigned gen = old / nloc;
        if (old + 1u == (gen + 1u) * nloc) {
            __builtin_amdgcn_fence(__ATOMIC_RELEASE, "agent");
            asm volatile("s_waitcnt vmcnt(0)" ::: "memory");
            const unsigned og = xb_add(&bar[XB_TOP], 1u);
            const unsigned tg = og / nx;
            if (og + 1u == (tg + 1u) * nx) xb_add(&bar[XB_TOPGEN], 1u);
            else XB_SPIN(xb_ld(&bar[XB_TOPGEN]) == tg, bar);
            __builtin_amdgcn_fence(__ATOMIC_ACQUIRE, "agent");
            xb_add(&bar[XB_XGEN(b.x)], 1u);
            asm volatile("s_waitcnt vmcnt(0)" ::: "memory");
        } else {
            XB_SPIN(xb_ld(&bar[XB_XGEN(b.x)]) == gen, bar);
            __builtin_amdgcn_fence(__ATOMIC_ACQUIRE, "agent");
            asm volatile("s_waitcnt vmcnt(0)" ::: "memory");
        }
    }
    __syncthreads();
}

constexpr int NWAVES = 8, NTHR = 512;
constexpr int D = 1024, SEQ = 8192, NBATCH = 4, M = NBATCH * SEQ, NCHUNK = SEQ / 64;
constexpr int DIN = 2824, PN = 2816;
constexpr int PC_Z = 0, PC_XBC = 512, PC_U = 1536, PC_V = 1792, PC_Q = 2048, PC_K = 2304, PC_VV = 2560;
constexpr int DFF = 2816, DFFE = 3584, NEXP = 8;
constexpr int MOE_CH = 128, MOE_NCH = 2, MOE_MAXT = 264;
constexpr int NIN = 27;
constexpr size_t MiB = 1u << 20;
constexpr size_t WS_CTL = 0, CTL_ZERO_BYTES = 65536;
constexpr size_t WS_AEND = 65536, WS_WGCNT = 98304;
constexpr size_t WS_DTRAW = 1 * MiB, WS_TOKE = 2 * MiB, WS_TOKG = 2 * MiB + 262144, WS_POS = 2 * MiB + 524288;
constexpr size_t WS_WIN = 4 * MiB, WS_WOUT = 15 * MiB, WS_WGU = 19 * MiB, WS_WD = 30 * MiB;
constexpr size_t WS_A1 = 36 * MiB, WS_XBCC = 36 * MiB;
constexpr size_t WS_PROJ = 100 * MiB, WS_MIXED = 100 * MiB, WS_H1 = 100 * MiB;
constexpr size_t WS_ST = 276 * MiB, WS_FOUT = 276 * MiB;
constexpr size_t WS_Y = 404 * MiB;
constexpr size_t WS_HM = 36 * MiB, WS_XS = 155 * MiB, WS_YM = 221 * MiB, WS_MWGU = 353 * MiB, WS_MWD = 409 * MiB, WS_END = 468 * MiB;
constexpr float FP8_SX = 8.0f, FP8_SW = 64.0f, FP8_SH = 16.0f;
constexpr int CW_BAR = 4096;
constexpr int LDS_BYTES = 163840, LDSCTL_OFF = 147456;
constexpr int CTL_MISC = LDSCTL_OFF, CTL_CNT = LDSCTL_OFF + 128, CTL_TE = LDSCTL_OFF + 512;

#ifndef PROBE_DUP
#define PROBE_DUP 0
#endif
#define REP(n) for (int rep_ = 0; rep_ < (((PROBE_DUP >> (n)) & 1) ? 2 : 1); ++rep_)
struct Args { const float* in[NIN]; float* out; unsigned char* ws; int ph_lo, ph_hi; };

struct Frame {
    LAS unsigned char* lds;
    int tid, lane, wave, vcu, G;
};
__device__ __forceinline__ bool fresh(Frame& F) { int t_ = threadIdx.x; asm volatile("" : "+v"(t_)); F.tid = t_; F.lane = t_ & 63; F.wave = __builtin_amdgcn_readfirstlane(t_ >> 6); return true; }

__device__ __forceinline__ void cvt_task(const float* W, int N, int k0, int n0, bf16* WT, int K, int row0, int lane) {
    const float* s = W + (size_t)k0 * N + n0 + lane;
    bf16* d = WT + (size_t)(row0 + lane) * K + k0;
#pragma unroll
    for (int hb = 0; hb < 2; ++hb) {
        float v[32];
#pragma unroll
        for (int j = 0; j < 32; ++j) v[j] = s[(size_t)(32 * hb + j) * N];
#pragma unroll
        for (int q = 0; q < 4; ++q) { v4u o; o.x = pk2(v[8 * q], v[8 * q + 1]); o.y = pk2(v[8 * q + 2], v[8 * q + 3]); o.z = pk2(v[8 * q + 4], v[8 * q + 5]); o.w = pk2(v[8 * q + 6], v[8 * q + 7]);
            *(GAS v4u*)(d + 32 * hb + 8 * q) = o; }
    }
}
__device__ __forceinline__ void cvt_small_weights(Frame& F, const Args& A) {
    const int gw = F.vcu * NWAVES + F.wave, NGW = F.G * NWAVES;
    bf16* WIN = (bf16*)(A.ws + WS_WIN); bf16* WOUT = (bf16*)(A.ws + WS_WOUT); bf16* WGU = (bf16*)(A.ws + WS_WGU); bf16* WD = (bf16*)(A.ws + WS_WD);
    constexpr int NI = 1408 + 512 + 1408 + 704;
    for (int it = gw; it < NI; it += NGW) {
        int r = it;
        if (r < 1408) { const int L = r / 704; r %= 704; const int kb = r / 44, nb = r % 44; const int ns = 64 * nb + (64 * nb >= 1536 ? 8 : 0);
            cvt_task(A.in[5] + (size_t)L * D * DIN, DIN, 64 * kb, ns, WIN + (size_t)L * PN * D, D, 64 * nb, F.lane); continue; }
        r -= 1408;
        if (r < 512) { const int L = r / 256; r %= 256; const int kb = r / 16, nb = r % 16;
            cvt_task(A.in[19] + (size_t)L * D * D, D, 64 * kb, 64 * nb, WOUT + (size_t)L * D * D, D, 64 * nb, F.lane); continue; }
        r -= 512;
        if (r < 1408) { const int up = r / 704; r %= 704; const int kb = r / 44, nb = r % 44;
            cvt_task(up ? A.in[21] : A.in[20], DFF, 64 * kb, 64 * nb, WGU, D, 256 * (nb >> 1) + 64 * (nb & 1) + 128 * up, F.lane); continue; }
        r -= 1408;
        { const int kb = r / 16, nb = r % 16; cvt_task(A.in[22], D, 64 * kb, 64 * nb, WD, DFF, 64 * nb, F.lane); }
    }
}
__device__ __forceinline__ void cvt_task8(const float* W, int N, int k0, int n0, unsigned char* WT, int K, int row0, float scale, int lane) {
    const float* s = W + (size_t)k0 * N + n0 + lane;
    unsigned char* d = WT + (size_t)(row0 + lane) * K + k0;
#pragma unroll
    for (int hb = 0; hb < 2; ++hb) {
        float v[32];
#pragma unroll
        for (int j = 0; j < 32; ++j) v[j] = s[(size_t)(32 * hb + j) * N] * scale;
#pragma unroll
        for (int q = 0; q < 2; ++q) { v4u o; o.x = pg8::pack_fp8x4(v[16 * q], v[16 * q + 1], v[16 * q + 2], v[16 * q + 3]); o.y = pg8::pack_fp8x4(v[16 * q + 4], v[16 * q + 5], v[16 * q + 6], v[16 * q + 7]);
            o.z = pg8::pack_fp8x4(v[16 * q + 8], v[16 * q + 9], v[16 * q + 10], v[16 * q + 11]); o.w = pg8::pack_fp8x4(v[16 * q + 12], v[16 * q + 13], v[16 * q + 14], v[16 * q + 15]);
            *(GAS v4u*)(d + 32 * hb + 16 * q) = o; }
    }
}
__device__ __forceinline__ void cvt_moe_weights(Frame& F, const Args& A) {
    const int gw = F.vcu * NWAVES + F.wave, NGW = F.G * NWAVES;
    unsigned char* MWGU = A.ws + WS_MWGU; unsigned char* MWD = A.ws + WS_MWD;
    constexpr int NI = 14336 + 7168;
    for (int it = gw; it < NI; it += NGW) {
        int r = it;
        if (r < 14336) { const int ue = r / 896; r %= 896; const int up = ue >> 3, e = ue & 7; const int kb = r / 56, nb = r % 56;
            cvt_task8((up ? A.in[25] : A.in[24]) + (size_t)e * D * DFFE, DFFE, 64 * kb, 64 * nb, MWGU + (size_t)e * 7168 * D, D, 256 * (nb >> 1) + 64 * (nb & 1) + 128 * up, FP8_SW, F.lane); continue; }
        r -= 14336;
        { const int e = r / 896; r %= 896; const int kb = r / 16, nb = r % 16;
          cvt_task8(A.in[26] + (size_t)e * DFFE * D, D, 64 * kb, 64 * nb, MWD + (size_t)e * D * DFFE, DFFE, 64 * nb, FP8_SW, F.lane); }
    }
}

struct RowArgs {
    const float* hsrc; float* hdst;
    int branch;
    const bf16* ybuf; const float* gpost;
    const float* gpre; bf16* a1;
    int proj;
    const float* w8; int w8ld;
};
__device__ __forceinline__ void row_phase(Frame& F, const Args& A, const RowArgs& R) {
    LAS float* W8T = (LAS float*)F.lds;
    LAS int* cnt = (LAS int*)(F.lds + CTL_CNT);
    const int lane = F.lane;
    if (R.proj) { for (int idx = F.tid; idx < 8192; idx += NTHR) { const int e = idx & 7, k = idx >> 3; W8T[e * 1024 + k] = R.w8[(size_t)k * R.w8ld + e]; } }
    if (R.proj == 2 && F.tid < 8) cnt[F.tid] = 0;
    __syncthreads();
    f32x4 gpo[4], gpr[4];
#pragma unroll
    for (int j = 0; j < 4; ++j) { gpo[j] = R.branch ? *(const f32x4*)(R.gpost + 4 * lane + 256 * j) : (f32x4){0.f, 0.f, 0.f, 0.f}; gpr[j] = R.gpre ? *(const f32x4*)(R.gpre + 4 * lane + 256 * j) : (f32x4){0.f, 0.f, 0.f, 0.f}; }
    float* DTRAW = (float*)(A.ws + WS_DTRAW); int* TOKE = (int*)(A.ws + WS_TOKE); float* TOKG = (float*)(A.ws + WS_TOKG); const int* POS = (const int*)(A.ws + WS_POS);
    const int gw = F.vcu * NWAVES + F.wave, NGW = F.G * NWAVES;
    for (int m = gw; m < M; m += NGW) {
        f32x4 v[4];
#pragma unroll
        for (int j = 0; j < 4; ++j) v[j] = *(const f32x4*)(R.hsrc + (size_t)m * D + 4 * lane + 256 * j);
        if (R.branch) {
            f32x4 y[4];
            if (R.branch == 1) {
#pragma unroll
                for (int j = 0; j < 4; ++j) { const v2u raw = *(const v2u*)(R.ybuf + (size_t)m * D + 4 * lane + 256 * j); y[j] = (f32x4){bflo(raw.x), bfhi(raw.x), bflo(raw.y), bfhi(raw.y)}; }
            } else {
                const int p0 = POS[2 * m], p1 = POS[2 * m + 1]; const float g0 = TOKG[2 * m], g1 = TOKG[2 * m + 1];
#pragma unroll
                for (int j = 0; j < 4; ++j) { const v2u r0 = *(const v2u*)(R.ybuf + (size_t)p0 * D + 4 * lane + 256 * j); const v2u r1 = *(const v2u*)(R.ybuf + (size_t)p1 * D + 4 * lane + 256 * j);
                    y[j] = (f32x4){g0 * bflo(r0.x) + g1 * bflo(r1.x), g0 * bfhi(r0.x) + g1 * bfhi(r1.x), g0 * bflo(r0.y) + g1 * bflo(r1.y), g0 * bfhi(r0.y) + g1 * bfhi(r1.y)}; }
            }
            float ss = 0.f;
#pragma unroll
            for (int j = 0; j < 4; ++j) ss += (y[j].x * y[j].x + y[j].y * y[j].y) + (y[j].z * y[j].z + y[j].w * y[j].w);
            const float sc = 1.0f / sqrtf(wave_sum(ss) * (1.0f / D) + 1e-6f);
#pragma unroll
            for (int j = 0; j < 4; ++j) v[j] = v[j] + y[j] * sc * gpo[j];
        }
        if (R.hdst) {
#pragma unroll
            for (int j = 0; j < 4; ++j) *(f32x4*)(R.hdst + (size_t)m * D + 4 * lane + 256 * j) = v[j];
        }
        if (R.gpre) {
            float ss = 0.f;
#pragma unroll
            for (int j = 0; j < 4; ++j) ss += (v[j].x * v[j].x + v[j].y * v[j].y) + (v[j].z * v[j].z + v[j].w * v[j].w);
            const float sc = 1.0f / sqrtf(wave_sum(ss) * (1.0f / D) + 1e-6f);
#pragma unroll
            for (int j = 0; j < 4; ++j) { v[j] = v[j] * sc * gpr[j]; v2u o; o.x = pk2(v[j].x, v[j].y); o.y = pk2(v[j].z, v[j].w); *(v2u*)(R.a1 + (size_t)m * D + 4 * lane + 256 * j) = o; }
            if (R.proj) {
                float p[8];
#pragma unroll
                for (int e = 0; e < 8; ++e) { float s = 0.f;
#pragma unroll
                    for (int j = 0; j < 4; ++j) { const f32x4 w = *(const LAS f32x4*)(W8T + e * 1024 + 4 * lane + 256 * j); s += (v[j].x * w.x + v[j].y * w.y) + (v[j].z * w.z + v[j].w * w.w); }
                    p[e] = wave_sum(s); }
                if (R.proj == 1) {
                    float mine = p[0];
#pragma unroll
                    for (int e = 1; e < 8; ++e) mine = (lane == e) ? p[e] : mine;
                    if (lane < 8) DTRAW[(size_t)m * 8 + lane] = mine;
                } else {
                    float best = p[0]; int bi = 0;
#pragma unroll
                    for (int e = 1; e < 8; ++e) if (p[e] > best) { best = p[e]; bi = e; }
                    float sb = -3.0e38f; int si = 0;
#pragma unroll
                    for (int e = 0; e < 8; ++e) if (e != bi && p[e] > sb) { sb = p[e]; si = e; }
                    const float g0 = 1.0f / (1.0f + expf(sb - best)), g1 = 1.0f - g0;
                    if (lane == 0) { TOKE[2 * m] = bi; TOKE[2 * m + 1] = si; TOKG[2 * m] = g0; TOKG[2 * m + 1] = g1;
                        __hip_atomic_fetch_add(cnt + bi, 1, __ATOMIC_RELAXED, __HIP_MEMORY_SCOPE_WORKGROUP); __hip_atomic_fetch_add(cnt + si, 1, __ATOMIC_RELAXED, __HIP_MEMORY_SCOPE_WORKGROUP); }
                }
            }
        }
    }
    if (R.proj == 2) { __syncthreads(); if (F.tid < 8) ((int*)(A.ws + WS_WGCNT))[F.vcu * 8 + F.tid] = cnt[F.tid]; }
    __syncthreads();
}

__device__ __forceinline__ void moe_tables(Frame& F, const Args& A) {
    LAS int* c = (LAS int*)(F.lds + CTL_CNT); LAS int* te = (LAS int*)(F.lds + CTL_TE);
    if (F.tid < 40) c[F.tid] = 0;
    __syncthreads();
    const int* WGCNT = (const int*)(A.ws + WS_WGCNT);
    for (int idx = F.tid; idx < F.G * 8; idx += NTHR) { const int wg = idx >> 3, e = idx & 7; const int v = WGCNT[idx];
        __hip_atomic_fetch_add(c + e, v, __ATOMIC_RELAXED, __HIP_MEMORY_SCOPE_WORKGROUP); if (wg < F.vcu) __hip_atomic_fetch_add(c + 8 + e, v, __ATOMIC_RELAXED, __HIP_MEMORY_SCOPE_WORKGROUP); }
    __syncthreads();
    if (F.tid == 0) { int t = 0; for (int e = 0; e < 8; ++e) { c[16 + e] = t * 256; const int n = (c[e] + 255) >> 8; for (int j = 0; j < n && t + j < MOE_MAXT; ++j) te[t + j] = e; t += n; } c[32] = t < MOE_MAXT ? t : MOE_MAXT; }
    __syncthreads();
}
__device__ __forceinline__ void moe_gather(Frame& F, const Args& A) {
    LAS int* c = (LAS int*)(F.lds + CTL_CNT);
    const int* TOKE = (const int*)(A.ws + WS_TOKE); int* POS = (int*)(A.ws + WS_POS);
    const bf16* A1 = (const bf16*)(A.ws + WS_A1); unsigned char* XS = A.ws + WS_XS;
    const int gw = F.vcu * NWAVES + F.wave, NGW = F.G * NWAVES, lane = F.lane;
    for (int m = gw; m < M; m += NGW) {
        int d0 = 0, d1 = 0;
        if (lane == 0) { const int e0 = TOKE[2 * m], e1 = TOKE[2 * m + 1];
            d0 = c[16 + e0] + c[8 + e0] + __hip_atomic_fetch_add(c + 24 + e0, 1, __ATOMIC_RELAXED, __HIP_MEMORY_SCOPE_WORKGROUP);
            d1 = c[16 + e1] + c[8 + e1] + __hip_atomic_fetch_add(c + 24 + e1, 1, __ATOMIC_RELAXED, __HIP_MEMORY_SCOPE_WORKGROUP);
            POS[2 * m] = d0; POS[2 * m + 1] = d1; }
        d0 = __builtin_amdgcn_readfirstlane(d0); d1 = __builtin_amdgcn_readfirstlane(d1);
        const v4u r0 = *(const v4u*)(A1 + (size_t)m * D + 16 * lane), r1 = *(const v4u*)(A1 + (size_t)m * D + 16 * lane + 8);
        v4u o;
        o.x = pg8::pack_fp8x4(bflo(r0.x) * FP8_SX, bfhi(r0.x) * FP8_SX, bflo(r0.y) * FP8_SX, bfhi(r0.y) * FP8_SX); o.y = pg8::pack_fp8x4(bflo(r0.z) * FP8_SX, bfhi(r0.z) * FP8_SX, bflo(r0.w) * FP8_SX, bfhi(r0.w) * FP8_SX);
        o.z = pg8::pack_fp8x4(bflo(r1.x) * FP8_SX, bfhi(r1.x) * FP8_SX, bflo(r1.y) * FP8_SX, bfhi(r1.y) * FP8_SX); o.w = pg8::pack_fp8x4(bflo(r1.z) * FP8_SX, bfhi(r1.z) * FP8_SX, bflo(r1.w) * FP8_SX, bfhi(r1.w) * FP8_SX);
        *(v4u*)(XS + (size_t)d0 * D + 16 * lane) = o; *(v4u*)(XS + (size_t)d1 * D + 16 * lane) = o;
    }
    __syncthreads();
}

__device__ __forceinline__ void gmlp_unit(Frame& F, const Args& A, int L, int nb) {
    LAS unsigned char* Ls = F.lds; const int lane = F.lane, w = F.wave, fr = lane & 15, q4 = lane >> 4;
    const size_t m0 = (size_t)nb * 128;
    const bf16* P = (const bf16*)(A.ws + WS_PROJ); bf16* Y = (bf16*)(A.ws + WS_Y);
    { const f32x4 g4 = *(const f32x4*)(A.in[12] + L * 256 + 4 * lane), b4 = *(const f32x4*)(A.in[13] + L * 256 + 4 * lane);
#pragma unroll 2
      for (int i = 0; i < 16; ++i) { const int r = 16 * w + i;
        const v2u raw = *(const v2u*)(P + (m0 + r) * PN + PC_V + 4 * lane);
        f32x4 v = (f32x4){bflo(raw.x), bfhi(raw.x), bflo(raw.y), bfhi(raw.y)};
        const float mu = wave_sum((v.x + v.y) + (v.z + v.w)) * (1.0f / 256.0f);
        v = v - mu;
        const float var = wave_sum((v.x * v.x + v.y * v.y) + (v.z * v.z + v.w * v.w)) * (1.0f / 256.0f);
        const float rstd = 1.0f / sqrtf(var + 1e-5f);
        v = v * rstd * g4 + b4;
        v2u o; o.x = pk2(v.x, v.y); o.y = pk2(v.z, v.w);
        *(LAS v2u*)(Ls + r * 544 + lane * 8) = o; } }
    __syncthreads();
    const int g = w & 3;
    f32x4 acc[4][4];
    const float* Wg = A.in[14] + (size_t)(L * 4 + g) * 128 * 128;
    const float* bsg = A.in[15] + (size_t)(L * 4 + g) * 128;
#pragma unroll
    for (int pi = 0; pi < 4; ++pi) {
        const int it = (w >> 2) == 0 ? (pi == 0 ? 0 : pi == 1 ? 7 : pi == 2 ? 1 : 6) : (pi == 0 ? 2 : pi == 1 ? 5 : pi == 2 ? 3 : 4);
#pragma unroll
        for (int ct = 0; ct < 4; ++ct) acc[pi][ct] = (f32x4){0.f, 0.f, 0.f, 0.f};
        const int t = 16 * it + fr, nks = (it >> 1) + 1;
        for (int ks = 0; ks < nks; ++ks) {
            const int sA = 32 * ks + 4 * q4, sB = sA + 16;
            const f32x4 wa = *(const f32x4*)(Wg + t * 128 + sA), wb = *(const f32x4*)(Wg + t * 128 + sB);
            const bf16x8 xf = pack8(sA + 0 <= t ? wa.x : 0.f, sA + 1 <= t ? wa.y : 0.f, sA + 2 <= t ? wa.z : 0.f, sA + 3 <= t ? wa.w : 0.f,
                                    sB + 0 <= t ? wb.x : 0.f, sB + 1 <= t ? wb.y : 0.f, sB + 2 <= t ? wb.z : 0.f, sB + 3 <= t ? wb.w : 0.f);
#pragma unroll
            for (int ct = 0; ct < 4; ++ct) { const int col = g * 64 + ct * 16 + 4 * (lane & 3);
                const v4i16 lo = trrd(Ls + (sA + (fr >> 2)) * 544 + col * 2), hi = trrd(Ls + (sB + (fr >> 2)) * 544 + col * 2);
                acc[pi][ct] = mfma16(xf, cat8(lo, hi), acc[pi][ct]); }
        }
#pragma unroll
        for (int r = 0; r < 4; ++r) { const float bs = bsg[16 * it + 4 * q4 + r];
#pragma unroll
            for (int ct = 0; ct < 4; ++ct) acc[pi][ct][r] += bs; }
    }
    __syncthreads();
#pragma unroll
    for (int pi = 0; pi < 4; ++pi) {
        const int it = (w >> 2) == 0 ? (pi == 0 ? 0 : pi == 1 ? 7 : pi == 2 ? 1 : 6) : (pi == 0 ? 2 : pi == 1 ? 5 : pi == 2 ? 3 : 4);
#pragma unroll
        for (int ct = 0; ct < 4; ++ct)
#pragma unroll
            for (int r = 0; r < 4; ++r) *(LAS float*)(Ls + (16 * it + 4 * q4 + r) * 1040 + (g * 64 + ct * 16 + fr) * 4) = acc[pi][ct][r];
    }
    __syncthreads();
    { const f32x4 gn = *(const f32x4*)(A.in[16] + L * 256 + 4 * lane);
#pragma unroll 2
      for (int i = 0; i < 16; ++i) { const int r = 16 * w + i;
        const f32x4 mx = *(const LAS f32x4*)(Ls + r * 1040 + lane * 16);
        const v2u raw = *(const v2u*)(P + (m0 + r) * PN + PC_U + 4 * lane);
        f32x4 v = (f32x4){bflo(raw.x), bfhi(raw.x), bflo(raw.y), bfhi(raw.y)} * mx;
        const float ss = wave_sum((v.x * v.x + v.y * v.y) + (v.z * v.z + v.w * v.w)) * (1.0f / 256.0f);
        v = v * (1.0f / sqrtf(ss + 1e-6f)) * gn;
        v2u o; o.x = pk2(v.x, v.y); o.y = pk2(v.z, v.w);
        *(v2u*)(Y + (m0 + r) * D + 512 + 4 * lane) = o; } }
    __syncthreads();
}

__device__ __forceinline__ void attn_unit(Frame& F, const Args& A, int L, int bc) {
    LAS unsigned char* Ls = F.lds; const int lane = F.lane, w = F.wave, fr = lane & 15, q4 = lane >> 4;
    const int b = bc >> 7, c = bc & 127; const size_t m0 = (size_t)b * SEQ + (size_t)c * 64;
    const bf16* P = (const bf16*)(A.ws + WS_PROJ); bf16* Y = (bf16*)(A.ws + WS_Y);
    const int h = w >> 1, qh = w & 1;
    LAS unsigned char* Vb = Ls + w * 10240;
    const float* bias = A.in[17] + (size_t)(L * 4 + h) * 257;
    bf16x8 qf[2][2];
#pragma unroll
    for (int qb = 0; qb < 2; ++qb)
#pragma unroll
        for (int ks = 0; ks < 2; ++ks) qf[qb][ks] = *(const bf16x8*)(P + (m0 + 32 * qh + 16 * qb + fr) * PN + PC_Q + h * 64 + 32 * ks + 8 * q4);
    f32x4 o[4][2];
#pragma unroll
    for (int dt = 0; dt < 4; ++dt) { o[dt][0] = (f32x4){0.f, 0.f, 0.f, 0.f}; o[dt][1] = (f32x4){0.f, 0.f, 0.f, 0.f}; }
    float mrun[2] = {-1e30f, -1e30f}, lrun[2] = {0.f, 0.f};
    const int jmin = c >= 8 ? 0 : 8 - c;
    for (int j = jmin; j <= 8; ++j) {
        const size_t kr0 = m0 - (size_t)(8 - j) * 64;
#pragma unroll
        for (int i = 0; i < 8; ++i) { const int row = i * 8 + (lane >> 3), ch = lane & 7;
            const v4u v = *(const v4u*)(P + (kr0 + row) * PN + PC_VV + h * 64 + ch * 8); *(LAS v4u*)(Vb + row * 160 + ch * 16) = v; }
        f32x4 st[4][2];
#pragma unroll
        for (int kt = 0; kt < 4; ++kt) { st[kt][0] = (f32x4){0.f, 0.f, 0.f, 0.f}; st[kt][1] = (f32x4){0.f, 0.f, 0.f, 0.f};
#pragma unroll
            for (int ks = 0; ks < 2; ++ks) { const bf16x8 kf = *(const bf16x8*)(P + (kr0 + 16 * kt + fr) * PN + PC_K + h * 64 + 32 * ks + 8 * q4);
                st[kt][0] = mfma16(kf, qf[0][ks], st[kt][0]); st[kt][1] = mfma16(kf, qf[1][ks], st[kt][1]); } }
#pragma unroll
        for (int qb = 0; qb < 2; ++qb) {
            const int qpos = 32 * qh + 16 * qb + fr; float mx = -1e30f;
#pragma unroll
            for (int kt = 0; kt < 4; ++kt)
#pragma unroll
                for (int r = 0; r < 4; ++r) { const int key = 16 * kt + 4 * q4 + r; int rel = 512 - 64 * j + qpos - key; rel = rel < -128 ? -128 : (rel > 128 ? 128 : rel);
                    const float s = st[kt][qb][r] * 0.125f + bias[rel + 128]; st[kt][qb][r] = s; mx = fmaxf(mx, s); }
            mx = fmaxf(mx, __shfl_xor(mx, 16)); mx = fmaxf(mx, __shfl_xor(mx, 32));
            const float mnew = fmaxf(mrun[qb], mx), alpha = __expf(mrun[qb] - mnew); mrun[qb] = mnew;
            float rs = 0.f;
#pragma unroll
            for (int kt = 0; kt < 4; ++kt)
#pragma unroll
                for (int r = 0; r < 4; ++r) { const float p = __expf(st[kt][qb][r] - mnew); st[kt][qb][r] = p; rs += p; }
            rs += __shfl_xor(rs, 16); rs += __shfl_xor(rs, 32);
            lrun[qb] = lrun[qb] * alpha + rs;
#pragma unroll
            for (int dt = 0; dt < 4; ++dt) o[dt][qb] = o[dt][qb] * alpha;
        }
#pragma unroll
        for (int kk = 0; kk < 2; ++kk) {
            const bf16x8 y0 = pack8(st[2 * kk][0][0], st[2 * kk][0][1], st[2 * kk][0][2], st[2 * kk][0][3], st[2 * kk + 1][0][0], st[2 * kk + 1][0][1], st[2 * kk + 1][0][2], st[2 * kk + 1][0][3]);
            const bf16x8 y1 = pack8(st[2 * kk][1][0], st[2 * kk][1][1], st[2 * kk][1][2], st[2 * kk][1][3], st[2 * kk + 1][1][0], st[2 * kk + 1][1][1], st[2 * kk + 1][1][2], st[2 * kk + 1][1][3]);
            const int rowA = 32 * kk + 4 * q4 + (fr >> 2), rowB = rowA + 16;
#pragma unroll
            for (int dt = 0; dt < 4; ++dt) { const int cb = (16 * dt + 4 * (lane & 3)) * 2;
                const bf16x8 xf = cat8(trrd(Vb + rowA * 160 + cb), trrd(Vb + rowB * 160 + cb));
                o[dt][0] = mfma16(xf, y0, o[dt][0]); o[dt][1] = mfma16(xf, y1, o[dt][1]); }
        }
    }
    const float il0 = 1.0f / lrun[0], il1 = 1.0f / lrun[1];
    __syncthreads();
#pragma unroll
    for (int dt = 0; dt < 4; ++dt) {
        *(LAS f32x4*)(Ls + (32 * qh + fr) * 1040 + (h * 64 + 16 * dt + 4 * q4) * 4) = o[dt][0] * il0;
        *(LAS f32x4*)(Ls + (32 * qh + 16 + fr) * 1040 + (h * 64 + 16 * dt + 4 * q4) * 4) = o[dt][1] * il1; }
    __syncthreads();
    { const f32x4 gn = *(const f32x4*)(A.in[18] + L * 256 + 4 * lane);
#pragma unroll 2
      for (int i = 0; i < 8; ++i) { const int r = 8 * w + i;
        f32x4 v = *(const LAS f32x4*)(Ls + r * 1040 + lane * 16);
        const float ss = wave_sum((v.x * v.x + v.y * v.y) + (v.z * v.z + v.w * v.w)) * (1.0f / 256.0f);
        v = v * (1.0f / sqrtf(ss + 1e-6f)) * gn;
        v2u ov; ov.x = pk2(v.x, v.y); ov.y = pk2(v.z, v.w);
        *(v2u*)(Y + (m0 + r) * D + 768 + 4 * lane) = ov; } }
    __syncthreads();
}

__device__ __forceinline__ void ssd_prepass(Frame& F, const Args& A, int L, size_t m0, LAS float* dtl, LAS float* acs) {
    const float* DTRAW = (const float*)(A.ws + WS_DTRAW);
    if (F.wave == 0) { const int l = F.lane;
        const f32x4 r0 = *(const f32x4*)(DTRAW + (m0 + l) * 8), r1 = *(const f32x4*)(DTRAW + (m0 + l) * 8 + 4);
        const float raw[8] = {r0.x, r0.y, r0.z, r0.w, r1.x, r1.y, r1.z, r1.w};
#pragma unroll
        for (int h = 0; h < 8; ++h) { const float x = raw[h] + A.in[8][L * 8 + h];
            const float dt = x > 20.f ? x : log1pf(expf(x));
            float s = -dt * expf(A.in[9][L * 8 + h]);
#pragma unroll
            for (int o = 1; o < 64; o <<= 1) { const float t = __shfl_up(s, o); s += (l >= o) ? t : 0.f; }
            dtl[l * 8 + h] = dt; acs[l * 8 + h] = s; } }
    __syncthreads();
}
__device__ __forceinline__ void ssd1_unit(Frame& F, const Args& A, int L, int bc) {
    LAS unsigned char* Ls = F.lds; const int lane = F.lane, w = F.wave, fr = lane & 15, q4 = lane >> 4;
    const int b = bc >> 7, c = bc & 127; const size_t m0 = (size_t)b * SEQ + (size_t)c * 64;
    const bf16* P = (const bf16*)(A.ws + WS_PROJ); bf16* XBCC = (bf16*)(A.ws + WS_XBCC); bf16* ST = (bf16*)(A.ws + WS_ST); float* AEND = (float*)(A.ws + WS_AEND);
    LAS unsigned char* XI = Ls; LAS unsigned char* BI = Ls + 67584;
    LAS float* dtl = (LAS float*)(Ls + 102400); LAS float* acs = (LAS float*)(Ls + 104448);
    ssd_prepass(F, A, L, m0, dtl, acs);
    if (F.tid < 8) AEND[(size_t)bc * 8 + F.tid] = acs[63 * 8 + F.tid];
    { const int cg = F.tid & 127, tg = F.tid >> 7, ch0 = 8 * cg;
      float wk[4][8], bs[8];
#pragma unroll
      for (int k = 0; k < 4; ++k) { const f32x4 a = *(const f32x4*)(A.in[6] + (size_t)(L * 4 + k) * 1024 + ch0), bq = *(const f32x4*)(A.in[6] + (size_t)(L * 4 + k) * 1024 + ch0 + 4);
          wk[k][0] = a.x; wk[k][1] = a.y; wk[k][2] = a.z; wk[k][3] = a.w; wk[k][4] = bq.x; wk[k][5] = bq.y; wk[k][6] = bq.z; wk[k][7] = bq.w; }
      { const f32x4 a = *(const f32x4*)(A.in[7] + (size_t)L * 1024 + ch0), bq = *(const f32x4*)(A.in[7] + (size_t)L * 1024 + ch0 + 4);
          bs[0] = a.x; bs[1] = a.y; bs[2] = a.z; bs[3] = a.w; bs[4] = bq.x; bs[5] = bq.y; bs[6] = bq.z; bs[7] = bq.w; }
      const int hh = cg >> 3;
#pragma unroll 1
      for (int hf = 0; hf < 2; ++hf) {
      v4u raw[11];
#pragma unroll
      for (int tt = 0; tt < 11; ++tt) { const int lp = 16 * tg + 8 * hf - 3 + tt; const bool ok = (c * 64 + lp) >= 0;
          raw[tt] = ok ? *(const v4u*)(P + (size_t)((long)m0 + lp) * PN + PC_XBC + ch0) : (v4u){0u, 0u, 0u, 0u}; }
#pragma unroll
      for (int t = 0; t < 8; ++t) { const int l = 16 * tg + 8 * hf + t;
          float y[8];
#pragma unroll
          for (int e = 0; e < 8; ++e) y[e] = bs[e];
#pragma unroll
          for (int k = 0; k < 4; ++k) { const v4u rw = raw[t + k];
              y[0] += wk[k][0] * bflo(rw.x); y[1] += wk[k][1] * bfhi(rw.x); y[2] += wk[k][2] * bflo(rw.y); y[3] += wk[k][3] * bfhi(rw.y);
              y[4] += wk[k][4] * bflo(rw.z); y[5] += wk[k][5] * bfhi(rw.z); y[6] += wk[k][6] * bflo(rw.w); y[7] += wk[k][7] * bfhi(rw.w); }
#pragma unroll
          for (int e = 0; e < 8; ++e) y[e] = silu(y[e]);
          v4u o; o.x = pk2(y[0], y[1]); o.y = pk2(y[2], y[3]); o.z = pk2(y[4], y[5]); o.w = pk2(y[6], y[7]);
          *(v4u*)(XBCC + (m0 + l) * 1024 + ch0) = o;
          if (cg < 64) { const float sc = dtl[l * 8 + hh] * __expf(acs[63 * 8 + hh] - acs[l * 8 + hh]);
              v4u os; os.x = pk2(y[0] * sc, y[1] * sc); os.y = pk2(y[2] * sc, y[3] * sc); os.z = pk2(y[4] * sc, y[5] * sc); os.w = pk2(y[6] * sc, y[7] * sc);
              *(LAS v4u*)(XI + l * 1056 + ch0 * 2) = os; }
          else if (cg < 96) *(LAS v4u*)(BI + l * 544 + (ch0 - 512) * 2) = o;
      } } }
    __syncthreads();
    { const int h = w, gi = h >> 2;
      bf16* STh = ST + ((size_t)bc * 8 + h) * 8192;
#pragma unroll 1
      for (int nh = 0; nh < 2; ++nh) {
      f32x4 acc[4][4];
#pragma unroll
      for (int nt = 0; nt < 4; ++nt)
#pragma unroll
          for (int pt = 0; pt < 4; ++pt) acc[nt][pt] = (f32x4){0.f, 0.f, 0.f, 0.f};
#pragma unroll
      for (int ks = 0; ks < 2; ++ks) {
          const int rowA = 32 * ks + 4 * q4 + (fr >> 2), rowB = rowA + 16;
          bf16x8 yf[4];
#pragma unroll
          for (int pt = 0; pt < 4; ++pt) { const int cb = (h * 64 + 16 * pt + 4 * (lane & 3)) * 2; yf[pt] = cat8(trrd(XI + rowA * 1056 + cb), trrd(XI + rowB * 1056 + cb)); }
#pragma unroll
          for (int nt = 0; nt < 4; ++nt) { const int cb = (gi * 128 + 64 * nh + 16 * nt + 4 * (lane & 3)) * 2;
              const bf16x8 xf = cat8(trrd(BI + rowA * 544 + cb), trrd(BI + rowB * 544 + cb));
#pragma unroll
              for (int pt = 0; pt < 4; ++pt) acc[nt][pt] = mfma16(xf, yf[pt], acc[nt][pt]); }
      }
#pragma unroll
      for (int nt = 0; nt < 4; ++nt)
#pragma unroll
          for (int pt = 0; pt < 4; ++pt) { v2u o; o.x = pk2(acc[nt][pt][0], acc[nt][pt][1]); o.y = pk2(acc[nt][pt][2], acc[nt][pt][3]); *(v2u*)(STh + (16 * pt + fr) * 128 + 64 * nh + 16 * nt + 4 * q4) = o; }
      }
    }
    __syncthreads();
}
__device__ __forceinline__ void ssd_scan(Frame& F, const Args& A) {
    unsigned* ST = (unsigned*)(A.ws + WS_ST); const float* AEND = (const float*)(A.ws + WS_AEND);
    for (int it = F.vcu * NTHR + F.tid; it < 32 * 4096; it += F.G * NTHR) {
        const int bh = it >> 12, b = bh >> 3, h = bh & 7, e = (it & 4095);
        unsigned* base = ST + ((size_t)(b * NCHUNK) * 8 + h) * 4096 + e;
        float s0 = 0.f, s1 = 0.f;
        for (int c0 = 0; c0 < NCHUNK; c0 += 16) {
            unsigned v[16]; float dec[16];
#pragma unroll
            for (int i = 0; i < 16; ++i) { v[i] = base[(size_t)(c0 + i) * 32768]; dec[i] = __expf(AEND[(size_t)(b * NCHUNK + c0 + i) * 8 + h]); }
#pragma unroll
            for (int i = 0; i < 16; ++i) { base[(size_t)(c0 + i) * 32768] = pk2(s0, s1); s0 = s0 * dec[i] + bflo(v[i]); s1 = s1 * dec[i] + bfhi(v[i]); }
        }
    }
}
__device__ __forceinline__ void ssd3_unit(Frame& F, const Args& A, int L, int bc) {
    LAS unsigned char* Ls = F.lds; const int lane = F.lane, w = F.wave, fr = lane & 15, q4 = lane >> 4;
    const int b = bc >> 7, c = bc & 127; const size_t m0 = (size_t)b * SEQ + (size_t)c * 64;
    const bf16* P = (const bf16*)(A.ws + WS_PROJ); const bf16* XBCC = (const bf16*)(A.ws + WS_XBCC); const bf16* ST = (const bf16*)(A.ws + WS_ST); bf16* Y = (bf16*)(A.ws + WS_Y);
    LAS unsigned char* XI = Ls; LAS unsigned char* BI = Ls + 67584; LAS unsigned char* CI = Ls + 102400;
    LAS float* dtl = (LAS float*)(Ls + 137216); LAS float* acs = (LAS float*)(Ls + 139264);
    ssd_prepass(F, A, L, m0, dtl, acs);
#pragma unroll 4
    for (int i = 0; i < 16; ++i) { const int pc = F.tid + NTHR * i, row = pc >> 7, cg = pc & 127;
        const v4u v = *(const v4u*)(XBCC + (m0 + row) * 1024 + 8 * cg);
        LAS unsigned char* dst = cg < 64 ? XI + row * 1056 + cg * 16 : (cg < 96 ? BI + row * 544 + (cg - 64) * 16 : CI + row * 544 + (cg - 96) * 16);
        *(LAS v4u*)dst = v; }
    __syncthreads();
    const int h = w, gi = h >> 2;
    f32x4 acc[4][4];
#pragma unroll
    for (int lt = 0; lt < 4; ++lt)
#pragma unroll
        for (int pt = 0; pt < 4; ++pt) acc[lt][pt] = (f32x4){0.f, 0.f, 0.f, 0.f};
    { const bf16* Sh = ST + ((size_t)bc * 8 + h) * 8192;
#pragma unroll 1
      for (int kn = 0; kn < 4; ++kn) {
          bf16x8 yf[4];
#pragma unroll
          for (int pt = 0; pt < 4; ++pt) yf[pt] = *(const bf16x8*)(Sh + (16 * pt + fr) * 128 + 32 * kn + 8 * q4);
#pragma unroll
          for (int lt = 0; lt < 4; ++lt) { const bf16x8 xf = *(const LAS bf16x8*)(CI + (16 * lt + fr) * 544 + (gi * 128 + 32 * kn + 8 * q4) * 2);
#pragma unroll
              for (int pt = 0; pt < 4; ++pt) acc[lt][pt] = mfma16(xf, yf[pt], acc[lt][pt]); }
      }
#pragma unroll
      for (int lt = 0; lt < 4; ++lt)
#pragma unroll
          for (int r = 0; r < 4; ++r) { const float sc = __expf(acs[(16 * lt + 4 * q4 + r) * 8 + h]);
#pragma unroll
              for (int pt = 0; pt < 4; ++pt) acc[lt][pt][r] *= sc; }
    }
#pragma unroll
    for (int lt = 0; lt < 4; ++lt) {
#pragma unroll
        for (int ksp = 0; ksp <= (lt >> 1); ++ksp) {
            __builtin_amdgcn_sched_barrier(0);
            const bool hasb = (2 * ksp + 1) <= lt;
            f32x4 d0a = (f32x4){0.f, 0.f, 0.f, 0.f}, d0b = (f32x4){0.f, 0.f, 0.f, 0.f};
#pragma unroll
            for (int kn = 0; kn < 4; ++kn) { const int cb = (gi * 128 + 32 * kn + 8 * q4) * 2;
                const bf16x8 cf = *(const LAS bf16x8*)(CI + (16 * lt + fr) * 544 + cb);
                const bf16x8 ba = *(const LAS bf16x8*)(BI + (32 * ksp + fr) * 544 + cb); d0a = mfma16(ba, cf, d0a);
                if (hasb) { const bf16x8 bb = *(const LAS bf16x8*)(BI + (32 * ksp + 16 + fr) * 544 + cb); d0b = mfma16(bb, cf, d0b); } }
            const int l = 16 * lt + fr; const float al = acs[l * 8 + h];
            float ga[4], gb[4];
#pragma unroll
            for (int r = 0; r < 4; ++r) { const int sa = 32 * ksp + 4 * q4 + r, sb = sa + 16;
                ga[r] = sa <= l ? d0a[r] * __expf(al - acs[sa * 8 + h]) * dtl[sa * 8 + h] : 0.f;
                gb[r] = (hasb && sb <= l) ? d0b[r] * __expf(al - acs[sb * 8 + h]) * dtl[sb * 8 + h] : 0.f; }
            const bf16x8 xf = pack8(ga[0], ga[1], ga[2], ga[3], gb[0], gb[1], gb[2], gb[3]);
            const int rowA = 32 * ksp + 4 * q4 + (fr >> 2), rowB = rowA + 16;
#pragma unroll
            for (int pt = 0; pt < 4; ++pt) { const int cb = (h * 64 + 16 * pt + 4 * (lane & 3)) * 2;
                acc[lt][pt] = mfma16(xf, cat8(trrd(XI + rowA * 1056 + cb), trrd(XI + rowB * 1056 + cb)), acc[lt][pt]); }
        }
    }
    { const float dsk = A.in[10][L * 8 + h];
#pragma unroll
      for (int lt = 0; lt < 4; ++lt)
#pragma unroll
          for (int pt = 0; pt < 4; ++pt)
#pragma unroll
              for (int r = 0; r < 4; ++r) { const unsigned short xv = *(const LAS unsigned short*)(XI + (16 * lt + 4 * q4 + r) * 1056 + (h * 64 + 16 * pt + fr) * 2);
                  acc[lt][pt][r] += dsk * __uint_as_float((unsigned)xv << 16); } }
    __syncthreads();
#pragma unroll
    for (int lt = 0; lt < 4; ++lt)
#pragma unroll
        for (int pt = 0; pt < 4; ++pt)
#pragma unroll
            for (int r = 0; r < 4; ++r) *(LAS float*)(Ls + (16 * lt + 4 * q4 + r) * 2112 + (h * 64 + 16 * pt + fr) * 4) = acc[lt][pt][r];
    __syncthreads();
    { const f32x4 g0 = *(const f32x4*)(A.in[11] + L * 512 + 8 * lane), g1 = *(const f32x4*)(A.in[11] + L * 512 + 8 * lane + 4);
#pragma unroll 2
      for (int i = 0; i < 8; ++i) { const int r = 8 * w + i;
        f32x4 v0 = *(const LAS f32x4*)(Ls + r * 2112 + lane * 32), v1 = *(const LAS f32x4*)(Ls + r * 2112 + lane * 32 + 16);
        const v4u z = *(const v4u*)(P + (m0 + r) * PN + PC_Z + 8 * lane);
        v0 = v0 * (f32x4){silu(bflo(z.x)), silu(bfhi(z.x)), silu(bflo(z.y)), silu(bfhi(z.y))};
        v1 = v1 * (f32x4){silu(bflo(z.z)), silu(bfhi(z.z)), silu(bflo(z.w)), silu(bfhi(z.w))};
        const float ss = wave_sum((v0.x * v0.x + v0.y * v0.y) + (v0.z * v0.z + v0.w * v0.w) + (v1.x * v1.x + v1.y * v1.y) + (v1.z * v1.z + v1.w * v1.w)) * (1.0f / 512.0f);
        const float sc = 1.0f / sqrtf(ss + 1e-6f);
        v0 = v0 * sc * g0; v1 = v1 * sc * g1;
        v4u ov; ov.x = pk2(v0.x, v0.y); ov.y = pk2(v0.z, v0.w); ov.z = pk2(v1.x, v1.y); ov.w = pk2(v1.z, v1.w);
        *(v4u*)(Y + (m0 + r) * D + 8 * lane) = ov; } }
    __syncthreads();
}

#ifndef PROBE_FP8TEST
#define PROBE_FP8TEST 0
#endif
#if PROBE_FP8TEST
typedef int v8i __attribute__((ext_vector_type(8)));
__device__ __forceinline__ int fp8_selftest(int lane) {
    const int ij = lane & 15, g = lane >> 4;
    v8i Af, Bf;
#pragma unroll
    for (int r = 0; r < 8; ++r) { int wa = 0, wb = 0; const int k = 32 * g + 4 * r;
        wa = __builtin_amdgcn_cvt_pk_fp8_f32((float)((7 * ij + 3 * (k + 0)) % 5), (float)((7 * ij + 3 * (k + 1)) % 5), wa, false);
        wa = __builtin_amdgcn_cvt_pk_fp8_f32((float)((7 * ij + 3 * (k + 2)) % 5), (float)((7 * ij + 3 * (k + 3)) % 5), wa, true);
        wb = __builtin_amdgcn_cvt_pk_fp8_f32((float)((5 * (k + 0) + 11 * ij) % 7), (float)((5 * (k + 1) + 11 * ij) % 7), wb, false);
        wb = __builtin_amdgcn_cvt_pk_fp8_f32((float)((5 * (k + 2) + 11 * ij) % 7), (float)((5 * (k + 3) + 11 * ij) % 7), wb, true);
        Af[r] = wa; Bf[r] = wb; }
    f32x4 d = (f32x4){0.f, 0.f, 0.f, 0.f};
    d = __builtin_amdgcn_mfma_scale_f32_16x16x128_f8f6f4(Af, Bf, d, 0, 0, 0, 0, 0, 0);
    int bad = 0;
#pragma unroll
    for (int r = 0; r < 4; ++r) { const int i = 4 * g + r, j = ij; float e = 0.f;
        for (int k = 0; k < 128; ++k) e += (float)(((7 * i + 3 * k) % 5) * ((5 * k + 11 * j) % 7));
        bad += (d[r] != e + (PROBE_FP8TEST == 2 ? 1.f : 0.f)) ? 1 : 0; }
    return bad;
}
#endif
constexpr int NPHASE = 1 + 16 + 7 + 2 * MOE_NCH + 1;
__global__ void __launch_bounds__(NTHR, 2) fwd_kernel(Args args) {
    extern __shared__ __attribute__((aligned(16))) unsigned char lds[];
    Frame F;
    F.lds = (LAS unsigned char*)lds;
    F.tid = threadIdx.x; F.lane = F.tid & 63; F.wave = __builtin_amdgcn_readfirstlane(F.tid >> 6);
    F.G = gridDim.x; { const int bx = blockIdx.x; F.vcu = (F.G % 8 == 0) ? (bx % 8) * (F.G / 8) + bx / 8 : bx; }
    gu32* ctl = (gu32*)(args.ws + WS_CTL);
    for (int u = F.tid; u < (LDS_BYTES - LDSCTL_OFF) / 4; u += NTHR) ((LAS unsigned*)(F.lds + LDSCTL_OFF))[u] = 0u;
    __syncthreads();
    XcdBarrier bar; bar.bar = (unsigned*)(ctl + CW_BAR); bar.x = 0; bar.st = nullptr;
    const int lo = args.ph_lo, hi = args.ph_hi;
    if (hi - lo > 1) bar = xcd_barrier_post((unsigned*)(ctl + CW_BAR), (volatile LAS unsigned*)(F.lds + CTL_MISC) + 8);
#define IN(k) ((lo <= (k) && (k) < hi) && fresh(F))
#define SEAM(k) do { if ((k) + 1 < hi) { REP(12) xcd_barrier(bar); } } while (0)
    unsigned char* ws = args.ws;
    bf16* A1 = (bf16*)(ws + WS_A1); bf16* PROJ = (bf16*)(ws + WS_PROJ); bf16* Yb = (bf16*)(ws + WS_Y); bf16* MIXED = (bf16*)(ws + WS_MIXED);
    const int bid = (int)blockIdx.x;

    if (IN(0)) {
#if PROBE_FP8TEST
        if (blockIdx.x == 0 && F.wave == 0) { const int bad = fp8_selftest(F.lane); if (bad) atomicAdd((unsigned*)(args.ws + WS_CTL) + 2, (unsigned)bad); }
#endif
        REP(10) { cvt_small_weights(F, args);
        __syncthreads(); }
        RowArgs R{args.in[0], nullptr, 0, nullptr, nullptr, args.in[1], A1, 1, args.in[5] + 1536, DIN};
        REP(9) row_phase(F, args, R);
        SEAM(0);
    }
    for (int L = 0; L < 2; ++L) {
        const int pb = 1 + 16 * L;
        if (IN(pb + 0)) {
            pg8::Gemm g{A1, (const bf16*)(ws + WS_WIN) + (size_t)L * PN * D, M, PN, D}; pg8::StaticOrder S; S.init(M, PN, F.G, bid);
            pg8::EpiStore E{PROJ, PN, 1.0f};
            REP(5) pg8::gemm_phase<pg8::EpiStore, pg8::StaticOrder, true, true>(F.lds, g, S, E);
            SEAM(pb + 0);
        }
        if (IN(pb + 1)) {
                        REP(0) for (int u = F.vcu; u < NBATCH * NCHUNK; u += F.G) ssd1_unit(F, args, L, u);
                        REP(1) for (int u = F.vcu; u < NBATCH * NCHUNK; u += F.G) attn_unit(F, args, L, u);
                        REP(2) for (int u = F.vcu; u < M / 128; u += F.G) gmlp_unit(F, args, L, u);
            SEAM(pb + 1);
        }
                if (IN(pb + 2)) { ssd_scan(F, args); SEAM(pb + 2); }
                if (IN(pb + 3)) { REP(3) for (int u = F.vcu; u < NBATCH * NCHUNK; u += F.G) ssd3_unit(F, args, L, u); SEAM(pb + 3); }
        if (IN(pb + 4)) {
            pg8::Gemm g{Yb, (const bf16*)(ws + WS_WOUT) + (size_t)L * D * D, M, D, D}; pg8::StaticOrder S; S.init(M, D, F.G, bid);
            pg8::EpiStore E{MIXED, D, 1.0f};
            REP(5) pg8::gemm_phase<pg8::EpiStore, pg8::StaticOrder, true, true>(F.lds, g, S, E);
            SEAM(pb + 4);
        }
        if (IN(pb + 5)) {
            RowArgs R{L == 0 ? args.in[0] : args.out, args.out, 1, MIXED, args.in[2] + L * D, args.in[3] + L * D, A1, L == 1 ? 2 : 0, args.in[23], 8};
            if (L == 0) { REP(8) row_phase(F, args, R); } else row_phase(F, args, R);
            if (L == 1) REP(4) cvt_moe_weights(F, args);
            SEAM(pb + 5);
        }
        if (L == 0) {
            if (IN(pb + 6)) {
                pg8::Gemm g{A1, (const bf16*)(ws + WS_WGU), M, 2 * DFF, D}; pg8::StaticOrder S; S.init(M, 2 * DFF, F.G, bid);
                pg8::EpiSwiglu E{(bf16*)(ws + WS_H1), DFF};
                REP(6) pg8::gemm_phase<pg8::EpiSwiglu, pg8::StaticOrder, true, true>(F.lds, g, S, E);
                SEAM(pb + 6);
            }
            if (IN(pb + 7)) {
                pg8::Gemm g{(const bf16*)(ws + WS_H1), (const bf16*)(ws + WS_WD), M, D, DFF}; pg8::StaticOrder S; S.init(M, D, F.G, bid);
                pg8::EpiStore E{(bf16*)(ws + WS_FOUT), D, 1.0f};
                REP(6) pg8::gemm_phase<pg8::EpiStore, pg8::StaticOrder, true, true>(F.lds, g, S, E);
                SEAM(pb + 7);
            }
            if (IN(pb + 8)) {
                RowArgs R{args.out, args.out, 1, (const bf16*)(ws + WS_FOUT), args.in[4], args.in[1] + D, A1, 1, args.in[5] + (size_t)D * DIN + 1536, DIN};
                row_phase(F, args, R);
                SEAM(pb + 8);
            }
        } else {
            if (IN(pb + 6)) { REP(11) { moe_tables(F, args); moe_gather(F, args); } SEAM(pb + 6); }
            for (int k = 0; k < MOE_NCH; ++k) {
                if (IN(pb + 7 + 2 * k)) {
                    moe_tables(F, args);
                    const int nT = *(LAS int*)(F.lds + CTL_CNT + 32 * 4); int nk = nT - MOE_CH * k; nk = nk < 0 ? 0 : ((k < MOE_NCH - 1 && nk > MOE_CH) ? MOE_CH : nk);
                    pg8::Gemm g{(const bf16*)(ws + WS_XS), (const bf16*)(ws + WS_MWGU), 0, 0, D / 2};
                    pg8::MoeOrder<false, true> S{MOE_CH * k, nk, 28, F.G, bid, (const LAS int*)(F.lds + CTL_TE)};
                    pg8::EpiSwiglu8 E{ws + WS_HM, DFFE, 1.0f / (FP8_SX * FP8_SW), FP8_SH};
                    REP(7) pg8::gemm_phase<pg8::EpiSwiglu8, pg8::MoeOrder<false, true>, true, true, true>(F.lds, g, S, E);
                    SEAM(pb + 7 + 2 * k);
                }
                if (IN(pb + 8 + 2 * k)) {
                    moe_tables(F, args);
                    const int nT = *(LAS int*)(F.lds + CTL_CNT + 32 * 4); int nk = nT - MOE_CH * k; nk = nk < 0 ? 0 : ((k < MOE_NCH - 1 && nk > MOE_CH) ? MOE_CH : nk);
                    pg8::Gemm g{(const bf16*)(ws + WS_HM), (const bf16*)(ws + WS_MWD), 0, 0, DFFE / 2};
                    pg8::MoeOrder<true, false> S{MOE_CH * k, nk, 4, F.G, bid, (const LAS int*)(F.lds + CTL_TE)};
                    pg8::EpiStore E{(bf16*)(ws + WS_YM), D, 1.0f / (FP8_SH * FP8_SW)};
                    REP(7) pg8::gemm_phase<pg8::EpiStore, pg8::MoeOrder<true, false>, true, true, true>(F.lds, g, S, E);
                    SEAM(pb + 8 + 2 * k);
                }
            }
            if (IN(pb + 7 + 2 * MOE_NCH)) {
                RowArgs R{args.out, args.out, 2, (const bf16*)(ws + WS_YM), args.in[4] + D, nullptr, nullptr, 0, nullptr, 0};
                row_phase(F, args, R);
#if PROBE_FP8TEST
                if (__hip_atomic_load((unsigned*)(args.ws + WS_CTL) + 2, RLX_AGENT) != 0u) { __syncthreads(); for (size_t i = (size_t)blockIdx.x * NTHR + F.tid; i < (size_t)M * D; i += (size_t)F.G * NTHR) args.out[i] += 1.0f; }
#endif
            }
        }
    }
#undef IN
#undef SEAM
}

extern "C" void kernel_launch(void* const* d_in, const int* in_sizes, int n_in, void* d_out, int out_size, void* d_ws, size_t ws_size, hipStream_t stream) {
    static int grid = 0;
    if (grid == 0) {
        if (n_in != NIN || out_size != M * D || ws_size < WS_END) { fprintf(stderr, "kernel_launch: unexpected shapes (n_in %d, out %d, ws %zu)\n", n_in, out_size, ws_size); grid = -1; return; }
        int dev = 0, cus = 0;
        if (hipGetDevice(&dev) != hipSuccess || hipDeviceGetAttribute(&cus, hipDeviceAttributeMultiprocessorCount, dev) != hipSuccess) { grid = -1; return; }
        if (hipFuncSetAttribute((const void*)fwd_kernel, hipFuncAttributeMaxDynamicSharedMemorySize, LDS_BYTES) != hipSuccess) { fprintf(stderr, "kernel_launch: hipFuncSetAttribute failed\n"); grid = -1; return; }
        int per_cu = 0;
        if (hipOccupancyMaxActiveBlocksPerMultiprocessor(&per_cu, (const void*)fwd_kernel, NTHR, LDS_BYTES) != hipSuccess || per_cu < 1) fprintf(stderr, "kernel_launch: occupancy query says %d\n", per_cu);
        (void)hipGetLastError();
        grid = cus > 256 ? 256 : cus;
    }
    if (grid < 0) return;
    (void)hipMemsetAsync((char*)d_ws + WS_CTL, 0, CTL_ZERO_BYTES, stream);
    Args a{};
    for (int i = 0; i < NIN; ++i) a.in[i] = (const float*)d_in[i];
    a.out = (float*)d_out; a.ws = (unsigned char*)d_ws;
#if MK_SINGLE
    a.ph_lo = 0; a.ph_hi = NPHASE;
    hipLaunchKernelGGL(fwd_kernel, dim3(grid), dim3(NTHR), LDS_BYTES, stream, a);
#else
    for (int ph = 0; ph < NPHASE; ++ph) { if (ph >= 10 && ph < 17) continue; a.ph_lo = ph; a.ph_hi = ph + 1; hipLaunchKernelGGL(fwd_kernel, dim3(grid), dim3(NTHR), LDS_BYTES, stream, a); }
#endif
}
```

```cpp
#include <hip/hip_runtime.h>
#include <cstdio>
#include <cstdint>

#ifndef MK_SINGLE
#define MK_SINGLE 1
#endif

namespace pg8 {
#define PG8_LAS __attribute__((address_space(3)))
typedef unsigned short bf16_t;
typedef short bf16x8 __attribute__((ext_vector_type(8)));
typedef float f32x4 __attribute__((ext_vector_type(4)));
typedef unsigned u32x4 __attribute__((ext_vector_type(4)));
constexpr int BM = 256, BK = 64, HALF = 128, HTB = HALF * BK * 2  , STAGE_BYTES = 8 * HTB, NXCD = 8, WGM = 8;

__host__ __device__ __forceinline__ int lds_byte(int r, int c) { const int st = (r >> 4) * 2 + (c >> 5), rr = r & 15, cc = c & 31, ob = rr * 64 + cc * 2; return st * 1024 + (ob ^ (((ob >> 9) & 1) << 5)); }
__host__ __device__ __forceinline__ void stage_rc(int b, int& R, int& C) { const int st = b / 1024, sb = b % 1024, swz = sb ^ (((sb >> 9) & 1) << 5); R = (st >> 1) * 16 + swz / 64; C = (st & 1) * 32 + (swz % 64) / 2; }
__host__ __device__ __forceinline__ int perm32(int rho) { const int n = rho >> 4, i = rho & 15; return 8 * (i >> 2) + 4 * n + (i & 3); }

struct Unit { int pm, pn, om, on; };
struct Gemm { const bf16_t* A; const bf16_t* Bt; int M, N, K; };

__host__ __device__ __forceinline__ bool tile_order(int i, int G, int c, int nM, int nN, int& pm, int& pn) {
    const int nwg = nM * nN; const long L = (long)i * G + c; if (L >= nwg) return false;
    int wgid = (int)L; { const int q = nwg / NXCD, r = nwg % NXCD, xcd = wgid % NXCD, off = wgid / NXCD; wgid = (xcd < r ? xcd * (q + 1) : r * (q + 1) + (xcd - r) * q) + off; }
    const int nig = WGM * nN, gid = wgid / nig, fm = gid * WGM, gsz = (nM - fm) < WGM ? (nM - fm) : WGM;
    pm = fm + ((wgid % nig) % gsz); pn = (wgid % nig) / gsz; return true;
}
struct StaticOrder {
    int nM, nN, G, c;
    __host__ __device__ void init(int M, int N, int G_, int c_) { nM = M / BM; nN = N / BM; G = G_; c = c_; }
    __host__ __device__ bool next(int i, Unit& u) const { int pm, pn; if (!tile_order(i, G, c, nM, nN, pm, pn)) return false; u.pm = pm; u.pn = pn; u.om = pm; u.on = pn; return true; }
    __device__ __forceinline__ void a_ready(const Unit&) const {}
    __device__ __forceinline__ void done(const Unit&) const {}
};
template <bool A_LOCAL, bool O_LOCAL>
struct MoeOrder {
    int t0, nT, nN, G, c; const PG8_LAS int* te;
    __device__ __forceinline__ bool next(int i, Unit& u) const { int pm, pn; if (!tile_order(i, G, c, nT, nN, pm, pn)) return false;
        const int e = __builtin_amdgcn_readfirstlane(te[t0 + pm]);
        u.pm = A_LOCAL ? pm : t0 + pm; u.pn = e * nN + pn; u.om = O_LOCAL ? pm : t0 + pm; u.on = pn; return true; }
    __device__ __forceinline__ void a_ready(const Unit&) const {}
    __device__ __forceinline__ void done(const Unit&) const {}
};

__device__ __forceinline__ unsigned cvt_pk_bf16(float lo, float hi) { unsigned r; asm volatile("v_cvt_pk_bf16_f32 %0, %1, %2" : "=v"(r) : "v"(lo), "v"(hi)); return r; }

typedef int v8i32 __attribute__((ext_vector_type(8)));
__device__ __forceinline__ v8i32 cat16(bf16x8 lo, bf16x8 hi) { const u32x4 a = __builtin_bit_cast(u32x4, lo), b = __builtin_bit_cast(u32x4, hi); return (v8i32){(int)a.x, (int)a.y, (int)a.z, (int)a.w, (int)b.x, (int)b.y, (int)b.z, (int)b.w}; }
__device__ __forceinline__ float clamp448(float x) { return __builtin_fminf(__builtin_fmaxf(x, -448.0f), 448.0f); }
__device__ __forceinline__ unsigned pack_fp8x4(float a, float b, float c, float d) {
    int r = 0; r = __builtin_amdgcn_cvt_pk_fp8_f32(clamp448(a), clamp448(b), r, false); r = __builtin_amdgcn_cvt_pk_fp8_f32(clamp448(c), clamp448(d), r, true); return (unsigned)r; }
struct EpiStore {
    static constexpr bool PERM = true, AFTER_DRAIN = false;
    bf16_t* O; int ldc; float scale;
    __device__ __forceinline__ void operator()(const f32x4 (&acc)[2][2][4][2], const Unit& u, int wr, int wc, int fr, int fq) const {
        const int row0 = u.om * BM + wr * 64 + fr; const int col0 = u.on * BM + wc * 32 + 8 * fq;
#pragma unroll
        for (int ai = 0; ai < 2; ++ai)
#pragma unroll
            for (int m = 0; m < 4; ++m) { bf16_t* rowp = O + (size_t)(row0 + ai * HALF + m * 16) * ldc + col0;
#pragma unroll
                for (int bj = 0; bj < 2; ++bj) { const f32x4 v0 = acc[ai][bj][m][0] * scale, v1 = acc[ai][bj][m][1] * scale;
                    u32x4 w; w.x = cvt_pk_bf16(v0[0], v0[1]); w.y = cvt_pk_bf16(v0[2], v0[3]); w.z = cvt_pk_bf16(v1[0], v1[1]); w.w = cvt_pk_bf16(v1[2], v1[3]);
                    *(u32x4*)(rowp + bj * HALF) = w; } }
    }
};
__device__ __forceinline__ float silu_f(float x) { return x * __builtin_amdgcn_rcpf(1.0f + __expf(-x)); }
struct EpiSwiglu {
    static constexpr bool PERM = true, AFTER_DRAIN = false;
    bf16_t* O; int ldc;
    __device__ __forceinline__ void operator()(const f32x4 (&acc)[2][2][4][2], const Unit& u, int wr, int wc, int fr, int fq) const {
        const int row0 = u.om * BM + wr * 64 + fr; const int col0 = u.on * HALF + wc * 32 + 8 * fq;
#pragma unroll
        for (int ai = 0; ai < 2; ++ai)
#pragma unroll
            for (int m = 0; m < 4; ++m) { bf16_t* rowp = O + (size_t)(row0 + ai * HALF + m * 16) * ldc + col0;
                const f32x4 g0 = acc[ai][0][m][0], g1 = acc[ai][0][m][1], u0 = acc[ai][1][m][0], u1 = acc[ai][1][m][1];
                u32x4 w;
                w.x = cvt_pk_bf16(silu_f(g0[0]) * u0[0], silu_f(g0[1]) * u0[1]); w.y = cvt_pk_bf16(silu_f(g0[2]) * u0[2], silu_f(g0[3]) * u0[3]);
                w.z = cvt_pk_bf16(silu_f(g1[0]) * u1[0], silu_f(g1[1]) * u1[1]); w.w = cvt_pk_bf16(silu_f(g1[2]) * u1[2], silu_f(g1[3]) * u1[3]);
                *(u32x4*)rowp = w; }
    }
};

struct EpiSwiglu8 {
    static constexpr bool PERM = true, AFTER_DRAIN = false;
    unsigned char* O; int ldc; float in_scale, out_scale;
    __device__ __forceinline__ void operator()(const f32x4 (&acc)[2][2][4][2], const Unit& u, int wr, int wc, int fr, int fq) const {
        const int row0 = u.om * BM + wr * 64 + fr; const int col0 = u.on * HALF + wc * 32 + 8 * fq;
#pragma unroll
        for (int ai = 0; ai < 2; ++ai)
#pragma unroll
            for (int m = 0; m < 4; ++m) { unsigned char* rowp = O + (size_t)(row0 + ai * HALF + m * 16) * ldc + col0;
                const f32x4 g0 = acc[ai][0][m][0] * in_scale, g1 = acc[ai][0][m][1] * in_scale, u0 = acc[ai][1][m][0] * (in_scale * out_scale), u1 = acc[ai][1][m][1] * (in_scale * out_scale);
                typedef unsigned u32x2 __attribute__((ext_vector_type(2)));
                u32x2 w;
                w.x = pack_fp8x4(silu_f(g0[0]) * u0[0], silu_f(g0[1]) * u0[1], silu_f(g0[2]) * u0[2], silu_f(g0[3]) * u0[3]);
                w.y = pack_fp8x4(silu_f(g1[0]) * u1[0], silu_f(g1[1]) * u1[1], silu_f(g1[2]) * u1[2], silu_f(g1[3]) * u1[3]);
                *(u32x2*)rowp = w; }
    }
};

template <class Epi, class Sched, bool ALIGN_EPI = false, bool SP2 = false, bool FP8 = false>
__device__ __forceinline__ void gemm_phase(PG8_LAS unsigned char* lds, const Gemm g, const Sched& S, const Epi& E) {
    int tid_ = threadIdx.x; asm volatile("" : "+v"(tid_));
    const int tid = tid_, wid = __builtin_amdgcn_readfirstlane(tid >> 6), lane = tid & 63, wr = wid >> 2, wc = wid & 3, fr = lane & 15, fq = lane >> 4;
    int K_ = g.K; asm volatile("" : "+s"(K_));
    const int K = K_, nt = K / BK;
    unsigned voffA[2], voffB[2];
#pragma unroll
    for (int i = 0; i < 2; ++i) { int R, C; stage_rc(tid * 16 + i * 8192, R, C); const int Rb = Epi::PERM ? ((R & ~31) + perm32(R & 31)) : R;
        voffA[i] = (unsigned)(R * K + C) * 2u; voffB[i] = (unsigned)(Rb * K + C) * 2u; }
    const size_t kstep = (size_t)(BK * 2);
    const size_t hstep = (size_t)HALF * K * 2;
    const size_t tstep = 2 * hstep;
    const unsigned ldsw = (unsigned)wid * 1024u;
    const int aoff = lds_byte(wr * 64 + fr, fq * 8), boff = lds_byte(wc * 32 + fr, fq * 8);
#define PG8_SA(b, h) (((b) * 2 + (h)) * HTB)
#define PG8_SB(b, h) ((4 + (b) * 2 + (h)) * HTB)
#define PG8_STAGE(bufoff, gbase, voff) do { _Pragma("unroll") for (int _i = 0; _i < 2; ++_i) \
        __builtin_amdgcn_global_load_lds((const unsigned*)((const char*)(gbase) + (voff)[_i]), (PG8_LAS unsigned*)(lds + (bufoff) + ldsw + _i * 8192), 16, 0, 0); } while (0)
#define PG8_LDA(dst, dst8, b, h) do { _Pragma("unroll") for (int m = 0; m < 4; ++m) { \
        if constexpr (FP8) dst8[m] = cat16(*(const PG8_LAS bf16x8*)(lds + PG8_SA(b, h) + aoff + m * 2048), *(const PG8_LAS bf16x8*)(lds + PG8_SA(b, h) + aoff + m * 2048 + 1024)); \
        else { _Pragma("unroll") for (int k = 0; k < 2; ++k) dst[m][k] = *(const PG8_LAS bf16x8*)(lds + PG8_SA(b, h) + aoff + m * 2048 + k * 1024); } } } while (0)
#define PG8_LDB(dst, dst8, b, h) do { _Pragma("unroll") for (int n = 0; n < 2; ++n) { \
        if constexpr (FP8) dst8[n] = cat16(*(const PG8_LAS bf16x8*)(lds + PG8_SB(b, h) + boff + n * 2048), *(const PG8_LAS bf16x8*)(lds + PG8_SB(b, h) + boff + n * 2048 + 1024)); \
        else { _Pragma("unroll") for (int k = 0; k < 2; ++k) dst[n][k] = *(const PG8_LAS bf16x8*)(lds + PG8_SB(b, h) + boff + n * 2048 + k * 1024); } } } while (0)
#define PG8_MMA(ai, bj, At, At8, Bt, Bt8) do { __builtin_amdgcn_s_setprio(1); _Pragma("unroll") for (int m = 0; m < 4; ++m) _Pragma("unroll") for (int n = 0; n < 2; ++n) { \
        if constexpr (FP8) { asm volatile("v_mfma_f32_16x16x128_f8f6f4 %0, %1, %2, %0" : "+v"(acc[ai][bj][m][n]) : "v"(Bt8[n]), "v"(At8[m])); } \
        else { _Pragma("unroll") for (int k = 0; k < 2; ++k) acc[ai][bj][m][n] = __builtin_amdgcn_mfma_f32_16x16x32_bf16(Bt[n][k], At[m][k], acc[ai][bj][m][n], 0, 0, 0); } } __builtin_amdgcn_s_setprio(0); } while (0)
#define PG8_WAIT_V(n) asm volatile("s_waitcnt vmcnt(" #n ")" ::: "memory")
#define PG8_WAIT_L(n) asm volatile("s_waitcnt lgkmcnt(" #n ")" ::: "memory")
#define PG8_BAR __builtin_amdgcn_s_barrier()
#define PG8_SCHED __builtin_amdgcn_sched_barrier(0)
    Unit cur, nxt; int ui = 0;
    if (!S.next(0, cur)) return;
    f32x4 acc[2][2][4][2];
#pragma unroll
    for (int a = 0; a < 2; ++a)
#pragma unroll
        for (int b = 0; b < 2; ++b)
#pragma unroll
            for (int m = 0; m < 4; ++m)
#pragma unroll
                for (int n = 0; n < 2; ++n) acc[a][b][m][n] = (f32x4){0.f, 0.f, 0.f, 0.f};
    bf16x8 At[4][2], B0[2][2], B1[2][2]; v8i32 At8[4], B08[2], B18[2];
    const char* cA = (const char*)g.A + (size_t)cur.pm * tstep; const char* cB = (const char*)g.Bt + (size_t)cur.pn * tstep;
    S.a_ready(cur);
    if constexpr (SP2) {
        PG8_STAGE(PG8_SB(0, 0), cB, voffB); PG8_STAGE(PG8_SB(0, 1), cB + hstep, voffB); PG8_STAGE(PG8_SA(0, 0), cA, voffA); PG8_STAGE(PG8_SA(0, 1), cA + hstep, voffA);
        if (wr == 1) PG8_BAR;
        PG8_WAIT_V(2); PG8_BAR;
        PG8_STAGE(PG8_SB(1, 0), cB + kstep, voffB); PG8_STAGE(PG8_SA(1, 0), cA + kstep, voffA); PG8_STAGE(PG8_SB(1, 1), cB + hstep + kstep, voffB);
        PG8_WAIT_V(6); PG8_BAR;
    } else {
        PG8_STAGE(PG8_SB(0, 0), cB, voffB); PG8_STAGE(PG8_SA(0, 0), cA, voffA); PG8_STAGE(PG8_SB(0, 1), cB + hstep, voffB); PG8_STAGE(PG8_SA(0, 1), cA + hstep, voffA);
        if (wr == 1) PG8_BAR;
        PG8_WAIT_V(4); PG8_BAR;
        PG8_STAGE(PG8_SB(1, 0), cB + kstep, voffB); PG8_STAGE(PG8_SA(1, 0), cA + kstep, voffA); PG8_STAGE(PG8_SB(1, 1), cB + hstep + kstep, voffB);
        PG8_WAIT_V(6); PG8_BAR;
    }
    for (;;) {
        const bool has_next = S.next(ui + 1, nxt);
        const char* nA = has_next ? (const char*)g.A + (size_t)nxt.pm * tstep : cA; const char* nB = has_next ? (const char*)g.Bt + (size_t)nxt.pn * tstep : cB;
#pragma unroll 1
        for (int t = 0; t < nt; t += 2) {
            const bool last = (t == nt - 2);
            const char* a1 = cA + (size_t)(t + 1) * kstep;
            const char* a2 = last ? nA : cA + (size_t)(t + 2) * kstep; const char* b2 = last ? nB : cB + (size_t)(t + 2) * kstep;
            const char* a3 = a2 + kstep; const char* b3 = b2 + kstep;
            if (last && has_next) S.a_ready(nxt);
            if constexpr (SP2) {
            PG8_LDB(B0, B08, 0, 0); PG8_LDB(B1, B18, 0, 1); PG8_SCHED; PG8_LDA(At, At8, 0, 0); PG8_STAGE(PG8_SA(1, 1), a1 + hstep, voffA);
            PG8_WAIT_V(8); PG8_WAIT_L(0); PG8_BAR; PG8_MMA(0, 0, At, At8, B0, B08); PG8_MMA(0, 1, At, At8, B1, B18); PG8_BAR; PG8_SCHED;
            PG8_LDA(At, At8, 0, 1); PG8_STAGE(PG8_SB(0, 0), b2, voffB); PG8_STAGE(PG8_SB(0, 1), b2 + hstep, voffB); PG8_STAGE(PG8_SA(0, 0), a2, voffA);
            PG8_WAIT_V(8); PG8_WAIT_L(0); PG8_BAR; PG8_MMA(1, 0, At, At8, B0, B08); PG8_MMA(1, 1, At, At8, B1, B18); PG8_BAR; PG8_SCHED;
            PG8_LDB(B0, B08, 1, 0); PG8_LDB(B1, B18, 1, 1); PG8_SCHED; PG8_LDA(At, At8, 1, 0); PG8_STAGE(PG8_SA(0, 1), a2 + hstep, voffA);
            PG8_WAIT_V(8); PG8_WAIT_L(0); PG8_BAR; PG8_MMA(0, 0, At, At8, B0, B08); PG8_MMA(0, 1, At, At8, B1, B18); PG8_BAR; PG8_SCHED;
            PG8_LDA(At, At8, 1, 1); PG8_STAGE(PG8_SB(1, 0), b3, voffB); PG8_STAGE(PG8_SB(1, 1), b3 + hstep, voffB); PG8_STAGE(PG8_SA(1, 0), a3, voffA);
            PG8_WAIT_V(8); PG8_WAIT_L(0); PG8_BAR; PG8_MMA(1, 0, At, At8, B0, B08); PG8_MMA(1, 1, At, At8, B1, B18); PG8_BAR; PG8_SCHED;
            } else {
            PG8_LDB(B0, B08, 0, 0); PG8_SCHED; PG8_LDA(At, At8, 0, 0); PG8_STAGE(PG8_SA(1, 1), a1 + hstep, voffA);
            PG8_WAIT_L(8); PG8_BAR; PG8_WAIT_L(0); PG8_MMA(0, 0, At, At8, B0, B08); PG8_BAR; PG8_SCHED;
            PG8_LDB(B1, B18, 0, 1); PG8_STAGE(PG8_SB(0, 0), b2, voffB);
            PG8_BAR; PG8_WAIT_L(0); PG8_MMA(0, 1, At, At8, B1, B18); PG8_BAR;
            PG8_LDA(At, At8, 0, 1); PG8_STAGE(PG8_SA(0, 0), a2, voffA);
            PG8_BAR; PG8_WAIT_L(0); PG8_MMA(1, 0, At, At8, B0, B08); PG8_BAR; PG8_SCHED;
            PG8_STAGE(PG8_SB(0, 1), b2 + hstep, voffB);
            PG8_WAIT_V(6); PG8_BAR; PG8_MMA(1, 1, At, At8, B1, B18); PG8_BAR;
            PG8_LDB(B0, B08, 1, 0); PG8_SCHED; PG8_LDA(At, At8, 1, 0); PG8_STAGE(PG8_SA(0, 1), a2 + hstep, voffA);
            PG8_WAIT_L(8); PG8_BAR; PG8_WAIT_L(0); PG8_MMA(0, 0, At, At8, B0, B08); PG8_BAR; PG8_SCHED;
            PG8_LDB(B1, B18, 1, 1); PG8_STAGE(PG8_SB(1, 0), b3, voffB);
            PG8_BAR; PG8_WAIT_L(0); PG8_MMA(0, 1, At, At8, B1, B18); PG8_BAR;
            PG8_LDA(At, At8, 1, 1); PG8_STAGE(PG8_SA(1, 0), a3, voffA);
            PG8_BAR; PG8_WAIT_L(0); PG8_MMA(1, 0, At, At8, B0, B08); PG8_BAR; PG8_SCHED;
            PG8_STAGE(PG8_SB(1, 1), b3 + hstep, voffB);
            PG8_WAIT_V(6); PG8_BAR; PG8_MMA(1, 1, At, At8, B1, B18); PG8_BAR;
            }
        }
        if constexpr (FP8) asm volatile("s_nop 15\n\ts_nop 15" ::: "memory");
        if constexpr (ALIGN_EPI) { if (wr == 0) PG8_BAR; }
        if constexpr (!Epi::AFTER_DRAIN) { E(acc, cur, wr, wc, fr, fq); S.done(cur); }
        if (!has_next) break;
#pragma unroll
        for (int a = 0; a < 2; ++a)
#pragma unroll
            for (int b = 0; b < 2; ++b)
#pragma unroll
                for (int m = 0; m < 4; ++m)
#pragma unroll
                    for (int n = 0; n < 2; ++n) acc[a][b][m][n] = (f32x4){0.f, 0.f, 0.f, 0.f};
        cur = nxt; cA = nA; cB = nB; ++ui;
        if constexpr (ALIGN_EPI) { if (wr == 1) PG8_BAR; }
    }
    PG8_WAIT_V(0);
    if constexpr (!ALIGN_EPI) { if (wr == 0) PG8_BAR; }
    PG8_BAR;
    if constexpr (Epi::AFTER_DRAIN) { E.fused(acc, cur, wr, wc, fr, fq, lds, wid, lane); S.done(cur); }
#undef PG8_SA
#undef PG8_SB
#undef PG8_STAGE
#undef PG8_LDA
#undef PG8_LDB
#undef PG8_MMA
#undef PG8_WAIT_V
#undef PG8_WAIT_L
#undef PG8_BAR
#undef PG8_SCHED
}
}

#define GAS __attribute__((address_space(1)))
#define LAS __attribute__((address_space(3)))
typedef unsigned short bf16;
typedef unsigned v4u __attribute__((ext_vector_type(4)));
typedef unsigned v2u __attribute__((ext_vector_type(2)));
typedef float f32x4 __attribute__((ext_vector_type(4)));
typedef float f32x2 __attribute__((ext_vector_type(2)));
typedef short bf16x8 __attribute__((ext_vector_type(8)));
typedef short v4i16 __attribute__((ext_vector_type(4)));
typedef GAS unsigned gu32;
#define RLX_AGENT __ATOMIC_RELAXED, __HIP_MEMORY_SCOPE_AGENT
#define LDS_WAIT() asm volatile("s_waitcnt lgkmcnt(0)" ::: "memory")
#define VM_WAIT() asm volatile("s_waitcnt vmcnt(0)" ::: "memory")
__device__ __forceinline__ unsigned pk2(float lo, float hi) { return pg8::cvt_pk_bf16(lo, hi); }
__device__ __forceinline__ float bflo(unsigned u) { return __uint_as_float(u << 16); }
__device__ __forceinline__ float bfhi(unsigned u) { return __uint_as_float(u & 0xffff0000u); }
__device__ __forceinline__ float wave_sum(float v) {
#pragma unroll
    for (int o = 1; o < 64; o <<= 1) v += __shfl_xor(v, o);
    return v;
}
__device__ __forceinline__ f32x4 mfma16(bf16x8 a, bf16x8 b, f32x4 c) { return __builtin_amdgcn_mfma_f32_16x16x32_bf16(a, b, c, 0, 0, 0); }
__device__ __forceinline__ v4i16 trrd(LAS unsigned char* p) { return __builtin_amdgcn_ds_read_tr16_b64_v4i16((LAS v4i16*)p); }
__device__ __forceinline__ bf16x8 cat8(v4i16 lo, v4i16 hi) { return (bf16x8){lo[0], lo[1], lo[2], lo[3], hi[0], hi[1], hi[2], hi[3]}; }
__device__ __forceinline__ bf16x8 pack8(float a0, float a1, float a2, float a3, float a4, float a5, float a6, float a7) {
    v4u w; w.x = pk2(a0, a1); w.y = pk2(a2, a3); w.z = pk2(a4, a5); w.w = pk2(a6, a7); return __builtin_bit_cast(bf16x8, w); }
__device__ __forceinline__ float silu(float x) { return x * __builtin_amdgcn_rcpf(1.0f + __expf(-x)); }

#define XB_TMO      128
#define XB_XCNT(j)  (256  + 64 * (j))
#define XB_XSUB(j)  (1280 + 64 * (j))
#define XB_XGEN(j)  (2304 + 64 * (j))
#define XB_TOP      3328
#define XB_TOPGEN   3392
#define XCD_BAR_WORDS 3456
#define XB_SPIN_CAP (1u << 18)

__device__ __forceinline__ unsigned xb_ld(unsigned* p)              { return __hip_atomic_load(p, __ATOMIC_RELAXED, __HIP_MEMORY_SCOPE_AGENT); }
__device__ __forceinline__ unsigned xb_add(unsigned* p, unsigned v) { return __hip_atomic_fetch_add(p, v, __ATOMIC_RELAXED, __HIP_MEMORY_SCOPE_AGENT); }
__device__ __forceinline__ unsigned xb_xcc_id() { return (unsigned)__builtin_amdgcn_s_getreg((3 << 11) | 20) & 0xFu; }
#define XB_SPIN(cond, bar) do { unsigned _sp = 0; while (cond) { __builtin_amdgcn_s_sleep(1); \
    if ((++_sp & 255u) == 0u) { if (xb_ld(&(bar)[XB_TMO])) break; if (_sp > XB_SPIN_CAP) { atomicAdd(&(bar)[XB_TMO], 1u); break; } } } } while (0)

struct XcdBarrier {
    unsigned* bar; unsigned x;
    volatile LAS unsigned* st;
};

__device__ __forceinline__ XcdBarrier xcd_barrier_post(unsigned* bar, volatile LAS unsigned* st) {
    XcdBarrier b; b.bar = bar; b.x = xb_xcc_id(); b.st = st;
    if (threadIdx.x == 0) (void)xb_add(&bar[XB_XCNT(b.x)], 1u);
    return b;
}
__device__ __forceinline__ void xcd_barrier_complete(unsigned* bar, unsigned x, unsigned& nloc, unsigned& nx) {
    const unsigned G = gridDim.x * gridDim.y * gridDim.z;
    unsigned sum, cnt, mine, sp = 0u;
    for (;;) {
        sum = 0u; cnt = 0u; mine = 0u;
#pragma unroll
        for (unsigned j = 0; j < 16; ++j) { const unsigned c = xb_ld(&bar[XB_XCNT(j)]); sum += c; cnt += (c > 0u) ? 1u : 0u; mine = (j == x) ? c : mine; }
        if (sum == G) break;
        __builtin_amdgcn_s_sleep(1);
        if ((++sp & 255u) == 0u) { if (xb_ld(&bar[XB_TMO])) break; if (sp > XB_SPIN_CAP) { atomicAdd(&bar[XB_TMO], 1u); break; } }
    }
    nloc = mine > 0u ? mine : 1u; nx = cnt > 0u ? cnt : 1u;
}

__device__ __forceinline__ void xcd_barrier(const XcdBarrier& b) {
    asm volatile("s_waitcnt vmcnt(0)" ::: "memory");
    __syncthreads();
    if (threadIdx.x == 0) {
        unsigned* bar = b.bar;
        __builtin_amdgcn_s_waitcnt(0);
        unsigned nloc = b.st[0], nx = b.st[1];
        if (nloc == 0u) { xcd_barrier_complete(bar, b.x, nloc, nx); b.st[0] = nloc; b.st[1] = nx; }
        const unsigned old = xb_add(&bar[XB_XSUB(b.x)], 1u);
        const unsigned gen = old / nloc;
        if (old + 1u == (gen + 1u) * nloc) {
            __builtin_amdgcn_fence(__ATOMIC_RELEASE, "agent");
            asm volatile("s_waitcnt vmcnt(0)" ::: "memory");
            const unsigned og = xb_add(&bar[XB_TOP], 1u);
            const unsigned tg = og / nx;
            if (og + 1u == (tg + 1u) * nx) xb_add(&bar[XB_TOPGEN], 1u);
            else XB_SPIN(xb_ld(&bar[XB_TOPGEN]) == tg, bar);
            __builtin_amdgcn_fence(__ATOMIC_ACQUIRE, "agent");
            xb_add(&bar[XB_XGEN(b.x)], 1u);
            asm volatile("s_waitcnt vmcnt(0)" ::: "memory");
        } else {
            XB_SPIN(xb_ld(&bar[XB_XGEN(b.x)]) == gen, bar);
            __builtin_amdgcn_fence(__ATOMIC_ACQUIRE, "agent");
            asm volatile("s_waitcnt vmcnt(0)" ::: "memory");
        }
    }
    __syncthreads();
}

constexpr int NWAVES = 8, NTHR = 512;
constexpr int D = 1024, SEQ = 8192, NBATCH = 4, M = NBATCH * SEQ, NCHUNK = SEQ / 64;
constexpr int DIN = 2824, PN = 2816;
constexpr int PC_Z = 0, PC_XBC = 512, PC_U = 1536, PC_V = 1792, PC_Q = 2048, PC_K = 2304, PC_VV = 2560;
constexpr int DFF = 2816, DFFE = 3584, NEXP = 8;
constexpr int MOE_CH = 128, MOE_NCH = 2, MOE_MAXT = 264;
constexpr int NIN = 27;
constexpr size_t MiB = 1u << 20;
constexpr size_t WS_CTL = 0, CTL_ZERO_BYTES = 65536;
constexpr size_t WS_AEND = 65536, WS_WGCNT = 98304;
constexpr size_t WS_DTRAW = 1 * MiB, WS_TOKE = 2 * MiB, WS_TOKG = 2 * MiB + 262144, WS_POS = 2 * MiB + 524288;
constexpr size_t WS_WIN = 4 * MiB, WS_WOUT = 15 * MiB, WS_WGU = 19 * MiB, WS_WD = 30 * MiB;
constexpr size_t WS_A1 = 36 * MiB, WS_XBCC = 36 * MiB;
constexpr size_t WS_PROJ = 100 * MiB, WS_MIXED = 100 * MiB, WS_H1 = 100 * MiB;
constexpr size_t WS_ST = 276 * MiB, WS_FOUT = 276 * MiB;
constexpr size_t WS_Y = 404 * MiB;
constexpr size_t WS_HM = 36 * MiB, WS_XS = 155 * MiB, WS_YM = 221 * MiB, WS_MWGU = 353 * MiB, WS_MWD = 409 * MiB, WS_END = 468 * MiB;
constexpr float FP8_SX = 8.0f, FP8_SW = 64.0f, FP8_SH = 16.0f;
constexpr int CW_BAR = 4096;
constexpr int LDS_BYTES = 163840, LDSCTL_OFF = 147456;
constexpr int CTL_MISC = LDSCTL_OFF, CTL_CNT = LDSCTL_OFF + 128, CTL_TE = LDSCTL_OFF + 512;

#ifndef PROBE_DUP
#define PROBE_DUP 0
#endif
#ifndef PROBE_TG
#define PROBE_TG -1
#endif
__device__ __forceinline__ int tgroup_of(int k) {
    if (k == 0) return 0;
    const int L = (k - 1) >> 4, r = (k - 1) & 15;
    if (r == 0 || r == 4) return 1;
    if (r == 1) return 2;
    if (r == 2) return 3;
    if (r == 3) return 4;
    if (r == 5) return L == 0 ? 5 : 9;
    if (L == 0) return r == 8 ? 5 : 6;
    if (r == 6) return 7;
    if (r == 7 + 2 * 2) return 5;
    return 8;
}
#define REP(n) for (int rep_ = 0; rep_ < (((PROBE_DUP >> (n)) & 1) ? 2 : 1); ++rep_)
struct Args { const float* in[NIN]; float* out; unsigned char* ws; int ph_lo, ph_hi; };

typedef const __attribute__((address_space(4))) Args* ArgsP;
typedef const __attribute__((address_space(4))) Args& ArgsRef;
struct Frame {
    LAS unsigned char* lds;
    int tid, lane, wave, vcu, G;
};
__device__ __forceinline__ bool relaunder(ArgsP& p) { asm volatile("" : "+s"(p)); return true; }
__device__ __forceinline__ bool fresh(Frame& F) { int t_ = threadIdx.x; asm volatile("" : "+v"(t_)); F.tid = t_; F.lane = t_ & 63; F.wave = __builtin_amdgcn_readfirstlane(t_ >> 6); return true; }

__device__ __forceinline__ void cvt_task(const float* W, int N, int k0, int n0, bf16* WT, int K, int row0, int lane) {
    const float* s = W + (size_t)k0 * N + n0 + lane;
    bf16* d = WT + (size_t)(row0 + lane) * K + k0;
#pragma unroll
    for (int hb = 0; hb < 2; ++hb) {
        float v[32];
#pragma unroll
        for (int j = 0; j < 32; ++j) v[j] = s[(size_t)(32 * hb + j) * N];
#pragma unroll
        for (int q = 0; q < 4; ++q) { v4u o; o.x = pk2(v[8 * q], v[8 * q + 1]); o.y = pk2(v[8 * q + 2], v[8 * q + 3]); o.z = pk2(v[8 * q + 4], v[8 * q + 5]); o.w = pk2(v[8 * q + 6], v[8 * q + 7]);
            *(GAS v4u*)(d + 32 * hb + 8 * q) = o; }
    }
}
__device__ __forceinline__ void cvt_small_weights(Frame& F, ArgsRef A) {
    const int gw = F.vcu * NWAVES + F.wave, NGW = F.G * NWAVES;
    bf16* WIN = (bf16*)(A.ws + WS_WIN); bf16* WOUT = (bf16*)(A.ws + WS_WOUT); bf16* WGU = (bf16*)(A.ws + WS_WGU); bf16* WD = (bf16*)(A.ws + WS_WD);
    constexpr int NI = 1408 + 512 + 1408 + 704;
    for (int it = gw; it < NI; it += NGW) {
        int r = it;
        if (r < 1408) { const int L = r / 704; r %= 704; const int kb = r / 44, nb = r % 44; const int ns = 64 * nb + (64 * nb >= 1536 ? 8 : 0);
            cvt_task(A.in[5] + (size_t)L * D * DIN, DIN, 64 * kb, ns, WIN + (size_t)L * PN * D, D, 64 * nb, F.lane); continue; }
        r -= 1408;
        if (r < 512) { const int L = r / 256; r %= 256; const int kb = r / 16, nb = r % 16;
            cvt_task(A.in[19] + (size_t)L * D * D, D, 64 * kb, 64 * nb, WOUT + (size_t)L * D * D, D, 64 * nb, F.lane); continue; }
        r -= 512;
        if (r < 1408) { const int up = r / 704; r %= 704; const int kb = r / 44, nb = r % 44;
            cvt_task(up ? A.in[21] : A.in[20], DFF, 64 * kb, 64 * nb, WGU, D, 256 * (nb >> 1) + 64 * (nb & 1) + 128 * up, F.lane); continue; }
        r -= 1408;
        { const int kb = r / 16, nb = r % 16; cvt_task(A.in[22], D, 64 * kb, 64 * nb, WD, DFF, 64 * nb, F.lane); }
    }
}
__device__ __forceinline__ void cvt_task8(const float* W, int N, int k0, int n0, unsigned char* WT, int K, int row0, float scale, int lane) {
    const float* s = W + (size_t)k0 * N + n0 + lane;
    unsigned char* d = WT + (size_t)(row0 + lane) * K + k0;
#pragma unroll
    for (int hb = 0; hb < 2; ++hb) {
        float v[32];
#pragma unroll
        for (int j = 0; j < 32; ++j) v[j] = s[(size_t)(32 * hb + j) * N] * scale;
#pragma unroll
        for (int q = 0; q < 2; ++q) { v4u o; o.x = pg8::pack_fp8x4(v[16 * q], v[16 * q + 1], v[16 * q + 2], v[16 * q + 3]); o.y = pg8::pack_fp8x4(v[16 * q + 4], v[16 * q + 5], v[16 * q + 6], v[16 * q + 7]);
            o.z = pg8::pack_fp8x4(v[16 * q + 8], v[16 * q + 9], v[16 * q + 10], v[16 * q + 11]); o.w = pg8::pack_fp8x4(v[16 * q + 12], v[16 * q + 13], v[16 * q + 14], v[16 * q + 15]);
            *(GAS v4u*)(d + 32 * hb + 16 * q) = o; }
    }
}
__device__ __forceinline__ void cvt_moe_weights(Frame& F, ArgsRef A) {
    const int gw = F.vcu * NWAVES + F.wave, NGW = F.G * NWAVES;
    unsigned char* MWGU = A.ws + WS_MWGU; unsigned char* MWD = A.ws + WS_MWD;
    constexpr int NI = 14336 + 7168;
    for (int it = gw; it < NI; it += NGW) {
        int r = it;
        if (r < 14336) { const int ue = r / 896; r %= 896; const int up = ue >> 3, e = ue & 7; const int kb = r / 56, nb = r % 56;
            cvt_task8((up ? A.in[25] : A.in[24]) + (size_t)e * D * DFFE, DFFE, 64 * kb, 64 * nb, MWGU + (size_t)e * 7168 * D, D, 256 * (nb >> 1) + 64 * (nb & 1) + 128 * up, FP8_SW, F.lane); continue; }
        r -= 14336;
        { const int e = r / 896; r %= 896; const int kb = r / 16, nb = r % 16;
          cvt_task8(A.in[26] + (size_t)e * DFFE * D, D, 64 * kb, 64 * nb, MWD + (size_t)e * D * DFFE, DFFE, 64 * nb, FP8_SW, F.lane); }
    }
}

struct RowArgs {
    const float* hsrc; float* hdst;
    int branch;
    const bf16* ybuf; const float* gpost;
    const float* gpre; bf16* a1;
    int proj;
    const float* w8; int w8ld;
};
__device__ __forceinline__ void row_phase(Frame& F, ArgsRef A, const RowArgs& R) {
    LAS float* W8T = (LAS float*)F.lds;
    LAS int* cnt = (LAS int*)(F.lds + CTL_CNT);
    const int lane = F.lane;
    if (R.proj) { for (int idx = F.tid; idx < 8192; idx += NTHR) { const int e = idx & 7, k = idx >> 3; W8T[e * 1024 + k] = R.w8[(size_t)k * R.w8ld + e]; } }
    if (R.proj == 2 && F.tid < 8) cnt[F.tid] = 0;
    __syncthreads();
    f32x4 gpo[4], gpr[4];
#pragma unroll
    for (int j = 0; j < 4; ++j) { gpo[j] = R.branch ? *(const f32x4*)(R.gpost + 4 * lane + 256 * j) : (f32x4){0.f, 0.f, 0.f, 0.f}; gpr[j] = R.gpre ? *(const f32x4*)(R.gpre + 4 * lane + 256 * j) : (f32x4){0.f, 0.f, 0.f, 0.f}; }
    float* DTRAW = (float*)(A.ws + WS_DTRAW); int* TOKE = (int*)(A.ws + WS_TOKE); float* TOKG = (float*)(A.ws + WS_TOKG); const int* POS = (const int*)(A.ws + WS_POS);
    const int gw = F.vcu * NWAVES + F.wave, NGW = F.G * NWAVES;
    for (int m = gw; m < M; m += NGW) {
        f32x4 v[4];
#pragma unroll
        for (int j = 0; j < 4; ++j) v[j] = *(const f32x4*)(R.hsrc + (size_t)m * D + 4 * lane + 256 * j);
        if (R.branch) {
            f32x4 y[4];
            if (R.branch == 1) {
#pragma unroll
                for (int j = 0; j < 4; ++j) { const v2u raw = *(const v2u*)(R.ybuf + (size_t)m * D + 4 * lane + 256 * j); y[j] = (f32x4){bflo(raw.x), bfhi(raw.x), bflo(raw.y), bfhi(raw.y)}; }
            } else {
                const int p0 = POS[2 * m], p1 = POS[2 * m + 1]; const float g0 = TOKG[2 * m], g1 = TOKG[2 * m + 1];
#pragma unroll
                for (int j = 0; j < 4; ++j) { const v2u r0 = *(const v2u*)(R.ybuf + (size_t)p0 * D + 4 * lane + 256 * j); const v2u r1 = *(const v2u*)(R.ybuf + (size_t)p1 * D + 4 * lane + 256 * j);
                    y[j] = (f32x4){g0 * bflo(r0.x) + g1 * bflo(r1.x), g0 * bfhi(r0.x) + g1 * bfhi(r1.x), g0 * bflo(r0.y) + g1 * bflo(r1.y), g0 * bfhi(r0.y) + g1 * bfhi(r1.y)}; }
            }
            float ss = 0.f;
#pragma unroll
            for (int j = 0; j < 4; ++j) ss += (y[j].x * y[j].x + y[j].y * y[j].y) + (y[j].z * y[j].z + y[j].w * y[j].w);
            const float sc = 1.0f / sqrtf(wave_sum(ss) * (1.0f / D) + 1e-6f);
#pragma unroll
            for (int j = 0; j < 4; ++j) v[j] = v[j] + y[j] * sc * gpo[j];
        }
        if (R.hdst) {
#pragma unroll
            for (int j = 0; j < 4; ++j) *(f32x4*)(R.hdst + (size_t)m * D + 4 * lane + 256 * j) = v[j];
        }
        if (R.gpre) {
            float ss = 0.f;
#pragma unroll
            for (int j = 0; j < 4; ++j) ss += (v[j].x * v[j].x + v[j].y * v[j].y) + (v[j].z * v[j].z + v[j].w * v[j].w);
            const float sc = 1.0f / sqrtf(wave_sum(ss) * (1.0f / D) + 1e-6f);
#pragma unroll
            for (int j = 0; j < 4; ++j) { v[j] = v[j] * sc * gpr[j]; v2u o; o.x = pk2(v[j].x, v[j].y); o.y = pk2(v[j].z, v[j].w); *(v2u*)(R.a1 + (size_t)m * D + 4 * lane + 256 * j) = o; }
            if (R.proj) {
                float p[8];
#pragma unroll
                for (int e = 0; e < 8; ++e) { float s = 0.f;
#pragma unroll
                    for (int j = 0; j < 4; ++j) { const f32x4 w = *(const LAS f32x4*)(W8T + e * 1024 + 4 * lane + 256 * j); s += (v[j].x * w.x + v[j].y * w.y) + (v[j].z * w.z + v[j].w * w.w); }
                    p[e] = wave_sum(s); }
                if (R.proj == 1) {
                    float mine = p[0];
#pragma unroll
                    for (int e = 1; e < 8; ++e) mine = (lane == e) ? p[e] : mine;
                    if (lane < 8) DTRAW[(size_t)m * 8 + lane] = mine;
                } else {
                    float best = p[0]; int bi = 0;
#pragma unroll
                    for (int e = 1; e < 8; ++e) if (p[e] > best) { best = p[e]; bi = e; }
                    float sb = -3.0e38f; int si = 0;
#pragma unroll
                    for (int e = 0; e < 8; ++e) if (e != bi && p[e] > sb) { sb = p[e]; si = e; }
                    const float g0 = 1.0f / (1.0f + expf(sb - best)), g1 = 1.0f - g0;
                    if (lane == 0) { TOKE[2 * m] = bi; TOKE[2 * m + 1] = si; TOKG[2 * m] = g0; TOKG[2 * m + 1] = g1;
                        __hip_atomic_fetch_add(cnt + bi, 1, __ATOMIC_RELAXED, __HIP_MEMORY_SCOPE_WORKGROUP); __hip_atomic_fetch_add(cnt + si, 1, __ATOMIC_RELAXED, __HIP_MEMORY_SCOPE_WORKGROUP); }
                }
            }
        }
    }
    if (R.proj == 2) { __syncthreads(); if (F.tid < 8) ((int*)(A.ws + WS_WGCNT))[F.vcu * 8 + F.tid] = cnt[F.tid]; }
    __syncthreads();
}

__device__ __forceinline__ void moe_tables(Frame& F, ArgsRef A) {
    LAS int* c = (LAS int*)(F.lds + CTL_CNT); LAS int* te = (LAS int*)(F.lds + CTL_TE);
    if (F.tid < 40) c[F.tid] = 0;
    __syncthreads();
    const int* WGCNT = (const int*)(A.ws + WS_WGCNT);
    for (int idx = F.tid; idx < F.G * 8; idx += NTHR) { const int wg = idx >> 3, e = idx & 7; const int v = WGCNT[idx];
        __hip_atomic_fetch_add(c + e, v, __ATOMIC_RELAXED, __HIP_MEMORY_SCOPE_WORKGROUP); if (wg < F.vcu) __hip_atomic_fetch_add(c + 8 + e, v, __ATOMIC_RELAXED, __HIP_MEMORY_SCOPE_WORKGROUP); }
    __syncthreads();
    if (F.tid == 0) { int t = 0; for (int e = 0; e < 8; ++e) { c[16 + e] = t * 256; const int n = (c[e] + 255) >> 8; for (int j = 0; j < n && t + j < MOE_MAXT; ++j) te[t + j] = e; t += n; } c[32] = t < MOE_MAXT ? t : MOE_MAXT; }
    __syncthreads();
}
__device__ __forceinline__ void moe_gather(Frame& F, ArgsRef A) {
    LAS int* c = (LAS int*)(F.lds + CTL_CNT);
    const int* TOKE = (const int*)(A.ws + WS_TOKE); int* POS = (int*)(A.ws + WS_POS);
    const bf16* A1 = (const bf16*)(A.ws + WS_A1); unsigned char* XS = A.ws + WS_XS;
    const int gw = F.vcu * NWAVES + F.wave, NGW = F.G * NWAVES, lane = F.lane;
    for (int m = gw; m < M; m += NGW) {
        int d0 = 0, d1 = 0;
        if (lane == 0) { const int e0 = TOKE[2 * m], e1 = TOKE[2 * m + 1];
            d0 = c[16 + e0] + c[8 + e0] + __hip_atomic_fetch_add(c + 24 + e0, 1, __ATOMIC_RELAXED, __HIP_MEMORY_SCOPE_WORKGROUP);
            d1 = c[16 + e1] + c[8 + e1] + __hip_atomic_fetch_add(c + 24 + e1, 1, __ATOMIC_RELAXED, __HIP_MEMORY_SCOPE_WORKGROUP);
            POS[2 * m] = d0; POS[2 * m + 1] = d1; }
        d0 = __builtin_amdgcn_readfirstlane(d0); d1 = __builtin_amdgcn_readfirstlane(d1);
        const v4u r0 = *(const v4u*)(A1 + (size_t)m * D + 16 * lane), r1 = *(const v4u*)(A1 + (size_t)m * D + 16 * lane + 8);
        v4u o;
        o.x = pg8::pack_fp8x4(bflo(r0.x) * FP8_SX, bfhi(r0.x) * FP8_SX, bflo(r0.y) * FP8_SX, bfhi(r0.y) * FP8_SX); o.y = pg8::pack_fp8x4(bflo(r0.z) * FP8_SX, bfhi(r0.z) * FP8_SX, bflo(r0.w) * FP8_SX, bfhi(r0.w) * FP8_SX);
        o.z = pg8::pack_fp8x4(bflo(r1.x) * FP8_SX, bfhi(r1.x) * FP8_SX, bflo(r1.y) * FP8_SX, bfhi(r1.y) * FP8_SX); o.w = pg8::pack_fp8x4(bflo(r1.z) * FP8_SX, bfhi(r1.z) * FP8_SX, bflo(r1.w) * FP8_SX, bfhi(r1.w) * FP8_SX);
        *(v4u*)(XS + (size_t)d0 * D + 16 * lane) = o; *(v4u*)(XS + (size_t)d1 * D + 16 * lane) = o;
    }
    __syncthreads();
}

__device__ __forceinline__ void gmlp_unit(Frame& F, ArgsRef A, int L, int nb) {
    LAS unsigned char* Ls = F.lds; const int lane = F.lane, w = F.wave, fr = lane & 15, q4 = lane >> 4;
    const size_t m0 = (size_t)nb * 128;
    const bf16* P = (const bf16*)(A.ws + WS_PROJ); bf16* Y = (bf16*)(A.ws + WS_Y);
    { const f32x4 g4 = *(const f32x4*)(A.in[12] + L * 256 + 4 * lane), b4 = *(const f32x4*)(A.in[13] + L * 256 + 4 * lane);
#pragma unroll 2
      for (int i = 0; i < 16; ++i) { const int r = 16 * w + i;
        const v2u raw = *(const v2u*)(P + (m0 + r) * PN + PC_V + 4 * lane);
        f32x4 v = (f32x4){bflo(raw.x), bfhi(raw.x), bflo(raw.y), bfhi(raw.y)};
        const float mu = wave_sum((v.x + v.y) + (v.z + v.w)) * (1.0f / 256.0f);
        v = v - mu;
        const float var = wave_sum((v.x * v.x + v.y * v.y) + (v.z * v.z + v.w * v.w)) * (1.0f / 256.0f);
        const float rstd = 1.0f / sqrtf(var + 1e-5f);
        v = v * rstd * g4 + b4;
        v2u o; o.x = pk2(v.x, v.y); o.y = pk2(v.z, v.w);
        *(LAS v2u*)(Ls + r * 544 + lane * 8) = o; } }
    __syncthreads();
    const int g = w & 3;
    f32x4 acc[4][4];
    const float* Wg = A.in[14] + (size_t)(L * 4 + g) * 128 * 128;
    const float* bsg = A.in[15] + (size_t)(L * 4 + g) * 128;
#pragma unroll
    for (int pi = 0; pi < 4; ++pi) {
        const int it = (w >> 2) == 0 ? (pi == 0 ? 0 : pi == 1 ? 7 : pi == 2 ? 1 : 6) : (pi == 0 ? 2 : pi == 1 ? 5 : pi == 2 ? 3 : 4);
#pragma unroll
        for (int ct = 0; ct < 4; ++ct) acc[pi][ct] = (f32x4){0.f, 0.f, 0.f, 0.f};
        const int t = 16 * it + fr, nks = (it >> 1) + 1;
        for (int ks = 0; ks < nks; ++ks) {
            const int sA = 32 * ks + 4 * q4, sB = sA + 16;
            const f32x4 wa = *(const f32x4*)(Wg + t * 128 + sA), wb = *(const f32x4*)(Wg + t * 128 + sB);
            const bf16x8 xf = pack8(sA + 0 <= t ? wa.x : 0.f, sA + 1 <= t ? wa.y : 0.f, sA + 2 <= t ? wa.z : 0.f, sA + 3 <= t ? wa.w : 0.f,
                                    sB + 0 <= t ? wb.x : 0.f, sB + 1 <= t ? wb.y : 0.f, sB + 2 <= t ? wb.z : 0.f, sB + 3 <= t ? wb.w : 0.f);
#pragma unroll
            for (int ct = 0; ct < 4; ++ct) { const int col = g * 64 + ct * 16 + 4 * (lane & 3);
                const v4i16 lo = trrd(Ls + (sA + (fr >> 2)) * 544 + col * 2), hi = trrd(Ls + (sB + (fr >> 2)) * 544 + col * 2);
                acc[pi][ct] = mfma16(xf, cat8(lo, hi), acc[pi][ct]); }
        }
#pragma unroll
        for (int r = 0; r < 4; ++r) { const float bs = bsg[16 * it + 4 * q4 + r];
#pragma unroll
            for (int ct = 0; ct < 4; ++ct) acc[pi][ct][r] += bs; }
    }
    __syncthreads();
#pragma unroll
    for (int pi = 0; pi < 4; ++pi) {
        const int it = (w >> 2) == 0 ? (pi == 0 ? 0 : pi == 1 ? 7 : pi == 2 ? 1 : 6) : (pi == 0 ? 2 : pi == 1 ? 5 : pi == 2 ? 3 : 4);
#pragma unroll
        for (int ct = 0; ct < 4; ++ct)
#pragma unroll
            for (int r = 0; r < 4; ++r) *(LAS float*)(Ls + (16 * it + 4 * q4 + r) * 1040 + (g * 64 + ct * 16 + fr) * 4) = acc[pi][ct][r];
    }
    __syncthreads();
    { const f32x4 gn = *(const f32x4*)(A.in[16] + L * 256 + 4 * lane);
#pragma unroll 2
      for (int i = 0; i < 16; ++i) { const int r = 16 * w + i;
        const f32x4 mx = *(const LAS f32x4*)(Ls + r * 1040 + lane * 16);
        const v2u raw = *(const v2u*)(P + (m0 + r) * PN + PC_U + 4 * lane);
        f32x4 v = (f32x4){bflo(raw.x), bfhi(raw.x), bflo(raw.y), bfhi(raw.y)} * mx;
        const float ss = wave_sum((v.x * v.x + v.y * v.y) + (v.z * v.z + v.w * v.w)) * (1.0f / 256.0f);
        v = v * (1.0f / sqrtf(ss + 1e-6f)) * gn;
        v2u o; o.x = pk2(v.x, v.y); o.y = pk2(v.z, v.w);
        *(v2u*)(Y + (m0 + r) * D + 512 + 4 * lane) = o; } }
    __syncthreads();
}

__device__ __forceinline__ void attn_unit(Frame& F, ArgsRef A, int L, int bc) {
    LAS unsigned char* Ls = F.lds; const int lane = F.lane, w = F.wave, fr = lane & 15, q4 = lane >> 4;
    const int b = bc >> 7, c = bc & 127; const size_t m0 = (size_t)b * SEQ + (size_t)c * 64;
    const bf16* P = (const bf16*)(A.ws + WS_PROJ); bf16* Y = (bf16*)(A.ws + WS_Y);
    const int h = w >> 1, qh = w & 1;
    LAS unsigned char* Vb = Ls + w * 10240;
    LAS float* BT = (LAS float*)(Ls + 81920);
    constexpr float LOG2E = 1.4426950408889634f;
    for (int i = F.tid; i < 4 * 257; i += NTHR) BT[i] = A.in[17][(size_t)L * 4 * 257 + i] * LOG2E;
    bf16x8 qf[2][2];
#pragma unroll
    for (int qb = 0; qb < 2; ++qb)
#pragma unroll
        for (int ks = 0; ks < 2; ++ks) qf[qb][ks] = *(const bf16x8*)(P + (m0 + 32 * qh + 16 * qb + fr) * PN + PC_Q + h * 64 + 32 * ks + 8 * q4);
    f32x4 o[4][2];
#pragma unroll
    for (int dt = 0; dt < 4; ++dt) { o[dt][0] = (f32x4){0.f, 0.f, 0.f, 0.f}; o[dt][1] = (f32x4){0.f, 0.f, 0.f, 0.f}; }
    float mrun[2] = {-1e30f, -1e30f}, lrun[2] = {0.f, 0.f};
    const int jmin = c >= 8 ? 0 : 8 - c;
    const bf16* Kp = P + PC_K + h * 64 + 8 * q4 + (size_t)fr * PN;
    const bf16* Vp = P + PC_VV + h * 64 + (lane & 7) * 8 + (size_t)(lane >> 3) * PN;
    bf16x8 kreg[4][2]; v4u vreg[8];
    { const size_t kr0 = m0 - (size_t)(8 - jmin) * 64;
#pragma unroll
      for (int kt = 0; kt < 4; ++kt)
#pragma unroll
          for (int ks = 0; ks < 2; ++ks) kreg[kt][ks] = *(const bf16x8*)(Kp + (kr0 + 16 * kt) * PN + 32 * ks);
#pragma unroll
      for (int i = 0; i < 8; ++i) vreg[i] = *(const v4u*)(Vp + (kr0 + 8 * i) * PN); }
    __syncthreads();
    const float cb = BT[h * 257 + 256];
    for (int j = jmin; j <= 8; ++j) {
        const int jn = j < 8 ? j + 1 : 8; const size_t krn = m0 - (size_t)(8 - jn) * 64;
#pragma unroll
        for (int i = 0; i < 8; ++i) *(LAS v4u*)(Vb + (i * 8 + (lane >> 3)) * 160 + (lane & 7) * 16) = vreg[i];
#pragma unroll
        for (int i = 0; i < 8; ++i) vreg[i] = *(const v4u*)(Vp + (krn + 8 * i) * PN);
        f32x4 st[4][2];
#pragma unroll
        for (int kt = 0; kt < 4; ++kt) { st[kt][0] = (f32x4){0.f, 0.f, 0.f, 0.f}; st[kt][1] = (f32x4){0.f, 0.f, 0.f, 0.f};
#pragma unroll
            for (int ks = 0; ks < 2; ++ks) { st[kt][0] = mfma16(kreg[kt][ks], qf[0][ks], st[kt][0]); st[kt][1] = mfma16(kreg[kt][ks], qf[1][ks], st[kt][1]); } }
#pragma unroll
        for (int kt = 0; kt < 4; ++kt)
#pragma unroll
            for (int ks = 0; ks < 2; ++ks) kreg[kt][ks] = *(const bf16x8*)(Kp + (krn + 16 * kt) * PN + 32 * ks);
#pragma unroll
        for (int qb = 0; qb < 2; ++qb) {
            float mx = -1e30f;
            if (j <= 5) {
#pragma unroll
                for (int kt = 0; kt < 4; ++kt)
#pragma unroll
                    for (int r = 0; r < 4; ++r) { const float s = st[kt][qb][r] * (0.125f * LOG2E) + cb; st[kt][qb][r] = s; mx = fmaxf(mx, s); }
            } else {
                const LAS float* bt = BT + h * 257 + (512 - 64 * j + 32 * qh + 16 * qb + fr - 4 * q4 + 128);
                const int i0 = 512 - 64 * j + 32 * qh + 16 * qb + fr - 4 * q4 + 128;
#pragma unroll
                for (int kt = 0; kt < 4; ++kt)
#pragma unroll
                    for (int r = 0; r < 4; ++r) { int idx = i0 - 16 * kt - r; idx = idx > 256 ? 256 : idx;
                        const float s = st[kt][qb][r] * (0.125f * LOG2E) + BT[h * 257 + idx]; st[kt][qb][r] = s; mx = fmaxf(mx, s); }
                (void)bt;
            }
            mx = fmaxf(mx, __shfl_xor(mx, 16)); mx = fmaxf(mx, __shfl_xor(mx, 32));
            const float mold = mrun[qb], mnew = fmaxf(mold, mx); mrun[qb] = mnew;
            float rs = 0.f;
#pragma unroll
            for (int kt = 0; kt < 4; ++kt)
#pragma unroll
                for (int r = 0; r < 4; ++r) { const float p = __builtin_amdgcn_exp2f(st[kt][qb][r] - mnew); st[kt][qb][r] = p; rs += p; }
            rs += __shfl_xor(rs, 16); rs += __shfl_xor(rs, 32);
            if (__any(mnew > mold)) { const float alpha = __builtin_amdgcn_exp2f(mold - mnew); lrun[qb] = lrun[qb] * alpha + rs;
#pragma unroll
                for (int dt = 0; dt < 4; ++dt) o[dt][qb] = o[dt][qb] * alpha; }
            else lrun[qb] += rs;
        }
#pragma unroll
        for (int kk = 0; kk < 2; ++kk) {
            const bf16x8 y0 = pack8(st[2 * kk][0][0], st[2 * kk][0][1], st[2 * kk][0][2], st[2 * kk][0][3], st[2 * kk + 1][0][0], st[2 * kk + 1][0][1], st[2 * kk + 1][0][2], st[2 * kk + 1][0][3]);
            const bf16x8 y1 = pack8(st[2 * kk][1][0], st[2 * kk][1][1], st[2 * kk][1][2], st[2 * kk][1][3], st[2 * kk + 1][1][0], st[2 * kk + 1][1][1], st[2 * kk + 1][1][2], st[2 * kk + 1][1][3]);
            const int rowA = 32 * kk + 4 * q4 + (fr >> 2), rowB = rowA + 16;
#pragma unroll
            for (int dt = 0; dt < 4; ++dt) { const int cbt = (16 * dt + 4 * (lane & 3)) * 2;
                const bf16x8 xf = cat8(trrd(Vb + rowA * 160 + cbt), trrd(Vb + rowB * 160 + cbt));
                o[dt][0] = mfma16(xf, y0, o[dt][0]); o[dt][1] = mfma16(xf, y1, o[dt][1]); }
        }
    }
    const float il0 = 1.0f / lrun[0], il1 = 1.0f / lrun[1];
    __syncthreads();
#pragma unroll
    for (int dt = 0; dt < 4; ++dt) {
        *(LAS f32x4*)(Ls + (32 * qh + fr) * 1040 + (h * 64 + 16 * dt + 4 * q4) * 4) = o[dt][0] * il0;
        *(LAS f32x4*)(Ls + (32 * qh + 16 + fr) * 1040 + (h * 64 + 16 * dt + 4 * q4) * 4) = o[dt][1] * il1; }
    __syncthreads();
    { const f32x4 gn = *(const f32x4*)(A.in[18] + L * 256 + 4 * lane);
#pragma unroll 2
      for (int i = 0; i < 8; ++i) { const int r = 8 * w + i;
        f32x4 v = *(const LAS f32x4*)(Ls + r * 1040 + lane * 16);
        const float ss = wave_sum((v.x * v.x + v.y * v.y) + (v.z * v.z + v.w * v.w)) * (1.0f / 256.0f);
        v = v * (1.0f / sqrtf(ss + 1e-6f)) * gn;
        v2u ov; ov.x = pk2(v.x, v.y); ov.y = pk2(v.z, v.w);
        *(v2u*)(Y + (m0 + r) * D + 768 + 4 * lane) = ov; } }
    __syncthreads();
}

__device__ __forceinline__ void ssd_prepass(Frame& F, ArgsRef A, int L, size_t m0, LAS float* dtl, LAS float* acs) {
    const float* DTRAW = (const float*)(A.ws + WS_DTRAW);
    if (F.wave == 0) { const int l = F.lane;
        const f32x4 r0 = *(const f32x4*)(DTRAW + (m0 + l) * 8), r1 = *(const f32x4*)(DTRAW + (m0 + l) * 8 + 4);
        const float raw[8] = {r0.x, r0.y, r0.z, r0.w, r1.x, r1.y, r1.z, r1.w};
#pragma unroll
        for (int h = 0; h < 8; ++h) { const float x = raw[h] + A.in[8][L * 8 + h];
            const float dt = x > 20.f ? x : log1pf(expf(x));
            float s = -dt * expf(A.in[9][L * 8 + h]);
#pragma unroll
            for (int o = 1; o < 64; o <<= 1) { const float t = __shfl_up(s, o); s += (l >= o) ? t : 0.f; }
            dtl[l * 8 + h] = dt; acs[l * 8 + h] = s; } }
    __syncthreads();
}
__device__ __forceinline__ void ssd1_unit(Frame& F, ArgsRef A, int L, int bc) {
    LAS unsigned char* Ls = F.lds; const int lane = F.lane, w = F.wave, fr = lane & 15, q4 = lane >> 4;
    const int b = bc >> 7, c = bc & 127; const size_t m0 = (size_t)b * SEQ + (size_t)c * 64;
    const bf16* P = (const bf16*)(A.ws + WS_PROJ); bf16* XBCC = (bf16*)(A.ws + WS_XBCC); bf16* ST = (bf16*)(A.ws + WS_ST); float* AEND = (float*)(A.ws + WS_AEND);
    LAS unsigned char* XI = Ls; LAS unsigned char* BI = Ls + 67584;
    LAS float* dtl = (LAS float*)(Ls + 102400); LAS float* acs = (LAS float*)(Ls + 104448);
    ssd_prepass(F, A, L, m0, dtl, acs);
    if (F.tid < 8) AEND[(size_t)bc * 8 + F.tid] = acs[63 * 8 + F.tid];
    { const int cg = F.tid & 127, tg = F.tid >> 7, ch0 = 8 * cg;
      float wk[4][8], bs[8];
#pragma unroll
      for (int k = 0; k < 4; ++k) { const f32x4 a = *(const f32x4*)(A.in[6] + (size_t)(L * 4 + k) * 1024 + ch0), bq = *(const f32x4*)(A.in[6] + (size_t)(L * 4 + k) * 1024 + ch0 + 4);
          wk[k][0] = a.x; wk[k][1] = a.y; wk[k][2] = a.z; wk[k][3] = a.w; wk[k][4] = bq.x; wk[k][5] = bq.y; wk[k][6] = bq.z; wk[k][7] = bq.w; }
      { const f32x4 a = *(const f32x4*)(A.in[7] + (size_t)L * 1024 + ch0), bq = *(const f32x4*)(A.in[7] + (size_t)L * 1024 + ch0 + 4);
          bs[0] = a.x; bs[1] = a.y; bs[2] = a.z; bs[3] = a.w; bs[4] = bq.x; bs[5] = bq.y; bs[6] = bq.z; bs[7] = bq.w; }
      const int hh = cg >> 3;
#pragma unroll 1
      for (int hf = 0; hf < 2; ++hf) {
      v4u raw[11];
#pragma unroll
      for (int tt = 0; tt < 11; ++tt) { const int lp = 16 * tg + 8 * hf - 3 + tt; const bool ok = (c * 64 + lp) >= 0;
          raw[tt] = ok ? *(const v4u*)(P + (size_t)((long)m0 + lp) * PN + PC_XBC + ch0) : (v4u){0u, 0u, 0u, 0u}; }
#pragma unroll
      for (int t = 0; t < 8; ++t) { const int l = 16 * tg + 8 * hf + t;
          float y[8];
#pragma unroll
          for (int e = 0; e < 8; ++e) y[e] = bs[e];
#pragma unroll
          for (int k = 0; k < 4; ++k) { const v4u rw = raw[t + k];
              y[0] += wk[k][0] * bflo(rw.x); y[1] += wk[k][1] * bfhi(rw.x); y[2] += wk[k][2] * bflo(rw.y); y[3] += wk[k][3] * bfhi(rw.y);
              y[4] += wk[k][4] * bflo(rw.z); y[5] += wk[k][5] * bfhi(rw.z); y[6] += wk[k][6] * bflo(rw.w); y[7] += wk[k][7] * bfhi(rw.w); }
#pragma unroll
          for (int e = 0; e < 8; ++e) y[e] = silu(y[e]);
          v4u o; o.x = pk2(y[0], y[1]); o.y = pk2(y[2], y[3]); o.z = pk2(y[4], y[5]); o.w = pk2(y[6], y[7]);
          *(v4u*)(XBCC + (m0 + l) * 1024 + ch0) = o;
          if (cg < 64) { const float sc = dtl[l * 8 + hh] * __expf(acs[63 * 8 + hh] - acs[l * 8 + hh]);
              v4u os; os.x = pk2(y[0] * sc, y[1] * sc); os.y = pk2(y[2] * sc, y[3] * sc); os.z = pk2(y[4] * sc, y[5] * sc); os.w = pk2(y[6] * sc, y[7] * sc);
              *(LAS v4u*)(XI + l * 1056 + ch0 * 2) = os; }
          else if (cg < 96) *(LAS v4u*)(BI + l * 544 + (ch0 - 512) * 2) = o;
      } } }
    __syncthreads();
    { const int h = w, gi = h >> 2;
      bf16* STh = ST + ((size_t)bc * 8 + h) * 8192;
#pragma unroll 1
      for (int nh = 0; nh < 2; ++nh) {
      f32x4 acc[4][4];
#pragma unroll
      for (int nt = 0; nt < 4; ++nt)
#pragma unroll
          for (int pt = 0; pt < 4; ++pt) acc[nt][pt] = (f32x4){0.f, 0.f, 0.f, 0.f};
#pragma unroll
      for (int ks = 0; ks < 2; ++ks) {
          const int rowA = 32 * ks + 4 * q4 + (fr >> 2), rowB = rowA + 16;
          bf16x8 yf[4];
#pragma unroll
          for (int pt = 0; pt < 4; ++pt) { const int cb = (h * 64 + 16 * pt + 4 * (lane & 3)) * 2; yf[pt] = cat8(trrd(XI + rowA * 1056 + cb), trrd(XI + rowB * 1056 + cb)); }
#pragma unroll
          for (int nt = 0; nt < 4; ++nt) { const int cb = (gi * 128 + 64 * nh + 16 * nt + 4 * (lane & 3)) * 2;
              const bf16x8 xf = cat8(trrd(BI + rowA * 544 + cb), trrd(BI + rowB * 544 + cb));
#pragma unroll
              for (int pt = 0; pt < 4; ++pt) acc[nt][pt] = mfma16(xf, yf[pt], acc[nt][pt]); }
      }
#pragma unroll
      for (int nt = 0; nt < 4; ++nt)
#pragma unroll
          for (int pt = 0; pt < 4; ++pt) { v2u o; o.x = pk2(acc[nt][pt][0], acc[nt][pt][1]); o.y = pk2(acc[nt][pt][2], acc[nt][pt][3]); *(v2u*)(STh + (16 * pt + fr) * 128 + 64 * nh + 16 * nt + 4 * q4) = o; }
      }
    }
    __syncthreads();
}
__device__ __forceinline__ void ssd_scan(Frame& F, ArgsRef A) {
    unsigned* ST = (unsigned*)(A.ws + WS_ST); const float* AEND = (const float*)(A.ws + WS_AEND);
    for (int it = F.vcu * NTHR + F.tid; it < 32 * 4096; it += F.G * NTHR) {
        const int bh = it >> 12, b = bh >> 3, h = bh & 7, e = (it & 4095);
        unsigned* base = ST + ((size_t)(b * NCHUNK) * 8 + h) * 4096 + e;
        float s0 = 0.f, s1 = 0.f;
        for (int c0 = 0; c0 < NCHUNK; c0 += 16) {
            unsigned v[16]; float dec[16];
#pragma unroll
            for (int i = 0; i < 16; ++i) { v[i] = base[(size_t)(c0 + i) * 32768]; dec[i] = __expf(AEND[(size_t)(b * NCHUNK + c0 + i) * 8 + h]); }
#pragma unroll
            for (int i = 0; i < 16; ++i) { base[(size_t)(c0 + i) * 32768] = pk2(s0, s1); s0 = s0 * dec[i] + bflo(v[i]); s1 = s1 * dec[i] + bfhi(v[i]); }
        }
    }
}
__device__ __forceinline__ void ssd3_unit(Frame& F, ArgsRef A, int L, int bc) {
    LAS unsigned char* Ls = F.lds; const int lane = F.lane, w = F.wave, fr = lane & 15, q4 = lane >> 4;
    const int b = bc >> 7, c = bc & 127; const size_t m0 = (size_t)b * SEQ + (size_t)c * 64;
    const bf16* P = (const bf16*)(A.ws + WS_PROJ); const bf16* XBCC = (const bf16*)(A.ws + WS_XBCC); const bf16* ST = (const bf16*)(A.ws + WS_ST); bf16* Y = (bf16*)(A.ws + WS_Y);
    LAS unsigned char* XI = Ls; LAS unsigned char* BI = Ls + 67584; LAS unsigned char* CI = Ls + 102400;
    LAS float* dtl = (LAS float*)(Ls + 137216); LAS float* acs = (LAS float*)(Ls + 139264);
    ssd_prepass(F, A, L, m0, dtl, acs);
#pragma unroll 4
    for (int i = 0; i < 16; ++i) { const int pc = F.tid + NTHR * i, row = pc >> 7, cg = pc & 127;
        const v4u v = *(const v4u*)(XBCC + (m0 + row) * 1024 + 8 * cg);
        LAS unsigned char* dst = cg < 64 ? XI + row * 1056 + cg * 16 : (cg < 96 ? BI + row * 544 + (cg - 64) * 16 : CI + row * 544 + (cg - 96) * 16);
        *(LAS v4u*)dst = v; }
    __syncthreads();
    const int h = w, gi = h >> 2;
    f32x4 acc[4][4];
#pragma unroll
    for (int lt = 0; lt < 4; ++lt)
#pragma unroll
        for (int pt = 0; pt < 4; ++pt) acc[lt][pt] = (f32x4){0.f, 0.f, 0.f, 0.f};
    { const bf16* Sh = ST + ((size_t)bc * 8 + h) * 8192;
#pragma unroll 1
      for (int kn = 0; kn < 4; ++kn) {
          bf16x8 yf[4];
#pragma unroll
          for (int pt = 0; pt < 4; ++pt) yf[pt] = *(const bf16x8*)(Sh + (16 * pt + fr) * 128 + 32 * kn + 8 * q4);
#pragma unroll
          for (int lt = 0; lt < 4; ++lt) { const bf16x8 xf = *(const LAS bf16x8*)(CI + (16 * lt + fr) * 544 + (gi * 128 + 32 * kn + 8 * q4) * 2);
#pragma unroll
              for (int pt = 0; pt < 4; ++pt) acc[lt][pt] = mfma16(xf, yf[pt], acc[lt][pt]); }
      }
#pragma unroll
      for (int lt = 0; lt < 4; ++lt)
#pragma unroll
          for (int r = 0; r < 4; ++r) { const float sc = __expf(acs[(16 * lt + 4 * q4 + r) * 8 + h]);
#pragma unroll
              for (int pt = 0; pt < 4; ++pt) acc[lt][pt][r] *= sc; }
    }
#pragma unroll
    for (int lt = 0; lt < 4; ++lt) {
#pragma unroll
        for (int ksp = 0; ksp <= (lt >> 1); ++ksp) {
            __builtin_amdgcn_sched_barrier(0);
            const bool hasb = (2 * ksp + 1) <= lt;
            f32x4 d0a = (f32x4){0.f, 0.f, 0.f, 0.f}, d0b = (f32x4){0.f, 0.f, 0.f, 0.f};
#pragma unroll
            for (int kn = 0; kn < 4; ++kn) { const int cb = (gi * 128 + 32 * kn + 8 * q4) * 2;
                const bf16x8 cf = *(const LAS bf16x8*)(CI + (16 * lt + fr) * 544 + cb);
                const bf16x8 ba = *(const LAS bf16x8*)(BI + (32 * ksp + fr) * 544 + cb); d0a = mfma16(ba, cf, d0a);
                if (hasb) { const bf16x8 bb = *(const LAS bf16x8*)(BI + (32 * ksp + 16 + fr) * 544 + cb); d0b = mfma16(bb, cf, d0b); } }
            const int l = 16 * lt + fr; const float al = acs[l * 8 + h];
            float ga[4], gb[4];
#pragma unroll
            for (int r = 0; r < 4; ++r) { const int sa = 32 * ksp + 4 * q4 + r, sb = sa + 16;
                ga[r] = sa <= l ? d0a[r] * __expf(al - acs[sa * 8 + h]) * dtl[sa * 8 + h] : 0.f;
                gb[r] = (hasb && sb <= l) ? d0b[r] * __expf(al - acs[sb * 8 + h]) * dtl[sb * 8 + h] : 0.f; }
            const bf16x8 xf = pack8(ga[0], ga[1], ga[2], ga[3], gb[0], gb[1], gb[2], gb[3]);
            const int rowA = 32 * ksp + 4 * q4 + (fr >> 2), rowB = rowA + 16;
#pragma unroll
            for (int pt = 0; pt < 4; ++pt) { const int cb = (h * 64 + 16 * pt + 4 * (lane & 3)) * 2;
                acc[lt][pt] = mfma16(xf, cat8(trrd(XI + rowA * 1056 + cb), trrd(XI + rowB * 1056 + cb)), acc[lt][pt]); }
        }
    }
    { const float dsk = A.in[10][L * 8 + h];
#pragma unroll
      for (int lt = 0; lt < 4; ++lt)
#pragma unroll
          for (int pt = 0; pt < 4; ++pt)
#pragma unroll
              for (int r = 0; r < 4; ++r) { const unsigned short xv = *(const LAS unsigned short*)(XI + (16 * lt + 4 * q4 + r) * 1056 + (h * 64 + 16 * pt + fr) * 2);
                  acc[lt][pt][r] += dsk * __uint_as_float((unsigned)xv << 16); } }
    __syncthreads();
#pragma unroll
    for (int lt = 0; lt < 4; ++lt)
#pragma unroll
        for (int pt = 0; pt < 4; ++pt)
#pragma unroll
            for (int r = 0; r < 4; ++r) *(LAS float*)(Ls + (16 * lt + 4 * q4 + r) * 2112 + (h * 64 + 16 * pt + fr) * 4) = acc[lt][pt][r];
    __syncthreads();
    { const f32x4 g0 = *(const f32x4*)(A.in[11] + L * 512 + 8 * lane), g1 = *(const f32x4*)(A.in[11] + L * 512 + 8 * lane + 4);
#pragma unroll 2
      for (int i = 0; i < 8; ++i) { const int r = 8 * w + i;
        f32x4 v0 = *(const LAS f32x4*)(Ls + r * 2112 + lane * 32), v1 = *(const LAS f32x4*)(Ls + r * 2112 + lane * 32 + 16);
        const v4u z = *(const v4u*)(P + (m0 + r) * PN + PC_Z + 8 * lane);
        v0 = v0 * (f32x4){silu(bflo(z.x)), silu(bfhi(z.x)), silu(bflo(z.y)), silu(bfhi(z.y))};
        v1 = v1 * (f32x4){silu(bflo(z.z)), silu(bfhi(z.z)), silu(bflo(z.w)), silu(bfhi(z.w))};
        const float ss = wave_sum((v0.x * v0.x + v0.y * v0.y) + (v0.z * v0.z + v0.w * v0.w) + (v1.x * v1.x + v1.y * v1.y) + (v1.z * v1.z + v1.w * v1.w)) * (1.0f / 512.0f);
        const float sc = 1.0f / sqrtf(ss + 1e-6f);
        v0 = v0 * sc * g0; v1 = v1 * sc * g1;
        v4u ov; ov.x = pk2(v0.x, v0.y); ov.y = pk2(v0.z, v0.w); ov.z = pk2(v1.x, v1.y); ov.w = pk2(v1.z, v1.w);
        *(v4u*)(Y + (m0 + r) * D + 8 * lane) = ov; } }
    __syncthreads();
}

#ifndef PROBE_FP8TEST
#define PROBE_FP8TEST 0
#endif
#if PROBE_FP8TEST
typedef int v8i __attribute__((ext_vector_type(8)));
__device__ __forceinline__ int fp8_selftest(int lane) {
    const int ij = lane & 15, g = lane >> 4;
    v8i Af, Bf;
#pragma unroll
    for (int r = 0; r < 8; ++r) { int wa = 0, wb = 0; const int k = 32 * g + 4 * r;
        wa = __builtin_amdgcn_cvt_pk_fp8_f32((float)((7 * ij + 3 * (k + 0)) % 5), (float)((7 * ij + 3 * (k + 1)) % 5), wa, false);
        wa = __builtin_amdgcn_cvt_pk_fp8_f32((float)((7 * ij + 3 * (k + 2)) % 5), (float)((7 * ij + 3 * (k + 3)) % 5), wa, true);
        wb = __builtin_amdgcn_cvt_pk_fp8_f32((float)((5 * (k + 0) + 11 * ij) % 7), (float)((5 * (k + 1) + 11 * ij) % 7), wb, false);
        wb = __builtin_amdgcn_cvt_pk_fp8_f32((float)((5 * (k + 2) + 11 * ij) % 7), (float)((5 * (k + 3) + 11 * ij) % 7), wb, true);
        Af[r] = wa; Bf[r] = wb; }
    f32x4 d = (f32x4){0.f, 0.f, 0.f, 0.f};
    d = __builtin_amdgcn_mfma_scale_f32_16x16x128_f8f6f4(Af, Bf, d, 0, 0, 0, 0, 0, 0);
    int bad = 0;
#pragma unroll
    for (int r = 0; r < 4; ++r) { const int i = 4 * g + r, j = ij; float e = 0.f;
        for (int k = 0; k < 128; ++k) e += (float)(((7 * i + 3 * k) % 5) * ((5 * k + 11 * j) % 7));
        bad += (d[r] != e + (PROBE_FP8TEST == 2 ? 1.f : 0.f)) ? 1 : 0; }
    return bad;
}
#endif
constexpr int NPHASE = 1 + 16 + 7 + 2 * MOE_NCH + 1;
__global__ void __launch_bounds__(NTHR, 2) fwd_kernel(Args kargs) {
    ArgsP ap = (ArgsP)__builtin_amdgcn_kernarg_segment_ptr();
#define args (*ap)
    extern __shared__ __attribute__((aligned(16))) unsigned char lds[];
    Frame F;
    F.lds = (LAS unsigned char*)lds;
    F.tid = threadIdx.x; F.lane = F.tid & 63; F.wave = __builtin_amdgcn_readfirstlane(F.tid >> 6);
    F.G = gridDim.x; { const int bx = blockIdx.x; F.vcu = (F.G % 8 == 0) ? (bx % 8) * (F.G / 8) + bx / 8 : bx; }
    gu32* ctl = (gu32*)(args.ws + WS_CTL);
    for (int u = F.tid; u < (LDS_BYTES - LDSCTL_OFF) / 4; u += NTHR) ((LAS unsigned*)(F.lds + LDSCTL_OFF))[u] = 0u;
    __syncthreads();
    XcdBarrier bar; bar.bar = (unsigned*)(ctl + CW_BAR); bar.x = 0; bar.st = nullptr;
    const int lo = args.ph_lo, hi = args.ph_hi;
    if (hi - lo > 1) bar = xcd_barrier_post((unsigned*)(ctl + CW_BAR), (volatile LAS unsigned*)(F.lds + CTL_MISC) + 8);
#if PROBE_TG >= 0
    unsigned long long t_acc = 0ull, t_ph = 0ull;
#define IN(k) ((lo <= (k) && (k) < hi) && fresh(F) && relaunder(ap) && ((t_ph = __builtin_amdgcn_s_memrealtime()), true))
#define T_STOP(k) do { if (tgroup_of(k) == PROBE_TG) t_acc += __builtin_amdgcn_s_memrealtime() - t_ph; } while (0)
    unsigned long long t_sub = 0ull;
#define T_SUB0() (t_sub = __builtin_amdgcn_s_memrealtime())
#define T_SUB(g) do { const unsigned long long n_ = __builtin_amdgcn_s_memrealtime(); if ((g) == PROBE_TG) t_acc += n_ - t_sub; t_sub = n_; } while (0)
#else
#define T_SUB0() do { } while (0)
#define T_SUB(g) do { } while (0)
#define IN(k) ((lo <= (k) && (k) < hi) && fresh(F) && relaunder(ap))
#define T_STOP(k) do { } while (0)
#endif
#define SEAM(k) do { if ((k) + 1 < hi) { REP(12) xcd_barrier(bar); } T_STOP(k); } while (0)
    unsigned char* ws = args.ws;
    bf16* A1 = (bf16*)(ws + WS_A1); bf16* PROJ = (bf16*)(ws + WS_PROJ); bf16* Yb = (bf16*)(ws + WS_Y); bf16* MIXED = (bf16*)(ws + WS_MIXED);
    const int bid = (int)blockIdx.x;

    if (IN(0)) {
#if PROBE_FP8TEST
        if (blockIdx.x == 0 && F.wave == 0) { const int bad = fp8_selftest(F.lane); if (bad) atomicAdd((unsigned*)(args.ws + WS_CTL) + 2, (unsigned)bad); }
#endif
        REP(10) { cvt_small_weights(F, args);
        __syncthreads(); }
        RowArgs R{args.in[0], nullptr, 0, nullptr, nullptr, args.in[1], A1, 1, args.in[5] + 1536, DIN};
        REP(9) row_phase(F, args, R);
        SEAM(0);
    }
    for (int L = 0; L < 2; ++L) {
        const int pb = 1 + 16 * L;
        if (IN(pb + 0)) {
            pg8::Gemm g{A1, (const bf16*)(ws + WS_WIN) + (size_t)L * PN * D, M, PN, D}; pg8::StaticOrder S; S.init(M, PN, F.G, bid);
            pg8::EpiStore E{PROJ, PN, 1.0f};
            REP(5) pg8::gemm_phase<pg8::EpiStore, pg8::StaticOrder, true, true>(F.lds, g, S, E);
            SEAM(pb + 0);
        }
        if (IN(pb + 1)) {
            T_SUB0();
            REP(0) for (int u = F.vcu; u < NBATCH * NCHUNK; u += F.G) ssd1_unit(F, args, L, u);
            T_SUB(10);
            REP(1) for (int u = F.vcu; u < NBATCH * NCHUNK; u += F.G) attn_unit(F, args, L, u);
            T_SUB(11);
            REP(2) for (int u = F.vcu; u < M / 128; u += F.G) gmlp_unit(F, args, L, u);
            T_SUB(12);
            SEAM(pb + 1);
        }
                if (IN(pb + 2)) { ssd_scan(F, args); SEAM(pb + 2); }
                if (IN(pb + 3)) { REP(3) for (int u = F.vcu; u < NBATCH * NCHUNK; u += F.G) ssd3_unit(F, args, L, u); SEAM(pb + 3); }
        if (IN(pb + 4)) {
            pg8::Gemm g{Yb, (const bf16*)(ws + WS_WOUT) + (size_t)L * D * D, M, D, D}; pg8::StaticOrder S; S.init(M, D, F.G, bid);
            pg8::EpiStore E{MIXED, D, 1.0f};
            REP(5) pg8::gemm_phase<pg8::EpiStore, pg8::StaticOrder, true, true>(F.lds, g, S, E);
            SEAM(pb + 4);
        }
        if (IN(pb + 5)) {
            RowArgs R{L == 0 ? args.in[0] : args.out, args.out, 1, MIXED, args.in[2] + L * D, args.in[3] + L * D, A1, L == 1 ? 2 : 0, args.in[23], 8};
            if (L == 0) { REP(8) row_phase(F, args, R); } else row_phase(F, args, R);
            if (L == 1) REP(4) cvt_moe_weights(F, args);
            SEAM(pb + 5);
        }
        if (L == 0) {
            if (IN(pb + 6)) {
                pg8::Gemm g{A1, (const bf16*)(ws + WS_WGU), M, 2 * DFF, D}; pg8::StaticOrder S; S.init(M, 2 * DFF, F.G, bid);
                pg8::EpiSwiglu E{(bf16*)(ws + WS_H1), DFF};
                REP(6) pg8::gemm_phase<pg8::EpiSwiglu, pg8::StaticOrder, true, true>(F.lds, g, S, E);
                SEAM(pb + 6);
            }
            if (IN(pb + 7)) {
                pg8::Gemm g{(const bf16*)(ws + WS_H1), (const bf16*)(ws + WS_WD), M, D, DFF}; pg8::StaticOrder S; S.init(M, D, F.G, bid);
                pg8::EpiStore E{(bf16*)(ws + WS_FOUT), D, 1.0f};
                REP(6) pg8::gemm_phase<pg8::EpiStore, pg8::StaticOrder, true, true>(F.lds, g, S, E);
                SEAM(pb + 7);
            }
            if (IN(pb + 8)) {
                RowArgs R{args.out, args.out, 1, (const bf16*)(ws + WS_FOUT), args.in[4], args.in[1] + D, A1, 1, args.in[5] + (size_t)D * DIN + 1536, DIN};
                row_phase(F, args, R);
                SEAM(pb + 8);
            }
        } else {
#if PROBE_TG >= 10
#ifdef PROBE_TMIN
            if (lo <= pb + 6 && pb + 6 < hi && threadIdx.x == 0) atomicMax((unsigned*)(args.ws + WS_CTL) + 8, 0xffffffffu - (unsigned)t_acc);
#else
            if (lo <= pb + 6 && pb + 6 < hi && threadIdx.x == 0) atomicMax((unsigned*)(args.ws + WS_CTL) + 8, (unsigned)t_acc);
#endif
#endif
            if (IN(pb + 6)) { REP(11) { moe_tables(F, args); moe_gather(F, args); } SEAM(pb + 6); }
            for (int k = 0; k < MOE_NCH; ++k) {
                if (IN(pb + 7 + 2 * k)) {
                    moe_tables(F, args);
                    const int nT = *(LAS int*)(F.lds + CTL_CNT + 32 * 4); int nk = nT - MOE_CH * k; nk = nk < 0 ? 0 : ((k < MOE_NCH - 1 && nk > MOE_CH) ? MOE_CH : nk);
                    pg8::Gemm g{(const bf16*)(ws + WS_XS), (const bf16*)(ws + WS_MWGU), 0, 0, D / 2};
                    pg8::MoeOrder<false, true> S{MOE_CH * k, nk, 28, F.G, bid, (const LAS int*)(F.lds + CTL_TE)};
                    pg8::EpiSwiglu8 E{ws + WS_HM, DFFE, 1.0f / (FP8_SX * FP8_SW), FP8_SH};
                    REP(7) pg8::gemm_phase<pg8::EpiSwiglu8, pg8::MoeOrder<false, true>, true, true, true>(F.lds, g, S, E);
                    SEAM(pb + 7 + 2 * k);
                }
                if (IN(pb + 8 + 2 * k)) {
                    moe_tables(F, args);
                    const int nT = *(LAS int*)(F.lds + CTL_CNT + 32 * 4); int nk = nT - MOE_CH * k; nk = nk < 0 ? 0 : ((k < MOE_NCH - 1 && nk > MOE_CH) ? MOE_CH : nk);
                    pg8::Gemm g{(const bf16*)(ws + WS_HM), (const bf16*)(ws + WS_MWD), 0, 0, DFFE / 2};
                    pg8::MoeOrder<true, false> S{MOE_CH * k, nk, 4, F.G, bid, (const LAS int*)(F.lds + CTL_TE)};
                    pg8::EpiStore E{(bf16*)(ws + WS_YM), D, 1.0f / (FP8_SH * FP8_SW)};
                    REP(7) pg8::gemm_phase<pg8::EpiStore, pg8::MoeOrder<true, false>, true, true, true>(F.lds, g, S, E);
                    SEAM(pb + 8 + 2 * k);
                }
            }
            if (IN(pb + 7 + 2 * MOE_NCH)) {
                RowArgs R{args.out, args.out, 2, (const bf16*)(ws + WS_YM), args.in[4] + D, nullptr, nullptr, 0, nullptr, 0};
                row_phase(F, args, R);
#if PROBE_FP8TEST
                if (__hip_atomic_load((unsigned*)(args.ws + WS_CTL) + 2, RLX_AGENT) != 0u) { __syncthreads(); for (size_t i = (size_t)blockIdx.x * NTHR + F.tid; i < (size_t)M * D; i += (size_t)F.G * NTHR) args.out[i] += 1.0f; }
#endif
            }
        }
    }
#if PROBE_TG >= 0
    T_STOP(1 + 16 + 7 + 2 * MOE_NCH);
#if PROBE_TG >= 10
#endif
    if (blockIdx.x == 77) { unsigned long long t_spin = t_acc;
#if PROBE_TG >= 10
        t_spin = __hip_atomic_load((unsigned*)(args.ws + WS_CTL) + 8, RLX_AGENT);
#ifdef PROBE_TMIN
        t_spin = 0xffffffffu - (unsigned)t_spin;
#endif
#endif
        const unsigned long long t_end = __builtin_amdgcn_s_memrealtime(); while (__builtin_amdgcn_s_memrealtime() - t_end < t_spin) __builtin_amdgcn_s_sleep(8); }
#endif
#undef IN
#undef SEAM
#undef args
}

extern "C" void kernel_launch(void* const* d_in, const int* in_sizes, int n_in, void* d_out, int out_size, void* d_ws, size_t ws_size, hipStream_t stream) {
    static int grid = 0;
    if (grid == 0) {
        if (n_in != NIN || out_size != M * D || ws_size < WS_END) { fprintf(stderr, "kernel_launch: unexpected shapes (n_in %d, out %d, ws %zu)\n", n_in, out_size, ws_size); grid = -1; return; }
        int dev = 0, cus = 0;
        if (hipGetDevice(&dev) != hipSuccess || hipDeviceGetAttribute(&cus, hipDeviceAttributeMultiprocessorCount, dev) != hipSuccess) { grid = -1; return; }
        if (hipFuncSetAttribute((const void*)fwd_kernel, hipFuncAttributeMaxDynamicSharedMemorySize, LDS_BYTES) != hipSuccess) { fprintf(stderr, "kernel_launch: hipFuncSetAttribute failed\n"); grid = -1; return; }
        int per_cu = 0;
        if (hipOccupancyMaxActiveBlocksPerMultiprocessor(&per_cu, (const void*)fwd_kernel, NTHR, LDS_BYTES) != hipSuccess || per_cu < 1) fprintf(stderr, "kernel_launch: occupancy query says %d\n", per_cu);
        (void)hipGetLastError();
        grid = cus > 256 ? 256 : cus;
    }
    if (grid < 0) return;
    (void)hipMemsetAsync((char*)d_ws + WS_CTL, 0, CTL_ZERO_BYTES, stream);
    Args a{};
    for (int i = 0; i < NIN; ++i) a.in[i] = (const float*)d_in[i];
    a.out = (float*)d_out; a.ws = (unsigned char*)d_ws;
#if MK_SINGLE
    a.ph_lo = 0; a.ph_hi = NPHASE;
    hipLaunchKernelGGL(fwd_kernel, dim3(grid), dim3(NTHR), LDS_BYTES, stream, a);
#else
    for (int ph = 0; ph < NPHASE; ++ph) { if (ph >= 10 && ph < 17) continue; a.ph_lo = ph; a.ph_hi = ph + 1; hipLaunchKernelGGL(fwd_kernel, dim3(grid), dim3(NTHR), LDS_BYTES, stream, a); }
#endif
}
```

```cpp
#include <hip/hip_runtime.h>
#include <cstdio>
#include <cstdint>

#ifndef MK_SINGLE
#define MK_SINGLE 1
#endif

namespace pg8 {
#define PG8_LAS __attribute__((address_space(3)))
typedef unsigned short bf16_t;
typedef short bf16x8 __attribute__((ext_vector_type(8)));
typedef float f32x4 __attribute__((ext_vector_type(4)));
typedef unsigned u32x4 __attribute__((ext_vector_type(4)));
constexpr int BM = 256, BK = 64, HALF = 128, HTB = HALF * BK * 2  , STAGE_BYTES = 8 * HTB, NXCD = 8, WGM = 8;

__host__ __device__ __forceinline__ int lds_byte(int r, int c) { const int st = (r >> 4) * 2 + (c >> 5), rr = r & 15, cc = c & 31, ob = rr * 64 + cc * 2; return st * 1024 + (ob ^ (((ob >> 9) & 1) << 5)); }
__host__ __device__ __forceinline__ void stage_rc(int b, int& R, int& C) { const int st = b / 1024, sb = b % 1024, swz = sb ^ (((sb >> 9) & 1) << 5); R = (st >> 1) * 16 + swz / 64; C = (st & 1) * 32 + (swz % 64) / 2; }
__host__ __device__ __forceinline__ int perm32(int rho) { const int n = rho >> 4, i = rho & 15; return 8 * (i >> 2) + 4 * n + (i & 3); }

struct Unit { int pm, pn, om, on; };
struct Gemm { const bf16_t* A; const bf16_t* Bt; int M, N, K; };

__host__ __device__ __forceinline__ bool tile_order(int i, int G, int c, int nM, int nN, int& pm, int& pn) {
    const int nwg = nM * nN; const long L = (long)i * G + c; if (L >= nwg) return false;
    int wgid = (int)L; { const int q = nwg / NXCD, r = nwg % NXCD, xcd = wgid % NXCD, off = wgid / NXCD; wgid = (xcd < r ? xcd * (q + 1) : r * (q + 1) + (xcd - r) * q) + off; }
    const int nig = WGM * nN, gid = wgid / nig, fm = gid * WGM, gsz = (nM - fm) < WGM ? (nM - fm) : WGM;
    pm = fm + ((wgid % nig) % gsz); pn = (wgid % nig) / gsz; return true;
}
struct StaticOrder {
    int nM, nN, G, c;
    __host__ __device__ void init(int M, int N, int G_, int c_) { nM = M / BM; nN = N / BM; G = G_; c = c_; }
    __host__ __device__ bool next(int i, Unit& u) const { int pm, pn; if (!tile_order(i, G, c, nM, nN, pm, pn)) return false; u.pm = pm; u.pn = pn; u.om = pm; u.on = pn; return true; }
    __device__ __forceinline__ void a_ready(const Unit&) const {}
    __device__ __forceinline__ void done(const Unit&) const {}
};
template <bool A_LOCAL, bool O_LOCAL>
struct MoeOrder {
    int t0, nT, nN, G, c; const PG8_LAS int* te;
    __device__ __forceinline__ bool next(int i, Unit& u) const { int pm, pn; if (!tile_order(i, G, c, nT, nN, pm, pn)) return false;
        const int e = __builtin_amdgcn_readfirstlane(te[t0 + pm]);
        u.pm = A_LOCAL ? pm : t0 + pm; u.pn = e * nN + pn; u.om = O_LOCAL ? pm : t0 + pm; u.on = pn; return true; }
    __device__ __forceinline__ void a_ready(const Unit&) const {}
    __device__ __forceinline__ void done(const Unit&) const {}
};

__device__ __forceinline__ unsigned cvt_pk_bf16(float lo, float hi) { unsigned r; asm volatile("v_cvt_pk_bf16_f32 %0, %1, %2" : "=v"(r) : "v"(lo), "v"(hi)); return r; }

typedef int v8i32 __attribute__((ext_vector_type(8)));
__device__ __forceinline__ v8i32 cat16(bf16x8 lo, bf16x8 hi) { const u32x4 a = __builtin_bit_cast(u32x4, lo), b = __builtin_bit_cast(u32x4, hi); return (v8i32){(int)a.x, (int)a.y, (int)a.z, (int)a.w, (int)b.x, (int)b.y, (int)b.z, (int)b.w}; }
__device__ __forceinline__ float clamp448(float x) { return __builtin_fminf(__builtin_fmaxf(x, -448.0f), 448.0f); }
__device__ __forceinline__ unsigned pack_fp8x4(float a, float b, float c, float d) {
    int r = 0; r = __builtin_amdgcn_cvt_pk_fp8_f32(clamp448(a), clamp448(b), r, false); r = __builtin_amdgcn_cvt_pk_fp8_f32(clamp448(c), clamp448(d), r, true); return (unsigned)r; }
struct EpiStore {
    static constexpr bool PERM = true, AFTER_DRAIN = false;
    bf16_t* O; int ldc; float scale;
    __device__ __forceinline__ void operator()(const f32x4 (&acc)[2][2][4][2], const Unit& u, int wr, int wc, int fr, int fq) const {
        const int row0 = u.om * BM + wr * 64 + fr; const int col0 = u.on * BM + wc * 32 + 8 * fq;
#pragma unroll
        for (int ai = 0; ai < 2; ++ai)
#pragma unroll
            for (int m = 0; m < 4; ++m) { bf16_t* rowp = O + (size_t)(row0 + ai * HALF + m * 16) * ldc + col0;
#pragma unroll
                for (int bj = 0; bj < 2; ++bj) { const f32x4 v0 = acc[ai][bj][m][0] * scale, v1 = acc[ai][bj][m][1] * scale;
                    u32x4 w; w.x = cvt_pk_bf16(v0[0], v0[1]); w.y = cvt_pk_bf16(v0[2], v0[3]); w.z = cvt_pk_bf16(v1[0], v1[1]); w.w = cvt_pk_bf16(v1[2], v1[3]);
                    *(u32x4*)(rowp + bj * HALF) = w; } }
    }
};
__device__ __forceinline__ float silu_f(float x) { return x * __builtin_amdgcn_rcpf(1.0f + __expf(-x)); }
struct EpiSwiglu {
    static constexpr bool PERM = true, AFTER_DRAIN = false;
    bf16_t* O; int ldc;
    __device__ __forceinline__ void operator()(const f32x4 (&acc)[2][2][4][2], const Unit& u, int wr, int wc, int fr, int fq) const {
        const int row0 = u.om * BM + wr * 64 + fr; const int col0 = u.on * HALF + wc * 32 + 8 * fq;
#pragma unroll
        for (int ai = 0; ai < 2; ++ai)
#pragma unroll
            for (int m = 0; m < 4; ++m) { bf16_t* rowp = O + (size_t)(row0 + ai * HALF + m * 16) * ldc + col0;
                const f32x4 g0 = acc[ai][0][m][0], g1 = acc[ai][0][m][1], u0 = acc[ai][1][m][0], u1 = acc[ai][1][m][1];
                u32x4 w;
                w.x = cvt_pk_bf16(silu_f(g0[0]) * u0[0], silu_f(g0[1]) * u0[1]); w.y = cvt_pk_bf16(silu_f(g0[2]) * u0[2], silu_f(g0[3]) * u0[3]);
                w.z = cvt_pk_bf16(silu_f(g1[0]) * u1[0], silu_f(g1[1]) * u1[1]); w.w = cvt_pk_bf16(silu_f(g1[2]) * u1[2], silu_f(g1[3]) * u1[3]);
                *(u32x4*)rowp = w; }
    }
};

struct EpiSwiglu8 {
    static constexpr bool PERM = true, AFTER_DRAIN = false;
    unsigned char* O; int ldc; float in_scale, out_scale;
    __device__ __forceinline__ void operator()(const f32x4 (&acc)[2][2][4][2], const Unit& u, int wr, int wc, int fr, int fq) const {
        const int row0 = u.om * BM + wr * 64 + fr; const int col0 = u.on * HALF + wc * 32 + 8 * fq;
#pragma unroll
        for (int ai = 0; ai < 2; ++ai)
#pragma unroll
            for (int m = 0; m < 4; ++m) { unsigned char* rowp = O + (size_t)(row0 + ai * HALF + m * 16) * ldc + col0;
                const f32x4 g0 = acc[ai][0][m][0] * in_scale, g1 = acc[ai][0][m][1] * in_scale, u0 = acc[ai][1][m][0] * (in_scale * out_scale), u1 = acc[ai][1][m][1] * (in_scale * out_scale);
                typedef unsigned u32x2 __attribute__((ext_vector_type(2)));
                u32x2 w;
                w.x = pack_fp8x4(silu_f(g0[0]) * u0[0], silu_f(g0[1]) * u0[1], silu_f(g0[2]) * u0[2], silu_f(g0[3]) * u0[3]);
                w.y = pack_fp8x4(silu_f(g1[0]) * u1[0], silu_f(g1[1]) * u1[1], silu_f(g1[2]) * u1[2], silu_f(g1[3]) * u1[3]);
                *(u32x2*)rowp = w; }
    }
};

template <class Epi, class Sched, bool ALIGN_EPI = false, bool SP2 = false, bool FP8 = false>
__device__ __forceinline__ void gemm_phase(PG8_LAS unsigned char* lds, const Gemm g, const Sched& S, const Epi& E) {
    int tid_ = threadIdx.x; asm volatile("" : "+v"(tid_));
    const int tid = tid_, wid = __builtin_amdgcn_readfirstlane(tid >> 6), lane = tid & 63, wr = wid >> 2, wc = wid & 3, fr = lane & 15, fq = lane >> 4;
    int K_ = g.K; asm volatile("" : "+s"(K_));
    const int K = K_, nt = K / BK;
    unsigned voffA[2], voffB[2];
#pragma unroll
    for (int i = 0; i < 2; ++i) { int R, C; stage_rc(tid * 16 + i * 8192, R, C); const int Rb = Epi::PERM ? ((R & ~31) + perm32(R & 31)) : R;
        voffA[i] = (unsigned)(R * K + C) * 2u; voffB[i] = (unsigned)(Rb * K + C) * 2u; }
    const size_t kstep = (size_t)(BK * 2);
    const size_t hstep = (size_t)HALF * K * 2;
    const size_t tstep = 2 * hstep;
    const unsigned ldsw = (unsigned)wid * 1024u;
    const int aoff = lds_byte(wr * 64 + fr, fq * 8), boff = lds_byte(wc * 32 + fr, fq * 8);
#define PG8_SA(b, h) (((b) * 2 + (h)) * HTB)
#define PG8_SB(b, h) ((4 + (b) * 2 + (h)) * HTB)
#define PG8_STAGE(bufoff, gbase, voff) do { _Pragma("unroll") for (int _i = 0; _i < 2; ++_i) \
        __builtin_amdgcn_global_load_lds((const unsigned*)((const char*)(gbase) + (voff)[_i]), (PG8_LAS unsigned*)(lds + (bufoff) + ldsw + _i * 8192), 16, 0, 0); } while (0)
#define PG8_LDA(dst, dst8, b, h) do { _Pragma("unroll") for (int m = 0; m < 4; ++m) { \
        if constexpr (FP8) dst8[m] = cat16(*(const PG8_LAS bf16x8*)(lds + PG8_SA(b, h) + aoff + m * 2048), *(const PG8_LAS bf16x8*)(lds + PG8_SA(b, h) + aoff + m * 2048 + 1024)); \
        else { _Pragma("unroll") for (int k = 0; k < 2; ++k) dst[m][k] = *(const PG8_LAS bf16x8*)(lds + PG8_SA(b, h) + aoff + m * 2048 + k * 1024); } } } while (0)
#define PG8_LDB(dst, dst8, b, h) do { _Pragma("unroll") for (int n = 0; n < 2; ++n) { \
        if constexpr (FP8) dst8[n] = cat16(*(const PG8_LAS bf16x8*)(lds + PG8_SB(b, h) + boff + n * 2048), *(const PG8_LAS bf16x8*)(lds + PG8_SB(b, h) + boff + n * 2048 + 1024)); \
        else { _Pragma("unroll") for (int k = 0; k < 2; ++k) dst[n][k] = *(const PG8_LAS bf16x8*)(lds + PG8_SB(b, h) + boff + n * 2048 + k * 1024); } } } while (0)
#define PG8_MMA(ai, bj, At, At8, Bt, Bt8) do { __builtin_amdgcn_s_setprio(1); _Pragma("unroll") for (int m = 0; m < 4; ++m) _Pragma("unroll") for (int n = 0; n < 2; ++n) { \
        if constexpr (FP8) { asm volatile("v_mfma_f32_16x16x128_f8f6f4 %0, %1, %2, %0" : "+v"(acc[ai][bj][m][n]) : "v"(Bt8[n]), "v"(At8[m])); } \
        else { _Pragma("unroll") for (int k = 0; k < 2; ++k) acc[ai][bj][m][n] = __builtin_amdgcn_mfma_f32_16x16x32_bf16(Bt[n][k], At[m][k], acc[ai][bj][m][n], 0, 0, 0); } } __builtin_amdgcn_s_setprio(0); } while (0)
#define PG8_WAIT_V(n) asm volatile("s_waitcnt vmcnt(" #n ")" ::: "memory")
#define PG8_WAIT_L(n) asm volatile("s_waitcnt lgkmcnt(" #n ")" ::: "memory")
#define PG8_BAR __builtin_amdgcn_s_barrier()
#define PG8_SCHED __builtin_amdgcn_sched_barrier(0)
    Unit cur, nxt; int ui = 0;
    if (!S.next(0, cur)) return;
    f32x4 acc[2][2][4][2];
#pragma unroll
    for (int a = 0; a < 2; ++a)
#pragma unroll
        for (int b = 0; b < 2; ++b)
#pragma unroll
            for (int m = 0; m < 4; ++m)
#pragma unroll
                for (int n = 0; n < 2; ++n) acc[a][b][m][n] = (f32x4){0.f, 0.f, 0.f, 0.f};
    bf16x8 At[4][2], B0[2][2], B1[2][2]; v8i32 At8[4], B08[2], B18[2];
    const char* cA = (const char*)g.A + (size_t)cur.pm * tstep; const char* cB = (const char*)g.Bt + (size_t)cur.pn * tstep;
    S.a_ready(cur);
    if constexpr (SP2) {
        PG8_STAGE(PG8_SB(0, 0), cB, voffB); PG8_STAGE(PG8_SB(0, 1), cB + hstep, voffB); PG8_STAGE(PG8_SA(0, 0), cA, voffA); PG8_STAGE(PG8_SA(0, 1), cA + hstep, voffA);
        if (wr == 1) PG8_BAR;
        PG8_WAIT_V(2); PG8_BAR;
        PG8_STAGE(PG8_SB(1, 0), cB + kstep, voffB); PG8_STAGE(PG8_SA(1, 0), cA + kstep, voffA); PG8_STAGE(PG8_SB(1, 1), cB + hstep + kstep, voffB);
        PG8_WAIT_V(6); PG8_BAR;
    } else {
        PG8_STAGE(PG8_SB(0, 0), cB, voffB); PG8_STAGE(PG8_SA(0, 0), cA, voffA); PG8_STAGE(PG8_SB(0, 1), cB + hstep, voffB); PG8_STAGE(PG8_SA(0, 1), cA + hstep, voffA);
        if (wr == 1) PG8_BAR;
        PG8_WAIT_V(4); PG8_BAR;
        PG8_STAGE(PG8_SB(1, 0), cB + kstep, voffB); PG8_STAGE(PG8_SA(1, 0), cA + kstep, voffA); PG8_STAGE(PG8_SB(1, 1), cB + hstep + kstep, voffB);
        PG8_WAIT_V(6); PG8_BAR;
    }
    for (;;) {
        const bool has_next = S.next(ui + 1, nxt);
        const char* nA = has_next ? (const char*)g.A + (size_t)nxt.pm * tstep : cA; const char* nB = has_next ? (const char*)g.Bt + (size_t)nxt.pn * tstep : cB;
#pragma unroll 1
        for (int t = 0; t < nt; t += 2) {
            const bool last = (t == nt - 2);
            const char* a1 = cA + (size_t)(t + 1) * kstep;
            const char* a2 = last ? nA : cA + (size_t)(t + 2) * kstep; const char* b2 = last ? nB : cB + (size_t)(t + 2) * kstep;
            const char* a3 = a2 + kstep; const char* b3 = b2 + kstep;
            if (last && has_next) S.a_ready(nxt);
            if constexpr (SP2) {
            PG8_LDB(B0, B08, 0, 0); PG8_LDB(B1, B18, 0, 1); PG8_SCHED; PG8_LDA(At, At8, 0, 0); PG8_STAGE(PG8_SA(1, 1), a1 + hstep, voffA);
            PG8_WAIT_V(8); PG8_WAIT_L(0); PG8_BAR; PG8_MMA(0, 0, At, At8, B0, B08); PG8_MMA(0, 1, At, At8, B1, B18); PG8_BAR; PG8_SCHED;
            PG8_LDA(At, At8, 0, 1); PG8_STAGE(PG8_SB(0, 0), b2, voffB); PG8_STAGE(PG8_SB(0, 1), b2 + hstep, voffB); PG8_STAGE(PG8_SA(0, 0), a2, voffA);
            PG8_WAIT_V(8); PG8_WAIT_L(0); PG8_BAR; PG8_MMA(1, 0, At, At8, B0, B08); PG8_MMA(1, 1, At, At8, B1, B18); PG8_BAR; PG8_SCHED;
            PG8_LDB(B0, B08, 1, 0); PG8_LDB(B1, B18, 1, 1); PG8_SCHED; PG8_LDA(At, At8, 1, 0); PG8_STAGE(PG8_SA(0, 1), a2 + hstep, voffA);
            PG8_WAIT_V(8); PG8_WAIT_L(0); PG8_BAR; PG8_MMA(0, 0, At, At8, B0, B08); PG8_MMA(0, 1, At, At8, B1, B18); PG8_BAR; PG8_SCHED;
            PG8_LDA(At, At8, 1, 1); PG8_STAGE(PG8_SB(1, 0), b3, voffB); PG8_STAGE(PG8_SB(1, 1), b3 + hstep, voffB); PG8_STAGE(PG8_SA(1, 0), a3, voffA);
            PG8_WAIT_V(8); PG8_WAIT_L(0); PG8_BAR; PG8_MMA(1, 0, At, At8, B0, B08); PG8_MMA(1, 1, At, At8, B1, B18); PG8_BAR; PG8_SCHED;
            } else {
            PG8_LDB(B0, B08, 0, 0); PG8_SCHED; PG8_LDA(At, At8, 0, 0); PG8_STAGE(PG8_SA(1, 1), a1 + hstep, voffA);
            PG8_WAIT_L(8); PG8_BAR; PG8_WAIT_L(0); PG8_MMA(0, 0, At, At8, B0, B08); PG8_BAR; PG8_SCHED;
            PG8_LDB(B1, B18, 0, 1); PG8_STAGE(PG8_SB(0, 0), b2, voffB);
            PG8_BAR; PG8_WAIT_L(0); PG8_MMA(0, 1, At, At8, B1, B18); PG8_BAR;
            PG8_LDA(At, At8, 0, 1); PG8_STAGE(PG8_SA(0, 0), a2, voffA);
            PG8_BAR; PG8_WAIT_L(0); PG8_MMA(1, 0, At, At8, B0, B08); PG8_BAR; PG8_SCHED;
            PG8_STAGE(PG8_SB(0, 1), b2 + hstep, voffB);
            PG8_WAIT_V(6); PG8_BAR; PG8_MMA(1, 1, At, At8, B1, B18); PG8_BAR;
            PG8_LDB(B0, B08, 1, 0); PG8_SCHED; PG8_LDA(At, At8, 1, 0); PG8_STAGE(PG8_SA(0, 1), a2 + hstep, voffA);
            PG8_WAIT_L(8); PG8_BAR; PG8_WAIT_L(0); PG8_MMA(0, 0, At, At8, B0, B08); PG8_BAR; PG8_SCHED;
            PG8_LDB(B1, B18, 1, 1); PG8_STAGE(PG8_SB(1, 0), b3, voffB);
            PG8_BAR; PG8_WAIT_L(0); PG8_MMA(0, 1, At, At8, B1, B18); PG8_BAR;
            PG8_LDA(At, At8, 1, 1); PG8_STAGE(PG8_SA(1, 0), a3, voffA);
            PG8_BAR; PG8_WAIT_L(0); PG8_MMA(1, 0, At, At8, B0, B08); PG8_BAR; PG8_SCHED;
            PG8_STAGE(PG8_SB(1, 1), b3 + hstep, voffB);
            PG8_WAIT_V(6); PG8_BAR; PG8_MMA(1, 1, At, At8, B1, B18); PG8_BAR;
            }
        }
        if constexpr (FP8) asm volatile("s_nop 15\n\ts_nop 15" ::: "memory");
        if constexpr (ALIGN_EPI) { if (wr == 0) PG8_BAR; }
        if constexpr (!Epi::AFTER_DRAIN) { E(acc, cur, wr, wc, fr, fq); S.done(cur); }
        if (!has_next) break;
#pragma unroll
        for (int a = 0; a < 2; ++a)
#pragma unroll
            for (int b = 0; b < 2; ++b)
#pragma unroll
                for (int m = 0; m < 4; ++m)
#pragma unroll
                    for (int n = 0; n < 2; ++n) acc[a][b][m][n] = (f32x4){0.f, 0.f, 0.f, 0.f};
        cur = nxt; cA = nA; cB = nB; ++ui;
        if constexpr (ALIGN_EPI) { if (wr == 1) PG8_BAR; }
    }
    PG8_WAIT_V(0);
    if constexpr (!ALIGN_EPI) { if (wr == 0) PG8_BAR; }
    PG8_BAR;
    if constexpr (Epi::AFTER_DRAIN) { E.fused(acc, cur, wr, wc, fr, fq, lds, wid, lane); S.done(cur); }
#undef PG8_SA
#undef PG8_SB
#undef PG8_STAGE
#undef PG8_LDA
#undef PG8_LDB
#undef PG8_MMA
#undef PG8_WAIT_V
#undef PG8_WAIT_L
#undef PG8_BAR
#undef PG8_SCHED
}
}

#define GAS __attribute__((address_space(1)))
#define LAS __attribute__((address_space(3)))
typedef unsigned short bf16;
typedef unsigned v4u __attribute__((ext_vector_type(4)));
typedef unsigned v2u __attribute__((ext_vector_type(2)));
typedef float f32x4 __attribute__((ext_vector_type(4)));
typedef float f32x2 __attribute__((ext_vector_type(2)));
typedef short bf16x8 __attribute__((ext_vector_type(8)));
typedef short v4i16 __attribute__((ext_vector_type(4)));
typedef GAS unsigned gu32;
#define RLX_AGENT __ATOMIC_RELAXED, __HIP_MEMORY_SCOPE_AGENT
#define LDS_WAIT() asm volatile("s_waitcnt lgkmcnt(0)" ::: "memory")
#define VM_WAIT() asm volatile("s_waitcnt vmcnt(0)" ::: "memory")
__device__ __forceinline__ unsigned pk2(float lo, float hi) { return pg8::cvt_pk_bf16(lo, hi); }
__device__ __forceinline__ float bflo(unsigned u) { return __uint_as_float(u << 16); }
__device__ __forceinline__ float bfhi(unsigned u) { return __uint_as_float(u & 0xffff0000u); }
__device__ __forceinline__ float wave_sum(float v) {
#pragma unroll
    for (int o = 1; o < 64; o <<= 1) v += __shfl_xor(v, o);
    return v;
}
__device__ __forceinline__ f32x4 mfma16(bf16x8 a, bf16x8 b, f32x4 c) { return __builtin_amdgcn_mfma_f32_16x16x32_bf16(a, b, c, 0, 0, 0); }
__device__ __forceinline__ v4i16 trrd(LAS unsigned char* p) { return __builtin_amdgcn_ds_read_tr16_b64_v4i16((LAS v4i16*)p); }
__device__ __forceinline__ bf16x8 cat8(v4i16 lo, v4i16 hi) { return (bf16x8){lo[0], lo[1], lo[2], lo[3], hi[0], hi[1], hi[2], hi[3]}; }
__device__ __forceinline__ bf16x8 pack8(float a0, float a1, float a2, float a3, float a4, float a5, float a6, float a7) {
    v4u w; w.x = pk2(a0, a1); w.y = pk2(a2, a3); w.z = pk2(a4, a5); w.w = pk2(a6, a7); return __builtin_bit_cast(bf16x8, w); }
__device__ __forceinline__ float silu(float x) { return x * __builtin_amdgcn_rcpf(1.0f + __expf(-x)); }

#define XB_TMO      128
#define XB_XCNT(j)  (256  + 64 * (j))
#define XB_XSUB(j)  (1280 + 64 * (j))
#define XB_XGEN(j)  (2304 + 64 * (j))
#define XB_TOP      3328
#define XB_TOPGEN   3392
#define XCD_BAR_WORDS 3456
#define XB_SPIN_CAP (1u << 18)

__device__ __forceinline__ unsigned xb_ld(unsigned* p)              { return __hip_atomic_load(p, __ATOMIC_RELAXED, __HIP_MEMORY_SCOPE_AGENT); }
__device__ __forceinline__ unsigned xb_add(unsigned* p, unsigned v) { return __hip_atomic_fetch_add(p, v, __ATOMIC_RELAXED, __HIP_MEMORY_SCOPE_AGENT); }
__device__ __forceinline__ unsigned xb_xcc_id() { return (unsigned)__builtin_amdgcn_s_getreg((3 << 11) | 20) & 0xFu; }
#define XB_SPIN(cond, bar) do { unsigned _sp = 0; while (cond) { __builtin_amdgcn_s_sleep(1); \
    if ((++_sp & 255u) == 0u) { if (xb_ld(&(bar)[XB_TMO])) break; if (_sp > XB_SPIN_CAP) { atomicAdd(&(bar)[XB_TMO], 1u); break; } } } } while (0)

struct XcdBarrier {
    unsigned* bar; unsigned x;
    volatile LAS unsigned* st;
};

__device__ __forceinline__ XcdBarrier xcd_barrier_post(unsigned* bar, volatile LAS unsigned* st) {
    XcdBarrier b; b.bar = bar; b.x = xb_xcc_id(); b.st = st;
    if (threadIdx.x == 0) (void)xb_add(&bar[XB_XCNT(b.x)], 1u);
    return b;
}
__device__ __forceinline__ void xcd_barrier_complete(unsigned* bar, unsigned x, unsigned& nloc, unsigned& nx) {
    const unsigned G = gridDim.x * gridDim.y * gridDim.z;
    unsigned sum, cnt, mine, sp = 0u;
    for (;;) {
        sum = 0u; cnt = 0u; mine = 0u;
#pragma unroll
        for (unsigned j = 0; j < 16; ++j) { const unsigned c = xb_ld(&bar[XB_XCNT(j)]); sum += c; cnt += (c > 0u) ? 1u : 0u; mine = (j == x) ? c : mine; }
        if (sum == G) break;
        __builtin_amdgcn_s_sleep(1);
        if ((++sp & 255u) == 0u) { if (xb_ld(&bar[XB_TMO])) break; if (sp > XB_SPIN_CAP) { atomicAdd(&bar[XB_TMO], 1u); break; } }
    }
    nloc = mine > 0u ? mine : 1u; nx = cnt > 0u ? cnt : 1u;
}

__device__ __forceinline__ void xcd_barrier(const XcdBarrier& b) {
    asm volatile("s_waitcnt vmcnt(0)" ::: "memory");
    __syncthreads();
    if (threadIdx.x == 0) {
        unsigned* bar = b.bar;
        __builtin_amdgcn_s_waitcnt(0);
        unsigned nloc = b.st[0], nx = b.st[1];
        if (nloc == 0u) { xcd_barrier_complete(bar, b.x, nloc, nx); b.st[0] = nloc; b.st[1] = nx; }
        const unsigned old = xb_add(&bar[XB_XSUB(b.x)], 1u);
        const unsigned gen = old / nloc;
        if (old + 1u == (gen + 1u) * nloc) {
            __builtin_amdgcn_fence(__ATOMIC_RELEASE, "agent");
            asm volatile("s_waitcnt vmcnt(0)" ::: "memory");
            const unsigned og = xb_add(&bar[XB_TOP], 1u);
            const unsigned tg = og / nx;
            if (og + 1u == (tg + 1u) * nx) xb_add(&bar[XB_TOPGEN], 1u);
            else XB_SPIN(xb_ld(&bar[XB_TOPGEN]) == tg, bar);
            __builtin_amdgcn_fence(__ATOMIC_ACQUIRE, "agent");
            xb_add(&bar[XB_XGEN(b.x)], 1u);
            asm volatile("s_waitcnt vmcnt(0)" ::: "memory");
        } else {
            XB_SPIN(xb_ld(&bar[XB_XGEN(b.x)]) == gen, bar);
            __builtin_amdgcn_fence(__ATOMIC_ACQUIRE, "agent");
            asm volatile("s_waitcnt vmcnt(0)" ::: "memory");
        }
    }
    __syncthreads();
}

constexpr int NWAVES = 8, NTHR = 512;
constexpr int D = 1024, SEQ = 8192, NBATCH = 4, M = NBATCH * SEQ, NCHUNK = SEQ / 64;
constexpr int DIN = 2824, PN = 2816;
constexpr int PC_Z = 0, PC_XBC = 512, PC_U = 1536, PC_V = 1792, PC_Q = 2048, PC_K = 2304, PC_VV = 2560;
constexpr int DFF = 2816, DFFE = 3584, NEXP = 8;
constexpr int MOE_CH = 128, MOE_NCH = 2, MOE_MAXT = 264;
constexpr int NIN = 27;
constexpr size_t MiB = 1u << 20;
constexpr size_t WS_CTL = 0, CTL_ZERO_BYTES = 65536;
constexpr size_t WS_AEND = 65536, WS_WGCNT = 98304;
constexpr size_t WS_DTRAW = 1 * MiB, WS_TOKE = 2 * MiB, WS_TOKG = 2 * MiB + 262144, WS_POS = 2 * MiB + 524288;
constexpr size_t WS_WIN = 4 * MiB, WS_WOUT = 15 * MiB, WS_WGU = 19 * MiB, WS_WD = 30 * MiB;
constexpr size_t WS_A1 = 36 * MiB, WS_XBCC = 36 * MiB;
constexpr size_t WS_PROJ = 100 * MiB, WS_MIXED = 100 * MiB, WS_H1 = 100 * MiB;
constexpr size_t WS_ST = 276 * MiB, WS_FOUT = 276 * MiB;
constexpr size_t WS_Y = 404 * MiB;
constexpr size_t WS_HM = 36 * MiB, WS_XS = 155 * MiB, WS_YM = 221 * MiB, WS_MWGU = 353 * MiB, WS_MWD = 409 * MiB, WS_END = 468 * MiB;
constexpr float FP8_SX = 8.0f, FP8_SW = 64.0f, FP8_SH = 16.0f;
constexpr int CW_BAR = 4096;
constexpr int LDS_BYTES = 163840, LDSCTL_OFF = 147456;
constexpr int CTL_MISC = LDSCTL_OFF, CTL_CNT = LDSCTL_OFF + 128, CTL_TE = LDSCTL_OFF + 512;

#ifndef PROBE_DUP
#define PROBE_DUP 0
#endif
#ifndef PROBE_TG
#define PROBE_TG -1
#endif
__device__ __forceinline__ int tgroup_of(int k) {
    if (k == 0) return 0;
    const int L = (k - 1) >> 4, r = (k - 1) & 15;
    if (r == 0 || r == 4) return 1;
    if (r == 1) return 2;
    if (r == 2) return 3;
    if (r == 3) return 4;
    if (r == 5) return L == 0 ? 5 : 9;
    if (L == 0) return r == 8 ? 5 : 6;
    if (r == 6) return 7;
    if (r == 7 + 2 * 2) return 5;
    return 8;
}
#define REP(n) for (int rep_ = 0; rep_ < (((PROBE_DUP >> (n)) & 1) ? 2 : 1); ++rep_)
struct Args { const float* in[NIN]; float* out; unsigned char* ws; int ph_lo, ph_hi; };

typedef const __attribute__((address_space(4))) Args* ArgsP;
typedef const __attribute__((address_space(4))) Args& ArgsRef;
struct Frame {
    LAS unsigned char* lds;
    int tid, lane, wave, vcu, G;
};
__device__ __forceinline__ bool relaunder(ArgsP& p) { asm volatile("" : "+s"(p)); return true; }
__device__ __forceinline__ bool fresh(Frame& F) { int t_ = threadIdx.x; asm volatile("" : "+v"(t_)); F.tid = t_; F.lane = t_ & 63; F.wave = __builtin_amdgcn_readfirstlane(t_ >> 6); return true; }

__device__ __forceinline__ void cvt_task(const float* W, int N, int k0, int n0, bf16* WT, int K, int row0, int lane) {
    const float* s = W + (size_t)k0 * N + n0 + lane;
    bf16* d = WT + (size_t)(row0 + lane) * K + k0;
    float v[64];
#pragma unroll
    for (int j = 0; j < 64; ++j) v[j] = __builtin_nontemporal_load(s + (size_t)j * N);
#pragma unroll
    for (int q = 0; q < 8; ++q) { v4u o; o.x = pk2(v[8 * q], v[8 * q + 1]); o.y = pk2(v[8 * q + 2], v[8 * q + 3]); o.z = pk2(v[8 * q + 4], v[8 * q + 5]); o.w = pk2(v[8 * q + 6], v[8 * q + 7]);
        *(GAS v4u*)(d + 8 * q) = o; }
}
__device__ __forceinline__ void cvt_small_weights(Frame& F, ArgsRef A) {
    const int gw = F.vcu * NWAVES + F.wave, NGW = F.G * NWAVES;
    bf16* WIN = (bf16*)(A.ws + WS_WIN); bf16* WOUT = (bf16*)(A.ws + WS_WOUT); bf16* WGU = (bf16*)(A.ws + WS_WGU); bf16* WD = (bf16*)(A.ws + WS_WD);
    constexpr int NI = 1408 + 512 + 1408 + 704;
    for (int it = gw; it < NI; it += NGW) {
        int r = it;
        if (r < 1408) { const int L = r / 704; r %= 704; const int kb = r / 44, nb = r % 44; const int ns = 64 * nb + (64 * nb >= 1536 ? 8 : 0);
            cvt_task(A.in[5] + (size_t)L * D * DIN, DIN, 64 * kb, ns, WIN + (size_t)L * PN * D, D, 64 * nb, F.lane); continue; }
        r -= 1408;
        if (r < 512) { const int L = r / 256; r %= 256; const int kb = r / 16, nb = r % 16;
            cvt_task(A.in[19] + (size_t)L * D * D, D, 64 * kb, 64 * nb, WOUT + (size_t)L * D * D, D, 64 * nb, F.lane); continue; }
        r -= 512;
        if (r < 1408) { const int up = r / 704; r %= 704; const int kb = r / 44, nb = r % 44;
            cvt_task(up ? A.in[21] : A.in[20], DFF, 64 * kb, 64 * nb, WGU, D, 256 * (nb >> 1) + 64 * (nb & 1) + 128 * up, F.lane); continue; }
        r -= 1408;
        { const int kb = r / 16, nb = r % 16; cvt_task(A.in[22], D, 64 * kb, 64 * nb, WD, DFF, 64 * nb, F.lane); }
    }
}
__device__ __forceinline__ void cvt_task8(const float* W, int N, int k0, int n0, unsigned char* WT, int K, int row0, float scale, int lane) {
    const float* s = W + (size_t)k0 * N + n0 + lane;
    unsigned char* d = WT + (size_t)(row0 + lane) * K + k0;
    float v[64];
#pragma unroll
    for (int j = 0; j < 64; ++j) v[j] = __builtin_nontemporal_load(s + (size_t)j * N);
#pragma unroll
    for (int q = 0; q < 4; ++q) { v4u o;
        o.x = pg8::pack_fp8x4(v[16 * q] * scale, v[16 * q + 1] * scale, v[16 * q + 2] * scale, v[16 * q + 3] * scale); o.y = pg8::pack_fp8x4(v[16 * q + 4] * scale, v[16 * q + 5] * scale, v[16 * q + 6] * scale, v[16 * q + 7] * scale);
        o.z = pg8::pack_fp8x4(v[16 * q + 8] * scale, v[16 * q + 9] * scale, v[16 * q + 10] * scale, v[16 * q + 11] * scale); o.w = pg8::pack_fp8x4(v[16 * q + 12] * scale, v[16 * q + 13] * scale, v[16 * q + 14] * scale, v[16 * q + 15] * scale);
        *(GAS v4u*)(d + 16 * q) = o; }
}
__device__ __forceinline__ void cvt_moe_weights(Frame& F, ArgsRef A) {
    const int gw = F.vcu * NWAVES + F.wave, NGW = F.G * NWAVES;
    unsigned char* MWGU = A.ws + WS_MWGU; unsigned char* MWD = A.ws + WS_MWD;
    constexpr int NI = 14336 + 7168;
    for (int it = gw; it < NI; it += NGW) {
        int r = it;
        if (r < 14336) { const int ue = r / 896; r %= 896; const int up = ue >> 3, e = ue & 7; const int kb = r / 56, nb = r % 56;
            cvt_task8((up ? A.in[25] : A.in[24]) + (size_t)e * D * DFFE, DFFE, 64 * kb, 64 * nb, MWGU + (size_t)e * 7168 * D, D, 256 * (nb >> 1) + 64 * (nb & 1) + 128 * up, FP8_SW, F.lane); continue; }
        r -= 14336;
        { const int e = r / 896; r %= 896; const int kb = r / 16, nb = r % 16;
          cvt_task8(A.in[26] + (size_t)e * DFFE * D, D, 64 * kb, 64 * nb, MWD + (size_t)e * D * DFFE, DFFE, 64 * nb, FP8_SW, F.lane); }
    }
}

struct RowArgs {
    const float* hsrc; float* hdst;
    int branch;
    const bf16* ybuf; const float* gpost;
    const float* gpre; bf16* a1;
    int proj;
    const float* w8; int w8ld;
};
__device__ __forceinline__ void row_phase(Frame& F, ArgsRef A, const RowArgs& R) {
    LAS float* W8T = (LAS float*)F.lds;
    LAS int* cnt = (LAS int*)(F.lds + CTL_CNT);
    const int lane = F.lane;
    if (R.proj) { for (int idx = F.tid; idx < 8192; idx += NTHR) { const int e = idx & 7, k = idx >> 3; W8T[e * 1024 + k] = R.w8[(size_t)k * R.w8ld + e]; } }
    if (R.proj == 2 && F.tid < 8) cnt[F.tid] = 0;
    __syncthreads();
    f32x4 gpo[4], gpr[4];
#pragma unroll
    for (int j = 0; j < 4; ++j) { gpo[j] = R.branch ? *(const f32x4*)(R.gpost + 4 * lane + 256 * j) : (f32x4){0.f, 0.f, 0.f, 0.f}; gpr[j] = R.gpre ? *(const f32x4*)(R.gpre + 4 * lane + 256 * j) : (f32x4){0.f, 0.f, 0.f, 0.f}; }
    float* DTRAW = (float*)(A.ws + WS_DTRAW); int* TOKE = (int*)(A.ws + WS_TOKE); float* TOKG = (float*)(A.ws + WS_TOKG); const int* POS = (const int*)(A.ws + WS_POS);
    const int gw = F.vcu * NWAVES + F.wave, NGW = F.G * NWAVES;
    f32x4 vn[2][4]; v2u yn0[2][4], yn1[2][4]; int pn0[2] = {0, 0}, pn1[2] = {0, 0}; float gn0[2] = {0.f, 0.f}, gn1[2] = {0.f, 0.f}, gc0[2] = {0.f, 0.f}, gc1[2] = {0.f, 0.f};
#define ROW_LOAD_IDX(mb) do { if (R.branch == 2) { _Pragma("unroll") for (int q = 0; q < 2; ++q) { const int mm = (mb) + q * NGW; if (mm < M) { pn0[q] = POS[2 * mm]; pn1[q] = POS[2 * mm + 1]; gn0[q] = TOKG[2 * mm]; gn1[q] = TOKG[2 * mm + 1]; } } } } while (0)
#define ROW_LOAD(mb) do { _Pragma("unroll") for (int q = 0; q < 2; ++q) { const int mm = (mb) + q * NGW; if (mm < M) { \
        _Pragma("unroll") for (int j = 0; j < 4; ++j) vn[q][j] = *(const f32x4*)(R.hsrc + (size_t)mm * D + 4 * lane + 256 * j); \
        if (R.branch == 1) { _Pragma("unroll") for (int j = 0; j < 4; ++j) yn0[q][j] = *(const v2u*)(R.ybuf + (size_t)mm * D + 4 * lane + 256 * j); } \
        if (R.branch == 2) { gc0[q] = gn0[q]; gc1[q] = gn1[q]; _Pragma("unroll") for (int j = 0; j < 4; ++j) { yn0[q][j] = *(const v2u*)(R.ybuf + (size_t)pn0[q] * D + 4 * lane + 256 * j); yn1[q][j] = *(const v2u*)(R.ybuf + (size_t)pn1[q] * D + 4 * lane + 256 * j); } } } } } while (0)
    ROW_LOAD_IDX(gw); ROW_LOAD(gw); ROW_LOAD_IDX(gw + 2 * NGW);
    for (int mb = gw; mb < M; mb += 2 * NGW) {
        f32x4 v[2][4], y[2][4];
#pragma unroll
        for (int q = 0; q < 2; ++q) {
#pragma unroll
            for (int j = 0; j < 4; ++j) v[q][j] = vn[q][j];
            if (R.branch == 1) {
#pragma unroll
                for (int j = 0; j < 4; ++j) y[q][j] = (f32x4){bflo(yn0[q][j].x), bfhi(yn0[q][j].x), bflo(yn0[q][j].y), bfhi(yn0[q][j].y)};
            } else if (R.branch == 2) {
#pragma unroll
                for (int j = 0; j < 4; ++j) y[q][j] = (f32x4){gc0[q] * bflo(yn0[q][j].x) + gc1[q] * bflo(yn1[q][j].x), gc0[q] * bfhi(yn0[q][j].x) + gc1[q] * bfhi(yn1[q][j].x), gc0[q] * bflo(yn0[q][j].y) + gc1[q] * bflo(yn1[q][j].y), gc0[q] * bfhi(yn0[q][j].y) + gc1[q] * bfhi(yn1[q][j].y)};
            }
        }
        ROW_LOAD(mb + 2 * NGW); ROW_LOAD_IDX(mb + 4 * NGW);
#pragma unroll
        for (int q = 0; q < 2; ++q) {
        const int m = mb + q * NGW;
        if (m < M) {
        if (R.branch) {
            float ss = 0.f;
#pragma unroll
            for (int j = 0; j < 4; ++j) ss += (y[q][j].x * y[q][j].x + y[q][j].y * y[q][j].y) + (y[q][j].z * y[q][j].z + y[q][j].w * y[q][j].w);
            const float sc = 1.0f / sqrtf(wave_sum(ss) * (1.0f / D) + 1e-6f);
#pragma unroll
            for (int j = 0; j < 4; ++j) v[q][j] = v[q][j] + y[q][j] * sc * gpo[j];
        }
        if (R.hdst) {
#pragma unroll
            for (int j = 0; j < 4; ++j) *(f32x4*)(R.hdst + (size_t)m * D + 4 * lane + 256 * j) = v[q][j];
        }
        if (R.gpre) {
            float ss = 0.f;
#pragma unroll
            for (int j = 0; j < 4; ++j) ss += (v[q][j].x * v[q][j].x + v[q][j].y * v[q][j].y) + (v[q][j].z * v[q][j].z + v[q][j].w * v[q][j].w);
            const float sc = 1.0f / sqrtf(wave_sum(ss) * (1.0f / D) + 1e-6f);
#pragma unroll
            for (int j = 0; j < 4; ++j) { v[q][j] = v[q][j] * sc * gpr[j]; v2u o; o.x = pk2(v[q][j].x, v[q][j].y); o.y = pk2(v[q][j].z, v[q][j].w); *(v2u*)(R.a1 + (size_t)m * D + 4 * lane + 256 * j) = o; }
            if (R.proj) {
                float p[8];
#pragma unroll
                for (int e = 0; e < 8; ++e) { float s = 0.f;
#pragma unroll
                    for (int j = 0; j < 4; ++j) { const f32x4 w = *(const LAS f32x4*)(W8T + e * 1024 + 4 * lane + 256 * j); s += (v[q][j].x * w.x + v[q][j].y * w.y) + (v[q][j].z * w.z + v[q][j].w * w.w); }
                    p[e] = wave_sum(s); }
                if (R.proj == 1) {
                    float mine = p[0];
#pragma unroll
                    for (int e = 1; e < 8; ++e) mine = (lane == e) ? p[e] : mine;
                    if (lane < 8) DTRAW[(size_t)m * 8 + lane] = mine;
                } else {
                    float best = p[0]; int bi = 0;
#pragma unroll
                    for (int e = 1; e < 8; ++e) if (p[e] > best) { best = p[e]; bi = e; }
                    float sb = -3.0e38f; int si = 0;
#pragma unroll
                    for (int e = 0; e < 8; ++e) if (e != bi && p[e] > sb) { sb = p[e]; si = e; }
                    const float g0 = 1.0f / (1.0f + expf(sb - best)), g1 = 1.0f - g0;
                    if (lane == 0) { TOKE[2 * m] = bi; TOKE[2 * m + 1] = si; TOKG[2 * m] = g0; TOKG[2 * m + 1] = g1;
                        __hip_atomic_fetch_add(cnt + bi, 1, __ATOMIC_RELAXED, __HIP_MEMORY_SCOPE_WORKGROUP); __hip_atomic_fetch_add(cnt + si, 1, __ATOMIC_RELAXED, __HIP_MEMORY_SCOPE_WORKGROUP); }
                }
            }
        }
        } }
    }
#undef ROW_LOAD
#undef ROW_LOAD_IDX
    if (R.proj == 2) { __syncthreads(); if (F.tid < 8) ((int*)(A.ws + WS_WGCNT))[F.vcu * 8 + F.tid] = cnt[F.tid]; }
    __syncthreads();
}

__device__ __forceinline__ void moe_tables(Frame& F, ArgsRef A) {
    LAS int* c = (LAS int*)(F.lds + CTL_CNT); LAS int* te = (LAS int*)(F.lds + CTL_TE);
    if (F.tid < 48) c[F.tid] = 0;
    __syncthreads();
    const int* WGCNT = (const int*)(A.ws + WS_WGCNT);
    for (int idx = F.tid; idx < F.G * 8; idx += NTHR) { const int wg = idx >> 3, e = idx & 7; const int v = WGCNT[idx];
        __hip_atomic_fetch_add(c + e, v, __ATOMIC_RELAXED, __HIP_MEMORY_SCOPE_WORKGROUP); if (wg < F.vcu) __hip_atomic_fetch_add(c + 8 + e, v, __ATOMIC_RELAXED, __HIP_MEMORY_SCOPE_WORKGROUP); }
    __syncthreads();
    if (F.tid == 0) { int t = 0;
#pragma unroll 1
        for (int e = 0; e < 8; ++e) { c[16 + e] = t * 256; t += (c[e] + 255) >> 8; c[40 + e] = t; }
        c[32] = t < MOE_MAXT ? t : MOE_MAXT; }
    __syncthreads();
    if (F.tid < MOE_MAXT) { int e = 0;
#pragma unroll
        for (int q = 0; q < 7; ++q) e += (F.tid >= c[40 + q]) ? 1 : 0;
        te[F.tid] = e; }
    __syncthreads();
}
__device__ __forceinline__ void moe_gather(Frame& F, ArgsRef A) {
    LAS int* c = (LAS int*)(F.lds + CTL_CNT);
    const int* TOKE = (const int*)(A.ws + WS_TOKE); int* POS = (int*)(A.ws + WS_POS);
    const bf16* A1 = (const bf16*)(A.ws + WS_A1); unsigned char* XS = A.ws + WS_XS;
    const int gw = F.vcu * NWAVES + F.wave, NGW = F.G * NWAVES, lane = F.lane;
    for (int m = gw; m < M; m += NGW) {
        int d0 = 0, d1 = 0;
        if (lane == 0) { const int e0 = TOKE[2 * m], e1 = TOKE[2 * m + 1];
            d0 = c[16 + e0] + c[8 + e0] + __hip_atomic_fetch_add(c + 24 + e0, 1, __ATOMIC_RELAXED, __HIP_MEMORY_SCOPE_WORKGROUP);
            d1 = c[16 + e1] + c[8 + e1] + __hip_atomic_fetch_add(c + 24 + e1, 1, __ATOMIC_RELAXED, __HIP_MEMORY_SCOPE_WORKGROUP);
            POS[2 * m] = d0; POS[2 * m + 1] = d1; }
        d0 = __builtin_amdgcn_readfirstlane(d0); d1 = __builtin_amdgcn_readfirstlane(d1);
        const v4u r0 = *(const v4u*)(A1 + (size_t)m * D + 16 * lane), r1 = *(const v4u*)(A1 + (size_t)m * D + 16 * lane + 8);
        v4u o;
        o.x = pg8::pack_fp8x4(bflo(r0.x) * FP8_SX, bfhi(r0.x) * FP8_SX, bflo(r0.y) * FP8_SX, bfhi(r0.y) * FP8_SX); o.y = pg8::pack_fp8x4(bflo(r0.z) * FP8_SX, bfhi(r0.z) * FP8_SX, bflo(r0.w) * FP8_SX, bfhi(r0.w) * FP8_SX);
        o.z = pg8::pack_fp8x4(bflo(r1.x) * FP8_SX, bfhi(r1.x) * FP8_SX, bflo(r1.y) * FP8_SX, bfhi(r1.y) * FP8_SX); o.w = pg8::pack_fp8x4(bflo(r1.z) * FP8_SX, bfhi(r1.z) * FP8_SX, bflo(r1.w) * FP8_SX, bfhi(r1.w) * FP8_SX);
        *(v4u*)(XS + (size_t)d0 * D + 16 * lane) = o; *(v4u*)(XS + (size_t)d1 * D + 16 * lane) = o;
    }
    __syncthreads();
}

__device__ __forceinline__ void gmlp_unit(Frame& F, ArgsRef A, int L, int nb) {
    LAS unsigned char* Ls = F.lds; int tl_ = F.tid; asm volatile("" : "+v"(tl_));
    const int tid = tl_, lane = tid & 63, w = F.wave, fr = lane & 15, q4 = lane >> 4;
    const size_t m0 = (size_t)nb * 128;
    const bf16* P = (const bf16*)(A.ws + WS_PROJ); bf16* Y = (bf16*)(A.ws + WS_Y);
    { const f32x4 g4 = *(const f32x4*)(A.in[12] + L * 256 + 4 * lane), b4 = *(const f32x4*)(A.in[13] + L * 256 + 4 * lane);
#pragma unroll 2
      for (int i = 0; i < 16; ++i) { const int r = 16 * w + i;
        const v2u raw = *(const v2u*)(P + (m0 + r) * PN + PC_V + 4 * lane);
        f32x4 v = (f32x4){bflo(raw.x), bfhi(raw.x), bflo(raw.y), bfhi(raw.y)};
        const float mu = wave_sum((v.x + v.y) + (v.z + v.w)) * (1.0f / 256.0f);
        v = v - mu;
        const float var = wave_sum((v.x * v.x + v.y * v.y) + (v.z * v.z + v.w * v.w)) * (1.0f / 256.0f);
        const float rstd = 1.0f / sqrtf(var + 1e-5f);
        v = v * rstd * g4 + b4;
        v2u o; o.x = pk2(v.x, v.y); o.y = pk2(v.z, v.w);
        *(LAS v2u*)(Ls + r * 544 + lane * 8) = o; } }
    __syncthreads();
    const int g = w & 3;
    f32x4 acc[4][4];
    const float* Wg = A.in[14] + (size_t)(L * 4 + g) * 128 * 128;
    const float* bsg = A.in[15] + (size_t)(L * 4 + g) * 128;
#pragma unroll
    for (int pi = 0; pi < 4; ++pi) {
        const int it = (w >> 2) == 0 ? (pi == 0 ? 0 : pi == 1 ? 7 : pi == 2 ? 1 : 6) : (pi == 0 ? 2 : pi == 1 ? 5 : pi == 2 ? 3 : 4);
#pragma unroll
        for (int ct = 0; ct < 4; ++ct) acc[pi][ct] = (f32x4){0.f, 0.f, 0.f, 0.f};
        const int t = 16 * it + fr, nks = (it >> 1) + 1;
        for (int ks = 0; ks < nks; ++ks) {
            const int sA = 32 * ks + 4 * q4, sB = sA + 16;
            const f32x4 wa = *(const f32x4*)(Wg + t * 128 + sA), wb = *(const f32x4*)(Wg + t * 128 + sB);
            const bf16x8 xf = pack8(sA + 0 <= t ? wa.x : 0.f, sA + 1 <= t ? wa.y : 0.f, sA + 2 <= t ? wa.z : 0.f, sA + 3 <= t ? wa.w : 0.f,
                                    sB + 0 <= t ? wb.x : 0.f, sB + 1 <= t ? wb.y : 0.f, sB + 2 <= t ? wb.z : 0.f, sB + 3 <= t ? wb.w : 0.f);
#pragma unroll
            for (int ct = 0; ct < 4; ++ct) { const int col = g * 64 + ct * 16 + 4 * (lane & 3);
                const v4i16 lo = trrd(Ls + (sA + (fr >> 2)) * 544 + col * 2), hi = trrd(Ls + (sB + (fr >> 2)) * 544 + col * 2);
                acc[pi][ct] = mfma16(xf, cat8(lo, hi), acc[pi][ct]); }
        }
#pragma unroll
        for (int r = 0; r < 4; ++r) { const float bs = bsg[16 * it + 4 * q4 + r];
#pragma unroll
            for (int ct = 0; ct < 4; ++ct) acc[pi][ct][r] += bs; }
    }
    __syncthreads();
#pragma unroll
    for (int pi = 0; pi < 4; ++pi) {
        const int it = (w >> 2) == 0 ? (pi == 0 ? 0 : pi == 1 ? 7 : pi == 2 ? 1 : 6) : (pi == 0 ? 2 : pi == 1 ? 5 : pi == 2 ? 3 : 4);
#pragma unroll
        for (int ct = 0; ct < 4; ++ct)
#pragma unroll
            for (int r = 0; r < 4; ++r) *(LAS float*)(Ls + (16 * it + 4 * q4 + r) * 1040 + (g * 64 + ct * 16 + fr) * 4) = acc[pi][ct][r];
    }
    __syncthreads();
    { const f32x4 gn = *(const f32x4*)(A.in[16] + L * 256 + 4 * lane);
#pragma unroll 2
      for (int i = 0; i < 16; ++i) { const int r = 16 * w + i;
        const f32x4 mx = *(const LAS f32x4*)(Ls + r * 1040 + lane * 16);
        const v2u raw = *(const v2u*)(P + (m0 + r) * PN + PC_U + 4 * lane);
        f32x4 v = (f32x4){bflo(raw.x), bfhi(raw.x), bflo(raw.y), bfhi(raw.y)} * mx;
        const float ss = wave_sum((v.x * v.x + v.y * v.y) + (v.z * v.z + v.w * v.w)) * (1.0f / 256.0f);
        v = v * (1.0f / sqrtf(ss + 1e-6f)) * gn;
        v2u o; o.x = pk2(v.x, v.y); o.y = pk2(v.z, v.w);
        *(v2u*)(Y + (m0 + r) * D + 512 + 4 * lane) = o; } }
    __syncthreads();
}

__device__ __forceinline__ void attn_unit(Frame& F, ArgsRef A, int L, int bc) {
    LAS unsigned char* Ls = F.lds; int tl_ = F.tid; asm volatile("" : "+v"(tl_));
    const int tid = tl_, lane = tid & 63, w = F.wave, fr = lane & 15, q4 = lane >> 4;
    const int b = bc >> 7, c = bc & 127; const size_t m0 = (size_t)b * SEQ + (size_t)c * 64;
    const bf16* P = (const bf16*)(A.ws + WS_PROJ); bf16* Y = (bf16*)(A.ws + WS_Y);
    const int h = w >> 1, qh = w & 1;
    LAS unsigned char* Vb = Ls + w * 10240;
    LAS float* BT = (LAS float*)(Ls + 81920);
    constexpr float LOG2E = 1.4426950408889634f;
    for (int i = tid; i < 4 * 257; i += NTHR) BT[i] = A.in[17][(size_t)L * 4 * 257 + i] * LOG2E;
    bf16x8 qf[2][2];
#pragma unroll
    for (int qb = 0; qb < 2; ++qb)
#pragma unroll
        for (int ks = 0; ks < 2; ++ks) qf[qb][ks] = *(const bf16x8*)(P + (m0 + 32 * qh + 16 * qb + fr) * PN + PC_Q + h * 64 + 32 * ks + 8 * q4);
    f32x4 o[4][2];
#pragma unroll
    for (int dt = 0; dt < 4; ++dt) { o[dt][0] = (f32x4){0.f, 0.f, 0.f, 0.f}; o[dt][1] = (f32x4){0.f, 0.f, 0.f, 0.f}; }
    float mrun[2] = {-1e30f, -1e30f}, lrun[2] = {0.f, 0.f};
    const int jmin = c >= 8 ? 0 : 8 - c;
    const bf16* Kp = P + PC_K + h * 64 + 8 * q4 + (size_t)fr * PN;
    const bf16* Vp = P + PC_VV + h * 64 + (lane & 7) * 8 + (size_t)(lane >> 3) * PN;
    bf16x8 kreg[4][2]; v4u vreg[8];
    { const size_t kr0 = m0 - (size_t)(8 - jmin) * 64;
#pragma unroll
      for (int kt = 0; kt < 4; ++kt)
#pragma unroll
          for (int ks = 0; ks < 2; ++ks) kreg[kt][ks] = *(const bf16x8*)(Kp + (kr0 + 16 * kt) * PN + 32 * ks);
#pragma unroll
      for (int i = 0; i < 8; ++i) vreg[i] = *(const v4u*)(Vp + (kr0 + 8 * i) * PN); }
    __syncthreads();
    const float cb = BT[h * 257 + 256];
    for (int j = jmin; j <= 8; ++j) {
        const int jn = j < 8 ? j + 1 : 8; const size_t krn = m0 - (size_t)(8 - jn) * 64;
#pragma unroll
        for (int i = 0; i < 8; ++i) *(LAS v4u*)(Vb + (i * 8 + (lane >> 3)) * 160 + (lane & 7) * 16) = vreg[i];
#pragma unroll
        for (int i = 0; i < 8; ++i) vreg[i] = *(const v4u*)(Vp + (krn + 8 * i) * PN);
        f32x4 st[4][2];
#pragma unroll
        for (int kt = 0; kt < 4; ++kt) { st[kt][0] = (f32x4){0.f, 0.f, 0.f, 0.f}; st[kt][1] = (f32x4){0.f, 0.f, 0.f, 0.f};
#pragma unroll
            for (int ks = 0; ks < 2; ++ks) { st[kt][0] = mfma16(kreg[kt][ks], qf[0][ks], st[kt][0]); st[kt][1] = mfma16(kreg[kt][ks], qf[1][ks], st[kt][1]); } }
#pragma unroll
        for (int kt = 0; kt < 4; ++kt)
#pragma unroll
            for (int ks = 0; ks < 2; ++ks) kreg[kt][ks] = *(const bf16x8*)(Kp + (krn + 16 * kt) * PN + 32 * ks);
#pragma unroll
        for (int qb = 0; qb < 2; ++qb) {
            float mx = -1e30f;
            if (j <= 5) {
#pragma unroll
                for (int kt = 0; kt < 4; ++kt)
#pragma unroll
                    for (int r = 0; r < 4; ++r) { const float s = st[kt][qb][r] * (0.125f * LOG2E) + cb; st[kt][qb][r] = s; mx = fmaxf(mx, s); }
            } else {
                const LAS float* bt = BT + h * 257 + (512 - 64 * j + 32 * qh + 16 * qb + fr - 4 * q4 + 128);
                const int i0 = 512 - 64 * j + 32 * qh + 16 * qb + fr - 4 * q4 + 128;
#pragma unroll
                for (int kt = 0; kt < 4; ++kt)
#pragma unroll
                    for (int r = 0; r < 4; ++r) { int idx = i0 - 16 * kt - r; idx = idx > 256 ? 256 : idx;
                        const float s = st[kt][qb][r] * (0.125f * LOG2E) + BT[h * 257 + idx]; st[kt][qb][r] = s; mx = fmaxf(mx, s); }
                (void)bt;
            }
            mx = fmaxf(mx, __shfl_xor(mx, 16)); mx = fmaxf(mx, __shfl_xor(mx, 32));
            const float mold = mrun[qb], mnew = fmaxf(mold, mx); mrun[qb] = mnew;
            float rs = 0.f;
#pragma unroll
            for (int kt = 0; kt < 4; ++kt)
#pragma unroll
                for (int r = 0; r < 4; ++r) { const float p = __builtin_amdgcn_exp2f(st[kt][qb][r] - mnew); st[kt][qb][r] = p; rs += p; }
            rs += __shfl_xor(rs, 16); rs += __shfl_xor(rs, 32);
            if (__any(mnew > mold)) { const float alpha = __builtin_amdgcn_exp2f(mold - mnew); lrun[qb] = lrun[qb] * alpha + rs;
#pragma unroll
                for (int dt = 0; dt < 4; ++dt) o[dt][qb] = o[dt][qb] * alpha; }
            else lrun[qb] += rs;
        }
#pragma unroll
        for (int kk = 0; kk < 2; ++kk) {
            const bf16x8 y0 = pack8(st[2 * kk][0][0], st[2 * kk][0][1], st[2 * kk][0][2], st[2 * kk][0][3], st[2 * kk + 1][0][0], st[2 * kk + 1][0][1], st[2 * kk + 1][0][2], st[2 * kk + 1][0][3]);
            const bf16x8 y1 = pack8(st[2 * kk][1][0], st[2 * kk][1][1], st[2 * kk][1][2], st[2 * kk][1][3], st[2 * kk + 1][1][0], st[2 * kk + 1][1][1], st[2 * kk + 1][1][2], st[2 * kk + 1][1][3]);
            const int rowA = 32 * kk + 4 * q4 + (fr >> 2), rowB = rowA + 16;
#pragma unroll
            for (int dt = 0; dt < 4; ++dt) { const int cbt = (16 * dt + 4 * (lane & 3)) * 2;
                const bf16x8 xf = cat8(trrd(Vb + rowA * 160 + cbt), trrd(Vb + rowB * 160 + cbt));
                o[dt][0] = mfma16(xf, y0, o[dt][0]); o[dt][1] = mfma16(xf, y1, o[dt][1]); }
        }
    }
    const float il0 = 1.0f / lrun[0], il1 = 1.0f / lrun[1];
    __syncthreads();
#pragma unroll
    for (int dt = 0; dt < 4; ++dt) {
        *(LAS f32x4*)(Ls + (32 * qh + fr) * 1040 + (h * 64 + 16 * dt + 4 * q4) * 4) = o[dt][0] * il0;
        *(LAS f32x4*)(Ls + (32 * qh + 16 + fr) * 1040 + (h * 64 + 16 * dt + 4 * q4) * 4) = o[dt][1] * il1; }
    __syncthreads();
    { const f32x4 gn = *(const f32x4*)(A.in[18] + L * 256 + 4 * lane);
#pragma unroll 2
      for (int i = 0; i < 8; ++i) { const int r = 8 * w + i;
        f32x4 v = *(const LAS f32x4*)(Ls + r * 1040 + lane * 16);
        const float ss = wave_sum((v.x * v.x + v.y * v.y) + (v.z * v.z + v.w * v.w)) * (1.0f / 256.0f);
        v = v * (1.0f / sqrtf(ss + 1e-6f)) * gn;
        v2u ov; ov.x = pk2(v.x, v.y); ov.y = pk2(v.z, v.w);
        *(v2u*)(Y + (m0 + r) * D + 768 + 4 * lane) = ov; } }
    __syncthreads();
}

__device__ __forceinline__ void ssd_prepass(Frame& F, ArgsRef A, int L, size_t m0, LAS float* dtl, LAS float* acs) {
    const float* DTRAW = (const float*)(A.ws + WS_DTRAW);
    { const int l = F.lane, h = F.wave;
      const float x = DTRAW[(m0 + l) * 8 + h] + A.in[8][L * 8 + h];
      const float dt = x > 20.f ? x : log1pf(expf(x));
      float s = -dt * expf(A.in[9][L * 8 + h]);
#pragma unroll
      for (int o = 1; o < 64; o <<= 1) { const float t = __shfl_up(s, o); s += (l >= o) ? t : 0.f; }
      dtl[l * 8 + h] = dt; acs[l * 8 + h] = s; }
    __syncthreads();
}
__device__ __forceinline__ void ssd1_unit(Frame& F, ArgsRef A, int L, int bc) {
    LAS unsigned char* Ls = F.lds; int tl_ = F.tid; asm volatile("" : "+v"(tl_));
    const int tid = tl_, lane = tid & 63, w = F.wave, fr = lane & 15, q4 = lane >> 4;
    const int b = bc >> 7, c = bc & 127; const size_t m0 = (size_t)b * SEQ + (size_t)c * 64;
    const bf16* P = (const bf16*)(A.ws + WS_PROJ); bf16* XBCC = (bf16*)(A.ws + WS_XBCC); bf16* ST = (bf16*)(A.ws + WS_ST); float* AEND = (float*)(A.ws + WS_AEND);
    LAS unsigned char* XI = Ls; LAS unsigned char* BI = Ls + 67584;
    LAS float* dtl = (LAS float*)(Ls + 102400); LAS float* acs = (LAS float*)(Ls + 104448);
    const int cg = tid & 127, tg = tid >> 7, ch0 = 8 * cg;
    v4u raw[19];
#define SSD1_ROW(tt) do { const int lp = 16 * tg - 3 + (tt); const bool ok = (c * 64 + lp) >= 0; \
        raw[tt] = ok ? *(const v4u*)(P + (size_t)((long)m0 + lp) * PN + PC_XBC + ch0) : (v4u){0u, 0u, 0u, 0u}; } while (0)
#pragma unroll
    for (int tt = 0; tt < 11; ++tt) SSD1_ROW(tt);
    ssd_prepass(F, A, L, m0, dtl, acs);
    if (tid < 8) AEND[(size_t)bc * 8 + tid] = acs[63 * 8 + tid];
    { float wk[4][8], bs[8];
#pragma unroll
      for (int k = 0; k < 4; ++k) { const f32x4 a = *(const f32x4*)(A.in[6] + (size_t)(L * 4 + k) * 1024 + ch0), bq = *(const f32x4*)(A.in[6] + (size_t)(L * 4 + k) * 1024 + ch0 + 4);
          wk[k][0] = a.x; wk[k][1] = a.y; wk[k][2] = a.z; wk[k][3] = a.w; wk[k][4] = bq.x; wk[k][5] = bq.y; wk[k][6] = bq.z; wk[k][7] = bq.w; }
      { const f32x4 a = *(const f32x4*)(A.in[7] + (size_t)L * 1024 + ch0), bq = *(const f32x4*)(A.in[7] + (size_t)L * 1024 + ch0 + 4);
          bs[0] = a.x; bs[1] = a.y; bs[2] = a.z; bs[3] = a.w; bs[4] = bq.x; bs[5] = bq.y; bs[6] = bq.z; bs[7] = bq.w; }
      const int hh = cg >> 3;
#pragma unroll
      for (int t = 0; t < 16; ++t) { const int l = 16 * tg + t;
          if (t < 8) SSD1_ROW(t + 11);
          float y[8];
#pragma unroll
          for (int e = 0; e < 8; ++e) y[e] = bs[e];
#pragma unroll
          for (int k = 0; k < 4; ++k) { const v4u rw = raw[t + k];
              y[0] += wk[k][0] * bflo(rw.x); y[1] += wk[k][1] * bfhi(rw.x); y[2] += wk[k][2] * bflo(rw.y); y[3] += wk[k][3] * bfhi(rw.y);
              y[4] += wk[k][4] * bflo(rw.z); y[5] += wk[k][5] * bfhi(rw.z); y[6] += wk[k][6] * bflo(rw.w); y[7] += wk[k][7] * bfhi(rw.w); }
#pragma unroll
          for (int e = 0; e < 8; ++e) y[e] = silu(y[e]);
          v4u o; o.x = pk2(y[0], y[1]); o.y = pk2(y[2], y[3]); o.z = pk2(y[4], y[5]); o.w = pk2(y[6], y[7]);
          *(v4u*)(XBCC + (m0 + l) * 1024 + ch0) = o;
          if (cg < 64) { const float sc = dtl[l * 8 + hh] * __expf(acs[63 * 8 + hh] - acs[l * 8 + hh]);
              v4u os; os.x = pk2(y[0] * sc, y[1] * sc); os.y = pk2(y[2] * sc, y[3] * sc); os.z = pk2(y[4] * sc, y[5] * sc); os.w = pk2(y[6] * sc, y[7] * sc);
              *(LAS v4u*)(XI + l * 1056 + ch0 * 2) = os; }
          else if (cg < 96) *(LAS v4u*)(BI + l * 544 + (ch0 - 512) * 2) = o;
          __builtin_amdgcn_sched_barrier(0);
      } }
#undef SSD1_ROW
    __syncthreads();
    { const int h = w, gi = h >> 2;
      bf16* STh = ST + ((size_t)bc * 8 + h) * 8192;
#pragma unroll 1
      for (int nh = 0; nh < 2; ++nh) {
      f32x4 acc[4][4];
#pragma unroll
      for (int nt = 0; nt < 4; ++nt)
#pragma unroll
          for (int pt = 0; pt < 4; ++pt) acc[nt][pt] = (f32x4){0.f, 0.f, 0.f, 0.f};
#pragma unroll
      for (int ks = 0; ks < 2; ++ks) {
          const int rowA = 32 * ks + 4 * q4 + (fr >> 2), rowB = rowA + 16;
          bf16x8 yf[4];
#pragma unroll
          for (int pt = 0; pt < 4; ++pt) { const int cb = (h * 64 + 16 * pt + 4 * (lane & 3)) * 2; yf[pt] = cat8(trrd(XI + rowA * 1056 + cb), trrd(XI + rowB * 1056 + cb)); }
#pragma unroll
          for (int nt = 0; nt < 4; ++nt) { const int cb = (gi * 128 + 64 * nh + 16 * nt + 4 * (lane & 3)) * 2;
              const bf16x8 xf = cat8(trrd(BI + rowA * 544 + cb), trrd(BI + rowB * 544 + cb));
#pragma unroll
              for (int pt = 0; pt < 4; ++pt) acc[nt][pt] = mfma16(xf, yf[pt], acc[nt][pt]); }
      }
#pragma unroll
      for (int nt = 0; nt < 4; ++nt)
#pragma unroll
          for (int pt = 0; pt < 4; ++pt) { v2u o; o.x = pk2(acc[nt][pt][0], acc[nt][pt][1]); o.y = pk2(acc[nt][pt][2], acc[nt][pt][3]); *(v2u*)(STh + (16 * pt + fr) * 128 + 64 * nh + 16 * nt + 4 * q4) = o; }
      }
    }
    __syncthreads();
}
__device__ __forceinline__ void ssd_scan(Frame& F, ArgsRef A) {
    unsigned* ST = (unsigned*)(A.ws + WS_ST); const float* AEND = (const float*)(A.ws + WS_AEND);
    for (int it = F.vcu * NTHR + F.tid; it < 32 * 4096; it += F.G * NTHR) {
        const int bh = it >> 12, b = bh >> 3, h = bh & 7, e = (it & 4095);
        unsigned* base = ST + ((size_t)(b * NCHUNK) * 8 + h) * 4096 + e;
        float s0 = 0.f, s1 = 0.f;
        for (int c0 = 0; c0 < NCHUNK; c0 += 16) {
            unsigned v[16]; float dec[16];
#pragma unroll
            for (int i = 0; i < 16; ++i) { v[i] = base[(size_t)(c0 + i) * 32768]; dec[i] = __expf(AEND[(size_t)(b * NCHUNK + c0 + i) * 8 + h]); }
#pragma unroll
            for (int i = 0; i < 16; ++i) { base[(size_t)(c0 + i) * 32768] = pk2(s0, s1); s0 = s0 * dec[i] + bflo(v[i]); s1 = s1 * dec[i] + bfhi(v[i]); }
        }
    }
}
__device__ __forceinline__ void ssd3_unit(Frame& F, ArgsRef A, int L, int bc) {
    LAS unsigned char* Ls = F.lds; int tl_ = F.tid; asm volatile("" : "+v"(tl_));
    const int tid = tl_, lane = tid & 63, w = F.wave, fr = lane & 15, q4 = lane >> 4;
    const int b = bc >> 7, c = bc & 127; const size_t m0 = (size_t)b * SEQ + (size_t)c * 64;
    const bf16* P = (const bf16*)(A.ws + WS_PROJ); const bf16* XBCC = (const bf16*)(A.ws + WS_XBCC); const bf16* ST = (const bf16*)(A.ws + WS_ST); bf16* Y = (bf16*)(A.ws + WS_Y);
    LAS unsigned char* XI = Ls; LAS unsigned char* BI = Ls + 67584; LAS unsigned char* CI = Ls + 102400;
    LAS float* dtl = (LAS float*)(Ls + 137216); LAS float* acs = (LAS float*)(Ls + 139264);
    const int h = w, gi = h >> 2;
    v4u stg[16];
#pragma unroll
    for (int i = 0; i < 16; ++i) { const int pc = tid + NTHR * i; stg[i] = *(const v4u*)(XBCC + (m0 + (pc >> 7)) * 1024 + 8 * (pc & 127)); }
    ssd_prepass(F, A, L, m0, dtl, acs);
#pragma unroll
    for (int i = 0; i < 16; ++i) { const int pc = tid + NTHR * i, row = pc >> 7, cg = pc & 127;
        LAS unsigned char* dst = cg < 64 ? XI + row * 1056 + cg * 16 : (cg < 96 ? BI + row * 544 + (cg - 64) * 16 : CI + row * 544 + (cg - 96) * 16);
        *(LAS v4u*)dst = stg[i]; }
    __builtin_amdgcn_sched_barrier(0);
    bf16x8 sin_[4][4];
    { const bf16* Sh = ST + ((size_t)bc * 8 + h) * 8192;
#pragma unroll
      for (int kn = 0; kn < 4; ++kn)
#pragma unroll
          for (int pt = 0; pt < 4; ++pt) sin_[kn][pt] = *(const bf16x8*)(Sh + (16 * pt + fr) * 128 + 32 * kn + 8 * q4); }
    __syncthreads();
    f32x4 acc[4][4];
#pragma unroll
    for (int lt = 0; lt < 4; ++lt)
#pragma unroll
        for (int pt = 0; pt < 4; ++pt) acc[lt][pt] = (f32x4){0.f, 0.f, 0.f, 0.f};
    {
#pragma unroll
      for (int kn = 0; kn < 4; ++kn) {
#pragma unroll
          for (int lt = 0; lt < 4; ++lt) { const bf16x8 xf = *(const LAS bf16x8*)(CI + (16 * lt + fr) * 544 + (gi * 128 + 32 * kn + 8 * q4) * 2);
#pragma unroll
              for (int pt = 0; pt < 4; ++pt) acc[lt][pt] = mfma16(xf, sin_[kn][pt], acc[lt][pt]); }
      }
#pragma unroll
      for (int lt = 0; lt < 4; ++lt)
#pragma unroll
          for (int r = 0; r < 4; ++r) { const float sc = __expf(acs[(16 * lt + 4 * q4 + r) * 8 + h]);
#pragma unroll
              for (int pt = 0; pt < 4; ++pt) acc[lt][pt][r] *= sc; }
    }
#pragma unroll
    for (int lt = 0; lt < 4; ++lt) {
#pragma unroll
        for (int ksp = 0; ksp <= (lt >> 1); ++ksp) {
            __builtin_amdgcn_sched_barrier(0);
            const bool hasb = (2 * ksp + 1) <= lt;
            f32x4 d0a = (f32x4){0.f, 0.f, 0.f, 0.f}, d0b = (f32x4){0.f, 0.f, 0.f, 0.f};
#pragma unroll
            for (int kn = 0; kn < 4; ++kn) { const int cb = (gi * 128 + 32 * kn + 8 * q4) * 2;
                const bf16x8 cf = *(const LAS bf16x8*)(CI + (16 * lt + fr) * 544 + cb);
                const bf16x8 ba = *(const LAS bf16x8*)(BI + (32 * ksp + fr) * 544 + cb); d0a = mfma16(ba, cf, d0a);
                if (hasb) { const bf16x8 bb = *(const LAS bf16x8*)(BI + (32 * ksp + 16 + fr) * 544 + cb); d0b = mfma16(bb, cf, d0b); } }
            const int l = 16 * lt + fr; const float al = acs[l * 8 + h];
            float ga[4], gb[4];
#pragma unroll
            for (int r = 0; r < 4; ++r) { const int sa = 32 * ksp + 4 * q4 + r, sb = sa + 16;
                ga[r] = sa <= l ? d0a[r] * __expf(al - acs[sa * 8 + h]) * dtl[sa * 8 + h] : 0.f;
                gb[r] = (hasb && sb <= l) ? d0b[r] * __expf(al - acs[sb * 8 + h]) * dtl[sb * 8 + h] : 0.f; }
            const bf16x8 xf = pack8(ga[0], ga[1], ga[2], ga[3], gb[0], gb[1], gb[2], gb[3]);
            const int rowA = 32 * ksp + 4 * q4 + (fr >> 2), rowB = rowA + 16;
#pragma unroll
            for (int pt = 0; pt < 4; ++pt) { const int cb = (h * 64 + 16 * pt + 4 * (lane & 3)) * 2;
                acc[lt][pt] = mfma16(xf, cat8(trrd(XI + rowA * 1056 + cb), trrd(XI + rowB * 1056 + cb)), acc[lt][pt]); }
        }
    }
    { const float dsk = A.in[10][L * 8 + h];
#pragma unroll
      for (int lt = 0; lt < 4; ++lt)
#pragma unroll
          for (int pt = 0; pt < 4; ++pt)
#pragma unroll
              for (int r = 0; r < 4; ++r) { const unsigned short xv = *(const LAS unsigned short*)(XI + (16 * lt + 4 * q4 + r) * 1056 + (h * 64 + 16 * pt + fr) * 2);
                  acc[lt][pt][r] += dsk * __uint_as_float((unsigned)xv << 16); } }
    __builtin_amdgcn_sched_barrier(0);
    v4u zr[8];
#pragma unroll
    for (int i = 0; i < 8; ++i) zr[i] = *(const v4u*)(P + (m0 + 8 * w + i) * PN + PC_Z + 8 * lane);
    __syncthreads();
#pragma unroll
    for (int lt = 0; lt < 4; ++lt)
#pragma unroll
        for (int pt = 0; pt < 4; ++pt)
#pragma unroll
            for (int r = 0; r < 4; ++r) *(LAS float*)(Ls + (16 * lt + 4 * q4 + r) * 2112 + (h * 64 + 16 * pt + fr) * 4) = acc[lt][pt][r];
    __syncthreads();
    { const f32x4 g0 = *(const f32x4*)(A.in[11] + L * 512 + 8 * lane), g1 = *(const f32x4*)(A.in[11] + L * 512 + 8 * lane + 4);
#pragma unroll
      for (int i = 0; i < 8; ++i) { const int r = 8 * w + i;
        f32x4 v0 = *(const LAS f32x4*)(Ls + r * 2112 + lane * 32), v1 = *(const LAS f32x4*)(Ls + r * 2112 + lane * 32 + 16);
        const v4u z = zr[i];
        v0 = v0 * (f32x4){silu(bflo(z.x)), silu(bfhi(z.x)), silu(bflo(z.y)), silu(bfhi(z.y))};
        v1 = v1 * (f32x4){silu(bflo(z.z)), silu(bfhi(z.z)), silu(bflo(z.w)), silu(bfhi(z.w))};
        const float ss = wave_sum((v0.x * v0.x + v0.y * v0.y) + (v0.z * v0.z + v0.w * v0.w) + (v1.x * v1.x + v1.y * v1.y) + (v1.z * v1.z + v1.w * v1.w)) * (1.0f / 512.0f);
        const float sc = 1.0f / sqrtf(ss + 1e-6f);
        v0 = v0 * sc * g0; v1 = v1 * sc * g1;
        v4u ov; ov.x = pk2(v0.x, v0.y); ov.y = pk2(v0.z, v0.w); ov.z = pk2(v1.x, v1.y); ov.w = pk2(v1.z, v1.w);
        *(v4u*)(Y + (m0 + r) * D + 8 * lane) = ov; } }
    __syncthreads();
}

#ifndef PROBE_FP8TEST
#define PROBE_FP8TEST 0
#endif
#if PROBE_FP8TEST
typedef int v8i __attribute__((ext_vector_type(8)));
__device__ __forceinline__ int fp8_selftest(int lane) {
    const int ij = lane & 15, g = lane >> 4;
    v8i Af, Bf;
#pragma unroll
    for (int r = 0; r < 8; ++r) { int wa = 0, wb = 0; const int k = 32 * g + 4 * r;
        wa = __builtin_amdgcn_cvt_pk_fp8_f32((float)((7 * ij + 3 * (k + 0)) % 5), (float)((7 * ij + 3 * (k + 1)) % 5), wa, false);
        wa = __builtin_amdgcn_cvt_pk_fp8_f32((float)((7 * ij + 3 * (k + 2)) % 5), (float)((7 * ij + 3 * (k + 3)) % 5), wa, true);
        wb = __builtin_amdgcn_cvt_pk_fp8_f32((float)((5 * (k + 0) + 11 * ij) % 7), (float)((5 * (k + 1) + 11 * ij) % 7), wb, false);
        wb = __builtin_amdgcn_cvt_pk_fp8_f32((float)((5 * (k + 2) + 11 * ij) % 7), (float)((5 * (k + 3) + 11 * ij) % 7), wb, true);
        Af[r] = wa; Bf[r] = wb; }
    f32x4 d = (f32x4){0.f, 0.f, 0.f, 0.f};
    d = __builtin_amdgcn_mfma_scale_f32_16x16x128_f8f6f4(Af, Bf, d, 0, 0, 0, 0, 0, 0);
    int bad = 0;
#pragma unroll
    for (int r = 0; r < 4; ++r) { const int i = 4 * g + r, j = ij; float e = 0.f;
        for (int k = 0; k < 128; ++k) e += (float)(((7 * i + 3 * k) % 5) * ((5 * k + 11 * j) % 7));
        bad += (d[r] != e + (PROBE_FP8TEST == 2 ? 1.f : 0.f)) ? 1 : 0; }
    return bad;
}
#endif
constexpr int NPHASE = 1 + 16 + 7 + 2 * MOE_NCH + 1;
__global__ void __launch_bounds__(NTHR, 2) fwd_kernel(Args kargs) {
    ArgsP ap = (ArgsP)__builtin_amdgcn_kernarg_segment_ptr();
#define args (*ap)
    extern __shared__ __attribute__((aligned(16))) unsigned char lds[];
    Frame F;
    F.lds = (LAS unsigned char*)lds;
    F.tid = threadIdx.x; F.lane = F.tid & 63; F.wave = __builtin_amdgcn_readfirstlane(F.tid >> 6);
    F.G = gridDim.x; { const int bx = blockIdx.x; F.vcu = (F.G % 8 == 0) ? (bx % 8) * (F.G / 8) + bx / 8 : bx; }
    gu32* ctl = (gu32*)(args.ws + WS_CTL);
    for (int u = F.tid; u < (LDS_BYTES - LDSCTL_OFF) / 4; u += NTHR) ((LAS unsigned*)(F.lds + LDSCTL_OFF))[u] = 0u;
    __syncthreads();
    XcdBarrier bar; bar.bar = (unsigned*)(ctl + CW_BAR); bar.x = 0; bar.st = nullptr;
    const int lo = args.ph_lo, hi = args.ph_hi;
    if (hi - lo > 1) bar = xcd_barrier_post((unsigned*)(ctl + CW_BAR), (volatile LAS unsigned*)(F.lds + CTL_MISC) + 8);
#if PROBE_TG >= 0
    unsigned long long t_acc = 0ull, t_ph = 0ull;
#define IN(k) ((lo <= (k) && (k) < hi) && fresh(F) && relaunder(ap) && ((t_ph = __builtin_amdgcn_s_memrealtime()), true))
#define T_STOP(k) do { if (tgroup_of(k) == PROBE_TG) t_acc += __builtin_amdgcn_s_memrealtime() - t_ph; } while (0)
    unsigned long long t_sub = 0ull;
#define T_SUB0() (t_sub = __builtin_amdgcn_s_memrealtime())
#define T_SUB(g) do { const unsigned long long n_ = __builtin_amdgcn_s_memrealtime(); if ((g) == PROBE_TG) t_acc += n_ - t_sub; t_sub = n_; } while (0)
#else
#define T_SUB0() do { } while (0)
#define T_SUB(g) do { } while (0)
#define IN(k) ((lo <= (k) && (k) < hi) && fresh(F) && relaunder(ap))
#define T_STOP(k) do { } while (0)
#endif
#define SEAM(k) do { if ((k) + 1 < hi) { REP(12) xcd_barrier(bar); } T_STOP(k); } while (0)
    unsigned char* ws = args.ws;
    bf16* A1 = (bf16*)(ws + WS_A1); bf16* PROJ = (bf16*)(ws + WS_PROJ); bf16* Yb = (bf16*)(ws + WS_Y); bf16* MIXED = (bf16*)(ws + WS_MIXED);
    const int bid = (int)blockIdx.x;

#ifdef ONLY_UNIT
    { fresh(F); relaunder(ap);
#if ONLY_UNIT == 1
      for (int u = F.vcu; u < NBATCH * NCHUNK; u += F.G) ssd1_unit(F, args, 0, u);
#elif ONLY_UNIT == 2
      for (int u = F.vcu; u < NBATCH * NCHUNK; u += F.G) attn_unit(F, args, 0, u);
#elif ONLY_UNIT == 3
      for (int u = F.vcu; u < M / 128; u += F.G) gmlp_unit(F, args, 0, u);
#elif ONLY_UNIT == 4
      for (int u = F.vcu; u < NBATCH * NCHUNK; u += F.G) ssd3_unit(F, args, 0, u);
#elif ONLY_UNIT == 5
      { RowArgs R{args.out, args.out, 1, MIXED, args.in[2], args.in[3], A1, 2, args.in[23], 8}; row_phase(F, args, R); }
#endif
      return; }
#endif
    if (IN(0)) {
#if PROBE_FP8TEST
        if (blockIdx.x == 0 && F.wave == 0) { const int bad = fp8_selftest(F.lane); if (bad) atomicAdd((unsigned*)(args.ws + WS_CTL) + 2, (unsigned)bad); }
#endif
        REP(10) { cvt_small_weights(F, args);
        __syncthreads(); }
        RowArgs R{args.in[0], nullptr, 0, nullptr, nullptr, args.in[1], A1, 1, args.in[5] + 1536, DIN};
        REP(9) row_phase(F, args, R);
        SEAM(0);
    }
    for (int L = 0; L < 2; ++L) {
        const int pb = 1 + 16 * L;
        if (IN(pb + 0)) {
            pg8::Gemm g{A1, (const bf16*)(ws + WS_WIN) + (size_t)L * PN * D, M, PN, D}; pg8::StaticOrder S; S.init(M, PN, F.G, bid);
            pg8::EpiStore E{PROJ, PN, 1.0f};
            REP(5) pg8::gemm_phase<pg8::EpiStore, pg8::StaticOrder, true, true>(F.lds, g, S, E);
            SEAM(pb + 0);
        }
        if (IN(pb + 1)) {
            T_SUB0();
            REP(0) for (int u = F.vcu; u < NBATCH * NCHUNK; u += F.G) ssd1_unit(F, args, L, u);
            T_SUB(10);
            REP(1) for (int u = F.vcu; u < NBATCH * NCHUNK; u += F.G) attn_unit(F, args, L, u);
            T_SUB(11);
            REP(2) for (int u = F.vcu; u < M / 128; u += F.G) gmlp_unit(F, args, L, u);
            T_SUB(12);
            SEAM(pb + 1);
        }
                if (IN(pb + 2)) { ssd_scan(F, args); SEAM(pb + 2); }
                if (IN(pb + 3)) { REP(3) for (int u = F.vcu; u < NBATCH * NCHUNK; u += F.G) ssd3_unit(F, args, L, u); SEAM(pb + 3); }
        if (IN(pb + 4)) {
            pg8::Gemm g{Yb, (const bf16*)(ws + WS_WOUT) + (size_t)L * D * D, M, D, D}; pg8::StaticOrder S; S.init(M, D, F.G, bid);
            pg8::EpiStore E{MIXED, D, 1.0f};
            REP(5) pg8::gemm_phase<pg8::EpiStore, pg8::StaticOrder, true, true>(F.lds, g, S, E);
            SEAM(pb + 4);
        }
        if (IN(pb + 5)) {
            RowArgs R{L == 0 ? args.in[0] : args.out, args.out, 1, MIXED, args.in[2] + L * D, args.in[3] + L * D, A1, L == 1 ? 2 : 0, args.in[23], 8};
            if (L == 0) { REP(8) row_phase(F, args, R); } else row_phase(F, args, R);
            if (L == 1) REP(4) cvt_moe_weights(F, args);
            SEAM(pb + 5);
        }
        if (L == 0) {
            if (IN(pb + 6)) {
                pg8::Gemm g{A1, (const bf16*)(ws + WS_WGU), M, 2 * DFF, D}; pg8::StaticOrder S; S.init(M, 2 * DFF, F.G, bid);
                pg8::EpiSwiglu E{(bf16*)(ws + WS_H1), DFF};
                REP(6) pg8::gemm_phase<pg8::EpiSwiglu, pg8::StaticOrder, true, true>(F.lds, g, S, E);
                SEAM(pb + 6);
            }
            if (IN(pb + 7)) {
                pg8::Gemm g{(const bf16*)(ws + WS_H1), (const bf16*)(ws + WS_WD), M, D, DFF}; pg8::StaticOrder S; S.init(M, D, F.G, bid);
                pg8::EpiStore E{(bf16*)(ws + WS_FOUT), D, 1.0f};
                REP(6) pg8::gemm_phase<pg8::EpiStore, pg8::StaticOrder, true, true>(F.lds, g, S, E);
                SEAM(pb + 7);
            }
            if (IN(pb + 8)) {
                RowArgs R{args.out, args.out, 1, (const bf16*)(ws + WS_FOUT), args.in[4], args.in[1] + D, A1, 1, args.in[5] + (size_t)D * DIN + 1536, DIN};
                row_phase(F, args, R);
                SEAM(pb + 8);
            }
        } else {
#if PROBE_TG >= 10
#ifdef PROBE_TMIN
            if (lo <= pb + 6 && pb + 6 < hi && threadIdx.x == 0) atomicMax((unsigned*)(args.ws + WS_CTL) + 8, 0xffffffffu - (unsigned)t_acc);
#else
            if (lo <= pb + 6 && pb + 6 < hi && threadIdx.x == 0) atomicMax((unsigned*)(args.ws + WS_CTL) + 8, (unsigned)t_acc);
#endif
#endif
            if (IN(pb + 6)) { REP(11) { moe_tables(F, args); moe_gather(F, args); } SEAM(pb + 6); }
            for (int k = 0; k < MOE_NCH; ++k) {
                if (IN(pb + 7 + 2 * k)) {
                    moe_tables(F, args);
                    const int nT = *(LAS int*)(F.lds + CTL_CNT + 32 * 4); int nk = nT - MOE_CH * k; nk = nk < 0 ? 0 : ((k < MOE_NCH - 1 && nk > MOE_CH) ? MOE_CH : nk);
                    pg8::Gemm g{(const bf16*)(ws + WS_XS), (const bf16*)(ws + WS_MWGU), 0, 0, D / 2};
                    pg8::MoeOrder<false, true> S{MOE_CH * k, nk, 28, F.G, bid, (const LAS int*)(F.lds + CTL_TE)};
                    pg8::EpiSwiglu8 E{ws + WS_HM, DFFE, 1.0f / (FP8_SX * FP8_SW), FP8_SH};
                    REP(7) pg8::gemm_phase<pg8::EpiSwiglu8, pg8::MoeOrder<false, true>, true, true, true>(F.lds, g, S, E);
                    SEAM(pb + 7 + 2 * k);
                }
                if (IN(pb + 8 + 2 * k)) {
                    moe_tables(F, args);
                    const int nT = *(LAS int*)(F.lds + CTL_CNT + 32 * 4); int nk = nT - MOE_CH * k; nk = nk < 0 ? 0 : ((k < MOE_NCH - 1 && nk > MOE_CH) ? MOE_CH : nk);
                    pg8::Gemm g{(const bf16*)(ws + WS_HM), (const bf16*)(ws + WS_MWD), 0, 0, DFFE / 2};
                    pg8::MoeOrder<true, false> S{MOE_CH * k, nk, 4, F.G, bid, (const LAS int*)(F.lds + CTL_TE)};
                    pg8::EpiStore E{(bf16*)(ws + WS_YM), D, 1.0f / (FP8_SH * FP8_SW)};
                    REP(7) pg8::gemm_phase<pg8::EpiStore, pg8::MoeOrder<true, false>, true, true, true>(F.lds, g, S, E);
                    SEAM(pb + 8 + 2 * k);
                }
            }
            if (IN(pb + 7 + 2 * MOE_NCH)) {
                RowArgs R{args.out, args.out, 2, (const bf16*)(ws + WS_YM), args.in[4] + D, nullptr, nullptr, 0, nullptr, 0};
                row_phase(F, args, R);
#if PROBE_FP8TEST
                if (__hip_atomic_load((unsigned*)(args.ws + WS_CTL) + 2, RLX_AGENT) != 0u) { __syncthreads(); for (size_t i = (size_t)blockIdx.x * NTHR + F.tid; i < (size_t)M * D; i += (size_t)F.G * NTHR) args.out[i] += 1.0f; }
#endif
            }
        }
    }
#if PROBE_TG >= 0
    T_STOP(1 + 16 + 7 + 2 * MOE_NCH);
#if PROBE_TG >= 10
#endif
    if (blockIdx.x == 77) { unsigned long long t_spin = t_acc;
#if PROBE_TG >= 10
        t_spin = __hip_atomic_load((unsigned*)(args.ws + WS_CTL) + 8, RLX_AGENT);
#ifdef PROBE_TMIN
        t_spin = 0xffffffffu - (unsigned)t_spin;
#endif
#endif
        const unsigned long long t_end = __builtin_amdgcn_s_memrealtime(); while (__builtin_amdgcn_s_memrealtime() - t_end < t_spin) __builtin_amdgcn_s_sleep(8); }
#endif
#undef IN
#undef SEAM
#undef args
}

extern "C" void kernel_launch(void* const* d_in, const int* in_sizes, int n_in, void* d_out, int out_size, void* d_ws, size_t ws_size, hipStream_t stream) {
    static int grid = 0;
    if (grid == 0) {
        if (n_in != NIN || out_size != M * D || ws_size < WS_END) { fprintf(stderr, "kernel_launch: unexpected shapes (n_in %d, out %d, ws %zu)\n", n_in, out_size, ws_size); grid = -1; return; }
        int dev = 0, cus = 0;
        if (hipGetDevice(&dev) != hipSuccess || hipDeviceGetAttribute(&cus, hipDeviceAttributeMultiprocessorCount, dev) != hipSuccess) { grid = -1; return; }
        if (hipFuncSetAttribute((const void*)fwd_kernel, hipFuncAttributeMaxDynamicSharedMemorySize, LDS_BYTES) != hipSuccess) { fprintf(stderr, "kernel_launch: hipFuncSetAttribute failed\n"); grid = -1; return; }
        int per_cu = 0;
        if (hipOccupancyMaxActiveBlocksPerMultiprocessor(&per_cu, (const void*)fwd_kernel, NTHR, LDS_BYTES) != hipSuccess || per_cu < 1) fprintf(stderr, "kernel_launch: occupancy query says %d\n", per_cu);
        (void)hipGetLastError();
        grid = cus > 256 ? 256 : cus;
    }
    if (grid < 0) return;
    (void)hipMemsetAsync((char*)d_ws + WS_CTL, 0, CTL_ZERO_BYTES, stream);
    Args a{};
    for (int i = 0; i < NIN; ++i) a.in[i] = (const float*)d_in[i];
    a.out = (float*)d_out; a.ws = (unsigned char*)d_ws;
#if MK_SINGLE
    a.ph_lo = 0; a.ph_hi = NPHASE;
    hipLaunchKernelGGL(fwd_kernel, dim3(grid), dim3(NTHR), LDS_BYTES, stream, a);
#else
    for (int ph = 0; ph < NPHASE; ++ph) { if (ph >= 10 && ph < 17) continue; a.ph_lo = ph; a.ph_hi = ph + 1; hipLaunchKernelGGL(fwd_kernel, dim3(grid), dim3(NTHR), LDS_BYTES, stream, a); }
#endif
}
```

```cpp
#include <hip/hip_runtime.h>
#include <cstdio>
#include <cstdint>

#ifndef MK_SINGLE
#define MK_SINGLE 1
#endif

namespace pg8 {
#define PG8_LAS __attribute__((address_space(3)))
typedef unsigned short bf16_t;
typedef short bf16x8 __attribute__((ext_vector_type(8)));
typedef float f32x4 __attribute__((ext_vector_type(4)));
typedef unsigned u32x4 __attribute__((ext_vector_type(4)));
constexpr int BM = 256, BK = 64, HALF = 128, HTB = HALF * BK * 2  , STAGE_BYTES = 8 * HTB, NXCD = 8, WGM = 8;

__host__ __device__ __forceinline__ int lds_byte(int r, int c) { const int st = (r >> 4) * 2 + (c >> 5), rr = r & 15, cc = c & 31, ob = rr * 64 + cc * 2; return st * 1024 + (ob ^ (((ob >> 9) & 1) << 5)); }
__host__ __device__ __forceinline__ void stage_rc(int b, int& R, int& C) { const int st = b / 1024, sb = b % 1024, swz = sb ^ (((sb >> 9) & 1) << 5); R = (st >> 1) * 16 + swz / 64; C = (st & 1) * 32 + (swz % 64) / 2; }
__host__ __device__ __forceinline__ int perm32(int rho) { const int n = rho >> 4, i = rho & 15; return 8 * (i >> 2) + 4 * n + (i & 3); }

struct Unit { int pm, pn, om, on; };
struct Gemm { const bf16_t* A; const bf16_t* Bt; int M, N, K; };

__host__ __device__ __forceinline__ bool tile_order(int i, int G, int c, int nM, int nN, int& pm, int& pn) {
    const int nwg = nM * nN; const long L = (long)i * G + c; if (L >= nwg) return false;
    int wgid = (int)L; { const int q = nwg / NXCD, r = nwg % NXCD, xcd = wgid % NXCD, off = wgid / NXCD; wgid = (xcd < r ? xcd * (q + 1) : r * (q + 1) + (xcd - r) * q) + off; }
    const int nig = WGM * nN, gid = wgid / nig, fm = gid * WGM, gsz = (nM - fm) < WGM ? (nM - fm) : WGM;
    pm = fm + ((wgid % nig) % gsz); pn = (wgid % nig) / gsz; return true;
}
struct StaticOrder {
    int nM, nN, G, c;
    __host__ __device__ void init(int M, int N, int G_, int c_) { nM = M / BM; nN = N / BM; G = G_; c = c_; }
    __host__ __device__ bool next(int i, Unit& u) const { int pm, pn; if (!tile_order(i, G, c, nM, nN, pm, pn)) return false; u.pm = pm; u.pn = pn; u.om = pm; u.on = pn; return true; }
    __device__ __forceinline__ void a_ready(const Unit&) const {}
    __device__ __forceinline__ void done(const Unit&) const {}
};
template <bool A_LOCAL, bool O_LOCAL>
struct MoeOrder {
    int t0, nT, nN, G, c; const PG8_LAS int* te;
    __device__ __forceinline__ bool next(int i, Unit& u) const { int pm, pn; if (!tile_order(i, G, c, nT, nN, pm, pn)) return false;
        const int e = __builtin_amdgcn_readfirstlane(te[t0 + pm]);
        u.pm = A_LOCAL ? pm : t0 + pm; u.pn = e * nN + pn; u.om = O_LOCAL ? pm : t0 + pm; u.on = pn; return true; }
    __device__ __forceinline__ void a_ready(const Unit&) const {}
    __device__ __forceinline__ void done(const Unit&) const {}
};

__device__ __forceinline__ unsigned cvt_pk_bf16(float lo, float hi) { unsigned r; asm volatile("v_cvt_pk_bf16_f32 %0, %1, %2" : "=v"(r) : "v"(lo), "v"(hi)); return r; }

typedef int v8i32 __attribute__((ext_vector_type(8)));
__device__ __forceinline__ v8i32 cat16(bf16x8 lo, bf16x8 hi) { const u32x4 a = __builtin_bit_cast(u32x4, lo), b = __builtin_bit_cast(u32x4, hi); return (v8i32){(int)a.x, (int)a.y, (int)a.z, (int)a.w, (int)b.x, (int)b.y, (int)b.z, (int)b.w}; }
__device__ __forceinline__ float clamp448(float x) { return __builtin_fminf(__builtin_fmaxf(x, -448.0f), 448.0f); }
__device__ __forceinline__ unsigned pack_fp8x4(float a, float b, float c, float d) {
    int r = 0; r = __builtin_amdgcn_cvt_pk_fp8_f32(clamp448(a), clamp448(b), r, false); r = __builtin_amdgcn_cvt_pk_fp8_f32(clamp448(c), clamp448(d), r, true); return (unsigned)r; }
struct EpiStore {
    static constexpr bool PERM = true, AFTER_DRAIN = false;
    bf16_t* O; int ldc; float scale;
    __device__ __forceinline__ void operator()(const f32x4 (&acc)[2][2][4][2], const Unit& u, int wr, int wc, int fr, int fq) const {
        const int row0 = u.om * BM + wr * 64 + fr; const int col0 = u.on * BM + wc * 32 + 8 * fq;
#pragma unroll
        for (int ai = 0; ai < 2; ++ai)
#pragma unroll
            for (int m = 0; m < 4; ++m) { bf16_t* rowp = O + (size_t)(row0 + ai * HALF + m * 16) * ldc + col0;
#pragma unroll
                for (int bj = 0; bj < 2; ++bj) { const f32x4 v0 = acc[ai][bj][m][0] * scale, v1 = acc[ai][bj][m][1] * scale;
                    u32x4 w; w.x = cvt_pk_bf16(v0[0], v0[1]); w.y = cvt_pk_bf16(v0[2], v0[3]); w.z = cvt_pk_bf16(v1[0], v1[1]); w.w = cvt_pk_bf16(v1[2], v1[3]);
                    *(u32x4*)(rowp + bj * HALF) = w; } }
    }
};
__device__ __forceinline__ float silu_f(float x) { return x * __builtin_amdgcn_rcpf(1.0f + __expf(-x)); }
struct EpiSwiglu {
    static constexpr bool PERM = true, AFTER_DRAIN = false;
    bf16_t* O; int ldc;
    __device__ __forceinline__ void operator()(const f32x4 (&acc)[2][2][4][2], const Unit& u, int wr, int wc, int fr, int fq) const {
        const int row0 = u.om * BM + wr * 64 + fr; const int col0 = u.on * HALF + wc * 32 + 8 * fq;
#pragma unroll
        for (int ai = 0; ai < 2; ++ai)
#pragma unroll
            for (int m = 0; m < 4; ++m) { bf16_t* rowp = O + (size_t)(row0 + ai * HALF + m * 16) * ldc + col0;
                const f32x4 g0 = acc[ai][0][m][0], g1 = acc[ai][0][m][1], u0 = acc[ai][1][m][0], u1 = acc[ai][1][m][1];
                u32x4 w;
                w.x = cvt_pk_bf16(silu_f(g0[0]) * u0[0], silu_f(g0[1]) * u0[1]); w.y = cvt_pk_bf16(silu_f(g0[2]) * u0[2], silu_f(g0[3]) * u0[3]);
                w.z = cvt_pk_bf16(silu_f(g1[0]) * u1[0], silu_f(g1[1]) * u1[1]); w.w = cvt_pk_bf16(silu_f(g1[2]) * u1[2], silu_f(g1[3]) * u1[3]);
                *(u32x4*)rowp = w; }
    }
};

struct EpiSwiglu8 {
    static constexpr bool PERM = true, AFTER_DRAIN = false;
    unsigned char* O; int ldc; float in_scale, out_scale;
    __device__ __forceinline__ void operator()(const f32x4 (&acc)[2][2][4][2], const Unit& u, int wr, int wc, int fr, int fq) const {
        const int row0 = u.om * BM + wr * 64 + fr; const int col0 = u.on * HALF + wc * 32 + 8 * fq;
#pragma unroll
        for (int ai = 0; ai < 2; ++ai)
#pragma unroll
            for (int m = 0; m < 4; ++m) { unsigned char* rowp = O + (size_t)(row0 + ai * HALF + m * 16) * ldc + col0;
                const f32x4 g0 = acc[ai][0][m][0] * in_scale, g1 = acc[ai][0][m][1] * in_scale, u0 = acc[ai][1][m][0] * (in_scale * out_scale), u1 = acc[ai][1][m][1] * (in_scale * out_scale);
                typedef unsigned u32x2 __attribute__((ext_vector_type(2)));
                u32x2 w;
                w.x = pack_fp8x4(silu_f(g0[0]) * u0[0], silu_f(g0[1]) * u0[1], silu_f(g0[2]) * u0[2], silu_f(g0[3]) * u0[3]);
                w.y = pack_fp8x4(silu_f(g1[0]) * u1[0], silu_f(g1[1]) * u1[1], silu_f(g1[2]) * u1[2], silu_f(g1[3]) * u1[3]);
                *(u32x2*)rowp = w; }
    }
};

template <class Epi, class Sched, bool ALIGN_EPI = false, bool SP2 = false, bool FP8 = false>
__device__ __forceinline__ void gemm_phase(PG8_LAS unsigned char* lds, const Gemm g, const Sched& S, const Epi& E) {
    int tid_ = threadIdx.x; asm volatile("" : "+v"(tid_));
    const int tid = tid_, wid = __builtin_amdgcn_readfirstlane(tid >> 6), lane = tid & 63, wr = wid >> 2, wc = wid & 3, fr = lane & 15, fq = lane >> 4;
    int K_ = g.K; asm volatile("" : "+s"(K_));
    const int K = K_, nt = K / BK;
    unsigned voffA[2], voffB[2];
#pragma unroll
    for (int i = 0; i < 2; ++i) { int R, C; stage_rc(tid * 16 + i * 8192, R, C); const int Rb = Epi::PERM ? ((R & ~31) + perm32(R & 31)) : R;
        voffA[i] = (unsigned)(R * K + C) * 2u; voffB[i] = (unsigned)(Rb * K + C) * 2u; }
    const size_t kstep = (size_t)(BK * 2);
    const size_t hstep = (size_t)HALF * K * 2;
    const size_t tstep = 2 * hstep;
    const unsigned ldsw = (unsigned)wid * 1024u;
    const int aoff = lds_byte(wr * 64 + fr, fq * 8), boff = lds_byte(wc * 32 + fr, fq * 8);
#define PG8_SA(b, h) (((b) * 2 + (h)) * HTB)
#define PG8_SB(b, h) ((4 + (b) * 2 + (h)) * HTB)
#define PG8_STAGE(bufoff, gbase, voff) do { _Pragma("unroll") for (int _i = 0; _i < 2; ++_i) \
        __builtin_amdgcn_global_load_lds((const unsigned*)((const char*)(gbase) + (voff)[_i]), (PG8_LAS unsigned*)(lds + (bufoff) + ldsw + _i * 8192), 16, 0, 0); } while (0)
#define PG8_LDA(dst, dst8, b, h) do { _Pragma("unroll") for (int m = 0; m < 4; ++m) { \
        if constexpr (FP8) dst8[m] = cat16(*(const PG8_LAS bf16x8*)(lds + PG8_SA(b, h) + aoff + m * 2048), *(const PG8_LAS bf16x8*)(lds + PG8_SA(b, h) + aoff + m * 2048 + 1024)); \
        else { _Pragma("unroll") for (int k = 0; k < 2; ++k) dst[m][k] = *(const PG8_LAS bf16x8*)(lds + PG8_SA(b, h) + aoff + m * 2048 + k * 1024); } } } while (0)
#define PG8_LDB(dst, dst8, b, h) do { _Pragma("unroll") for (int n = 0; n < 2; ++n) { \
        if constexpr (FP8) dst8[n] = cat16(*(const PG8_LAS bf16x8*)(lds + PG8_SB(b, h) + boff + n * 2048), *(const PG8_LAS bf16x8*)(lds + PG8_SB(b, h) + boff + n * 2048 + 1024)); \
        else { _Pragma("unroll") for (int k = 0; k < 2; ++k) dst[n][k] = *(const PG8_LAS bf16x8*)(lds + PG8_SB(b, h) + boff + n * 2048 + k * 1024); } } } while (0)
#define PG8_MMA(ai, bj, At, At8, Bt, Bt8) do { __builtin_amdgcn_s_setprio(1); _Pragma("unroll") for (int m = 0; m < 4; ++m) _Pragma("unroll") for (int n = 0; n < 2; ++n) { \
        if constexpr (FP8) { asm volatile("v_mfma_f32_16x16x128_f8f6f4 %0, %1, %2, %0" : "+v"(acc[ai][bj][m][n]) : "v"(Bt8[n]), "v"(At8[m])); } \
        else { _Pragma("unroll") for (int k = 0; k < 2; ++k) acc[ai][bj][m][n] = __builtin_amdgcn_mfma_f32_16x16x32_bf16(Bt[n][k], At[m][k], acc[ai][bj][m][n], 0, 0, 0); } } __builtin_amdgcn_s_setprio(0); } while (0)
#define PG8_WAIT_V(n) asm volatile("s_waitcnt vmcnt(" #n ")" ::: "memory")
#define PG8_WAIT_L(n) asm volatile("s_waitcnt lgkmcnt(" #n ")" ::: "memory")
#define PG8_BAR __builtin_amdgcn_s_barrier()
#define PG8_SCHED __builtin_amdgcn_sched_barrier(0)
    Unit cur, nxt; int ui = 0;
    if (!S.next(0, cur)) return;
    f32x4 acc[2][2][4][2];
#pragma unroll
    for (int a = 0; a < 2; ++a)
#pragma unroll
        for (int b = 0; b < 2; ++b)
#pragma unroll
            for (int m = 0; m < 4; ++m)
#pragma unroll
                for (int n = 0; n < 2; ++n) acc[a][b][m][n] = (f32x4){0.f, 0.f, 0.f, 0.f};
    bf16x8 At[4][2], B0[2][2], B1[2][2]; v8i32 At8[4], B08[2], B18[2];
    const char* cA = (const char*)g.A + (size_t)cur.pm * tstep; const char* cB = (const char*)g.Bt + (size_t)cur.pn * tstep;
    S.a_ready(cur);
    if constexpr (SP2) {
        PG8_STAGE(PG8_SB(0, 0), cB, voffB); PG8_STAGE(PG8_SB(0, 1), cB + hstep, voffB); PG8_STAGE(PG8_SA(0, 0), cA, voffA); PG8_STAGE(PG8_SA(0, 1), cA + hstep, voffA);
        if (wr == 1) PG8_BAR;
        PG8_WAIT_V(2); PG8_BAR;
        PG8_STAGE(PG8_SB(1, 0), cB + kstep, voffB); PG8_STAGE(PG8_SA(1, 0), cA + kstep, voffA); PG8_STAGE(PG8_SB(1, 1), cB + hstep + kstep, voffB);
        PG8_WAIT_V(6); PG8_BAR;
    } else {
        PG8_STAGE(PG8_SB(0, 0), cB, voffB); PG8_STAGE(PG8_SA(0, 0), cA, voffA); PG8_STAGE(PG8_SB(0, 1), cB + hstep, voffB); PG8_STAGE(PG8_SA(0, 1), cA + hstep, voffA);
        if (wr == 1) PG8_BAR;
        PG8_WAIT_V(4); PG8_BAR;
        PG8_STAGE(PG8_SB(1, 0), cB + kstep, voffB); PG8_STAGE(PG8_SA(1, 0), cA + kstep, voffA); PG8_STAGE(PG8_SB(1, 1), cB + hstep + kstep, voffB);
        PG8_WAIT_V(6); PG8_BAR;
    }
    for (;;) {
        const bool has_next = S.next(ui + 1, nxt);
        const char* nA = has_next ? (const char*)g.A + (size_t)nxt.pm * tstep : cA; const char* nB = has_next ? (const char*)g.Bt + (size_t)nxt.pn * tstep : cB;
#pragma unroll 1
        for (int t = 0; t < nt; t += 2) {
            const bool last = (t == nt - 2);
            const char* a1 = cA + (size_t)(t + 1) * kstep;
            const char* a2 = last ? nA : cA + (size_t)(t + 2) * kstep; const char* b2 = last ? nB : cB + (size_t)(t + 2) * kstep;
            const char* a3 = a2 + kstep; const char* b3 = b2 + kstep;
            if (last && has_next) S.a_ready(nxt);
            if constexpr (SP2) {
            PG8_LDB(B0, B08, 0, 0); PG8_LDB(B1, B18, 0, 1); PG8_SCHED; PG8_LDA(At, At8, 0, 0); PG8_STAGE(PG8_SA(1, 1), a1 + hstep, voffA);
            PG8_WAIT_V(8); PG8_WAIT_L(0); PG8_BAR; PG8_MMA(0, 0, At, At8, B0, B08); PG8_MMA(0, 1, At, At8, B1, B18); PG8_BAR; PG8_SCHED;
            PG8_LDA(At, At8, 0, 1); PG8_STAGE(PG8_SB(0, 0), b2, voffB); PG8_STAGE(PG8_SB(0, 1), b2 + hstep, voffB); PG8_STAGE(PG8_SA(0, 0), a2, voffA);
            PG8_WAIT_V(8); PG8_WAIT_L(0); PG8_BAR; PG8_MMA(1, 0, At, At8, B0, B08); PG8_MMA(1, 1, At, At8, B1, B18); PG8_BAR; PG8_SCHED;
            PG8_LDB(B0, B08, 1, 0); PG8_LDB(B1, B18, 1, 1); PG8_SCHED; PG8_LDA(At, At8, 1, 0); PG8_STAGE(PG8_SA(0, 1), a2 + hstep, voffA);
            PG8_WAIT_V(8); PG8_WAIT_L(0); PG8_BAR; PG8_MMA(0, 0, At, At8, B0, B08); PG8_MMA(0, 1, At, At8, B1, B18); PG8_BAR; PG8_SCHED;
            PG8_LDA(At, At8, 1, 1); PG8_STAGE(PG8_SB(1, 0), b3, voffB); PG8_STAGE(PG8_SB(1, 1), b3 + hstep, voffB); PG8_STAGE(PG8_SA(1, 0), a3, voffA);
            PG8_WAIT_V(8); PG8_WAIT_L(0); PG8_BAR; PG8_MMA(1, 0, At, At8, B0, B08); PG8_MMA(1, 1, At, At8, B1, B18); PG8_BAR; PG8_SCHED;
            } else {
            PG8_LDB(B0, B08, 0, 0); PG8_SCHED; PG8_LDA(At, At8, 0, 0); PG8_STAGE(PG8_SA(1, 1), a1 + hstep, voffA);
            PG8_WAIT_L(8); PG8_BAR; PG8_WAIT_L(0); PG8_MMA(0, 0, At, At8, B0, B08); PG8_BAR; PG8_SCHED;
            PG8_LDB(B1, B18, 0, 1); PG8_STAGE(PG8_SB(0, 0), b2, voffB);
            PG8_BAR; PG8_WAIT_L(0); PG8_MMA(0, 1, At, At8, B1, B18); PG8_BAR;
            PG8_LDA(At, At8, 0, 1); PG8_STAGE(PG8_SA(0, 0), a2, voffA);
            PG8_BAR; PG8_WAIT_L(0); PG8_MMA(1, 0, At, At8, B0, B08); PG8_BAR; PG8_SCHED;
            PG8_STAGE(PG8_SB(0, 1), b2 + hstep, voffB);
            PG8_WAIT_V(6); PG8_BAR; PG8_MMA(1, 1, At, At8, B1, B18); PG8_BAR;
            PG8_LDB(B0, B08, 1, 0); PG8_SCHED; PG8_LDA(At, At8, 1, 0); PG8_STAGE(PG8_SA(0, 1), a2 + hstep, voffA);
            PG8_WAIT_L(8); PG8_BAR; PG8_WAIT_L(0); PG8_MMA(0, 0, At, At8, B0, B08); PG8_BAR; PG8_SCHED;
            PG8_LDB(B1, B18, 1, 1); PG8_STAGE(PG8_SB(1, 0), b3, voffB);
            PG8_BAR; PG8_WAIT_L(0); PG8_MMA(0, 1, At, At8, B1, B18); PG8_BAR;
            PG8_LDA(At, At8, 1, 1); PG8_STAGE(PG8_SA(1, 0), a3, voffA);
            PG8_BAR; PG8_WAIT_L(0); PG8_MMA(1, 0, At, At8, B0, B08); PG8_BAR; PG8_SCHED;
            PG8_STAGE(PG8_SB(1, 1), b3 + hstep, voffB);
            PG8_WAIT_V(6); PG8_BAR; PG8_MMA(1, 1, At, At8, B1, B18); PG8_BAR;
            }
        }
        if constexpr (FP8) asm volatile("s_nop 15\n\ts_nop 15" ::: "memory");
        if constexpr (ALIGN_EPI) { if (wr == 0) PG8_BAR; }
        if constexpr (!Epi::AFTER_DRAIN) { E(acc, cur, wr, wc, fr, fq); S.done(cur); }
        if (!has_next) break;
#pragma unroll
        for (int a = 0; a < 2; ++a)
#pragma unroll
            for (int b = 0; b < 2; ++b)
#pragma unroll
                for (int m = 0; m < 4; ++m)
#pragma unroll
                    for (int n = 0; n < 2; ++n) acc[a][b][m][n] = (f32x4){0.f, 0.f, 0.f, 0.f};
        cur = nxt; cA = nA; cB = nB; ++ui;
        if constexpr (ALIGN_EPI) { if (wr == 1) PG8_BAR; }
    }
    PG8_WAIT_V(0);
    if constexpr (!ALIGN_EPI) { if (wr == 0) PG8_BAR; }
    PG8_BAR;
    if constexpr (Epi::AFTER_DRAIN) { E.fused(acc, cur, wr, wc, fr, fq, lds, wid, lane); S.done(cur); }
#undef PG8_SA
#undef PG8_SB
#undef PG8_STAGE
#undef PG8_LDA
#undef PG8_LDB
#undef PG8_MMA
#undef PG8_WAIT_V
#undef PG8_WAIT_L
#undef PG8_BAR
#undef PG8_SCHED
}
}

#define GAS __attribute__((address_space(1)))
#define LAS __attribute__((address_space(3)))
typedef unsigned short bf16;
typedef unsigned v4u __attribute__((ext_vector_type(4)));
typedef unsigned v2u __attribute__((ext_vector_type(2)));
typedef float f32x4 __attribute__((ext_vector_type(4)));
typedef float f32x2 __attribute__((ext_vector_type(2)));
typedef short bf16x8 __attribute__((ext_vector_type(8)));
typedef short v4i16 __attribute__((ext_vector_type(4)));
typedef GAS unsigned gu32;
#define RLX_AGENT __ATOMIC_RELAXED, __HIP_MEMORY_SCOPE_AGENT
#define LDS_WAIT() asm volatile("s_waitcnt lgkmcnt(0)" ::: "memory")
#define VM_WAIT() asm volatile("s_waitcnt vmcnt(0)" ::: "memory")
__device__ __forceinline__ unsigned pk2(float lo, float hi) { return pg8::cvt_pk_bf16(lo, hi); }
__device__ __forceinline__ float bflo(unsigned u) { return __uint_as_float(u << 16); }
__device__ __forceinline__ float bfhi(unsigned u) { return __uint_as_float(u & 0xffff0000u); }
__device__ __forceinline__ float wave_sum(float v) {
#pragma unroll
    for (int o = 1; o < 64; o <<= 1) v += __shfl_xor(v, o);
    return v;
}
__device__ __forceinline__ f32x4 mfma16(bf16x8 a, bf16x8 b, f32x4 c) { return __builtin_amdgcn_mfma_f32_16x16x32_bf16(a, b, c, 0, 0, 0); }
__device__ __forceinline__ v4i16 trrd(LAS unsigned char* p) { return __builtin_amdgcn_ds_read_tr16_b64_v4i16((LAS v4i16*)p); }
__device__ __forceinline__ bf16x8 cat8(v4i16 lo, v4i16 hi) { return (bf16x8){lo[0], lo[1], lo[2], lo[3], hi[0], hi[1], hi[2], hi[3]}; }
__device__ __forceinline__ bf16x8 pack8(float a0, float a1, float a2, float a3, float a4, float a5, float a6, float a7) {
    v4u w; w.x = pk2(a0, a1); w.y = pk2(a2, a3); w.z = pk2(a4, a5); w.w = pk2(a6, a7); return __builtin_bit_cast(bf16x8, w); }
__device__ __forceinline__ float silu(float x) { return x * __builtin_amdgcn_rcpf(1.0f + __expf(-x)); }

#define XB_TMO      128
#define XB_XCNT(j)  (256  + 64 * (j))
#define XB_XSUB(j)  (1280 + 64 * (j))
#define XB_XGEN(j)  (2304 + 64 * (j))
#define XB_TOP      3328
#define XB_TOPGEN   3392
#define XCD_BAR_WORDS 3456
#define XB_SPIN_CAP (1u << 18)

__device__ __forceinline__ unsigned xb_ld(unsigned* p)              { return __hip_atomic_load(p, __ATOMIC_RELAXED, __HIP_MEMORY_SCOPE_AGENT); }
__device__ __forceinline__ unsigned xb_add(unsigned* p, unsigned v) { return __hip_atomic_fetch_add(p, v, __ATOMIC_RELAXED, __HIP_MEMORY_SCOPE_AGENT); }
__device__ __forceinline__ unsigned xb_xcc_id() { return (unsigned)__builtin_amdgcn_s_getreg((3 << 11) | 20) & 0xFu; }
#define XB_SPIN(cond, bar) do { unsigned _sp = 0; while (cond) { __builtin_amdgcn_s_sleep(1); \
    if ((++_sp & 255u) == 0u) { if (xb_ld(&(bar)[XB_TMO])) break; if (_sp > XB_SPIN_CAP) { atomicAdd(&(bar)[XB_TMO], 1u); break; } } } } while (0)

struct XcdBarrier {
    unsigned* bar; unsigned x;
    volatile LAS unsigned* st;
};

__device__ __forceinline__ XcdBarrier xcd_barrier_post(unsigned* bar, volatile LAS unsigned* st) {
    XcdBarrier b; b.bar = bar; b.x = xb_xcc_id(); b.st = st;
    if (threadIdx.x == 0) (void)xb_add(&bar[XB_XCNT(b.x)], 1u);
    return b;
}
__device__ __forceinline__ void xcd_barrier_complete(unsigned* bar, unsigned x, unsigned& nloc, unsigned& nx) {
    const unsigned G = gridDim.x * gridDim.y * gridDim.z;
    unsigned sum, cnt, mine, sp = 0u;
    for (;;) {
        sum = 0u; cnt = 0u; mine = 0u;
#pragma unroll
        for (unsigned j = 0; j < 16; ++j) { const unsigned c = xb_ld(&bar[XB_XCNT(j)]); sum += c; cnt += (c > 0u) ? 1u : 0u; mine = (j == x) ? c : mine; }
        if (sum == G) break;
        __builtin_amdgcn_s_sleep(1);
        if ((++sp & 255u) == 0u) { if (xb_ld(&bar[XB_TMO])) break; if (sp > XB_SPIN_CAP) { atomicAdd(&bar[XB_TMO], 1u); break; } }
    }
    nloc = mine > 0u ? mine : 1u; nx = cnt > 0u ? cnt : 1u;
}

__device__ __forceinline__ void xcd_barrier(const XcdBarrier& b) {
    asm volatile("s_waitcnt vmcnt(0)" ::: "memory");
    __syncthreads();
    if (threadIdx.x == 0) {
        unsigned* bar = b.bar;
        __builtin_amdgcn_s_waitcnt(0);
        unsigned nloc = b.st[0], nx = b.st[1];
        if (nloc == 0u) { xcd_barrier_complete(bar, b.x, nloc, nx); b.st[0] = nloc; b.st[1] = nx; }
        const unsigned old = xb_add(&bar[XB_XSUB(b.x)], 1u);
        const unsigned gen = old / nloc;
        if (old + 1u == (gen + 1u) * nloc) {
            __builtin_amdgcn_fence(__ATOMIC_RELEASE, "agent");
            asm volatile("s_waitcnt vmcnt(0)" ::: "memory");
            const unsigned og = xb_add(&bar[XB_TOP], 1u);
            const unsigned tg = og / nx;
            if (og + 1u == (tg + 1u) * nx) xb_add(&bar[XB_TOPGEN], 1u);
            else XB_SPIN(xb_ld(&bar[XB_TOPGEN]) == tg, bar);
            __builtin_amdgcn_fence(__ATOMIC_ACQUIRE, "agent");
            xb_add(&bar[XB_XGEN(b.x)], 1u);
            asm volatile("s_waitcnt vmcnt(0)" ::: "memory");
        } else {
            XB_SPIN(xb_ld(&bar[XB_XGEN(b.x)]) == gen, bar);
            __builtin_amdgcn_fence(__ATOMIC_ACQUIRE, "agent");
            asm volatile("s_waitcnt vmcnt(0)" ::: "memory");
        }
    }
    __syncthreads();
}

constexpr int NWAVES = 8, NTHR = 512;
constexpr int D = 1024, SEQ = 8192, NBATCH = 4, M = NBATCH * SEQ, NCHUNK = SEQ / 64;
constexpr int DIN = 2824, PN = 2816;
constexpr int PC_Z = 0, PC_XBC = 512, PC_U = 1536, PC_V = 1792, PC_Q = 2048, PC_K = 2304, PC_VV = 2560;
constexpr int DFF = 2816, DFFE = 3584, NEXP = 8;
constexpr int MOE_CH = 128, MOE_NCH = 2, MOE_MAXT = 264;
constexpr int NIN = 27;
constexpr int CVT_SMALL_TASKS = 1408 + 512 + 1408 + 704, MOE_CVT_TASKS = 14336 + 7168, MOE_CVT_EARLY = 4096;
constexpr size_t MiB = 1u << 20;
constexpr size_t WS_CTL = 0, CTL_ZERO_BYTES = 65536;
constexpr size_t WS_AEND = 65536, WS_WGCNT = 98304;
constexpr size_t WS_DTRAW = 1 * MiB, WS_TOKE = 2 * MiB, WS_TOKG = 2 * MiB + 262144, WS_POS = 2 * MiB + 524288;
constexpr size_t WS_WIN = 4 * MiB, WS_WOUT = 15 * MiB, WS_WGU = 19 * MiB, WS_WD = 30 * MiB;
constexpr size_t WS_A1 = 36 * MiB, WS_XBCC = 36 * MiB;
constexpr size_t WS_PROJ = 100 * MiB, WS_MIXED = 100 * MiB, WS_H1 = 100 * MiB;
constexpr size_t WS_ST = 276 * MiB, WS_FOUT = 276 * MiB;
constexpr size_t WS_Y = 340 * MiB;
constexpr size_t WS_HB = 404 * MiB;
constexpr size_t WS_HM = 36 * MiB, WS_XS = 155 * MiB, WS_YM = 221 * MiB, WS_MWD = 353 * MiB, WS_MWGU = 468 * MiB, WS_END = 524 * MiB;
constexpr float FP8_SX = 8.0f, FP8_SW = 64.0f, FP8_SH = 16.0f;
constexpr int CW_BAR = 4096, CW_TQ = 8192;
constexpr int LDS_BYTES = 163840, LDSCTL_OFF = 147456;
constexpr int CTL_MISC = LDSCTL_OFF, CTL_CNT = LDSCTL_OFF + 128, CTL_TE = LDSCTL_OFF + 512;

#ifndef PROBE_DUP
#define PROBE_DUP 0
#endif
#ifndef PROBE_TG
#define PROBE_TG -1
#endif
__device__ __forceinline__ int tgroup_of(int k) {
    if (k == 0) return 0;
    const int L = (k - 1) >> 4, r = (k - 1) & 15;
    if (r == 0 || r == 4) return 1;
    if (r == 1) return 2;
    if (r == 2) return 3;
    if (r == 3) return 4;
    if (r == 5) return L == 0 ? 5 : 9;
    if (L == 0) return r == 8 ? 5 : 6;
    if (r == 6) return 7;
    if (r == 7 + 2 * 2) return 5;
    return 8;
}
#define REP(n) for (int rep_ = 0; rep_ < (((PROBE_DUP >> (n)) & 1) ? 2 : 1); ++rep_)
struct Args { const float* in[NIN]; float* out; unsigned char* ws; int ph_lo, ph_hi; };

typedef const __attribute__((address_space(4))) Args* ArgsP;
typedef const __attribute__((address_space(4))) Args& ArgsRef;
struct Frame {
    LAS unsigned char* lds;
    int tid, lane, wave, vcu, G;
};
__device__ __forceinline__ bool relaunder(ArgsP& p) { asm volatile("" : "+s"(p)); return true; }
__device__ __forceinline__ bool fresh(Frame& F) { int t_ = threadIdx.x; asm volatile("" : "+v"(t_)); F.tid = t_; F.lane = t_ & 63; F.wave = __builtin_amdgcn_readfirstlane(t_ >> 6); return true; }

__device__ __forceinline__ void cvt_task(const float* W, int N, int k0, int n0, bf16* WT, int K, int row0, int lane) {
    const float* s = W + (size_t)k0 * N + n0 + lane;
    bf16* d = WT + (size_t)(row0 + lane) * K + k0;
    float v[64];
#pragma unroll
    for (int j = 0; j < 64; ++j) v[j] = __builtin_nontemporal_load(s + (size_t)j * N);
#pragma unroll
    for (int q = 0; q < 8; ++q) { v4u o; o.x = pk2(v[8 * q], v[8 * q + 1]); o.y = pk2(v[8 * q + 2], v[8 * q + 3]); o.z = pk2(v[8 * q + 4], v[8 * q + 5]); o.w = pk2(v[8 * q + 6], v[8 * q + 7]);
        *(GAS v4u*)(d + 8 * q) = o; }
}
__device__ __forceinline__ void cvt_small_weights(Frame& F, ArgsRef A, int t_lo, int t_hi, int gw, int NGW) {
    bf16* WIN = (bf16*)(A.ws + WS_WIN); bf16* WOUT = (bf16*)(A.ws + WS_WOUT); bf16* WGU = (bf16*)(A.ws + WS_WGU); bf16* WD = (bf16*)(A.ws + WS_WD);
    for (int it = t_lo + gw; it < t_hi; it += NGW) {
        int r = it;
        if (r < 1408) { const int L = r / 704; r %= 704; const int kb = r / 44, nb = r % 44; const int ns = 64 * nb + (64 * nb >= 1536 ? 8 : 0);
            cvt_task(A.in[5] + (size_t)L * D * DIN, DIN, 64 * kb, ns, WIN + (size_t)L * PN * D, D, 64 * nb, F.lane); continue; }
        r -= 1408;
        if (r < 512) { const int L = r / 256; r %= 256; const int kb = r / 16, nb = r % 16;
            cvt_task(A.in[19] + (size_t)L * D * D, D, 64 * kb, 64 * nb, WOUT + (size_t)L * D * D, D, 64 * nb, F.lane); continue; }
        r -= 512;
        if (r < 1408) { const int up = r / 704; r %= 704; const int kb = r / 44, nb = r % 44;
            cvt_task(up ? A.in[21] : A.in[20], DFF, 64 * kb, 64 * nb, WGU, D, 256 * (nb >> 1) + 64 * (nb & 1) + 128 * up, F.lane); continue; }
        r -= 1408;
        { const int kb = r / 16, nb = r % 16; cvt_task(A.in[22], D, 64 * kb, 64 * nb, WD, DFF, 64 * nb, F.lane); }
    }
}
__device__ __forceinline__ void cvt_task8(const float* W, int N, int k0, int n0, unsigned char* WT, int K, int row0, float scale, int lane) {
    const float* s = W + (size_t)k0 * N + n0 + lane;
    unsigned char* d = WT + (size_t)(row0 + lane) * K + k0;
    float v[64];
#pragma unroll
    for (int j = 0; j < 64; ++j) v[j] = __builtin_nontemporal_load(s + (size_t)j * N);
#pragma unroll
    for (int q = 0; q < 4; ++q) { v4u o;
        o.x = pg8::pack_fp8x4(v[16 * q] * scale, v[16 * q + 1] * scale, v[16 * q + 2] * scale, v[16 * q + 3] * scale); o.y = pg8::pack_fp8x4(v[16 * q + 4] * scale, v[16 * q + 5] * scale, v[16 * q + 6] * scale, v[16 * q + 7] * scale);
        o.z = pg8::pack_fp8x4(v[16 * q + 8] * scale, v[16 * q + 9] * scale, v[16 * q + 10] * scale, v[16 * q + 11] * scale); o.w = pg8::pack_fp8x4(v[16 * q + 12] * scale, v[16 * q + 13] * scale, v[16 * q + 14] * scale, v[16 * q + 15] * scale);
        *(GAS v4u*)(d + 16 * q) = o; }
}
__device__ __forceinline__ void cvt_moe_weights(Frame& F, ArgsRef A, int t_lo, int t_hi, int gw, int NGW) {
    unsigned char* MWGU = A.ws + WS_MWGU; unsigned char* MWD = A.ws + WS_MWD;
    for (int it = t_lo + gw; it < t_hi; it += NGW) {
        int r = it;
        if (r < 14336) { const int ue = r / 896; r %= 896; const int up = ue >> 3, e = ue & 7; const int kb = r / 56, nb = r % 56;
            cvt_task8((up ? A.in[25] : A.in[24]) + (size_t)e * D * DFFE, DFFE, 64 * kb, 64 * nb, MWGU + (size_t)e * 7168 * D, D, 256 * (nb >> 1) + 64 * (nb & 1) + 128 * up, FP8_SW, F.lane); continue; }
        r -= 14336;
        { const int e = r / 896; r %= 896; const int kb = r / 16, nb = r % 16;
          cvt_task8(A.in[26] + (size_t)e * DFFE * D, D, 64 * kb, 64 * nb, MWD + (size_t)e * D * DFFE, DFFE, 64 * nb, FP8_SW, F.lane); }
    }
}

struct RowArgs {
    const float* hsrc; float* hdst;
    const bf16* hsrc16; bf16* hdst16;
    int branch;
    const bf16* ybuf; const float* gpost;
    const float* gpre; bf16* a1;
    int proj;
    const float* w8; int w8ld;
};
__device__ __forceinline__ void row_phase(Frame& F, ArgsRef A, const RowArgs& R) {
    LAS float* W8T = (LAS float*)F.lds;
    LAS int* cnt = (LAS int*)(F.lds + CTL_CNT);
    const int lane = F.lane;
    if (R.proj) { for (int idx = F.tid; idx < 8192; idx += NTHR) { const int e = idx & 7, k = idx >> 3; W8T[e * 1024 + k] = R.w8[(size_t)k * R.w8ld + e]; } }
    if (R.proj == 2 && F.tid < 8) cnt[F.tid] = 0;
    __syncthreads();
    f32x4 gpo[4], gpr[4];
#pragma unroll
    for (int j = 0; j < 4; ++j) { gpo[j] = R.branch ? *(const f32x4*)(R.gpost + 4 * lane + 256 * j) : (f32x4){0.f, 0.f, 0.f, 0.f}; gpr[j] = R.gpre ? *(const f32x4*)(R.gpre + 4 * lane + 256 * j) : (f32x4){0.f, 0.f, 0.f, 0.f}; }
    float* DTRAW = (float*)(A.ws + WS_DTRAW); int* TOKE = (int*)(A.ws + WS_TOKE); float* TOKG = (float*)(A.ws + WS_TOKG); const int* POS = (const int*)(A.ws + WS_POS);
    const int gw = F.vcu * NWAVES + F.wave, NGW = F.G * NWAVES;
    f32x4 vn[2][4]; v2u yn0[2][4], yn1[2][4]; int pn0[2] = {0, 0}, pn1[2] = {0, 0}; float gn0[2] = {0.f, 0.f}, gn1[2] = {0.f, 0.f}, gc0[2] = {0.f, 0.f}, gc1[2] = {0.f, 0.f};
#define ROW_LOAD_IDX(mb) do { if (R.branch == 2) { _Pragma("unroll") for (int q = 0; q < 2; ++q) { const int mm = (mb) + q * NGW; if (mm < M) { pn0[q] = POS[2 * mm]; pn1[q] = POS[2 * mm + 1]; gn0[q] = TOKG[2 * mm]; gn1[q] = TOKG[2 * mm + 1]; } } } } while (0)
#define ROW_LOAD(mb) do { _Pragma("unroll") for (int q = 0; q < 2; ++q) { const int mm = (mb) + q * NGW; if (mm < M) { \
        if (R.hsrc) { _Pragma("unroll") for (int j = 0; j < 4; ++j) vn[q][j] = *(const f32x4*)(R.hsrc + (size_t)mm * D + 4 * lane + 256 * j); } \
        else { _Pragma("unroll") for (int j = 0; j < 4; ++j) { const v2u hr_ = *(const v2u*)(R.hsrc16 + (size_t)mm * D + 4 * lane + 256 * j); vn[q][j] = (f32x4){bflo(hr_.x), bfhi(hr_.x), bflo(hr_.y), bfhi(hr_.y)}; } } \
        if (R.branch == 1) { _Pragma("unroll") for (int j = 0; j < 4; ++j) yn0[q][j] = *(const v2u*)(R.ybuf + (size_t)mm * D + 4 * lane + 256 * j); } \
        if (R.branch == 2) { gc0[q] = gn0[q]; gc1[q] = gn1[q]; _Pragma("unroll") for (int j = 0; j < 4; ++j) { yn0[q][j] = *(const v2u*)(R.ybuf + (size_t)pn0[q] * D + 4 * lane + 256 * j); yn1[q][j] = *(const v2u*)(R.ybuf + (size_t)pn1[q] * D + 4 * lane + 256 * j); } } } } } while (0)
    ROW_LOAD_IDX(gw); ROW_LOAD(gw); ROW_LOAD_IDX(gw + 2 * NGW);
    for (int mb = gw; mb < M; mb += 2 * NGW) {
        f32x4 v[2][4], y[2][4];
#pragma unroll
        for (int q = 0; q < 2; ++q) {
#pragma unroll
            for (int j = 0; j < 4; ++j) v[q][j] = vn[q][j];
            if (R.branch == 1) {
#pragma unroll
                for (int j = 0; j < 4; ++j) y[q][j] = (f32x4){bflo(yn0[q][j].x), bfhi(yn0[q][j].x), bflo(yn0[q][j].y), bfhi(yn0[q][j].y)};
            } else if (R.branch == 2) {
#pragma unroll
                for (int j = 0; j < 4; ++j) y[q][j] = (f32x4){gc0[q] * bflo(yn0[q][j].x) + gc1[q] * bflo(yn1[q][j].x), gc0[q] * bfhi(yn0[q][j].x) + gc1[q] * bfhi(yn1[q][j].x), gc0[q] * bflo(yn0[q][j].y) + gc1[q] * bflo(yn1[q][j].y), gc0[q] * bfhi(yn0[q][j].y) + gc1[q] * bfhi(yn1[q][j].y)};
            }
        }
        ROW_LOAD(mb + 2 * NGW); ROW_LOAD_IDX(mb + 4 * NGW);
#pragma unroll
        for (int q = 0; q < 2; ++q) {
        const int m = mb + q * NGW;
        if (m < M) {
        if (R.branch) {
            float ss = 0.f;
#pragma unroll
            for (int j = 0; j < 4; ++j) ss += (y[q][j].x * y[q][j].x + y[q][j].y * y[q][j].y) + (y[q][j].z * y[q][j].z + y[q][j].w * y[q][j].w);
            const float sc = 1.0f / sqrtf(wave_sum(ss) * (1.0f / D) + 1e-6f);
#pragma unroll
            for (int j = 0; j < 4; ++j) v[q][j] = v[q][j] + y[q][j] * sc * gpo[j];
        }
        if (R.hdst) {
#pragma unroll
            for (int j = 0; j < 4; ++j) *(f32x4*)(R.hdst + (size_t)m * D + 4 * lane + 256 * j) = v[q][j];
        }
        if (R.hdst16) {
#pragma unroll
            for (int j = 0; j < 4; ++j) { v2u o; o.x = pk2(v[q][j].x, v[q][j].y); o.y = pk2(v[q][j].z, v[q][j].w); *(v2u*)(R.hdst16 + (size_t)m * D + 4 * lane + 256 * j) = o; }
        }
        if (R.gpre) {
            float ss = 0.f;
#pragma unroll
            for (int j = 0; j < 4; ++j) ss += (v[q][j].x * v[q][j].x + v[q][j].y * v[q][j].y) + (v[q][j].z * v[q][j].z + v[q][j].w * v[q][j].w);
            const float sc = 1.0f / sqrtf(wave_sum(ss) * (1.0f / D) + 1e-6f);
#pragma unroll
            for (int j = 0; j < 4; ++j) { v[q][j] = v[q][j] * sc * gpr[j]; v2u o; o.x = pk2(v[q][j].x, v[q][j].y); o.y = pk2(v[q][j].z, v[q][j].w); *(v2u*)(R.a1 + (size_t)m * D + 4 * lane + 256 * j) = o; }
            if (R.proj) {
                float p[8];
#pragma unroll
                for (int e = 0; e < 8; ++e) { float s = 0.f;
#pragma unroll
                    for (int j = 0; j < 4; ++j) { const f32x4 w = *(const LAS f32x4*)(W8T + e * 1024 + 4 * lane + 256 * j); s += (v[q][j].x * w.x + v[q][j].y * w.y) + (v[q][j].z * w.z + v[q][j].w * w.w); }
                    p[e] = wave_sum(s); }
                if (R.proj == 1) {
                    float mine = p[0];
#pragma unroll
                    for (int e = 1; e < 8; ++e) mine = (lane == e) ? p[e] : mine;
                    if (lane < 8) DTRAW[(size_t)m * 8 + lane] = mine;
                } else {
                    float best = p[0]; int bi = 0;
#pragma unroll
                    for (int e = 1; e < 8; ++e) if (p[e] > best) { best = p[e]; bi = e; }
                    float sb = -3.0e38f; int si = 0;
#pragma unroll
                    for (int e = 0; e < 8; ++e) if (e != bi && p[e] > sb) { sb = p[e]; si = e; }
                    const float g0 = 1.0f / (1.0f + expf(sb - best)), g1 = 1.0f - g0;
                    if (lane == 0) { TOKE[2 * m] = bi; TOKE[2 * m + 1] = si; TOKG[2 * m] = g0; TOKG[2 * m + 1] = g1;
                        __hip_atomic_fetch_add(cnt + bi, 1, __ATOMIC_RELAXED, __HIP_MEMORY_SCOPE_WORKGROUP); __hip_atomic_fetch_add(cnt + si, 1, __ATOMIC_RELAXED, __HIP_MEMORY_SCOPE_WORKGROUP); }
                }
            }
        }
        } }
    }
#undef ROW_LOAD
#undef ROW_LOAD_IDX
    if (R.proj == 2) { __syncthreads(); if (F.tid < 8) ((int*)(A.ws + WS_WGCNT))[F.vcu * 8 + F.tid] = cnt[F.tid]; }
    __syncthreads();
}

__device__ __forceinline__ void moe_tables(Frame& F, ArgsRef A) {
    LAS int* c = (LAS int*)(F.lds + CTL_CNT); LAS int* te = (LAS int*)(F.lds + CTL_TE);
    if (F.tid < 48) c[F.tid] = 0;
    __syncthreads();
    const int* WGCNT = (const int*)(A.ws + WS_WGCNT);
    for (int idx = F.tid; idx < F.G * 8; idx += NTHR) { const int wg = idx >> 3, e = idx & 7; const int v = WGCNT[idx];
        __hip_atomic_fetch_add(c + e, v, __ATOMIC_RELAXED, __HIP_MEMORY_SCOPE_WORKGROUP); if (wg < F.vcu) __hip_atomic_fetch_add(c + 8 + e, v, __ATOMIC_RELAXED, __HIP_MEMORY_SCOPE_WORKGROUP); }
    __syncthreads();
    if (F.tid == 0) { int t = 0;
#pragma unroll 1
        for (int e = 0; e < 8; ++e) { c[16 + e] = t * 256; t += (c[e] + 255) >> 8; c[40 + e] = t; }
        c[32] = t < MOE_MAXT ? t : MOE_MAXT; }
    __syncthreads();
    if (F.tid < MOE_MAXT) { int e = 0;
#pragma unroll
        for (int q = 0; q < 7; ++q) e += (F.tid >= c[40 + q]) ? 1 : 0;
        te[F.tid] = e; }
    __syncthreads();
}
__device__ __forceinline__ void moe_gather(Frame& F, ArgsRef A) {
    LAS int* c = (LAS int*)(F.lds + CTL_CNT);
    const int* TOKE = (const int*)(A.ws + WS_TOKE); int* POS = (int*)(A.ws + WS_POS);
    const bf16* A1 = (const bf16*)(A.ws + WS_A1); unsigned char* XS = A.ws + WS_XS;
    const int gw = F.vcu * NWAVES + F.wave, NGW = F.G * NWAVES, lane = F.lane;
    for (int m = gw; m < M; m += NGW) {
        int d0 = 0, d1 = 0;
        if (lane == 0) { const int e0 = TOKE[2 * m], e1 = TOKE[2 * m + 1];
            d0 = c[16 + e0] + c[8 + e0] + __hip_atomic_fetch_add(c + 24 + e0, 1, __ATOMIC_RELAXED, __HIP_MEMORY_SCOPE_WORKGROUP);
            d1 = c[16 + e1] + c[8 + e1] + __hip_atomic_fetch_add(c + 24 + e1, 1, __ATOMIC_RELAXED, __HIP_MEMORY_SCOPE_WORKGROUP);
            POS[2 * m] = d0; POS[2 * m + 1] = d1; }
        d0 = __builtin_amdgcn_readfirstlane(d0); d1 = __builtin_amdgcn_readfirstlane(d1);
        const v4u r0 = *(const v4u*)(A1 + (size_t)m * D + 16 * lane), r1 = *(const v4u*)(A1 + (size_t)m * D + 16 * lane + 8);
        v4u o;
        o.x = pg8::pack_fp8x4(bflo(r0.x) * FP8_SX, bfhi(r0.x) * FP8_SX, bflo(r0.y) * FP8_SX, bfhi(r0.y) * FP8_SX); o.y = pg8::pack_fp8x4(bflo(r0.z) * FP8_SX, bfhi(r0.z) * FP8_SX, bflo(r0.w) * FP8_SX, bfhi(r0.w) * FP8_SX);
        o.z = pg8::pack_fp8x4(bflo(r1.x) * FP8_SX, bfhi(r1.x) * FP8_SX, bflo(r1.y) * FP8_SX, bfhi(r1.y) * FP8_SX); o.w = pg8::pack_fp8x4(bflo(r1.z) * FP8_SX, bfhi(r1.z) * FP8_SX, bflo(r1.w) * FP8_SX, bfhi(r1.w) * FP8_SX);
        *(v4u*)(XS + (size_t)d0 * D + 16 * lane) = o; *(v4u*)(XS + (size_t)d1 * D + 16 * lane) = o;
    }
    __syncthreads();
}

__device__ __forceinline__ void gmlp_unit(Frame& F, ArgsRef A, int L, int nb) {
    LAS unsigned char* Ls = F.lds; int tl_ = F.tid; asm volatile("" : "+v"(tl_));
    const int tid = tl_, lane = tid & 63, w = F.wave, fr = lane & 15, q4 = lane >> 4;
    const size_t m0 = (size_t)nb * 128;
    const bf16* P = (const bf16*)(A.ws + WS_PROJ); bf16* Y = (bf16*)(A.ws + WS_Y);
    { const f32x4 g4 = *(const f32x4*)(A.in[12] + L * 256 + 4 * lane), b4 = *(const f32x4*)(A.in[13] + L * 256 + 4 * lane);
#pragma unroll 2
      for (int i = 0; i < 16; ++i) { const int r = 16 * w + i;
        const v2u raw = *(const v2u*)(P + (m0 + r) * PN + PC_V + 4 * lane);
        f32x4 v = (f32x4){bflo(raw.x), bfhi(raw.x), bflo(raw.y), bfhi(raw.y)};
        const float mu = wave_sum((v.x + v.y) + (v.z + v.w)) * (1.0f / 256.0f);
        v = v - mu;
        const float var = wave_sum((v.x * v.x + v.y * v.y) + (v.z * v.z + v.w * v.w)) * (1.0f / 256.0f);
        const float rstd = 1.0f / sqrtf(var + 1e-5f);
        v = v * rstd * g4 + b4;
        v2u o; o.x = pk2(v.x, v.y); o.y = pk2(v.z, v.w);
        *(LAS v2u*)(Ls + r * 544 + lane * 8) = o; } }
    __syncthreads();
    const int g = w & 3;
    f32x4 acc[4][4];
    const float* Wg = A.in[14] + (size_t)(L * 4 + g) * 128 * 128;
    const float* bsg = A.in[15] + (size_t)(L * 4 + g) * 128;
#pragma unroll
    for (int pi = 0; pi < 4; ++pi) {
        const int it = (w >> 2) == 0 ? (pi == 0 ? 0 : pi == 1 ? 7 : pi == 2 ? 1 : 6) : (pi == 0 ? 2 : pi == 1 ? 5 : pi == 2 ? 3 : 4);
#pragma unroll
        for (int ct = 0; ct < 4; ++ct) acc[pi][ct] = (f32x4){0.f, 0.f, 0.f, 0.f};
        const int t = 16 * it + fr, nks = (it >> 1) + 1;
        for (int ks = 0; ks < nks; ++ks) {
            const int sA = 32 * ks + 4 * q4, sB = sA + 16;
            const f32x4 wa = *(const f32x4*)(Wg + t * 128 + sA), wb = *(const f32x4*)(Wg + t * 128 + sB);
            const bf16x8 xf = pack8(sA + 0 <= t ? wa.x : 0.f, sA + 1 <= t ? wa.y : 0.f, sA + 2 <= t ? wa.z : 0.f, sA + 3 <= t ? wa.w : 0.f,
                                    sB + 0 <= t ? wb.x : 0.f, sB + 1 <= t ? wb.y : 0.f, sB + 2 <= t ? wb.z : 0.f, sB + 3 <= t ? wb.w : 0.f);
#pragma unroll
            for (int ct = 0; ct < 4; ++ct) { const int col = g * 64 + ct * 16 + 4 * (lane & 3);
                const v4i16 lo = trrd(Ls + (sA + (fr >> 2)) * 544 + col * 2), hi = trrd(Ls + (sB + (fr >> 2)) * 544 + col * 2);
                acc[pi][ct] = mfma16(xf, cat8(lo, hi), acc[pi][ct]); }
        }
#pragma unroll
        for (int r = 0; r < 4; ++r) { const float bs = bsg[16 * it + 4 * q4 + r];
#pragma unroll
            for (int ct = 0; ct < 4; ++ct) acc[pi][ct][r] += bs; }
    }
    __syncthreads();
#pragma unroll
    for (int pi = 0; pi < 4; ++pi) {
        const int it = (w >> 2) == 0 ? (pi == 0 ? 0 : pi == 1 ? 7 : pi == 2 ? 1 : 6) : (pi == 0 ? 2 : pi == 1 ? 5 : pi == 2 ? 3 : 4);
#pragma unroll
        for (int ct = 0; ct < 4; ++ct)
#pragma unroll
            for (int r = 0; r < 4; ++r) *(LAS float*)(Ls + (16 * it + 4 * q4 + r) * 1040 + (g * 64 + ct * 16 + fr) * 4) = acc[pi][ct][r];
    }
    __syncthreads();
    { const f32x4 gn = *(const f32x4*)(A.in[16] + L * 256 + 4 * lane);
#pragma unroll 2
      for (int i = 0; i < 16; ++i) { const int r = 16 * w + i;
        const f32x4 mx = *(const LAS f32x4*)(Ls + r * 1040 + lane * 16);
        const v2u raw = *(const v2u*)(P + (m0 + r) * PN + PC_U + 4 * lane);
        f32x4 v = (f32x4){bflo(raw.x), bfhi(raw.x), bflo(raw.y), bfhi(raw.y)} * mx;
        const float ss = wave_sum((v.x * v.x + v.y * v.y) + (v.z * v.z + v.w * v.w)) * (1.0f / 256.0f);
        v = v * (1.0f / sqrtf(ss + 1e-6f)) * gn;
        v2u o; o.x = pk2(v.x, v.y); o.y = pk2(v.z, v.w);
        *(v2u*)(Y + (m0 + r) * D + 512 + 4 * lane) = o; } }
    __syncthreads();
}

__device__ __forceinline__ void attn_unit(Frame& F, ArgsRef A, int L, int bc) {
    LAS unsigned char* Ls = F.lds; int tl_ = F.tid; asm volatile("" : "+v"(tl_));
    const int tid = tl_, lane = tid & 63, w = F.wave, fr = lane & 15, q4 = lane >> 4;
    const int b = bc >> 7, c = bc & 127; const size_t m0 = (size_t)b * SEQ + (size_t)c * 64;
    const bf16* P = (const bf16*)(A.ws + WS_PROJ); bf16* Y = (bf16*)(A.ws + WS_Y);
    const int h = w >> 1, qh = w & 1;
    LAS unsigned char* Vb = Ls + w * 10240;
    LAS float* BT = (LAS float*)(Ls + 81920);
    constexpr float LOG2E = 1.4426950408889634f;
    for (int i = tid; i < 4 * 257; i += NTHR) BT[i] = A.in[17][(size_t)L * 4 * 257 + i] * LOG2E;
    bf16x8 qf[2][2];
#pragma unroll
    for (int qb = 0; qb < 2; ++qb)
#pragma unroll
        for (int ks = 0; ks < 2; ++ks) qf[qb][ks] = *(const bf16x8*)(P + (m0 + 32 * qh + 16 * qb + fr) * PN + PC_Q + h * 64 + 32 * ks + 8 * q4);
    f32x4 o[4][2];
#pragma unroll
    for (int dt = 0; dt < 4; ++dt) { o[dt][0] = (f32x4){0.f, 0.f, 0.f, 0.f}; o[dt][1] = (f32x4){0.f, 0.f, 0.f, 0.f}; }
    float mrun[2] = {-1e30f, -1e30f}, lrun[2] = {0.f, 0.f};
    const int jmin = c >= 8 ? 0 : 8 - c;
    const bf16* Kp = P + PC_K + h * 64 + 8 * q4 + (size_t)fr * PN;
    const bf16* Vp = P + PC_VV + h * 64 + (lane & 7) * 8 + (size_t)(lane >> 3) * PN;
    bf16x8 kreg[4][2]; v4u vreg[8];
    { const size_t kr0 = m0 - (size_t)(8 - jmin) * 64;
#pragma unroll
      for (int kt = 0; kt < 4; ++kt)
#pragma unroll
          for (int ks = 0; ks < 2; ++ks) kreg[kt][ks] = *(const bf16x8*)(Kp + (kr0 + 16 * kt) * PN + 32 * ks);
#pragma unroll
      for (int i = 0; i < 8; ++i) vreg[i] = *(const v4u*)(Vp + (kr0 + 8 * i) * PN); }
    __syncthreads();
    const float cb = BT[h * 257 + 256];
    for (int j = jmin; j <= 8; ++j) {
        const int jn = j < 8 ? j + 1 : 8; const size_t krn = m0 - (size_t)(8 - jn) * 64;
#pragma unroll
        for (int i = 0; i < 8; ++i) *(LAS v4u*)(Vb + (i * 8 + (lane >> 3)) * 160 + (lane & 7) * 16) = vreg[i];
#pragma unroll
        for (int i = 0; i < 8; ++i) vreg[i] = *(const v4u*)(Vp + (krn + 8 * i) * PN);
        f32x4 st[4][2];
#pragma unroll
        for (int kt = 0; kt < 4; ++kt) { st[kt][0] = (f32x4){0.f, 0.f, 0.f, 0.f}; st[kt][1] = (f32x4){0.f, 0.f, 0.f, 0.f};
#pragma unroll
            for (int ks = 0; ks < 2; ++ks) { st[kt][0] = mfma16(kreg[kt][ks], qf[0][ks], st[kt][0]); st[kt][1] = mfma16(kreg[kt][ks], qf[1][ks], st[kt][1]); } }
#pragma unroll
        for (int kt = 0; kt < 4; ++kt)
#pragma unroll
            for (int ks = 0; ks < 2; ++ks) kreg[kt][ks] = *(const bf16x8*)(Kp + (krn + 16 * kt) * PN + 32 * ks);
#pragma unroll
        for (int qb = 0; qb < 2; ++qb) {
            float mx = -1e30f;
            if (j <= 5) {
#pragma unroll
                for (int kt = 0; kt < 4; ++kt)
#pragma unroll
                    for (int r = 0; r < 4; ++r) { const float s = st[kt][qb][r] * (0.125f * LOG2E) + cb; st[kt][qb][r] = s; mx = fmaxf(mx, s); }
            } else {
                const LAS float* bt = BT + h * 257 + (512 - 64 * j + 32 * qh + 16 * qb + fr - 4 * q4 + 128);
                const int i0 = 512 - 64 * j + 32 * qh + 16 * qb + fr - 4 * q4 + 128;
#pragma unroll
                for (int kt = 0; kt < 4; ++kt)
#pragma unroll
                    for (int r = 0; r < 4; ++r) { int idx = i0 - 16 * kt - r; idx = idx > 256 ? 256 : idx;
                        const float s = st[kt][qb][r] * (0.125f * LOG2E) + BT[h * 257 + idx]; st[kt][qb][r] = s; mx = fmaxf(mx, s); }
                (void)bt;
            }
            mx = fmaxf(mx, __shfl_xor(mx, 16)); mx = fmaxf(mx, __shfl_xor(mx, 32));
            const float mold = mrun[qb], mnew = fmaxf(mold, mx); mrun[qb] = mnew;
            float rs = 0.f;
#pragma unroll
            for (int kt = 0; kt < 4; ++kt)
#pragma unroll
                for (int r = 0; r < 4; ++r) { const float p = __builtin_amdgcn_exp2f(st[kt][qb][r] - mnew); st[kt][qb][r] = p; rs += p; }
            rs += __shfl_xor(rs, 16); rs += __shfl_xor(rs, 32);
            if (__any(mnew > mold)) { const float alpha = __builtin_amdgcn_exp2f(mold - mnew); lrun[qb] = lrun[qb] * alpha + rs;
#pragma unroll
                for (int dt = 0; dt < 4; ++dt) o[dt][qb] = o[dt][qb] * alpha; }
            else lrun[qb] += rs;
        }
#pragma unroll
        for (int kk = 0; kk < 2; ++kk) {
            const bf16x8 y0 = pack8(st[2 * kk][0][0], st[2 * kk][0][1], st[2 * kk][0][2], st[2 * kk][0][3], st[2 * kk + 1][0][0], st[2 * kk + 1][0][1], st[2 * kk + 1][0][2], st[2 * kk + 1][0][3]);
            const bf16x8 y1 = pack8(st[2 * kk][1][0], st[2 * kk][1][1], st[2 * kk][1][2], st[2 * kk][1][3], st[2 * kk + 1][1][0], st[2 * kk + 1][1][1], st[2 * kk + 1][1][2], st[2 * kk + 1][1][3]);
            const int rowA = 32 * kk + 4 * q4 + (fr >> 2), rowB = rowA + 16;
#pragma unroll
            for (int dt = 0; dt < 4; ++dt) { const int cbt = (16 * dt + 4 * (lane & 3)) * 2;
                const bf16x8 xf = cat8(trrd(Vb + rowA * 160 + cbt), trrd(Vb + rowB * 160 + cbt));
                o[dt][0] = mfma16(xf, y0, o[dt][0]); o[dt][1] = mfma16(xf, y1, o[dt][1]); }
        }
    }
    const float il0 = 1.0f / lrun[0], il1 = 1.0f / lrun[1];
    __syncthreads();
#pragma unroll
    for (int dt = 0; dt < 4; ++dt) {
        *(LAS f32x4*)(Ls + (32 * qh + fr) * 1040 + (h * 64 + 16 * dt + 4 * q4) * 4) = o[dt][0] * il0;
        *(LAS f32x4*)(Ls + (32 * qh + 16 + fr) * 1040 + (h * 64 + 16 * dt + 4 * q4) * 4) = o[dt][1] * il1; }
    __syncthreads();
    { const f32x4 gn = *(const f32x4*)(A.in[18] + L * 256 + 4 * lane);
#pragma unroll 2
      for (int i = 0; i < 8; ++i) { const int r = 8 * w + i;
        f32x4 v = *(const LAS f32x4*)(Ls + r * 1040 + lane * 16);
        const float ss = wave_sum((v.x * v.x + v.y * v.y) + (v.z * v.z + v.w * v.w)) * (1.0f / 256.0f);
        v = v * (1.0f / sqrtf(ss + 1e-6f)) * gn;
        v2u ov; ov.x = pk2(v.x, v.y); ov.y = pk2(v.z, v.w);
        *(v2u*)(Y + (m0 + r) * D + 768 + 4 * lane) = ov; } }
    __syncthreads();
}

__device__ __forceinline__ void ssd_prepass(Frame& F, ArgsRef A, int L, size_t m0, LAS float* dtl, LAS float* acs) {
    const float* DTRAW = (const float*)(A.ws + WS_DTRAW);
    { const int l = F.lane, h = F.wave;
      const float x = DTRAW[(m0 + l) * 8 + h] + A.in[8][L * 8 + h];
      const float dt = x > 20.f ? x : log1pf(expf(x));
      float s = -dt * expf(A.in[9][L * 8 + h]);
#pragma unroll
      for (int o = 1; o < 64; o <<= 1) { const float t = __shfl_up(s, o); s += (l >= o) ? t : 0.f; }
      dtl[l * 8 + h] = dt; acs[l * 8 + h] = s; }
    __syncthreads();
}
__device__ __forceinline__ void ssd1_unit(Frame& F, ArgsRef A, int L, int bc) {
    LAS unsigned char* Ls = F.lds; int tl_ = F.tid; asm volatile("" : "+v"(tl_));
    const int tid = tl_, lane = tid & 63, w = F.wave, fr = lane & 15, q4 = lane >> 4;
    const int b = bc >> 7, c = bc & 127; const size_t m0 = (size_t)b * SEQ + (size_t)c * 64;
    const bf16* P = (const bf16*)(A.ws + WS_PROJ); bf16* XBCC = (bf16*)(A.ws + WS_XBCC); bf16* ST = (bf16*)(A.ws + WS_ST); float* AEND = (float*)(A.ws + WS_AEND);
    LAS unsigned char* XI = Ls; LAS unsigned char* BI = Ls + 67584;
    LAS float* dtl = (LAS float*)(Ls + 102400); LAS float* acs = (LAS float*)(Ls + 104448);
    const int cg = tid & 127, tg = tid >> 7, ch0 = 8 * cg;
    v4u raw[19];
#define SSD1_ROW(tt) do { const int lp = 16 * tg - 3 + (tt); const bool ok = (c * 64 + lp) >= 0; \
        raw[tt] = ok ? *(const v4u*)(P + (size_t)((long)m0 + lp) * PN + PC_XBC + ch0) : (v4u){0u, 0u, 0u, 0u}; } while (0)
#pragma unroll
    for (int tt = 0; tt < 11; ++tt) SSD1_ROW(tt);
    ssd_prepass(F, A, L, m0, dtl, acs);
    if (tid < 8) AEND[(size_t)bc * 8 + tid] = acs[63 * 8 + tid];
    { float wk[4][8], bs[8];
#pragma unroll
      for (int k = 0; k < 4; ++k) { const f32x4 a = *(const f32x4*)(A.in[6] + (size_t)(L * 4 + k) * 1024 + ch0), bq = *(const f32x4*)(A.in[6] + (size_t)(L * 4 + k) * 1024 + ch0 + 4);
          wk[k][0] = a.x; wk[k][1] = a.y; wk[k][2] = a.z; wk[k][3] = a.w; wk[k][4] = bq.x; wk[k][5] = bq.y; wk[k][6] = bq.z; wk[k][7] = bq.w; }
      { const f32x4 a = *(const f32x4*)(A.in[7] + (size_t)L * 1024 + ch0), bq = *(const f32x4*)(A.in[7] + (size_t)L * 1024 + ch0 + 4);
          bs[0] = a.x; bs[1] = a.y; bs[2] = a.z; bs[3] = a.w; bs[4] = bq.x; bs[5] = bq.y; bs[6] = bq.z; bs[7] = bq.w; }
      const int hh = cg >> 3;
#pragma unroll
      for (int t = 0; t < 16; ++t) { const int l = 16 * tg + t;
          if (t < 8) SSD1_ROW(t + 11);
          float y[8];
#pragma unroll
          for (int e = 0; e < 8; ++e) y[e] = bs[e];
#pragma unroll
          for (int k = 0; k < 4; ++k) { const v4u rw = raw[t + k];
              y[0] += wk[k][0] * bflo(rw.x); y[1] += wk[k][1] * bfhi(rw.x); y[2] += wk[k][2] * bflo(rw.y); y[3] += wk[k][3] * bfhi(rw.y);
              y[4] += wk[k][4] * bflo(rw.z); y[5] += wk[k][5] * bfhi(rw.z); y[6] += wk[k][6] * bflo(rw.w); y[7] += wk[k][7] * bfhi(rw.w); }
#pragma unroll
          for (int e = 0; e < 8; ++e) y[e] = silu(y[e]);
          v4u o; o.x = pk2(y[0], y[1]); o.y = pk2(y[2], y[3]); o.z = pk2(y[4], y[5]); o.w = pk2(y[6], y[7]);
          *(v4u*)(XBCC + (m0 + l) * 1024 + ch0) = o;
          if (cg < 64) { const float sc = dtl[l * 8 + hh] * __expf(acs[63 * 8 + hh] - acs[l * 8 + hh]);
              v4u os; os.x = pk2(y[0] * sc, y[1] * sc); os.y = pk2(y[2] * sc, y[3] * sc); os.z = pk2(y[4] * sc, y[5] * sc); os.w = pk2(y[6] * sc, y[7] * sc);
              *(LAS v4u*)(XI + l * 1056 + ch0 * 2) = os; }
          else if (cg < 96) *(LAS v4u*)(BI + l * 544 + (ch0 - 512) * 2) = o;
          __builtin_amdgcn_sched_barrier(0);
      } }
#undef SSD1_ROW
    __syncthreads();
    { const int h = w, gi = h >> 2;
      bf16* STh = ST + ((size_t)bc * 8 + h) * 8192;
#pragma unroll 1
      for (int nh = 0; nh < 2; ++nh) {
      f32x4 acc[4][4];
#pragma unroll
      for (int nt = 0; nt < 4; ++nt)
#pragma unroll
          for (int pt = 0; pt < 4; ++pt) acc[nt][pt] = (f32x4){0.f, 0.f, 0.f, 0.f};
#pragma unroll
      for (int ks = 0; ks < 2; ++ks) {
          const int rowA = 32 * ks + 4 * q4 + (fr >> 2), rowB = rowA + 16;
          bf16x8 yf[4];
#pragma unroll
          for (int pt = 0; pt < 4; ++pt) { const int cb = (h * 64 + 16 * pt + 4 * (lane & 3)) * 2; yf[pt] = cat8(trrd(XI + rowA * 1056 + cb), trrd(XI + rowB * 1056 + cb)); }
#pragma unroll
          for (int nt = 0; nt < 4; ++nt) { const int cb = (gi * 128 + 64 * nh + 16 * nt + 4 * (lane & 3)) * 2;
              const bf16x8 xf = cat8(trrd(BI + rowA * 544 + cb), trrd(BI + rowB * 544 + cb));
#pragma unroll
              for (int pt = 0; pt < 4; ++pt) acc[nt][pt] = mfma16(xf, yf[pt], acc[nt][pt]); }
      }
#pragma unroll
      for (int nt = 0; nt < 4; ++nt)
#pragma unroll
          for (int pt = 0; pt < 4; ++pt) { v2u o; o.x = pk2(acc[nt][pt][0], acc[nt][pt][1]); o.y = pk2(acc[nt][pt][2], acc[nt][pt][3]); *(v2u*)(STh + (16 * pt + fr) * 128 + 64 * nh + 16 * nt + 4 * q4) = o; }
      }
    }
    __syncthreads();
}
__device__ __forceinline__ void ssd_scan(Frame& F, ArgsRef A) {
    unsigned* ST = (unsigned*)(A.ws + WS_ST); const float* AEND = (const float*)(A.ws + WS_AEND);
    for (int it = F.vcu * NTHR + F.tid; it < 32 * 4096; it += F.G * NTHR) {
        const int bh = it >> 12, b = bh >> 3, h = bh & 7, e = (it & 4095);
        unsigned* base = ST + ((size_t)(b * NCHUNK) * 8 + h) * 4096 + e;
        float s0 = 0.f, s1 = 0.f;
        for (int c0 = 0; c0 < NCHUNK; c0 += 16) {
            unsigned v[16]; float dec[16];
#pragma unroll
            for (int i = 0; i < 16; ++i) { v[i] = base[(size_t)(c0 + i) * 32768]; dec[i] = __expf(AEND[(size_t)(b * NCHUNK + c0 + i) * 8 + h]); }
#pragma unroll
            for (int i = 0; i < 16; ++i) { base[(size_t)(c0 + i) * 32768] = pk2(s0, s1); s0 = s0 * dec[i] + bflo(v[i]); s1 = s1 * dec[i] + bfhi(v[i]); }
        }
    }
}
__device__ __forceinline__ void ssd3_unit(Frame& F, ArgsRef A, int L, int bc) {
    LAS unsigned char* Ls = F.lds; int tl_ = F.tid; asm volatile("" : "+v"(tl_));
    const int tid = tl_, lane = tid & 63, w = F.wave, fr = lane & 15, q4 = lane >> 4;
    const int b = bc >> 7, c = bc & 127; const size_t m0 = (size_t)b * SEQ + (size_t)c * 64;
    const bf16* P = (const bf16*)(A.ws + WS_PROJ); const bf16* XBCC = (const bf16*)(A.ws + WS_XBCC); const bf16* ST = (const bf16*)(A.ws + WS_ST); bf16* Y = (bf16*)(A.ws + WS_Y);
    LAS unsigned char* XI = Ls; LAS unsigned char* BI = Ls + 67584; LAS unsigned char* CI = Ls + 102400;
    LAS float* dtl = (LAS float*)(Ls + 137216); LAS float* acs = (LAS float*)(Ls + 139264);
    const int h = w, gi = h >> 2;
    v4u stg[16];
#pragma unroll
    for (int i = 0; i < 16; ++i) { const int pc = tid + NTHR * i; stg[i] = *(const v4u*)(XBCC + (m0 + (pc >> 7)) * 1024 + 8 * (pc & 127)); }
    ssd_prepass(F, A, L, m0, dtl, acs);
#pragma unroll
    for (int i = 0; i < 16; ++i) { const int pc = tid + NTHR * i, row = pc >> 7, cg = pc & 127;
        LAS unsigned char* dst = cg < 64 ? XI + row * 1056 + cg * 16 : (cg < 96 ? BI + row * 544 + (cg - 64) * 16 : CI + row * 544 + (cg - 96) * 16);
        *(LAS v4u*)dst = stg[i]; }
    __builtin_amdgcn_sched_barrier(0);
    bf16x8 sin_[4][4];
    { const bf16* Sh = ST + ((size_t)bc * 8 + h) * 8192;
#pragma unroll
      for (int kn = 0; kn < 4; ++kn)
#pragma unroll
          for (int pt = 0; pt < 4; ++pt) sin_[kn][pt] = *(const bf16x8*)(Sh + (16 * pt + fr) * 128 + 32 * kn + 8 * q4); }
    __syncthreads();
    f32x4 acc[4][4];
#pragma unroll
    for (int lt = 0; lt < 4; ++lt)
#pragma unroll
        for (int pt = 0; pt < 4; ++pt) acc[lt][pt] = (f32x4){0.f, 0.f, 0.f, 0.f};
    {
#pragma unroll
      for (int kn = 0; kn < 4; ++kn) {
#pragma unroll
          for (int lt = 0; lt < 4; ++lt) { const bf16x8 xf = *(const LAS bf16x8*)(CI + (16 * lt + fr) * 544 + (gi * 128 + 32 * kn + 8 * q4) * 2);
#pragma unroll
              for (int pt = 0; pt < 4; ++pt) acc[lt][pt] = mfma16(xf, sin_[kn][pt], acc[lt][pt]); }
      }
#pragma unroll
      for (int lt = 0; lt < 4; ++lt)
#pragma unroll
          for (int r = 0; r < 4; ++r) { const float sc = __expf(acs[(16 * lt + 4 * q4 + r) * 8 + h]);
#pragma unroll
              for (int pt = 0; pt < 4; ++pt) acc[lt][pt][r] *= sc; }
    }
#pragma unroll
    for (int lt = 0; lt < 4; ++lt) {
#pragma unroll
        for (int ksp = 0; ksp <= (lt >> 1); ++ksp) {
            __builtin_amdgcn_sched_barrier(0);
            const bool hasb = (2 * ksp + 1) <= lt;
            f32x4 d0a = (f32x4){0.f, 0.f, 0.f, 0.f}, d0b = (f32x4){0.f, 0.f, 0.f, 0.f};
#pragma unroll
            for (int kn = 0; kn < 4; ++kn) { const int cb = (gi * 128 + 32 * kn + 8 * q4) * 2;
                const bf16x8 cf = *(const LAS bf16x8*)(CI + (16 * lt + fr) * 544 + cb);
                const bf16x8 ba = *(const LAS bf16x8*)(BI + (32 * ksp + fr) * 544 + cb); d0a = mfma16(ba, cf, d0a);
                if (hasb) { const bf16x8 bb = *(const LAS bf16x8*)(BI + (32 * ksp + 16 + fr) * 544 + cb); d0b = mfma16(bb, cf, d0b); } }
            const int l = 16 * lt + fr; const float al = acs[l * 8 + h];
            float ga[4], gb[4];
#pragma unroll
            for (int r = 0; r < 4; ++r) { const int sa = 32 * ksp + 4 * q4 + r, sb = sa + 16;
                ga[r] = sa <= l ? d0a[r] * __expf(al - acs[sa * 8 + h]) * dtl[sa * 8 + h] : 0.f;
                gb[r] = (hasb && sb <= l) ? d0b[r] * __expf(al - acs[sb * 8 + h]) * dtl[sb * 8 + h] : 0.f; }
            const bf16x8 xf = pack8(ga[0], ga[1], ga[2], ga[3], gb[0], gb[1], gb[2], gb[3]);
            const int rowA = 32 * ksp + 4 * q4 + (fr >> 2), rowB = rowA + 16;
#pragma unroll
            for (int pt = 0; pt < 4; ++pt) { const int cb = (h * 64 + 16 * pt + 4 * (lane & 3)) * 2;
                acc[lt][pt] = mfma16(xf, cat8(trrd(XI + rowA * 1056 + cb), trrd(XI + rowB * 1056 + cb)), acc[lt][pt]); }
        }
    }
    { const float dsk = A.in[10][L * 8 + h];
#pragma unroll
      for (int lt = 0; lt < 4; ++lt)
#pragma unroll
          for (int pt = 0; pt < 4; ++pt)
#pragma unroll
              for (int r = 0; r < 4; ++r) { const unsigned short xv = *(const LAS unsigned short*)(XI + (16 * lt + 4 * q4 + r) * 1056 + (h * 64 + 16 * pt + fr) * 2);
                  acc[lt][pt][r] += dsk * __uint_as_float((unsigned)xv << 16); } }
    __builtin_amdgcn_sched_barrier(0);
    v4u zr[8];
#pragma unroll
    for (int i = 0; i < 8; ++i) zr[i] = *(const v4u*)(P + (m0 + 8 * w + i) * PN + PC_Z + 8 * lane);
    __syncthreads();
#pragma unroll
    for (int lt = 0; lt < 4; ++lt)
#pragma unroll
        for (int pt = 0; pt < 4; ++pt)
#pragma unroll
            for (int r = 0; r < 4; ++r) *(LAS float*)(Ls + (16 * lt + 4 * q4 + r) * 2112 + (h * 64 + 16 * pt + fr) * 4) = acc[lt][pt][r];
    __syncthreads();
    { const f32x4 g0 = *(const f32x4*)(A.in[11] + L * 512 + 8 * lane), g1 = *(const f32x4*)(A.in[11] + L * 512 + 8 * lane + 4);
#pragma unroll
      for (int i = 0; i < 8; ++i) { const int r = 8 * w + i;
        f32x4 v0 = *(const LAS f32x4*)(Ls + r * 2112 + lane * 32), v1 = *(const LAS f32x4*)(Ls + r * 2112 + lane * 32 + 16);
        const v4u z = zr[i];
        v0 = v0 * (f32x4){silu(bflo(z.x)), silu(bfhi(z.x)), silu(bflo(z.y)), silu(bfhi(z.y))};
        v1 = v1 * (f32x4){silu(bflo(z.z)), silu(bfhi(z.z)), silu(bflo(z.w)), silu(bfhi(z.w))};
        const float ss = wave_sum((v0.x * v0.x + v0.y * v0.y) + (v0.z * v0.z + v0.w * v0.w) + (v1.x * v1.x + v1.y * v1.y) + (v1.z * v1.z + v1.w * v1.w)) * (1.0f / 512.0f);
        const float sc = 1.0f / sqrtf(ss + 1e-6f);
        v0 = v0 * sc * g0; v1 = v1 * sc * g1;
        v4u ov; ov.x = pk2(v0.x, v0.y); ov.y = pk2(v0.z, v0.w); ov.z = pk2(v1.x, v1.y); ov.w = pk2(v1.z, v1.w);
        *(v4u*)(Y + (m0 + r) * D + 8 * lane) = ov; } }
    __syncthreads();
}

#ifndef PROBE_FP8TEST
#define PROBE_FP8TEST 0
#endif
#if PROBE_FP8TEST
typedef int v8i __attribute__((ext_vector_type(8)));
__device__ __forceinline__ int fp8_selftest(int lane) {
    const int ij = lane & 15, g = lane >> 4;
    v8i Af, Bf;
#pragma unroll
    for (int r = 0; r < 8; ++r) { int wa = 0, wb = 0; const int k = 32 * g + 4 * r;
        wa = __builtin_amdgcn_cvt_pk_fp8_f32((float)((7 * ij + 3 * (k + 0)) % 5), (float)((7 * ij + 3 * (k + 1)) % 5), wa, false);
        wa = __builtin_amdgcn_cvt_pk_fp8_f32((float)((7 * ij + 3 * (k + 2)) % 5), (float)((7 * ij + 3 * (k + 3)) % 5), wa, true);
        wb = __builtin_amdgcn_cvt_pk_fp8_f32((float)((5 * (k + 0) + 11 * ij) % 7), (float)((5 * (k + 1) + 11 * ij) % 7), wb, false);
        wb = __builtin_amdgcn_cvt_pk_fp8_f32((float)((5 * (k + 2) + 11 * ij) % 7), (float)((5 * (k + 3) + 11 * ij) % 7), wb, true);
        Af[r] = wa; Bf[r] = wb; }
    f32x4 d = (f32x4){0.f, 0.f, 0.f, 0.f};
    d = __builtin_amdgcn_mfma_scale_f32_16x16x128_f8f6f4(Af, Bf, d, 0, 0, 0, 0, 0, 0);
    int bad = 0;
#pragma unroll
    for (int r = 0; r < 4; ++r) { const int i = 4 * g + r, j = ij; float e = 0.f;
        for (int k = 0; k < 128; ++k) e += (float)(((7 * i + 3 * k) % 5) * ((5 * k + 11 * j) % 7));
        bad += (d[r] != e + (PROBE_FP8TEST == 2 ? 1.f : 0.f)) ? 1 : 0; }
    return bad;
}
#endif
constexpr int NPHASE = 1 + 16 + 7 + 2 * MOE_NCH + 1;
__global__ void __launch_bounds__(NTHR, 2) fwd_kernel(Args kargs) {
    ArgsP ap = (ArgsP)__builtin_amdgcn_kernarg_segment_ptr();
#define args (*ap)
    extern __shared__ __attribute__((aligned(16))) unsigned char lds[];
    Frame F;
    F.lds = (LAS unsigned char*)lds;
    F.tid = threadIdx.x; F.lane = F.tid & 63; F.wave = __builtin_amdgcn_readfirstlane(F.tid >> 6);
    F.G = gridDim.x; { const int bx = blockIdx.x; F.vcu = (F.G % 8 == 0) ? (bx % 8) * (F.G / 8) + bx / 8 : bx; }
    gu32* ctl = (gu32*)(args.ws + WS_CTL);
    for (int u = F.tid; u < (LDS_BYTES - LDSCTL_OFF) / 4; u += NTHR) ((LAS unsigned*)(F.lds + LDSCTL_OFF))[u] = 0u;
    __syncthreads();
    XcdBarrier bar; bar.bar = (unsigned*)(ctl + CW_BAR); bar.x = 0; bar.st = nullptr;
    const int lo = args.ph_lo, hi = args.ph_hi;
    if (hi - lo > 1) bar = xcd_barrier_post((unsigned*)(ctl + CW_BAR), (volatile LAS unsigned*)(F.lds + CTL_MISC) + 8);
#if PROBE_TG >= 0
    unsigned long long t_acc = 0ull, t_ph = 0ull;
#define IN(k) ((lo <= (k) && (k) < hi) && fresh(F) && relaunder(ap) && ((t_ph = __builtin_amdgcn_s_memrealtime()), true))
#define T_STOP(k) do { if (tgroup_of(k) == PROBE_TG) t_acc += __builtin_amdgcn_s_memrealtime() - t_ph; } while (0)
    unsigned long long t_sub = 0ull;
#define T_SUB0() (t_sub = __builtin_amdgcn_s_memrealtime())
#define T_SUB(g) do { const unsigned long long n_ = __builtin_amdgcn_s_memrealtime(); if ((g) == PROBE_TG) t_acc += n_ - t_sub; t_sub = n_; } while (0)
#else
#define T_SUB0() do { } while (0)
#define T_SUB(g) do { } while (0)
#define IN(k) ((lo <= (k) && (k) < hi) && fresh(F) && relaunder(ap))
#define T_STOP(k) do { } while (0)
#endif
#if PROBE_TG == 20
#define SEAM(k) do { if ((k) + 1 < hi) { const unsigned long long tb_ = __builtin_amdgcn_s_memrealtime(); xcd_barrier(bar); t_acc += __builtin_amdgcn_s_memrealtime() - tb_; } } while (0)
#else
#define SEAM(k) do { if ((k) + 1 < hi) { REP(12) xcd_barrier(bar); } T_STOP(k); } while (0)
#endif
    unsigned char* ws = args.ws;
    bf16* A1 = (bf16*)(ws + WS_A1); bf16* HB = (bf16*)(ws + WS_HB); bf16* PROJ = (bf16*)(ws + WS_PROJ); bf16* Yb = (bf16*)(ws + WS_Y); bf16* MIXED = (bf16*)(ws + WS_MIXED);
    const int bid = (int)blockIdx.x;

#ifdef ONLY_UNIT
    { fresh(F); relaunder(ap);
#if ONLY_UNIT == 1
      for (int u = F.vcu; u < NBATCH * NCHUNK; u += F.G) ssd1_unit(F, args, 0, u);
#elif ONLY_UNIT == 2
      for (int u = F.vcu; u < NBATCH * NCHUNK; u += F.G) attn_unit(F, args, 0, u);
#elif ONLY_UNIT == 3
      for (int u = F.vcu; u < M / 128; u += F.G) gmlp_unit(F, args, 0, u);
#elif ONLY_UNIT == 4
      for (int u = F.vcu; u < NBATCH * NCHUNK; u += F.G) ssd3_unit(F, args, 0, u);
#elif ONLY_UNIT == 5
      { RowArgs R{nullptr, nullptr, HB, HB, 1, MIXED, args.in[2], args.in[3], A1, 2, args.in[23], 8}; row_phase(F, args, R); }
#endif
      return; }
#endif
    if (IN(0)) {
#if PROBE_FP8TEST
        if (blockIdx.x == 0 && F.wave == 0) { const int bad = fp8_selftest(F.lane); if (bad) atomicAdd((unsigned*)(args.ws + WS_CTL) + 2, (unsigned)bad); }
#endif
        cvt_small_weights(F, args, 0, 704, F.vcu * NWAVES + F.wave, F.G * NWAVES);
        __syncthreads();
        RowArgs R{args.in[0], nullptr, nullptr, nullptr, 0, nullptr, nullptr, args.in[1], A1, 1, args.in[5] + 1536, DIN};
        REP(9) row_phase(F, args, R);
        SEAM(0);
    }
    for (int L = 0; L < 2; ++L) {
        const int pb = 1 + 16 * L;
        if (IN(pb + 0)) {
            pg8::Gemm g{A1, (const bf16*)(ws + WS_WIN) + (size_t)L * PN * D, M, PN, D}; pg8::StaticOrder S; S.init(M, PN, F.G, bid);
            pg8::EpiStore E{PROJ, PN, 1.0f};
            pg8::gemm_phase<pg8::EpiStore, pg8::StaticOrder, true, true>(F.lds, g, S, E);
            if (F.G == 256 && bid >= 128) { const int gw = (bid - 128) * NWAVES + F.wave;
                if (L == 0) cvt_small_weights(F, args, 704, CVT_SMALL_TASKS, gw, 128 * NWAVES); }
            else if (F.G != 256 && L == 0) cvt_small_weights(F, args, 704, CVT_SMALL_TASKS, F.vcu * NWAVES + F.wave, F.G * NWAVES);
            SEAM(pb + 0);
        }
        if (IN(pb + 1)) {
            for (int u = F.vcu; u < NBATCH * NCHUNK; u += F.G) attn_unit(F, args, L, u);
            for (int u = F.vcu; u < NBATCH * NCHUNK; u += F.G) ssd1_unit(F, args, L, u);
            for (int u = F.vcu; u < M / 128; u += F.G) gmlp_unit(F, args, L, u);
            SEAM(pb + 1);
        }
                if (IN(pb + 2)) { ssd_scan(F, args); SEAM(pb + 2); }
        if (IN(pb + 3)) { for (int u = F.vcu; u < NBATCH * NCHUNK; u += F.G) ssd3_unit(F, args, L, u); SEAM(pb + 3); }
        if (IN(pb + 4)) {
            pg8::Gemm g{Yb, (const bf16*)(ws + WS_WOUT) + (size_t)L * D * D, M, D, D}; pg8::StaticOrder S; S.init(M, D, F.G, bid);
            pg8::EpiStore E{MIXED, D, 1.0f};
            REP(5) pg8::gemm_phase<pg8::EpiStore, pg8::StaticOrder, true, true>(F.lds, g, S, E);
            SEAM(pb + 4);
        }
        if (IN(pb + 5)) {
            RowArgs R{L == 0 ? args.in[0] : nullptr, nullptr, HB, HB, 1, MIXED, args.in[2] + L * D, args.in[3] + L * D, A1, L == 1 ? 2 : 0, args.in[23], 8};
            if (L == 0) { REP(8) row_phase(F, args, R); } else row_phase(F, args, R);
            if (L == 1) cvt_moe_weights(F, args, 0, MOE_CVT_TASKS, F.vcu * NWAVES + F.wave, F.G * NWAVES);
            SEAM(pb + 5);
        }
        if (L == 0) {
            if (IN(pb + 6)) {
                pg8::Gemm g{A1, (const bf16*)(ws + WS_WGU), M, 2 * DFF, D}; pg8::StaticOrder S; S.init(M, 2 * DFF, F.G, bid);
                pg8::EpiSwiglu E{(bf16*)(ws + WS_H1), DFF};
                REP(6) pg8::gemm_phase<pg8::EpiSwiglu, pg8::StaticOrder, true, true>(F.lds, g, S, E);
                SEAM(pb + 6);
            }
            if (IN(pb + 7)) {
                pg8::Gemm g{(const bf16*)(ws + WS_H1), (const bf16*)(ws + WS_WD), M, D, DFF}; pg8::StaticOrder S; S.init(M, D, F.G, bid);
                pg8::EpiStore E{(bf16*)(ws + WS_FOUT), D, 1.0f};
                REP(6) pg8::gemm_phase<pg8::EpiStore, pg8::StaticOrder, true, true>(F.lds, g, S, E);
                SEAM(pb + 7);
            }
            if (IN(pb + 8)) {
                RowArgs R{nullptr, nullptr, HB, HB, 1, (const bf16*)(ws + WS_FOUT), args.in[4], args.in[1] + D, A1, 1, args.in[5] + (size_t)D * DIN + 1536, DIN};
                row_phase(F, args, R);
                SEAM(pb + 8);
            }
        } else {
#if PROBE_TG >= 10
#ifdef PROBE_TMIN
            if (lo <= pb + 6 && pb + 6 < hi && threadIdx.x == 0) atomicMax((unsigned*)(args.ws + WS_CTL) + 8, 0xffffffffu - (unsigned)t_acc);
#else
            if (lo <= pb + 6 && pb + 6 < hi && threadIdx.x == 0) atomicMax((unsigned*)(args.ws + WS_CTL) + 8, (unsigned)t_acc);
#endif
#endif
            if (IN(pb + 6)) { REP(11) { moe_tables(F, args); moe_gather(F, args); } SEAM(pb + 6); }
            for (int k = 0; k < MOE_NCH; ++k) {
                if (IN(pb + 7 + 2 * k)) {
                    moe_tables(F, args);
                    const int nT = *(LAS int*)(F.lds + CTL_CNT + 32 * 4); int nk = nT - MOE_CH * k; nk = nk < 0 ? 0 : ((k < MOE_NCH - 1 && nk > MOE_CH) ? MOE_CH : nk);
                    pg8::Gemm g{(const bf16*)(ws + WS_XS), (const bf16*)(ws + WS_MWGU), 0, 0, D / 2};
                    pg8::MoeOrder<false, true> S{MOE_CH * k, nk, 28, F.G, bid, (const LAS int*)(F.lds + CTL_TE)};
                    pg8::EpiSwiglu8 E{ws + WS_HM, DFFE, 1.0f / (FP8_SX * FP8_SW), FP8_SH};
                    REP(7) pg8::gemm_phase<pg8::EpiSwiglu8, pg8::MoeOrder<false, true>, true, true, true>(F.lds, g, S, E);
                    SEAM(pb + 7 + 2 * k);
                }
                if (IN(pb + 8 + 2 * k)) {
                    moe_tables(F, args);
                    const int nT = *(LAS int*)(F.lds + CTL_CNT + 32 * 4); int nk = nT - MOE_CH * k; nk = nk < 0 ? 0 : ((k < MOE_NCH - 1 && nk > MOE_CH) ? MOE_CH : nk);
                    pg8::Gemm g{(const bf16*)(ws + WS_HM), (const bf16*)(ws + WS_MWD), 0, 0, DFFE / 2};
                    pg8::MoeOrder<true, false> S{MOE_CH * k, nk, 4, F.G, bid, (const LAS int*)(F.lds + CTL_TE)};
                    pg8::EpiStore E{(bf16*)(ws + WS_YM), D, 1.0f / (FP8_SH * FP8_SW)};
                    REP(7) pg8::gemm_phase<pg8::EpiStore, pg8::MoeOrder<true, false>, true, true, true>(F.lds, g, S, E);
                    SEAM(pb + 8 + 2 * k);
                }
            }
            if (IN(pb + 7 + 2 * MOE_NCH)) {
                RowArgs R{nullptr, args.out, HB, nullptr, 2, (const bf16*)(ws + WS_YM), args.in[4] + D, nullptr, nullptr, 0, nullptr, 0};
                row_phase(F, args, R);
#if PROBE_FP8TEST
                if (__hip_atomic_load((unsigned*)(args.ws + WS_CTL) + 2, RLX_AGENT) != 0u) { __syncthreads(); for (size_t i = (size_t)blockIdx.x * NTHR + F.tid; i < (size_t)M * D; i += (size_t)F.G * NTHR) args.out[i] += 1.0f; }
#endif
            }
        }
    }
#if PROBE_TG >= 0
    T_STOP(1 + 16 + 7 + 2 * MOE_NCH);
#if PROBE_TG >= 10
#endif
    if (blockIdx.x == 77) { unsigned long long t_spin = t_acc;
#if PROBE_TG >= 10 && PROBE_TG < 20
        t_spin = __hip_atomic_load((unsigned*)(args.ws + WS_CTL) + 8, RLX_AGENT);
#ifdef PROBE_TMIN
        t_spin = 0xffffffffu - (unsigned)t_spin;
#endif
#endif
        const unsigned long long t_end = __builtin_amdgcn_s_memrealtime(); while (__builtin_amdgcn_s_memrealtime() - t_end < t_spin) __builtin_amdgcn_s_sleep(8); }
#endif
#undef IN
#undef SEAM
#undef args
}

extern "C" void kernel_launch(void* const* d_in, const int* in_sizes, int n_in, void* d_out, int out_size, void* d_ws, size_t ws_size, hipStream_t stream) {
    static int grid = 0;
    if (grid == 0) {
        if (n_in != NIN || out_size != M * D || ws_size < WS_END) { fprintf(stderr, "kernel_launch: unexpected shapes (n_in %d, out %d, ws %zu)\n", n_in, out_size, ws_size); grid = -1; return; }
        int dev = 0, cus = 0;
        if (hipGetDevice(&dev) != hipSuccess || hipDeviceGetAttribute(&cus, hipDeviceAttributeMultiprocessorCount, dev) != hipSuccess) { grid = -1; return; }
        if (hipFuncSetAttribute((const void*)fwd_kernel, hipFuncAttributeMaxDynamicSharedMemorySize, LDS_BYTES) != hipSuccess) { fprintf(stderr, "kernel_launch: hipFuncSetAttribute failed\n"); grid = -1; return; }
        int per_cu = 0;
        if (hipOccupancyMaxActiveBlocksPerMultiprocessor(&per_cu, (const void*)fwd_kernel, NTHR, LDS_BYTES) != hipSuccess || per_cu < 1) fprintf(stderr, "kernel_launch: occupancy query says %d\n", per_cu);
        (void)hipGetLastError();
        grid = cus > 256 ? 256 : cus;
    }
    if (grid < 0) return;
    (void)hipMemsetAsync((char*)d_ws + WS_CTL, 0, CTL_ZERO_BYTES, stream);
    Args a{};
    for (int i = 0; i < NIN; ++i) a.in[i] = (const float*)d_in[i];
    a.out = (float*)d_out; a.ws = (unsigned char*)d_ws;
#if MK_SINGLE
    a.ph_lo = 0; a.ph_hi = NPHASE;
    hipLaunchKernelGGL(fwd_kernel, dim3(grid), dim3(NTHR), LDS_BYTES, stream, a);
#else
    for (int ph = 0; ph < NPHASE; ++ph) { if (ph >= 10 && ph < 17) continue; a.ph_lo = ph; a.ph_hi = ph + 1; hipLaunchKernelGGL(fwd_kernel, dim3(grid), dim3(NTHR), LDS_BYTES, stream, a); }
#endif
}
```

```cpp
#include <hip/hip_runtime.h>
#include <cstdio>
#include <cstdint>

#ifndef MK_SINGLE
#define MK_SINGLE 1
#endif

namespace pg8 {
#define PG8_LAS __attribute__((address_space(3)))
typedef unsigned short bf16_t;
typedef short bf16x8 __attribute__((ext_vector_type(8)));
typedef float f32x4 __attribute__((ext_vector_type(4)));
typedef unsigned u32x4 __attribute__((ext_vector_type(4)));
constexpr int BM = 256, BK = 64, HALF = 128, HTB = HALF * BK * 2  , STAGE_BYTES = 8 * HTB, NXCD = 8, WGM = 8;

__host__ __device__ __forceinline__ int lds_byte(int r, int c) { const int st = (r >> 4) * 2 + (c >> 5), rr = r & 15, cc = c & 31, ob = rr * 64 + cc * 2; return st * 1024 + (ob ^ (((ob >> 9) & 1) << 5)); }
__host__ __device__ __forceinline__ void stage_rc(int b, int& R, int& C) { const int st = b / 1024, sb = b % 1024, swz = sb ^ (((sb >> 9) & 1) << 5); R = (st >> 1) * 16 + swz / 64; C = (st & 1) * 32 + (swz % 64) / 2; }
__host__ __device__ __forceinline__ int perm32(int rho) { const int n = rho >> 4, i = rho & 15; return 8 * (i >> 2) + 4 * n + (i & 3); }

struct Unit { int pm, pn, om, on; };
struct Gemm { const bf16_t* A; const bf16_t* Bt; int M, N, K; };

__host__ __device__ __forceinline__ bool tile_order(int i, int G, int c, int nM, int nN, int& pm, int& pn) {
    const int nwg = nM * nN; const long L = (long)i * G + c; if (L >= nwg) return false;
    int wgid = (int)L; { const int q = nwg / NXCD, r = nwg % NXCD, xcd = wgid % NXCD, off = wgid / NXCD; wgid = (xcd < r ? xcd * (q + 1) : r * (q + 1) + (xcd - r) * q) + off; }
    const int nig = WGM * nN, gid = wgid / nig, fm = gid * WGM, gsz = (nM - fm) < WGM ? (nM - fm) : WGM;
    pm = fm + ((wgid % nig) % gsz); pn = (wgid % nig) / gsz; return true;
}
struct StaticOrder {
    int nM, nN, G, c;
    __host__ __device__ void init(int M, int N, int G_, int c_) { nM = M / BM; nN = N / BM; G = G_; c = c_; }
    __host__ __device__ bool next(int i, Unit& u) const { int pm, pn; if (!tile_order(i, G, c, nM, nN, pm, pn)) return false; u.pm = pm; u.pn = pn; u.om = pm; u.on = pn; return true; }
    __device__ __forceinline__ void a_ready(const Unit&) const {}
    __device__ __forceinline__ void done(const Unit&) const {}
};
template <bool A_LOCAL, bool O_LOCAL>
struct MoeOrder {
    int t0, nT, nN, G, c; const PG8_LAS int* te;
    __device__ __forceinline__ bool next(int i, Unit& u) const { int pm, pn; if (!tile_order(i, G, c, nT, nN, pm, pn)) return false;
        const int e = __builtin_amdgcn_readfirstlane(te[t0 + pm]);
        u.pm = A_LOCAL ? pm : t0 + pm; u.pn = e * nN + pn; u.om = O_LOCAL ? pm : t0 + pm; u.on = pn; return true; }
    __device__ __forceinline__ void a_ready(const Unit&) const {}
    __device__ __forceinline__ void done(const Unit&) const {}
};

__device__ __forceinline__ unsigned cvt_pk_bf16(float lo, float hi) { unsigned r; asm volatile("v_cvt_pk_bf16_f32 %0, %1, %2" : "=v"(r) : "v"(lo), "v"(hi)); return r; }

typedef int v8i32 __attribute__((ext_vector_type(8)));
__device__ __forceinline__ v8i32 cat16(bf16x8 lo, bf16x8 hi) { const u32x4 a = __builtin_bit_cast(u32x4, lo), b = __builtin_bit_cast(u32x4, hi); return (v8i32){(int)a.x, (int)a.y, (int)a.z, (int)a.w, (int)b.x, (int)b.y, (int)b.z, (int)b.w}; }
__device__ __forceinline__ float clamp448(float x) { return __builtin_fminf(__builtin_fmaxf(x, -448.0f), 448.0f); }
__device__ __forceinline__ unsigned pack_fp8x4(float a, float b, float c, float d) {
    int r = 0; r = __builtin_amdgcn_cvt_pk_fp8_f32(clamp448(a), clamp448(b), r, false); r = __builtin_amdgcn_cvt_pk_fp8_f32(clamp448(c), clamp448(d), r, true); return (unsigned)r; }
struct EpiStore {
    static constexpr bool PERM = true, AFTER_DRAIN = false;
    bf16_t* O; int ldc; float scale;
    __device__ __forceinline__ void operator()(const f32x4 (&acc)[2][2][4][2], const Unit& u, int wr, int wc, int fr, int fq) const {
        const int row0 = u.om * BM + wr * 64 + fr; const int col0 = u.on * BM + wc * 32 + 8 * fq;
#pragma unroll
        for (int ai = 0; ai < 2; ++ai)
#pragma unroll
            for (int m = 0; m < 4; ++m) { bf16_t* rowp = O + (size_t)(row0 + ai * HALF + m * 16) * ldc + col0;
#pragma unroll
                for (int bj = 0; bj < 2; ++bj) { const f32x4 v0 = acc[ai][bj][m][0] * scale, v1 = acc[ai][bj][m][1] * scale;
                    u32x4 w; w.x = cvt_pk_bf16(v0[0], v0[1]); w.y = cvt_pk_bf16(v0[2], v0[3]); w.z = cvt_pk_bf16(v1[0], v1[1]); w.w = cvt_pk_bf16(v1[2], v1[3]);
                    *(u32x4*)(rowp + bj * HALF) = w; } }
    }
};
__device__ __forceinline__ float silu_f(float x) { return x * __builtin_amdgcn_rcpf(1.0f + __expf(-x)); }
struct EpiSwiglu {
    static constexpr bool PERM = true, AFTER_DRAIN = false;
    bf16_t* O; int ldc;
    __device__ __forceinline__ void operator()(const f32x4 (&acc)[2][2][4][2], const Unit& u, int wr, int wc, int fr, int fq) const {
        const int row0 = u.om * BM + wr * 64 + fr; const int col0 = u.on * HALF + wc * 32 + 8 * fq;
#pragma unroll
        for (int ai = 0; ai < 2; ++ai)
#pragma unroll
            for (int m = 0; m < 4; ++m) { bf16_t* rowp = O + (size_t)(row0 + ai * HALF + m * 16) * ldc + col0;
                const f32x4 g0 = acc[ai][0][m][0], g1 = acc[ai][0][m][1], u0 = acc[ai][1][m][0], u1 = acc[ai][1][m][1];
                u32x4 w;
                w.x = cvt_pk_bf16(silu_f(g0[0]) * u0[0], silu_f(g0[1]) * u0[1]); w.y = cvt_pk_bf16(silu_f(g0[2]) * u0[2], silu_f(g0[3]) * u0[3]);
                w.z = cvt_pk_bf16(silu_f(g1[0]) * u1[0], silu_f(g1[1]) * u1[1]); w.w = cvt_pk_bf16(silu_f(g1[2]) * u1[2], silu_f(g1[3]) * u1[3]);
                *(u32x4*)rowp = w; }
    }
};

struct EpiSwiglu8 {
    static constexpr bool PERM = true, AFTER_DRAIN = false;
    unsigned char* O; int ldc; float in_scale, out_scale;
    __device__ __forceinline__ void operator()(const f32x4 (&acc)[2][2][4][2], const Unit& u, int wr, int wc, int fr, int fq) const {
        const int row0 = u.om * BM + wr * 64 + fr; const int col0 = u.on * HALF + wc * 32 + 8 * fq;
#pragma unroll
        for (int ai = 0; ai < 2; ++ai)
#pragma unroll
            for (int m = 0; m < 4; ++m) { unsigned char* rowp = O + (size_t)(row0 + ai * HALF + m * 16) * ldc + col0;
                const f32x4 g0 = acc[ai][0][m][0] * in_scale, g1 = acc[ai][0][m][1] * in_scale, u0 = acc[ai][1][m][0] * (in_scale * out_scale), u1 = acc[ai][1][m][1] * (in_scale * out_scale);
                typedef unsigned u32x2 __attribute__((ext_vector_type(2)));
                u32x2 w;
                w.x = pack_fp8x4(silu_f(g0[0]) * u0[0], silu_f(g0[1]) * u0[1], silu_f(g0[2]) * u0[2], silu_f(g0[3]) * u0[3]);
                w.y = pack_fp8x4(silu_f(g1[0]) * u1[0], silu_f(g1[1]) * u1[1], silu_f(g1[2]) * u1[2], silu_f(g1[3]) * u1[3]);
                *(u32x2*)rowp = w; }
    }
};

template <class Epi, class Sched, bool ALIGN_EPI = false, bool SP2 = false, bool FP8 = false>
__device__ __forceinline__ void gemm_phase(PG8_LAS unsigned char* lds, const Gemm g, const Sched& S, const Epi& E) {
    int tid_ = threadIdx.x; asm volatile("" : "+v"(tid_));
    const int tid = tid_, wid = __builtin_amdgcn_readfirstlane(tid >> 6), lane = tid & 63, wr = wid >> 2, wc = wid & 3, fr = lane & 15, fq = lane >> 4;
    int K_ = g.K; asm volatile("" : "+s"(K_));
    const int K = K_, nt = K / BK;
    unsigned voffA[2], voffB[2];
#pragma unroll
    for (int i = 0; i < 2; ++i) { int R, C; stage_rc(tid * 16 + i * 8192, R, C); const int Rb = Epi::PERM ? ((R & ~31) + perm32(R & 31)) : R;
        voffA[i] = (unsigned)(R * K + C) * 2u; voffB[i] = (unsigned)(Rb * K + C) * 2u; }
    const size_t kstep = (size_t)(BK * 2);
    const size_t hstep = (size_t)HALF * K * 2;
    const size_t tstep = 2 * hstep;
    const unsigned ldsw = (unsigned)wid * 1024u;
    const int aoff = lds_byte(wr * 64 + fr, fq * 8), boff = lds_byte(wc * 32 + fr, fq * 8);
#define PG8_SA(b, h) (((b) * 2 + (h)) * HTB)
#define PG8_SB(b, h) ((4 + (b) * 2 + (h)) * HTB)
#define PG8_STAGE(bufoff, gbase, voff) do { _Pragma("unroll") for (int _i = 0; _i < 2; ++_i) \
        __builtin_amdgcn_global_load_lds((const unsigned*)((const char*)(gbase) + (voff)[_i]), (PG8_LAS unsigned*)(lds + (bufoff) + ldsw + _i * 8192), 16, 0, 0); } while (0)
#define PG8_LDA(dst, dst8, b, h) do { _Pragma("unroll") for (int m = 0; m < 4; ++m) { \
        if constexpr (FP8) dst8[m] = cat16(*(const PG8_LAS bf16x8*)(lds + PG8_SA(b, h) + aoff + m * 2048), *(const PG8_LAS bf16x8*)(lds + PG8_SA(b, h) + aoff + m * 2048 + 1024)); \
        else { _Pragma("unroll") for (int k = 0; k < 2; ++k) dst[m][k] = *(const PG8_LAS bf16x8*)(lds + PG8_SA(b, h) + aoff + m * 2048 + k * 1024); } } } while (0)
#define PG8_LDB(dst, dst8, b, h) do { _Pragma("unroll") for (int n = 0; n < 2; ++n) { \
        if constexpr (FP8) dst8[n] = cat16(*(const PG8_LAS bf16x8*)(lds + PG8_SB(b, h) + boff + n * 2048), *(const PG8_LAS bf16x8*)(lds + PG8_SB(b, h) + boff + n * 2048 + 1024)); \
        else { _Pragma("unroll") for (int k = 0; k < 2; ++k) dst[n][k] = *(const PG8_LAS bf16x8*)(lds + PG8_SB(b, h) + boff + n * 2048 + k * 1024); } } } while (0)
#define PG8_MMA(ai, bj, At, At8, Bt, Bt8) do { __builtin_amdgcn_s_setprio(1); _Pragma("unroll") for (int m = 0; m < 4; ++m) _Pragma("unroll") for (int n = 0; n < 2; ++n) { \
        if constexpr (FP8) { asm volatile("v_mfma_f32_16x16x128_f8f6f4 %0, %1, %2, %0" : "+v"(acc[ai][bj][m][n]) : "v"(Bt8[n]), "v"(At8[m])); } \
        else { _Pragma("unroll") for (int k = 0; k < 2; ++k) acc[ai][bj][m][n] = __builtin_amdgcn_mfma_f32_16x16x32_bf16(Bt[n][k], At[m][k], acc[ai][bj][m][n], 0, 0, 0); } } __builtin_amdgcn_s_setprio(0); } while (0)
#define PG8_WAIT_V(n) asm volatile("s_waitcnt vmcnt(" #n ")" ::: "memory")
#define PG8_WAIT_L(n) asm volatile("s_waitcnt lgkmcnt(" #n ")" ::: "memory")
#define PG8_BAR __builtin_amdgcn_s_barrier()
#define PG8_SCHED __builtin_amdgcn_sched_barrier(0)
    Unit cur, nxt; int ui = 0;
    if (!S.next(0, cur)) return;
    f32x4 acc[2][2][4][2];
#pragma unroll
    for (int a = 0; a < 2; ++a)
#pragma unroll
        for (int b = 0; b < 2; ++b)
#pragma unroll
            for (int m = 0; m < 4; ++m)
#pragma unroll
                for (int n = 0; n < 2; ++n) acc[a][b][m][n] = (f32x4){0.f, 0.f, 0.f, 0.f};
    bf16x8 At[4][2], B0[2][2], B1[2][2]; v8i32 At8[4], B08[2], B18[2];
    const char* cA = (const char*)g.A + (size_t)cur.pm * tstep; const char* cB = (const char*)g.Bt + (size_t)cur.pn * tstep;
    S.a_ready(cur);
    if constexpr (SP2) {
        PG8_STAGE(PG8_SB(0, 0), cB, voffB); PG8_STAGE(PG8_SB(0, 1), cB + hstep, voffB); PG8_STAGE(PG8_SA(0, 0), cA, voffA); PG8_STAGE(PG8_SA(0, 1), cA + hstep, voffA);
        if (wr == 1) PG8_BAR;
        PG8_WAIT_V(2); PG8_BAR;
        PG8_STAGE(PG8_SB(1, 0), cB + kstep, voffB); PG8_STAGE(PG8_SA(1, 0), cA + kstep, voffA); PG8_STAGE(PG8_SB(1, 1), cB + hstep + kstep, voffB);
        PG8_WAIT_V(6); PG8_BAR;
    } else {
        PG8_STAGE(PG8_SB(0, 0), cB, voffB); PG8_STAGE(PG8_SA(0, 0), cA, voffA); PG8_STAGE(PG8_SB(0, 1), cB + hstep, voffB); PG8_STAGE(PG8_SA(0, 1), cA + hstep, voffA);
        if (wr == 1) PG8_BAR;
        PG8_WAIT_V(4); PG8_BAR;
        PG8_STAGE(PG8_SB(1, 0), cB + kstep, voffB); PG8_STAGE(PG8_SA(1, 0), cA + kstep, voffA); PG8_STAGE(PG8_SB(1, 1), cB + hstep + kstep, voffB);
        PG8_WAIT_V(6); PG8_BAR;
    }
    for (;;) {
        const bool has_next = S.next(ui + 1, nxt);
        const char* nA = has_next ? (const char*)g.A + (size_t)nxt.pm * tstep : cA; const char* nB = has_next ? (const char*)g.Bt + (size_t)nxt.pn * tstep : cB;
#pragma unroll 1
        for (int t = 0; t < nt; t += 2) {
            const bool last = (t == nt - 2);
            const char* a1 = cA + (size_t)(t + 1) * kstep;
            const char* a2 = last ? nA : cA + (size_t)(t + 2) * kstep; const char* b2 = last ? nB : cB + (size_t)(t + 2) * kstep;
            const char* a3 = a2 + kstep; const char* b3 = b2 + kstep;
            if (last && has_next) S.a_ready(nxt);
            if constexpr (SP2) {
            PG8_LDB(B0, B08, 0, 0); PG8_LDB(B1, B18, 0, 1); PG8_SCHED; PG8_LDA(At, At8, 0, 0); PG8_STAGE(PG8_SA(1, 1), a1 + hstep, voffA);
            PG8_WAIT_V(8); PG8_WAIT_L(0); PG8_BAR; PG8_MMA(0, 0, At, At8, B0, B08); PG8_MMA(0, 1, At, At8, B1, B18); PG8_BAR; PG8_SCHED;
            PG8_LDA(At, At8, 0, 1); PG8_STAGE(PG8_SB(0, 0), b2, voffB); PG8_STAGE(PG8_SB(0, 1), b2 + hstep, voffB); PG8_STAGE(PG8_SA(0, 0), a2, voffA);
            PG8_WAIT_V(8); PG8_WAIT_L(0); PG8_BAR; PG8_MMA(1, 0, At, At8, B0, B08); PG8_MMA(1, 1, At, At8, B1, B18); PG8_BAR; PG8_SCHED;
            PG8_LDB(B0, B08, 1, 0); PG8_LDB(B1, B18, 1, 1); PG8_SCHED; PG8_LDA(At, At8, 1, 0); PG8_STAGE(PG8_SA(0, 1), a2 + hstep, voffA);
            PG8_WAIT_V(8); PG8_WAIT_L(0); PG8_BAR; PG8_MMA(0, 0, At, At8, B0, B08); PG8_MMA(0, 1, At, At8, B1, B18); PG8_BAR; PG8_SCHED;
            PG8_LDA(At, At8, 1, 1); PG8_STAGE(PG8_SB(1, 0), b3, voffB); PG8_STAGE(PG8_SB(1, 1), b3 + hstep, voffB); PG8_STAGE(PG8_SA(1, 0), a3, voffA);
            PG8_WAIT_V(8); PG8_WAIT_L(0); PG8_BAR; PG8_MMA(1, 0, At, At8, B0, B08); PG8_MMA(1, 1, At, At8, B1, B18); PG8_BAR; PG8_SCHED;
            } else {
            PG8_LDB(B0, B08, 0, 0); PG8_SCHED; PG8_LDA(At, At8, 0, 0); PG8_STAGE(PG8_SA(1, 1), a1 + hstep, voffA);
            PG8_WAIT_L(8); PG8_BAR; PG8_WAIT_L(0); PG8_MMA(0, 0, At, At8, B0, B08); PG8_BAR; PG8_SCHED;
            PG8_LDB(B1, B18, 0, 1); PG8_STAGE(PG8_SB(0, 0), b2, voffB);
            PG8_BAR; PG8_WAIT_L(0); PG8_MMA(0, 1, At, At8, B1, B18); PG8_BAR;
            PG8_LDA(At, At8, 0, 1); PG8_STAGE(PG8_SA(0, 0), a2, voffA);
            PG8_BAR; PG8_WAIT_L(0); PG8_MMA(1, 0, At, At8, B0, B08); PG8_BAR; PG8_SCHED;
            PG8_STAGE(PG8_SB(0, 1), b2 + hstep, voffB);
            PG8_WAIT_V(6); PG8_BAR; PG8_MMA(1, 1, At, At8, B1, B18); PG8_BAR;
            PG8_LDB(B0, B08, 1, 0); PG8_SCHED; PG8_LDA(At, At8, 1, 0); PG8_STAGE(PG8_SA(0, 1), a2 + hstep, voffA);
            PG8_WAIT_L(8); PG8_BAR; PG8_WAIT_L(0); PG8_MMA(0, 0, At, At8, B0, B08); PG8_BAR; PG8_SCHED;
            PG8_LDB(B1, B18, 1, 1); PG8_STAGE(PG8_SB(1, 0), b3, voffB);
            PG8_BAR; PG8_WAIT_L(0); PG8_MMA(0, 1, At, At8, B1, B18); PG8_BAR;
            PG8_LDA(At, At8, 1, 1); PG8_STAGE(PG8_SA(1, 0), a3, voffA);
            PG8_BAR; PG8_WAIT_L(0); PG8_MMA(1, 0, At, At8, B0, B08); PG8_BAR; PG8_SCHED;
            PG8_STAGE(PG8_SB(1, 1), b3 + hstep, voffB);
            PG8_WAIT_V(6); PG8_BAR; PG8_MMA(1, 1, At, At8, B1, B18); PG8_BAR;
            }
        }
        if constexpr (FP8) asm volatile("s_nop 15\n\ts_nop 15" ::: "memory");
        if constexpr (ALIGN_EPI) { if (wr == 0) PG8_BAR; }
        if constexpr (!Epi::AFTER_DRAIN) { E(acc, cur, wr, wc, fr, fq); S.done(cur); }
        if (!has_next) break;
#pragma unroll
        for (int a = 0; a < 2; ++a)
#pragma unroll
            for (int b = 0; b < 2; ++b)
#pragma unroll
                for (int m = 0; m < 4; ++m)
#pragma unroll
                    for (int n = 0; n < 2; ++n) acc[a][b][m][n] = (f32x4){0.f, 0.f, 0.f, 0.f};
        cur = nxt; cA = nA; cB = nB; ++ui;
        if constexpr (ALIGN_EPI) { if (wr == 1) PG8_BAR; }
    }
    PG8_WAIT_V(0);
    if constexpr (!ALIGN_EPI) { if (wr == 0) PG8_BAR; }
    PG8_BAR;
    if constexpr (Epi::AFTER_DRAIN) { E.fused(acc, cur, wr, wc, fr, fq, lds, wid, lane); S.done(cur); }
#undef PG8_SA
#undef PG8_SB
#undef PG8_STAGE
#undef PG8_LDA
#undef PG8_LDB
#undef PG8_MMA
#undef PG8_WAIT_V
#undef PG8_WAIT_L
#undef PG8_BAR
#undef PG8_SCHED
}
}

#define GAS __attribute__((address_space(1)))
#define LAS __attribute__((address_space(3)))
typedef unsigned short bf16;
typedef unsigned v4u __attribute__((ext_vector_type(4)));
typedef unsigned v2u __attribute__((ext_vector_type(2)));
typedef float f32x4 __attribute__((ext_vector_type(4)));
typedef float f32x2 __attribute__((ext_vector_type(2)));
typedef short bf16x8 __attribute__((ext_vector_type(8)));
typedef short v4i16 __attribute__((ext_vector_type(4)));
typedef GAS unsigned gu32;
#define RLX_AGENT __ATOMIC_RELAXED, __HIP_MEMORY_SCOPE_AGENT
#define LDS_WAIT() asm volatile("s_waitcnt lgkmcnt(0)" ::: "memory")
#define VM_WAIT() asm volatile("s_waitcnt vmcnt(0)" ::: "memory")
__device__ __forceinline__ unsigned pk2(float lo, float hi) { return pg8::cvt_pk_bf16(lo, hi); }
__device__ __forceinline__ float bflo(unsigned u) { return __uint_as_float(u << 16); }
__device__ __forceinline__ float bfhi(unsigned u) { return __uint_as_float(u & 0xffff0000u); }
__device__ __forceinline__ float wave_sum(float v) {
#pragma unroll
    for (int o = 1; o < 64; o <<= 1) v += __shfl_xor(v, o);
    return v;
}
__device__ __forceinline__ f32x4 mfma16(bf16x8 a, bf16x8 b, f32x4 c) { return __builtin_amdgcn_mfma_f32_16x16x32_bf16(a, b, c, 0, 0, 0); }
__device__ __forceinline__ v4i16 trrd(LAS unsigned char* p) { return __builtin_amdgcn_ds_read_tr16_b64_v4i16((LAS v4i16*)p); }
__device__ __forceinline__ bf16x8 cat8(v4i16 lo, v4i16 hi) { return (bf16x8){lo[0], lo[1], lo[2], lo[3], hi[0], hi[1], hi[2], hi[3]}; }
__device__ __forceinline__ bf16x8 pack8(float a0, float a1, float a2, float a3, float a4, float a5, float a6, float a7) {
    v4u w; w.x = pk2(a0, a1); w.y = pk2(a2, a3); w.z = pk2(a4, a5); w.w = pk2(a6, a7); return __builtin_bit_cast(bf16x8, w); }
__device__ __forceinline__ float silu(float x) { return x * __builtin_amdgcn_rcpf(1.0f + __expf(-x)); }

#define XB_TMO      128
#define XB_XCNT(j)  (256  + 64 * (j))
#define XB_XSUB(j)  (1280 + 64 * (j))
#define XB_XGEN(j)  (2304 + 64 * (j))
#define XB_TOP      3328
#define XB_TOPGEN   3392
#define XCD_BAR_WORDS 3456
#define XB_SPIN_CAP (1u << 18)

__device__ __forceinline__ unsigned xb_ld(unsigned* p)              { return __hip_atomic_load(p, __ATOMIC_RELAXED, __HIP_MEMORY_SCOPE_AGENT); }
__device__ __forceinline__ unsigned xb_add(unsigned* p, unsigned v) { return __hip_atomic_fetch_add(p, v, __ATOMIC_RELAXED, __HIP_MEMORY_SCOPE_AGENT); }
__device__ __forceinline__ unsigned xb_xcc_id() { return (unsigned)__builtin_amdgcn_s_getreg((3 << 11) | 20) & 0xFu; }
#define XB_SPIN(cond, bar) do { unsigned _sp = 0; while (cond) { __builtin_amdgcn_s_sleep(1); \
    if ((++_sp & 255u) == 0u) { if (xb_ld(&(bar)[XB_TMO])) break; if (_sp > XB_SPIN_CAP) { atomicAdd(&(bar)[XB_TMO], 1u); break; } } } } while (0)

struct XcdBarrier {
    unsigned* bar; unsigned x;
    volatile LAS unsigned* st;
};

__device__ __forceinline__ XcdBarrier xcd_barrier_post(unsigned* bar, volatile LAS unsigned* st) {
    XcdBarrier b; b.bar = bar; b.x = xb_xcc_id(); b.st = st;
    if (threadIdx.x == 0) (void)xb_add(&bar[XB_XCNT(b.x)], 1u);
    return b;
}
__device__ __forceinline__ void xcd_barrier_complete(unsigned* bar, unsigned x, unsigned& nloc, unsigned& nx) {
    const unsigned G = gridDim.x * gridDim.y * gridDim.z;
    unsigned sum, cnt, mine, sp = 0u;
    for (;;) {
        sum = 0u; cnt = 0u; mine = 0u;
#pragma unroll
        for (unsigned j = 0; j < 16; ++j) { const unsigned c = xb_ld(&bar[XB_XCNT(j)]); sum += c; cnt += (c > 0u) ? 1u : 0u; mine = (j == x) ? c : mine; }
        if (sum == G) break;
        __builtin_amdgcn_s_sleep(1);
        if ((++sp & 255u) == 0u) { if (xb_ld(&bar[XB_TMO])) break; if (sp > XB_SPIN_CAP) { atomicAdd(&bar[XB_TMO], 1u); break; } }
    }
    nloc = mine > 0u ? mine : 1u; nx = cnt > 0u ? cnt : 1u;
}

__device__ __forceinline__ void xcd_barrier(const XcdBarrier& b) {
    asm volatile("s_waitcnt vmcnt(0)" ::: "memory");
    __syncthreads();
    if (threadIdx.x == 0) {
        unsigned* bar = b.bar;
        __builtin_amdgcn_s_waitcnt(0);
        unsigned nloc = b.st[0], nx = b.st[1];
        if (nloc == 0u) { xcd_barrier_complete(bar, b.x, nloc, nx); b.st[0] = nloc; b.st[1] = nx; }
        const unsigned old = xb_add(&bar[XB_XSUB(b.x)], 1u);
        const unsigned gen = old / nloc;
        if (old + 1u == (gen + 1u) * nloc) {
            __builtin_amdgcn_fence(__ATOMIC_RELEASE, "agent");
            asm volatile("s_waitcnt vmcnt(0)" ::: "memory");
            const unsigned og = xb_add(&bar[XB_TOP], 1u);
            const unsigned tg = og / nx;
            if (og + 1u == (tg + 1u) * nx) xb_add(&bar[XB_TOPGEN], 1u);
            else XB_SPIN(xb_ld(&bar[XB_TOPGEN]) == tg, bar);
            __builtin_amdgcn_fence(__ATOMIC_ACQUIRE, "agent");
            xb_add(&bar[XB_XGEN(b.x)], 1u);
            asm volatile("s_waitcnt vmcnt(0)" ::: "memory");
        } else {
            XB_SPIN(xb_ld(&bar[XB_XGEN(b.x)]) == gen, bar);
            __builtin_amdgcn_fence(__ATOMIC_ACQUIRE, "agent");
            asm volatile("s_waitcnt vmcnt(0)" ::: "memory");
        }
    }
    __syncthreads();
}

constexpr int NWAVES = 8, NTHR = 512;
constexpr int D = 1024, SEQ = 8192, NBATCH = 4, M = NBATCH * SEQ, NCHUNK = SEQ / 64;
constexpr int DIN = 2824, PN = 2816;
constexpr int PC_Z = 0, PC_XBC = 512, PC_U = 1536, PC_V = 1792, PC_Q = 2048, PC_K = 2304, PC_VV = 2560;
constexpr int DFF = 2816, DFFE = 3584, NEXP = 8;
constexpr int MOE_CH = 128, MOE_NCH = 2, MOE_MAXT = 264;
constexpr int NIN = 27;
constexpr int CVT_SMALL_TASKS = 1408 + 512 + 1408 + 704, MOE_CVT_TASKS = 14336 + 7168, MOE_CVT_EARLY = 4096;
constexpr size_t MiB = 1u << 20;
constexpr size_t WS_CTL = 0, CTL_ZERO_BYTES = 65536;
constexpr size_t WS_AEND = 65536, WS_WGCNT = 98304;
constexpr size_t WS_DTRAW = 1 * MiB, WS_TOKE = 2 * MiB, WS_TOKG = 2 * MiB + 262144, WS_POS = 2 * MiB + 524288;
constexpr size_t WS_WIN = 4 * MiB, WS_WOUT = 15 * MiB, WS_WGU = 19 * MiB, WS_WD = 30 * MiB;
constexpr size_t WS_A1 = 36 * MiB, WS_XBCC = 36 * MiB;
constexpr size_t WS_PROJ = 100 * MiB, WS_MIXED = 100 * MiB, WS_H1 = 100 * MiB;
constexpr size_t WS_ST = 276 * MiB, WS_FOUT = 276 * MiB;
constexpr size_t WS_Y = 340 * MiB;
constexpr size_t WS_HB = 404 * MiB;
constexpr size_t WS_HM = 36 * MiB, WS_XS = 155 * MiB, WS_YM = 221 * MiB, WS_MWD = 353 * MiB, WS_MWGU = 468 * MiB, WS_END = 524 * MiB;
constexpr float FP8_SX = 8.0f, FP8_SW = 64.0f, FP8_SH = 16.0f;
constexpr int CW_BAR = 4096, CW_TQ = 8192;
constexpr int LDS_BYTES = 163840, LDSCTL_OFF = 147456;
constexpr int CTL_MISC = LDSCTL_OFF, CTL_CNT = LDSCTL_OFF + 128, CTL_TE = LDSCTL_OFF + 512;

#ifndef PROBE_DUP
#define PROBE_DUP 0
#endif
#ifndef PROBE_TG
#define PROBE_TG -1
#endif
__device__ __forceinline__ int tgroup_of(int k) {
    if (k == 0) return 0;
    const int L = (k - 1) >> 4, r = (k - 1) & 15;
    if (r == 0 || r == 4) return 1;
    if (r == 1) return 2;
    if (r == 2) return 3;
    if (r == 3) return 4;
    if (r == 5) return L == 0 ? 5 : 9;
    if (L == 0) return r == 8 ? 5 : 6;
    if (r == 6) return 7;
    if (r == 7 + 2 * 2) return 5;
    return 8;
}
#define REP(n) for (int rep_ = 0; rep_ < (((PROBE_DUP >> (n)) & 1) ? 2 : 1); ++rep_)
struct Args { const float* in[NIN]; float* out; unsigned char* ws; int ph_lo, ph_hi; };

#ifndef PROBE_TG
#define PROBE_TG -1
#endif
typedef const __attribute__((address_space(4))) Args* ArgsP;
typedef const __attribute__((address_space(4))) Args& ArgsRef;
struct Frame {
    LAS unsigned char* lds;
    int tid, lane, wave, vcu, G;
#if PROBE_TG >= 30
    unsigned long long tr_acc, tr_mark;
#endif
};
#if PROBE_TG >= 30
#define TR0(F) ((F).tr_mark = __builtin_amdgcn_s_memrealtime())
#define TR(F, id) do { const unsigned long long n_ = __builtin_amdgcn_s_memrealtime(); if ((id) == PROBE_TG) (F).tr_acc += n_ - (F).tr_mark; (F).tr_mark = n_; } while (0)
#else
#define TR0(F) do { } while (0)
#define TR(F, id) do { } while (0)
#endif
__device__ __forceinline__ bool relaunder(ArgsP& p) { asm volatile("" : "+s"(p)); return true; }
__device__ __forceinline__ bool fresh(Frame& F) { int t_ = threadIdx.x; asm volatile("" : "+v"(t_)); F.tid = t_; F.lane = t_ & 63; F.wave = __builtin_amdgcn_readfirstlane(t_ >> 6); return true; }

__device__ __forceinline__ void cvt_task(const float* W, int N, int k0, int n0, bf16* WT, int K, int row0, int lane) {
    const float* s = W + (size_t)k0 * N + n0 + lane;
    bf16* d = WT + (size_t)(row0 + lane) * K + k0;
    float v[64];
#pragma unroll
    for (int j = 0; j < 64; ++j) v[j] = __builtin_nontemporal_load(s + (size_t)j * N);
#pragma unroll
    for (int q = 0; q < 8; ++q) { v4u o; o.x = pk2(v[8 * q], v[8 * q + 1]); o.y = pk2(v[8 * q + 2], v[8 * q + 3]); o.z = pk2(v[8 * q + 4], v[8 * q + 5]); o.w = pk2(v[8 * q + 6], v[8 * q + 7]);
        *(GAS v4u*)(d + 8 * q) = o; }
}
__device__ __forceinline__ void cvt_small_weights(Frame& F, ArgsRef A, int t_lo, int t_hi, int gw, int NGW) {
    bf16* WIN = (bf16*)(A.ws + WS_WIN); bf16* WOUT = (bf16*)(A.ws + WS_WOUT); bf16* WGU = (bf16*)(A.ws + WS_WGU); bf16* WD = (bf16*)(A.ws + WS_WD);
    for (int it = t_lo + gw; it < t_hi; it += NGW) {
        int r = it;
        if (r < 1408) { const int L = r / 704; r %= 704; const int kb = r / 44, nb = r % 44; const int ns = 64 * nb + (64 * nb >= 1536 ? 8 : 0);
            cvt_task(A.in[5] + (size_t)L * D * DIN, DIN, 64 * kb, ns, WIN + (size_t)L * PN * D, D, 64 * nb, F.lane); continue; }
        r -= 1408;
        if (r < 512) { const int L = r / 256; r %= 256; const int kb = r / 16, nb = r % 16;
            cvt_task(A.in[19] + (size_t)L * D * D, D, 64 * kb, 64 * nb, WOUT + (size_t)L * D * D, D, 64 * nb, F.lane); continue; }
        r -= 512;
        if (r < 1408) { const int up = r / 704; r %= 704; const int kb = r / 44, nb = r % 44;
            cvt_task(up ? A.in[21] : A.in[20], DFF, 64 * kb, 64 * nb, WGU, D, 256 * (nb >> 1) + 64 * (nb & 1) + 128 * up, F.lane); continue; }
        r -= 1408;
        { const int kb = r / 16, nb = r % 16; cvt_task(A.in[22], D, 64 * kb, 64 * nb, WD, DFF, 64 * nb, F.lane); }
    }
}
__device__ __forceinline__ void cvt_task8(const float* W, int N, int k0, int n0, unsigned char* WT, int K, int row0, float scale, int lane) {
    const float* s = W + (size_t)k0 * N + n0 + lane;
    unsigned char* d = WT + (size_t)(row0 + lane) * K + k0;
    float v[64];
#pragma unroll
    for (int j = 0; j < 64; ++j) v[j] = __builtin_nontemporal_load(s + (size_t)j * N);
#pragma unroll
    for (int q = 0; q < 4; ++q) { v4u o;
        o.x = pg8::pack_fp8x4(v[16 * q] * scale, v[16 * q + 1] * scale, v[16 * q + 2] * scale, v[16 * q + 3] * scale); o.y = pg8::pack_fp8x4(v[16 * q + 4] * scale, v[16 * q + 5] * scale, v[16 * q + 6] * scale, v[16 * q + 7] * scale);
        o.z = pg8::pack_fp8x4(v[16 * q + 8] * scale, v[16 * q + 9] * scale, v[16 * q + 10] * scale, v[16 * q + 11] * scale); o.w = pg8::pack_fp8x4(v[16 * q + 12] * scale, v[16 * q + 13] * scale, v[16 * q + 14] * scale, v[16 * q + 15] * scale);
        *(GAS v4u*)(d + 16 * q) = o; }
}
__device__ __forceinline__ void cvt_moe_weights(Frame& F, ArgsRef A, int t_lo, int t_hi, int gw, int NGW) {
    unsigned char* MWGU = A.ws + WS_MWGU; unsigned char* MWD = A.ws + WS_MWD;
    for (int it = t_lo + gw; it < t_hi; it += NGW) {
        int r = it;
        if (r < 14336) { const int ue = r / 896; r %= 896; const int up = ue >> 3, e = ue & 7; const int kb = r / 56, nb = r % 56;
            cvt_task8((up ? A.in[25] : A.in[24]) + (size_t)e * D * DFFE, DFFE, 64 * kb, 64 * nb, MWGU + (size_t)e * 7168 * D, D, 256 * (nb >> 1) + 64 * (nb & 1) + 128 * up, FP8_SW, F.lane); continue; }
        r -= 14336;
        { const int e = r / 896; r %= 896; const int kb = r / 16, nb = r % 16;
          cvt_task8(A.in[26] + (size_t)e * DFFE * D, D, 64 * kb, 64 * nb, MWD + (size_t)e * D * DFFE, DFFE, 64 * nb, FP8_SW, F.lane); }
    }
}

struct RowArgs {
    const float* hsrc; float* hdst;
    const bf16* hsrc16; bf16* hdst16;
    int branch;
    const bf16* ybuf; const float* gpost;
    const float* gpre; bf16* a1;
    int proj;
    const float* w8; int w8ld;
};
__device__ __forceinline__ void row_phase(Frame& F, ArgsRef A, const RowArgs& R) {
    LAS float* W8T = (LAS float*)F.lds;
    LAS int* cnt = (LAS int*)(F.lds + CTL_CNT);
    const int lane = F.lane;
    if (R.proj) { for (int idx = F.tid; idx < 8192; idx += NTHR) { const int e = idx & 7, k = idx >> 3; W8T[e * 1024 + k] = R.w8[(size_t)k * R.w8ld + e]; } }
    if (R.proj == 2 && F.tid < 8) cnt[F.tid] = 0;
    __syncthreads();
    f32x4 gpo[4], gpr[4];
#pragma unroll
    for (int j = 0; j < 4; ++j) { gpo[j] = R.branch ? *(const f32x4*)(R.gpost + 4 * lane + 256 * j) : (f32x4){0.f, 0.f, 0.f, 0.f}; gpr[j] = R.gpre ? *(const f32x4*)(R.gpre + 4 * lane + 256 * j) : (f32x4){0.f, 0.f, 0.f, 0.f}; }
    float* DTRAW = (float*)(A.ws + WS_DTRAW); int* TOKE = (int*)(A.ws + WS_TOKE); float* TOKG = (float*)(A.ws + WS_TOKG); const int* POS = (const int*)(A.ws + WS_POS);
    const int gw = F.vcu * NWAVES + F.wave, NGW = F.G * NWAVES;
    f32x4 hf[4][4]; v2u hp[4][4], y0p[4][4], y1p[4][4]; int ip0[4], ip1[4]; float ig0[4], ig1[4], gc0[4], gc1[4];
#define ROW_IDX(q, mm) do { if (R.branch == 2 && (mm) < M) { ip0[q] = POS[2 * (mm)]; ip1[q] = POS[2 * (mm) + 1]; ig0[q] = TOKG[2 * (mm)]; ig1[q] = TOKG[2 * (mm) + 1]; } } while (0)
#define ROW_DATA(q, mm) do { if ((mm) < M) { \
        if (R.hsrc) { _Pragma("unroll") for (int j = 0; j < 4; ++j) hf[q][j] = *(const f32x4*)(R.hsrc + (size_t)(mm) * D + 4 * lane + 256 * j); } \
        else { _Pragma("unroll") for (int j = 0; j < 4; ++j) hp[q][j] = *(const v2u*)(R.hsrc16 + (size_t)(mm) * D + 4 * lane + 256 * j); } \
        if (R.branch == 1) { _Pragma("unroll") for (int j = 0; j < 4; ++j) y0p[q][j] = *(const v2u*)(R.ybuf + (size_t)(mm) * D + 4 * lane + 256 * j); } \
        if (R.branch == 2) { gc0[q] = ig0[q]; gc1[q] = ig1[q]; _Pragma("unroll") for (int j = 0; j < 4; ++j) { y0p[q][j] = *(const v2u*)(R.ybuf + (size_t)ip0[q] * D + 4 * lane + 256 * j); y1p[q][j] = *(const v2u*)(R.ybuf + (size_t)ip1[q] * D + 4 * lane + 256 * j); } } } } while (0)
#pragma unroll
    for (int q = 0; q < 4; ++q) { ip0[q] = 0; ip1[q] = 0; ig0[q] = 0.f; ig1[q] = 0.f; gc0[q] = 0.f; gc1[q] = 0.f; ROW_IDX(q, gw + q * NGW); }
#pragma unroll
    for (int q = 0; q < 4; ++q) { ROW_DATA(q, gw + q * NGW); ROW_IDX(q, gw + (q + 4) * NGW); }
    for (int mb = gw; mb < M; mb += 4 * NGW) {
#pragma unroll
        for (int q = 0; q < 4; ++q) {
        const int m = mb + q * NGW;
        if (m < M) {
        f32x4 v[4], y[4];
#pragma unroll
        for (int j = 0; j < 4; ++j) v[j] = R.hsrc ? hf[q][j] : (f32x4){bflo(hp[q][j].x), bfhi(hp[q][j].x), bflo(hp[q][j].y), bfhi(hp[q][j].y)};
        if (R.branch == 1) {
#pragma unroll
            for (int j = 0; j < 4; ++j) y[j] = (f32x4){bflo(y0p[q][j].x), bfhi(y0p[q][j].x), bflo(y0p[q][j].y), bfhi(y0p[q][j].y)};
        } else if (R.branch == 2) {
#pragma unroll
            for (int j = 0; j < 4; ++j) y[j] = (f32x4){gc0[q] * bflo(y0p[q][j].x) + gc1[q] * bflo(y1p[q][j].x), gc0[q] * bfhi(y0p[q][j].x) + gc1[q] * bfhi(y1p[q][j].x), gc0[q] * bflo(y0p[q][j].y) + gc1[q] * bflo(y1p[q][j].y), gc0[q] * bfhi(y0p[q][j].y) + gc1[q] * bfhi(y1p[q][j].y)};
        }
        ROW_DATA(q, m + 4 * NGW); ROW_IDX(q, m + 8 * NGW);
        if (R.branch) {
            float ss = 0.f;
#pragma unroll
            for (int j = 0; j < 4; ++j) ss += (y[j].x * y[j].x + y[j].y * y[j].y) + (y[j].z * y[j].z + y[j].w * y[j].w);
            const float sc = 1.0f / sqrtf(wave_sum(ss) * (1.0f / D) + 1e-6f);
#pragma unroll
            for (int j = 0; j < 4; ++j) v[j] = v[j] + y[j] * sc * gpo[j];
        }
        if (R.hdst) {
#pragma unroll
            for (int j = 0; j < 4; ++j) *(f32x4*)(R.hdst + (size_t)m * D + 4 * lane + 256 * j) = v[j];
        }
        if (R.hdst16) {
#pragma unroll
            for (int j = 0; j < 4; ++j) { v2u o; o.x = pk2(v[j].x, v[j].y); o.y = pk2(v[j].z, v[j].w); *(v2u*)(R.hdst16 + (size_t)m * D + 4 * lane + 256 * j) = o; }
        }
        if (R.gpre) {
            float ss = 0.f;
#pragma unroll
            for (int j = 0; j < 4; ++j) ss += (v[j].x * v[j].x + v[j].y * v[j].y) + (v[j].z * v[j].z + v[j].w * v[j].w);
            const float sc = 1.0f / sqrtf(wave_sum(ss) * (1.0f / D) + 1e-6f);
#pragma unroll
            for (int j = 0; j < 4; ++j) { v[j] = v[j] * sc * gpr[j]; v2u o; o.x = pk2(v[j].x, v[j].y); o.y = pk2(v[j].z, v[j].w); *(v2u*)(R.a1 + (size_t)m * D + 4 * lane + 256 * j) = o; }
            if (R.proj) {
                float p[8];
#pragma unroll
                for (int e = 0; e < 8; ++e) { float s = 0.f;
#pragma unroll
                    for (int j = 0; j < 4; ++j) { const f32x4 w = *(const LAS f32x4*)(W8T + e * 1024 + 4 * lane + 256 * j); s += (v[j].x * w.x + v[j].y * w.y) + (v[j].z * w.z + v[j].w * w.w); }
                    p[e] = wave_sum(s); }
                if (R.proj == 1) {
                    float mine = p[0];
#pragma unroll
                    for (int e = 1; e < 8; ++e) mine = (lane == e) ? p[e] : mine;
                    if (lane < 8) DTRAW[(size_t)m * 8 + lane] = mine;
                } else {
                    float best = p[0]; int bi = 0;
#pragma unroll
                    for (int e = 1; e < 8; ++e) if (p[e] > best) { best = p[e]; bi = e; }
                    float sb = -3.0e38f; int si = 0;
#pragma unroll
                    for (int e = 0; e < 8; ++e) if (e != bi && p[e] > sb) { sb = p[e]; si = e; }
                    const float g0 = 1.0f / (1.0f + expf(sb - best)), g1 = 1.0f - g0;
                    if (lane == 0) { TOKE[2 * m] = bi; TOKE[2 * m + 1] = si; TOKG[2 * m] = g0; TOKG[2 * m + 1] = g1;
                        __hip_atomic_fetch_add(cnt + bi, 1, __ATOMIC_RELAXED, __HIP_MEMORY_SCOPE_WORKGROUP); __hip_atomic_fetch_add(cnt + si, 1, __ATOMIC_RELAXED, __HIP_MEMORY_SCOPE_WORKGROUP); }
                }
            }
        }
        } }
    }
#undef ROW_DATA
#undef ROW_IDX
    if (R.proj == 2) { __syncthreads(); if (F.tid < 8) ((int*)(A.ws + WS_WGCNT))[F.vcu * 8 + F.tid] = cnt[F.tid]; }
    __syncthreads();
}

__device__ __forceinline__ void moe_tables(Frame& F, ArgsRef A) {
    LAS int* c = (LAS int*)(F.lds + CTL_CNT); LAS int* te = (LAS int*)(F.lds + CTL_TE);
    if (F.tid < 48) c[F.tid] = 0;
    __syncthreads();
    const int* WGCNT = (const int*)(A.ws + WS_WGCNT);
    for (int idx = F.tid; idx < F.G * 8; idx += NTHR) { const int wg = idx >> 3, e = idx & 7; const int v = WGCNT[idx];
        __hip_atomic_fetch_add(c + e, v, __ATOMIC_RELAXED, __HIP_MEMORY_SCOPE_WORKGROUP); if (wg < F.vcu) __hip_atomic_fetch_add(c + 8 + e, v, __ATOMIC_RELAXED, __HIP_MEMORY_SCOPE_WORKGROUP); }
    __syncthreads();
    if (F.tid == 0) { int t = 0;
#pragma unroll 1
        for (int e = 0; e < 8; ++e) { c[16 + e] = t * 256; t += (c[e] + 255) >> 8; c[40 + e] = t; }
        c[32] = t < MOE_MAXT ? t : MOE_MAXT; }
    __syncthreads();
    if (F.tid < MOE_MAXT) { int e = 0;
#pragma unroll
        for (int q = 0; q < 7; ++q) e += (F.tid >= c[40 + q]) ? 1 : 0;
        te[F.tid] = e; }
    __syncthreads();
}
__device__ __forceinline__ void moe_gather(Frame& F, ArgsRef A) {
    LAS int* c = (LAS int*)(F.lds + CTL_CNT);
    const int* TOKE = (const int*)(A.ws + WS_TOKE); int* POS = (int*)(A.ws + WS_POS);
    const bf16* A1 = (const bf16*)(A.ws + WS_A1); unsigned char* XS = A.ws + WS_XS;
    const int gw = F.vcu * NWAVES + F.wave, NGW = F.G * NWAVES, lane = F.lane;
    for (int mb = gw; mb < M; mb += 4 * NGW) {
        v4u r0[4], r1[4]; int d0[4], d1[4];
#pragma unroll
        for (int q = 0; q < 4; ++q) { const int m = mb + q * NGW; d0[q] = 0; d1[q] = 0;
            if (m < M) { r0[q] = *(const v4u*)(A1 + (size_t)m * D + 16 * lane); r1[q] = *(const v4u*)(A1 + (size_t)m * D + 16 * lane + 8);
                if (lane == 0) { const int e0 = TOKE[2 * m], e1 = TOKE[2 * m + 1];
                    d0[q] = c[16 + e0] + c[8 + e0] + __hip_atomic_fetch_add(c + 24 + e0, 1, __ATOMIC_RELAXED, __HIP_MEMORY_SCOPE_WORKGROUP);
                    d1[q] = c[16 + e1] + c[8 + e1] + __hip_atomic_fetch_add(c + 24 + e1, 1, __ATOMIC_RELAXED, __HIP_MEMORY_SCOPE_WORKGROUP);
                    POS[2 * m] = d0[q]; POS[2 * m + 1] = d1[q]; } } }
#pragma unroll
        for (int q = 0; q < 4; ++q) { const int m = mb + q * NGW;
            if (m < M) { const int e0 = __builtin_amdgcn_readfirstlane(d0[q]), e1 = __builtin_amdgcn_readfirstlane(d1[q]);
                v4u o;
                o.x = pg8::pack_fp8x4(bflo(r0[q].x) * FP8_SX, bfhi(r0[q].x) * FP8_SX, bflo(r0[q].y) * FP8_SX, bfhi(r0[q].y) * FP8_SX); o.y = pg8::pack_fp8x4(bflo(r0[q].z) * FP8_SX, bfhi(r0[q].z) * FP8_SX, bflo(r0[q].w) * FP8_SX, bfhi(r0[q].w) * FP8_SX);
                o.z = pg8::pack_fp8x4(bflo(r1[q].x) * FP8_SX, bfhi(r1[q].x) * FP8_SX, bflo(r1[q].y) * FP8_SX, bfhi(r1[q].y) * FP8_SX); o.w = pg8::pack_fp8x4(bflo(r1[q].z) * FP8_SX, bfhi(r1[q].z) * FP8_SX, bflo(r1[q].w) * FP8_SX, bfhi(r1[q].w) * FP8_SX);
                *(v4u*)(XS + (size_t)e0 * D + 16 * lane) = o; *(v4u*)(XS + (size_t)e1 * D + 16 * lane) = o; } }
    }
    __syncthreads();
}

__device__ __forceinline__ void gmlp_unit(Frame& F, ArgsRef A, int L, int nb) {
    LAS unsigned char* Ls = F.lds; int tl_ = F.tid; asm volatile("" : "+v"(tl_));
    const int tid = tl_, lane = tid & 63, w = F.wave, fr = lane & 15, q4 = lane >> 4;
    const size_t m0 = (size_t)nb * 128;
    const bf16* P = (const bf16*)(A.ws + WS_PROJ); bf16* Y = (bf16*)(A.ws + WS_Y);
    { const f32x4 g4 = *(const f32x4*)(A.in[12] + L * 256 + 4 * lane), b4 = *(const f32x4*)(A.in[13] + L * 256 + 4 * lane);
      v2u rawv[16];
#pragma unroll
      for (int i = 0; i < 16; ++i) rawv[i] = *(const v2u*)(P + (m0 + 16 * w + i) * PN + PC_V + 4 * lane);
#pragma unroll
      for (int i = 0; i < 16; ++i) { const int r = 16 * w + i;
        const v2u raw = rawv[i];
        f32x4 v = (f32x4){bflo(raw.x), bfhi(raw.x), bflo(raw.y), bfhi(raw.y)};
        const float mu = wave_sum((v.x + v.y) + (v.z + v.w)) * (1.0f / 256.0f);
        v = v - mu;
        const float var = wave_sum((v.x * v.x + v.y * v.y) + (v.z * v.z + v.w * v.w)) * (1.0f / 256.0f);
        const float rstd = 1.0f / sqrtf(var + 1e-5f);
        v = v * rstd * g4 + b4;
        v2u o; o.x = pk2(v.x, v.y); o.y = pk2(v.z, v.w);
        *(LAS v2u*)(Ls + r * 544 + lane * 8) = o; } }
    const int g = w & 3;
    f32x4 acc[4][4];
    const float* Wg = A.in[14] + (size_t)(L * 4 + g) * 128 * 128;
    const float* bsg = A.in[15] + (size_t)(L * 4 + g) * 128;
    f32x4 wfa[4][4], wfb[4][4];
#pragma unroll
    for (int pi = 0; pi < 4; ++pi) {
        const int it = (w >> 2) == 0 ? (pi == 0 ? 0 : pi == 1 ? 7 : pi == 2 ? 1 : 6) : (pi == 0 ? 2 : pi == 1 ? 5 : pi == 2 ? 3 : 4);
#pragma unroll
        for (int ks = 0; ks < 4; ++ks) { wfa[pi][ks] = *(const f32x4*)(Wg + (16 * it + fr) * 128 + 32 * ks + 4 * q4); wfb[pi][ks] = *(const f32x4*)(Wg + (16 * it + fr) * 128 + 32 * ks + 4 * q4 + 16); }
    }
    __syncthreads();
#pragma unroll
    for (int pi = 0; pi < 4; ++pi) {
        const int it = (w >> 2) == 0 ? (pi == 0 ? 0 : pi == 1 ? 7 : pi == 2 ? 1 : 6) : (pi == 0 ? 2 : pi == 1 ? 5 : pi == 2 ? 3 : 4);
#pragma unroll
        for (int ct = 0; ct < 4; ++ct) acc[pi][ct] = (f32x4){0.f, 0.f, 0.f, 0.f};
        const int t = 16 * it + fr, nks = (it >> 1) + 1;
#pragma unroll
        for (int ks = 0; ks < 4; ++ks) {
            if (ks < nks) {
            const int sA = 32 * ks + 4 * q4, sB = sA + 16;
            const f32x4 wa = wfa[pi][ks], wb = wfb[pi][ks];
            const bf16x8 xf = pack8(sA + 0 <= t ? wa.x : 0.f, sA + 1 <= t ? wa.y : 0.f, sA + 2 <= t ? wa.z : 0.f, sA + 3 <= t ? wa.w : 0.f,
                                    sB + 0 <= t ? wb.x : 0.f, sB + 1 <= t ? wb.y : 0.f, sB + 2 <= t ? wb.z : 0.f, sB + 3 <= t ? wb.w : 0.f);
#pragma unroll
            for (int ct = 0; ct < 4; ++ct) { const int col = g * 64 + ct * 16 + 4 * (lane & 3);
                const v4i16 lo = trrd(Ls + (sA + (fr >> 2)) * 544 + col * 2), hi = trrd(Ls + (sB + (fr >> 2)) * 544 + col * 2);
                acc[pi][ct] = mfma16(xf, cat8(lo, hi), acc[pi][ct]); }
            }
        }
#pragma unroll
        for (int r = 0; r < 4; ++r) { const float bs = bsg[16 * it + 4 * q4 + r];
#pragma unroll
            for (int ct = 0; ct < 4; ++ct) acc[pi][ct][r] += bs; }
    }
    __syncthreads();
#pragma unroll
    for (int pi = 0; pi < 4; ++pi) {
        const int it = (w >> 2) == 0 ? (pi == 0 ? 0 : pi == 1 ? 7 : pi == 2 ? 1 : 6) : (pi == 0 ? 2 : pi == 1 ? 5 : pi == 2 ? 3 : 4);
#pragma unroll
        for (int ct = 0; ct < 4; ++ct)
#pragma unroll
            for (int r = 0; r < 4; ++r) *(LAS float*)(Ls + (16 * it + 4 * q4 + r) * 1040 + (g * 64 + ct * 16 + fr) * 4) = acc[pi][ct][r];
    }
    __syncthreads();
    { const f32x4 gn = *(const f32x4*)(A.in[16] + L * 256 + 4 * lane);
      v2u rawu[16];
#pragma unroll
      for (int i = 0; i < 16; ++i) rawu[i] = *(const v2u*)(P + (m0 + 16 * w + i) * PN + PC_U + 4 * lane);
#pragma unroll
      for (int i = 0; i < 16; ++i) { const int r = 16 * w + i;
        const f32x4 mx = *(const LAS f32x4*)(Ls + r * 1040 + lane * 16);
        const v2u raw = rawu[i];
        f32x4 v = (f32x4){bflo(raw.x), bfhi(raw.x), bflo(raw.y), bfhi(raw.y)} * mx;
        const float ss = wave_sum((v.x * v.x + v.y * v.y) + (v.z * v.z + v.w * v.w)) * (1.0f / 256.0f);
        v = v * (1.0f / sqrtf(ss + 1e-6f)) * gn;
        v2u o; o.x = pk2(v.x, v.y); o.y = pk2(v.z, v.w);
        *(v2u*)(Y + (m0 + r) * D + 512 + 4 * lane) = o; } }
    __syncthreads();
}

__device__ __forceinline__ void attn_unit(Frame& F, ArgsRef A, int L, int bc) {
    LAS unsigned char* Ls = F.lds; int tl_ = F.tid; asm volatile("" : "+v"(tl_));
    const int tid = tl_, lane = tid & 63, w = F.wave, fr = lane & 15, q4 = lane >> 4;
    const int b = bc >> 7, c = bc & 127; const size_t m0 = (size_t)b * SEQ + (size_t)c * 64;
    const bf16* P = (const bf16*)(A.ws + WS_PROJ); bf16* Y = (bf16*)(A.ws + WS_Y);
    const int h = w >> 1, qh = w & 1;
    LAS unsigned char* Vb = Ls + w * 10240;
    TR0(F);
    LAS float* BT = (LAS float*)(Ls + 81920);
    constexpr float LOG2E = 1.4426950408889634f;
    for (int i = tid; i < 4 * 257; i += NTHR) BT[i] = A.in[17][(size_t)L * 4 * 257 + i] * LOG2E;
    bf16x8 qf[2][2];
#pragma unroll
    for (int qb = 0; qb < 2; ++qb)
#pragma unroll
        for (int ks = 0; ks < 2; ++ks) qf[qb][ks] = *(const bf16x8*)(P + (m0 + 32 * qh + 16 * qb + fr) * PN + PC_Q + h * 64 + 32 * ks + 8 * q4);
    f32x4 o[4][2];
#pragma unroll
    for (int dt = 0; dt < 4; ++dt) { o[dt][0] = (f32x4){0.f, 0.f, 0.f, 0.f}; o[dt][1] = (f32x4){0.f, 0.f, 0.f, 0.f}; }
    float mrun[2] = {-1e30f, -1e30f}, lrun[2] = {0.f, 0.f};
    const int jmin = c >= 8 ? 0 : 8 - c;
    const bf16* Kp = P + PC_K + h * 64 + 8 * q4 + (size_t)fr * PN;
    const bf16* Vp = P + PC_VV + h * 64 + (lane & 7) * 8 + (size_t)(lane >> 3) * PN;
    bf16x8 kreg[4][2]; v4u vreg[8];
    { const size_t kr0 = m0 - (size_t)(8 - jmin) * 64;
#pragma unroll
      for (int kt = 0; kt < 4; ++kt)
#pragma unroll
          for (int ks = 0; ks < 2; ++ks) kreg[kt][ks] = *(const bf16x8*)(Kp + (kr0 + 16 * kt) * PN + 32 * ks);
#pragma unroll
      for (int i = 0; i < 8; ++i) vreg[i] = *(const v4u*)(Vp + (kr0 + 8 * i) * PN); }
    __syncthreads();
    TR(F, 33);
    const float cb = BT[h * 257 + 256];
    for (int j = jmin; j <= 8; ++j) {
        const int jn = j < 8 ? j + 1 : 8; const size_t krn = m0 - (size_t)(8 - jn) * 64;
#pragma unroll
        for (int i = 0; i < 8; ++i) *(LAS v4u*)(Vb + (i * 8 + (lane >> 3)) * 160 + (lane & 7) * 16) = vreg[i];
#pragma unroll
        for (int i = 0; i < 8; ++i) vreg[i] = *(const v4u*)(Vp + (krn + 8 * i) * PN);
        f32x4 st[4][2];
#pragma unroll
        for (int kt = 0; kt < 4; ++kt) { st[kt][0] = (f32x4){0.f, 0.f, 0.f, 0.f}; st[kt][1] = (f32x4){0.f, 0.f, 0.f, 0.f};
#pragma unroll
            for (int ks = 0; ks < 2; ++ks) { st[kt][0] = mfma16(kreg[kt][ks], qf[0][ks], st[kt][0]); st[kt][1] = mfma16(kreg[kt][ks], qf[1][ks], st[kt][1]); } }
#pragma unroll
        for (int kt = 0; kt < 4; ++kt)
#pragma unroll
            for (int ks = 0; ks < 2; ++ks) kreg[kt][ks] = *(const bf16x8*)(Kp + (krn + 16 * kt) * PN + 32 * ks);
#pragma unroll
        for (int qb = 0; qb < 2; ++qb) {
            float mx = -1e30f;
            if (j <= 5) {
#pragma unroll
                for (int kt = 0; kt < 4; ++kt)
#pragma unroll
                    for (int r = 0; r < 4; ++r) { const float s = st[kt][qb][r] * (0.125f * LOG2E) + cb; st[kt][qb][r] = s; mx = fmaxf(mx, s); }
            } else {
                const LAS float* bt = BT + h * 257 + (512 - 64 * j + 32 * qh + 16 * qb + fr - 4 * q4 + 128);
                const int i0 = 512 - 64 * j + 32 * qh + 16 * qb + fr - 4 * q4 + 128;
#pragma unroll
                for (int kt = 0; kt < 4; ++kt)
#pragma unroll
                    for (int r = 0; r < 4; ++r) { int idx = i0 - 16 * kt - r; idx = idx > 256 ? 256 : idx;
                        const float s = st[kt][qb][r] * (0.125f * LOG2E) + BT[h * 257 + idx]; st[kt][qb][r] = s; mx = fmaxf(mx, s); }
                (void)bt;
            }
            mx = fmaxf(mx, __shfl_xor(mx, 16)); mx = fmaxf(mx, __shfl_xor(mx, 32));
            const float mold = mrun[qb], mnew = fmaxf(mold, mx); mrun[qb] = mnew;
            float rs = 0.f;
#pragma unroll
            for (int kt = 0; kt < 4; ++kt)
#pragma unroll
                for (int r = 0; r < 4; ++r) { const float p = __builtin_amdgcn_exp2f(st[kt][qb][r] - mnew); st[kt][qb][r] = p; rs += p; }
            rs += __shfl_xor(rs, 16); rs += __shfl_xor(rs, 32);
            if (__any(mnew > mold)) { const float alpha = __builtin_amdgcn_exp2f(mold - mnew); lrun[qb] = lrun[qb] * alpha + rs;
#pragma unroll
                for (int dt = 0; dt < 4; ++dt) o[dt][qb] = o[dt][qb] * alpha; }
            else lrun[qb] += rs;
        }
#pragma unroll
        for (int kk = 0; kk < 2; ++kk) {
            const bf16x8 y0 = pack8(st[2 * kk][0][0], st[2 * kk][0][1], st[2 * kk][0][2], st[2 * kk][0][3], st[2 * kk + 1][0][0], st[2 * kk + 1][0][1], st[2 * kk + 1][0][2], st[2 * kk + 1][0][3]);
            const bf16x8 y1 = pack8(st[2 * kk][1][0], st[2 * kk][1][1], st[2 * kk][1][2], st[2 * kk][1][3], st[2 * kk + 1][1][0], st[2 * kk + 1][1][1], st[2 * kk + 1][1][2], st[2 * kk + 1][1][3]);
            const int rowA = 32 * kk + 4 * q4 + (fr >> 2), rowB = rowA + 16;
#pragma unroll
            for (int dt = 0; dt < 4; ++dt) { const int cbt = (16 * dt + 4 * (lane & 3)) * 2;
                const bf16x8 xf = cat8(trrd(Vb + rowA * 160 + cbt), trrd(Vb + rowB * 160 + cbt));
                o[dt][0] = mfma16(xf, y0, o[dt][0]); o[dt][1] = mfma16(xf, y1, o[dt][1]); }
        }
    }
    const float il0 = 1.0f / lrun[0], il1 = 1.0f / lrun[1];
    __syncthreads();
    TR(F, 34);
#pragma unroll
    for (int dt = 0; dt < 4; ++dt) {
        *(LAS f32x4*)(Ls + (32 * qh + fr) * 1040 + (h * 64 + 16 * dt + 4 * q4) * 4) = o[dt][0] * il0;
        *(LAS f32x4*)(Ls + (32 * qh + 16 + fr) * 1040 + (h * 64 + 16 * dt + 4 * q4) * 4) = o[dt][1] * il1; }
    __syncthreads();
    { const f32x4 gn = *(const f32x4*)(A.in[18] + L * 256 + 4 * lane);
#pragma unroll 2
      for (int i = 0; i < 8; ++i) { const int r = 8 * w + i;
        f32x4 v = *(const LAS f32x4*)(Ls + r * 1040 + lane * 16);
        const float ss = wave_sum((v.x * v.x + v.y * v.y) + (v.z * v.z + v.w * v.w)) * (1.0f / 256.0f);
        v = v * (1.0f / sqrtf(ss + 1e-6f)) * gn;
        v2u ov; ov.x = pk2(v.x, v.y); ov.y = pk2(v.z, v.w);
        *(v2u*)(Y + (m0 + r) * D + 768 + 4 * lane) = ov; } }
    __syncthreads();
    TR(F, 35);
}

__device__ __forceinline__ void ssd_prepass(Frame& F, ArgsRef A, int L, size_t m0, LAS float* dtl, LAS float* acs) {
    const float* DTRAW = (const float*)(A.ws + WS_DTRAW);
    { const int l = F.lane, h = F.wave;
      const float x = DTRAW[(m0 + l) * 8 + h] + A.in[8][L * 8 + h];
      const float dt = x > 20.f ? x : log1pf(expf(x));
      float s = -dt * expf(A.in[9][L * 8 + h]);
#pragma unroll
      for (int o = 1; o < 64; o <<= 1) { const float t = __shfl_up(s, o); s += (l >= o) ? t : 0.f; }
      dtl[l * 8 + h] = dt; acs[l * 8 + h] = s; }
    __syncthreads();
}
__device__ __forceinline__ void ssd1_unit(Frame& F, ArgsRef A, int L, int bc) {
    LAS unsigned char* Ls = F.lds; int tl_ = F.tid; asm volatile("" : "+v"(tl_));
    const int tid = tl_, lane = tid & 63, w = F.wave, fr = lane & 15, q4 = lane >> 4;
    const int b = bc >> 7, c = bc & 127; const size_t m0 = (size_t)b * SEQ + (size_t)c * 64;
    const bf16* P = (const bf16*)(A.ws + WS_PROJ); bf16* XBCC = (bf16*)(A.ws + WS_XBCC); bf16* ST = (bf16*)(A.ws + WS_ST); float* AEND = (float*)(A.ws + WS_AEND);
    LAS unsigned char* XI = Ls; LAS unsigned char* BI = Ls + 67584;
    LAS float* dtl = (LAS float*)(Ls + 102400); LAS float* acs = (LAS float*)(Ls + 104448);
    const int cg = tid & 127, tg = tid >> 7, ch0 = 8 * cg;
    v4u raw[19];
#define SSD1_ROW(tt) do { const int lp = 16 * tg - 3 + (tt); const bool ok = (c * 64 + lp) >= 0; \
        raw[tt] = ok ? *(const v4u*)(P + (size_t)((long)m0 + lp) * PN + PC_XBC + ch0) : (v4u){0u, 0u, 0u, 0u}; } while (0)
#pragma unroll
    for (int tt = 0; tt < 11; ++tt) SSD1_ROW(tt);
    TR0(F);
    ssd_prepass(F, A, L, m0, dtl, acs);
    TR(F, 30);
    if (tid < 8) AEND[(size_t)bc * 8 + tid] = acs[63 * 8 + tid];
    { float wk[4][8], bs[8];
#pragma unroll
      for (int k = 0; k < 4; ++k) { const f32x4 a = *(const f32x4*)(A.in[6] + (size_t)(L * 4 + k) * 1024 + ch0), bq = *(const f32x4*)(A.in[6] + (size_t)(L * 4 + k) * 1024 + ch0 + 4);
          wk[k][0] = a.x; wk[k][1] = a.y; wk[k][2] = a.z; wk[k][3] = a.w; wk[k][4] = bq.x; wk[k][5] = bq.y; wk[k][6] = bq.z; wk[k][7] = bq.w; }
      { const f32x4 a = *(const f32x4*)(A.in[7] + (size_t)L * 1024 + ch0), bq = *(const f32x4*)(A.in[7] + (size_t)L * 1024 + ch0 + 4);
          bs[0] = a.x; bs[1] = a.y; bs[2] = a.z; bs[3] = a.w; bs[4] = bq.x; bs[5] = bq.y; bs[6] = bq.z; bs[7] = bq.w; }
      const int hh = cg >> 3;
#pragma unroll
      for (int t = 0; t < 16; ++t) { const int l = 16 * tg + t;
          if (t < 8) SSD1_ROW(t + 11);
          float y[8];
#pragma unroll
          for (int e = 0; e < 8; ++e) y[e] = bs[e];
#pragma unroll
          for (int k = 0; k < 4; ++k) { const v4u rw = raw[t + k];
              y[0] += wk[k][0] * bflo(rw.x); y[1] += wk[k][1] * bfhi(rw.x); y[2] += wk[k][2] * bflo(rw.y); y[3] += wk[k][3] * bfhi(rw.y);
              y[4] += wk[k][4] * bflo(rw.z); y[5] += wk[k][5] * bfhi(rw.z); y[6] += wk[k][6] * bflo(rw.w); y[7] += wk[k][7] * bfhi(rw.w); }
#pragma unroll
          for (int e = 0; e < 8; ++e) y[e] = silu(y[e]);
          v4u o; o.x = pk2(y[0], y[1]); o.y = pk2(y[2], y[3]); o.z = pk2(y[4], y[5]); o.w = pk2(y[6], y[7]);
          *(v4u*)(XBCC + (m0 + l) * 1024 + ch0) = o;
          if (cg < 64) { const float sc = dtl[l * 8 + hh] * __expf(acs[63 * 8 + hh] - acs[l * 8 + hh]);
              v4u os; os.x = pk2(y[0] * sc, y[1] * sc); os.y = pk2(y[2] * sc, y[3] * sc); os.z = pk2(y[4] * sc, y[5] * sc); os.w = pk2(y[6] * sc, y[7] * sc);
              *(LAS v4u*)(XI + l * 1056 + ch0 * 2) = os; }
          else if (cg < 96) *(LAS v4u*)(BI + l * 544 + (ch0 - 512) * 2) = o;
          __builtin_amdgcn_sched_barrier(0);
      } }
#undef SSD1_ROW
    __syncthreads();
    TR(F, 31);
    { const int h = w, gi = h >> 2;
      bf16* STh = ST + ((size_t)bc * 8 + h) * 8192;
#pragma unroll 1
      for (int nh = 0; nh < 2; ++nh) {
      f32x4 acc[4][4];
#pragma unroll
      for (int nt = 0; nt < 4; ++nt)
#pragma unroll
          for (int pt = 0; pt < 4; ++pt) acc[nt][pt] = (f32x4){0.f, 0.f, 0.f, 0.f};
#pragma unroll
      for (int ks = 0; ks < 2; ++ks) {
          const int rowA = 32 * ks + 4 * q4 + (fr >> 2), rowB = rowA + 16;
          bf16x8 yf[4];
#pragma unroll
          for (int pt = 0; pt < 4; ++pt) { const int cb = (h * 64 + 16 * pt + 4 * (lane & 3)) * 2; yf[pt] = cat8(trrd(XI + rowA * 1056 + cb), trrd(XI + rowB * 1056 + cb)); }
#pragma unroll
          for (int nt = 0; nt < 4; ++nt) { const int cb = (gi * 128 + 64 * nh + 16 * nt + 4 * (lane & 3)) * 2;
              const bf16x8 xf = cat8(trrd(BI + rowA * 544 + cb), trrd(BI + rowB * 544 + cb));
#pragma unroll
              for (int pt = 0; pt < 4; ++pt) acc[nt][pt] = mfma16(xf, yf[pt], acc[nt][pt]); }
      }
#pragma unroll
      for (int nt = 0; nt < 4; ++nt)
#pragma unroll
          for (int pt = 0; pt < 4; ++pt) { v2u o; o.x = pk2(acc[nt][pt][0], acc[nt][pt][1]); o.y = pk2(acc[nt][pt][2], acc[nt][pt][3]); *(v2u*)(STh + (16 * pt + fr) * 128 + 64 * nh + 16 * nt + 4 * q4) = o; }
      }
    }
    __syncthreads();
    TR(F, 32);
}
__device__ __forceinline__ void ssd_scan(Frame& F, ArgsRef A) {
    unsigned* ST = (unsigned*)(A.ws + WS_ST); const float* AEND = (const float*)(A.ws + WS_AEND);
    for (int it = F.vcu * NTHR + F.tid; it < 32 * 4096; it += F.G * NTHR) {
        const int bh = it >> 12, b = bh >> 3, h = bh & 7, e = (it & 4095);
        unsigned* base = ST + ((size_t)(b * NCHUNK) * 8 + h) * 4096 + e;
        float s0 = 0.f, s1 = 0.f;
        for (int c0 = 0; c0 < NCHUNK; c0 += 16) {
            unsigned v[16]; float dec[16];
#pragma unroll
            for (int i = 0; i < 16; ++i) { v[i] = base[(size_t)(c0 + i) * 32768]; dec[i] = __expf(AEND[(size_t)(b * NCHUNK + c0 + i) * 8 + h]); }
#pragma unroll
            for (int i = 0; i < 16; ++i) { base[(size_t)(c0 + i) * 32768] = pk2(s0, s1); s0 = s0 * dec[i] + bflo(v[i]); s1 = s1 * dec[i] + bfhi(v[i]); }
        }
    }
}
__device__ __forceinline__ void ssd3_unit(Frame& F, ArgsRef A, int L, int bc) {
    LAS unsigned char* Ls = F.lds; int tl_ = F.tid; asm volatile("" : "+v"(tl_));
    const int tid = tl_, lane = tid & 63, w = F.wave, fr = lane & 15, q4 = lane >> 4;
    const int b = bc >> 7, c = bc & 127; const size_t m0 = (size_t)b * SEQ + (size_t)c * 64;
    const bf16* P = (const bf16*)(A.ws + WS_PROJ); const bf16* XBCC = (const bf16*)(A.ws + WS_XBCC); const bf16* ST = (const bf16*)(A.ws + WS_ST); bf16* Y = (bf16*)(A.ws + WS_Y);
    LAS unsigned char* XI = Ls; LAS unsigned char* BI = Ls + 67584; LAS unsigned char* CI = Ls + 102400;
    LAS float* dtl = (LAS float*)(Ls + 137216); LAS float* acs = (LAS float*)(Ls + 139264);
    const int h = w, gi = h >> 2;
    TR0(F);
    v4u stg[16];
#pragma unroll
    for (int i = 0; i < 16; ++i) { const int pc = tid + NTHR * i; stg[i] = *(const v4u*)(XBCC + (m0 + (pc >> 7)) * 1024 + 8 * (pc & 127)); }
    ssd_prepass(F, A, L, m0, dtl, acs);
#pragma unroll
    for (int i = 0; i < 16; ++i) { const int pc = tid + NTHR * i, row = pc >> 7, cg = pc & 127;
        LAS unsigned char* dst = cg < 64 ? XI + row * 1056 + cg * 16 : (cg < 96 ? BI + row * 544 + (cg - 64) * 16 : CI + row * 544 + (cg - 96) * 16);
        *(LAS v4u*)dst = stg[i]; }
    __builtin_amdgcn_sched_barrier(0);
    bf16x8 sin_[4][4];
    { const bf16* Sh = ST + ((size_t)bc * 8 + h) * 8192;
#pragma unroll
      for (int kn = 0; kn < 4; ++kn)
#pragma unroll
          for (int pt = 0; pt < 4; ++pt) sin_[kn][pt] = *(const bf16x8*)(Sh + (16 * pt + fr) * 128 + 32 * kn + 8 * q4); }
    __syncthreads();
    TR(F, 36);
    f32x4 acc[4][4];
#pragma unroll
    for (int lt = 0; lt < 4; ++lt)
#pragma unroll
        for (int pt = 0; pt < 4; ++pt) acc[lt][pt] = (f32x4){0.f, 0.f, 0.f, 0.f};
    {
#pragma unroll
      for (int kn = 0; kn < 4; ++kn) {
#pragma unroll
          for (int lt = 0; lt < 4; ++lt) { const bf16x8 xf = *(const LAS bf16x8*)(CI + (16 * lt + fr) * 544 + (gi * 128 + 32 * kn + 8 * q4) * 2);
#pragma unroll
              for (int pt = 0; pt < 4; ++pt) acc[lt][pt] = mfma16(xf, sin_[kn][pt], acc[lt][pt]); }
      }
#pragma unroll
      for (int lt = 0; lt < 4; ++lt)
#pragma unroll
          for (int r = 0; r < 4; ++r) { const float sc = __expf(acs[(16 * lt + 4 * q4 + r) * 8 + h]);
#pragma unroll
              for (int pt = 0; pt < 4; ++pt) acc[lt][pt][r] *= sc; }
    }
#pragma unroll
    for (int lt = 0; lt < 4; ++lt) {
#pragma unroll
        for (int ksp = 0; ksp <= (lt >> 1); ++ksp) {
            __builtin_amdgcn_sched_barrier(0);
            const bool hasb = (2 * ksp + 1) <= lt;
            f32x4 d0a = (f32x4){0.f, 0.f, 0.f, 0.f}, d0b = (f32x4){0.f, 0.f, 0.f, 0.f};
#pragma unroll
            for (int kn = 0; kn < 4; ++kn) { const int cb = (gi * 128 + 32 * kn + 8 * q4) * 2;
                const bf16x8 cf = *(const LAS bf16x8*)(CI + (16 * lt + fr) * 544 + cb);
                const bf16x8 ba = *(const LAS bf16x8*)(BI + (32 * ksp + fr) * 544 + cb); d0a = mfma16(ba, cf, d0a);
                if (hasb) { const bf16x8 bb = *(const LAS bf16x8*)(BI + (32 * ksp + 16 + fr) * 544 + cb); d0b = mfma16(bb, cf, d0b); } }
            const int l = 16 * lt + fr; const float al = acs[l * 8 + h];
            float ga[4], gb[4];
#pragma unroll
            for (int r = 0; r < 4; ++r) { const int sa = 32 * ksp + 4 * q4 + r, sb = sa + 16;
                ga[r] = sa <= l ? d0a[r] * __expf(al - acs[sa * 8 + h]) * dtl[sa * 8 + h] : 0.f;
                gb[r] = (hasb && sb <= l) ? d0b[r] * __expf(al - acs[sb * 8 + h]) * dtl[sb * 8 + h] : 0.f; }
            const bf16x8 xf = pack8(ga[0], ga[1], ga[2], ga[3], gb[0], gb[1], gb[2], gb[3]);
            const int rowA = 32 * ksp + 4 * q4 + (fr >> 2), rowB = rowA + 16;
#pragma unroll
            for (int pt = 0; pt < 4; ++pt) { const int cb = (h * 64 + 16 * pt + 4 * (lane & 3)) * 2;
                acc[lt][pt] = mfma16(xf, cat8(trrd(XI + rowA * 1056 + cb), trrd(XI + rowB * 1056 + cb)), acc[lt][pt]); }
        }
    }
    { const float dsk = A.in[10][L * 8 + h];
#pragma unroll
      for (int lt = 0; lt < 4; ++lt)
#pragma unroll
          for (int pt = 0; pt < 4; ++pt)
#pragma unroll
              for (int r = 0; r < 4; ++r) { const unsigned short xv = *(const LAS unsigned short*)(XI + (16 * lt + 4 * q4 + r) * 1056 + (h * 64 + 16 * pt + fr) * 2);
                  acc[lt][pt][r] += dsk * __uint_as_float((unsigned)xv << 16); } }
    __builtin_amdgcn_sched_barrier(0);
    v4u zr[8];
#pragma unroll
    for (int i = 0; i < 8; ++i) zr[i] = *(const v4u*)(P + (m0 + 8 * w + i) * PN + PC_Z + 8 * lane);
    __syncthreads();
    TR(F, 37);
#pragma unroll
    for (int lt = 0; lt < 4; ++lt)
#pragma unroll
        for (int pt = 0; pt < 4; ++pt)
#pragma unroll
            for (int r = 0; r < 4; ++r) *(LAS float*)(Ls + (16 * lt + 4 * q4 + r) * 2112 + (h * 64 + 16 * pt + fr) * 4) = acc[lt][pt][r];
    __syncthreads();
    { const f32x4 g0 = *(const f32x4*)(A.in[11] + L * 512 + 8 * lane), g1 = *(const f32x4*)(A.in[11] + L * 512 + 8 * lane + 4);
#pragma unroll
      for (int i = 0; i < 8; ++i) { const int r = 8 * w + i;
        f32x4 v0 = *(const LAS f32x4*)(Ls + r * 2112 + lane * 32), v1 = *(const LAS f32x4*)(Ls + r * 2112 + lane * 32 + 16);
        const v4u z = zr[i];
        v0 = v0 * (f32x4){silu(bflo(z.x)), silu(bfhi(z.x)), silu(bflo(z.y)), silu(bfhi(z.y))};
        v1 = v1 * (f32x4){silu(bflo(z.z)), silu(bfhi(z.z)), silu(bflo(z.w)), silu(bfhi(z.w))};
        const float ss = wave_sum((v0.x * v0.x + v0.y * v0.y) + (v0.z * v0.z + v0.w * v0.w) + (v1.x * v1.x + v1.y * v1.y) + (v1.z * v1.z + v1.w * v1.w)) * (1.0f / 512.0f);
        const float sc = 1.0f / sqrtf(ss + 1e-6f);
        v0 = v0 * sc * g0; v1 = v1 * sc * g1;
        v4u ov; ov.x = pk2(v0.x, v0.y); ov.y = pk2(v0.z, v0.w); ov.z = pk2(v1.x, v1.y); ov.w = pk2(v1.z, v1.w);
        *(v4u*)(Y + (m0 + r) * D + 8 * lane) = ov; } }
    __syncthreads();
    TR(F, 38);
}

#ifndef PROBE_FP8TEST
#define PROBE_FP8TEST 0
#endif
#if PROBE_FP8TEST
typedef int v8i __attribute__((ext_vector_type(8)));
__device__ __forceinline__ int fp8_selftest(int lane) {
    const int ij = lane & 15, g = lane >> 4;
    v8i Af, Bf;
#pragma unroll
    for (int r = 0; r < 8; ++r) { int wa = 0, wb = 0; const int k = 32 * g + 4 * r;
        wa = __builtin_amdgcn_cvt_pk_fp8_f32((float)((7 * ij + 3 * (k + 0)) % 5), (float)((7 * ij + 3 * (k + 1)) % 5), wa, false);
        wa = __builtin_amdgcn_cvt_pk_fp8_f32((float)((7 * ij + 3 * (k + 2)) % 5), (float)((7 * ij + 3 * (k + 3)) % 5), wa, true);
        wb = __builtin_amdgcn_cvt_pk_fp8_f32((float)((5 * (k + 0) + 11 * ij) % 7), (float)((5 * (k + 1) + 11 * ij) % 7), wb, false);
        wb = __builtin_amdgcn_cvt_pk_fp8_f32((float)((5 * (k + 2) + 11 * ij) % 7), (float)((5 * (k + 3) + 11 * ij) % 7), wb, true);
        Af[r] = wa; Bf[r] = wb; }
    f32x4 d = (f32x4){0.f, 0.f, 0.f, 0.f};
    d = __builtin_amdgcn_mfma_scale_f32_16x16x128_f8f6f4(Af, Bf, d, 0, 0, 0, 0, 0, 0);
    int bad = 0;
#pragma unroll
    for (int r = 0; r < 4; ++r) { const int i = 4 * g + r, j = ij; float e = 0.f;
        for (int k = 0; k < 128; ++k) e += (float)(((7 * i + 3 * k) % 5) * ((5 * k + 11 * j) % 7));
        bad += (d[r] != e + (PROBE_FP8TEST == 2 ? 1.f : 0.f)) ? 1 : 0; }
    return bad;
}
#endif
constexpr int NPHASE = 1 + 16 + 7 + 2 * MOE_NCH + 1;
__global__ void __launch_bounds__(NTHR, 2) fwd_kernel(Args kargs) {
    ArgsP ap = (ArgsP)__builtin_amdgcn_kernarg_segment_ptr();
#define args (*ap)
    extern __shared__ __attribute__((aligned(16))) unsigned char lds[];
    Frame F;
    F.lds = (LAS unsigned char*)lds;
    F.tid = threadIdx.x; F.lane = F.tid & 63; F.wave = __builtin_amdgcn_readfirstlane(F.tid >> 6);
#if PROBE_TG >= 30
    F.tr_acc = 0ull; F.tr_mark = 0ull;
#endif
    F.G = gridDim.x; { const int bx = blockIdx.x; F.vcu = (F.G % 8 == 0) ? (bx % 8) * (F.G / 8) + bx / 8 : bx; }
    gu32* ctl = (gu32*)(args.ws + WS_CTL);
    for (int u = F.tid; u < (LDS_BYTES - LDSCTL_OFF) / 4; u += NTHR) ((LAS unsigned*)(F.lds + LDSCTL_OFF))[u] = 0u;
    __syncthreads();
    XcdBarrier bar; bar.bar = (unsigned*)(ctl + CW_BAR); bar.x = 0; bar.st = nullptr;
    const int lo = args.ph_lo, hi = args.ph_hi;
    if (hi - lo > 1) bar = xcd_barrier_post((unsigned*)(ctl + CW_BAR), (volatile LAS unsigned*)(F.lds + CTL_MISC) + 8);
#if PROBE_TG >= 0
    unsigned long long t_acc = 0ull, t_ph = 0ull;
#define IN(k) ((lo <= (k) && (k) < hi) && fresh(F) && relaunder(ap) && ((t_ph = __builtin_amdgcn_s_memrealtime()), true))
#define T_STOP(k) do { if (tgroup_of(k) == PROBE_TG) t_acc += __builtin_amdgcn_s_memrealtime() - t_ph; } while (0)
    unsigned long long t_sub = 0ull;
#define T_SUB0() (t_sub = __builtin_amdgcn_s_memrealtime())
#define T_SUB(g) do { const unsigned long long n_ = __builtin_amdgcn_s_memrealtime(); if ((g) == PROBE_TG) t_acc += n_ - t_sub; t_sub = n_; } while (0)
#else
#define T_SUB0() do { } while (0)
#define T_SUB(g) do { } while (0)
#define IN(k) ((lo <= (k) && (k) < hi) && fresh(F) && relaunder(ap))
#define T_STOP(k) do { } while (0)
#endif
#if PROBE_TG == 20
#define SEAM(k) do { if ((k) + 1 < hi) { const unsigned long long tb_ = __builtin_amdgcn_s_memrealtime(); xcd_barrier(bar); t_acc += __builtin_amdgcn_s_memrealtime() - tb_; } } while (0)
#else
#define SEAM(k) do { if ((k) + 1 < hi) { REP(12) xcd_barrier(bar); } T_STOP(k); } while (0)
#endif
    unsigned char* ws = args.ws;
    bf16* A1 = (bf16*)(ws + WS_A1); bf16* HB = (bf16*)(ws + WS_HB); bf16* PROJ = (bf16*)(ws + WS_PROJ); bf16* Yb = (bf16*)(ws + WS_Y); bf16* MIXED = (bf16*)(ws + WS_MIXED);
    const int bid = (int)blockIdx.x;

#ifdef ONLY_UNIT
    { fresh(F); relaunder(ap);
#if ONLY_UNIT == 1
      for (int u = F.vcu; u < NBATCH * NCHUNK; u += F.G) ssd1_unit(F, args, 0, u);
#elif ONLY_UNIT == 2
      for (int u = F.vcu; u < NBATCH * NCHUNK; u += F.G) attn_unit(F, args, 0, u);
#elif ONLY_UNIT == 3
      for (int u = F.vcu; u < M / 128; u += F.G) gmlp_unit(F, args, 0, u);
#elif ONLY_UNIT == 4
      for (int u = F.vcu; u < NBATCH * NCHUNK; u += F.G) ssd3_unit(F, args, 0, u);
#elif ONLY_UNIT == 5
      { RowArgs R{nullptr, nullptr, HB, HB, 1, MIXED, args.in[2], args.in[3], A1, 2, args.in[23], 8}; row_phase(F, args, R); }
#endif
      return; }
#endif
    if (IN(0)) {
#if PROBE_FP8TEST
        if (blockIdx.x == 0 && F.wave == 0) { const int bad = fp8_selftest(F.lane); if (bad) atomicAdd((unsigned*)(args.ws + WS_CTL) + 2, (unsigned)bad); }
#endif
        cvt_small_weights(F, args, 0, 704, F.vcu * NWAVES + F.wave, F.G * NWAVES);
        __syncthreads();
        RowArgs R{args.in[0], nullptr, nullptr, nullptr, 0, nullptr, nullptr, args.in[1], A1, 1, args.in[5] + 1536, DIN};
        REP(9) row_phase(F, args, R);
        SEAM(0);
    }
#ifdef PROBE_SWEEP
    { fresh(F); const int gw = F.vcu * NWAVES + F.wave, NGW = F.G * NWAVES; float acc = 0.f;
      for (int mb = gw; mb < M; mb += PROBE_SWEEP * NGW) { f32x4 t[PROBE_SWEEP][4];
#pragma unroll
          for (int q = 0; q < PROBE_SWEEP; ++q)
#pragma unroll
              for (int j = 0; j < 4; ++j) t[q][j] = *(const f32x4*)(args.in[0] + (size_t)(mb + q * NGW) * D + 4 * F.lane + 256 * j);
#pragma unroll
          for (int q = 0; q < PROBE_SWEEP; ++q)
#pragma unroll
              for (int j = 0; j < 4; ++j) acc += t[q][j].x + t[q][j].y + t[q][j].z + t[q][j].w; }
      if (acc == 1.2345e-30f) ((float*)(args.ws + WS_CTL))[100] = acc;
      __syncthreads(); }
#endif
    for (int L = 0; L < 2; ++L) {
        const int pb = 1 + 16 * L;
        if (IN(pb + 0)) {
            pg8::Gemm g{A1, (const bf16*)(ws + WS_WIN) + (size_t)L * PN * D, M, PN, D}; pg8::StaticOrder S; S.init(M, PN, F.G, bid);
            pg8::EpiStore E{PROJ, PN, 1.0f};
            pg8::gemm_phase<pg8::EpiStore, pg8::StaticOrder, true, true>(F.lds, g, S, E);
            if (F.G == 256 && bid >= 128) { const int gw = (bid - 128) * NWAVES + F.wave;
                if (L == 0) cvt_small_weights(F, args, 704, CVT_SMALL_TASKS, gw, 128 * NWAVES); }
            else if (F.G != 256 && L == 0) cvt_small_weights(F, args, 704, CVT_SMALL_TASKS, F.vcu * NWAVES + F.wave, F.G * NWAVES);
            SEAM(pb + 0);
        }
        if (IN(pb + 1)) {
            T_SUB0();
            for (int u = F.vcu; u < NBATCH * NCHUNK; u += F.G) attn_unit(F, args, L, u);
            T_SUB(11);
            for (int u = F.vcu; u < NBATCH * NCHUNK; u += F.G) ssd1_unit(F, args, L, u);
            T_SUB(10);
            for (int u = F.vcu; u < M / 128; u += F.G) gmlp_unit(F, args, L, u);
            T_SUB(12);
            SEAM(pb + 1);
        }
                if (IN(pb + 2)) { ssd_scan(F, args); SEAM(pb + 2); }
        if (IN(pb + 3)) { for (int u = F.vcu; u < NBATCH * NCHUNK; u += F.G) ssd3_unit(F, args, L, u); SEAM(pb + 3); }
        if (IN(pb + 4)) {
            pg8::Gemm g{Yb, (const bf16*)(ws + WS_WOUT) + (size_t)L * D * D, M, D, D}; pg8::StaticOrder S; S.init(M, D, F.G, bid);
            pg8::EpiStore E{MIXED, D, 1.0f};
            REP(5) pg8::gemm_phase<pg8::EpiStore, pg8::StaticOrder, true, true>(F.lds, g, S, E);
            SEAM(pb + 4);
        }
        if (IN(pb + 5)) {
            RowArgs R{L == 0 ? args.in[0] : nullptr, nullptr, HB, HB, 1, MIXED, args.in[2] + L * D, args.in[3] + L * D, A1, L == 1 ? 2 : 0, args.in[23], 8};
            if (L == 0) { REP(8) row_phase(F, args, R); } else row_phase(F, args, R);
            if (L == 1) cvt_moe_weights(F, args, 0, MOE_CVT_TASKS, F.vcu * NWAVES + F.wave, F.G * NWAVES);
            SEAM(pb + 5);
        }
        if (L == 0) {
            if (IN(pb + 6)) {
                pg8::Gemm g{A1, (const bf16*)(ws + WS_WGU), M, 2 * DFF, D}; pg8::StaticOrder S; S.init(M, 2 * DFF, F.G, bid);
                pg8::EpiSwiglu E{(bf16*)(ws + WS_H1), DFF};
                REP(6) pg8::gemm_phase<pg8::EpiSwiglu, pg8::StaticOrder, true, true>(F.lds, g, S, E);
                SEAM(pb + 6);
            }
            if (IN(pb + 7)) {
                pg8::Gemm g{(const bf16*)(ws + WS_H1), (const bf16*)(ws + WS_WD), M, D, DFF}; pg8::StaticOrder S; S.init(M, D, F.G, bid);
                pg8::EpiStore E{(bf16*)(ws + WS_FOUT), D, 1.0f};
                REP(6) pg8::gemm_phase<pg8::EpiStore, pg8::StaticOrder, true, true>(F.lds, g, S, E);
                SEAM(pb + 7);
            }
            if (IN(pb + 8)) {
                RowArgs R{nullptr, nullptr, HB, HB, 1, (const bf16*)(ws + WS_FOUT), args.in[4], args.in[1] + D, A1, 1, args.in[5] + (size_t)D * DIN + 1536, DIN};
                row_phase(F, args, R);
                SEAM(pb + 8);
            }
        } else {
#if PROBE_TG >= 10
#ifdef PROBE_TMIN
            if (lo <= pb + 6 && pb + 6 < hi && threadIdx.x == 0) atomicMax((unsigned*)(args.ws + WS_CTL) + 8, 0xffffffffu - (unsigned)t_acc);
#else
            if (lo <= pb + 6 && pb + 6 < hi && threadIdx.x == 0) atomicMax((unsigned*)(args.ws + WS_CTL) + 8, (unsigned)t_acc);
#endif
#endif
            if (IN(pb + 6)) { REP(11) { moe_tables(F, args); moe_gather(F, args); } SEAM(pb + 6); }
            for (int k = 0; k < MOE_NCH; ++k) {
                if (IN(pb + 7 + 2 * k)) {
                    moe_tables(F, args);
                    const int nT = *(LAS int*)(F.lds + CTL_CNT + 32 * 4); int nk = nT - MOE_CH * k; nk = nk < 0 ? 0 : ((k < MOE_NCH - 1 && nk > MOE_CH) ? MOE_CH : nk);
                    pg8::Gemm g{(const bf16*)(ws + WS_XS), (const bf16*)(ws + WS_MWGU), 0, 0, D / 2};
                    pg8::MoeOrder<false, true> S{MOE_CH * k, nk, 28, F.G, bid, (const LAS int*)(F.lds + CTL_TE)};
                    pg8::EpiSwiglu8 E{ws + WS_HM, DFFE, 1.0f / (FP8_SX * FP8_SW), FP8_SH};
                    REP(7) pg8::gemm_phase<pg8::EpiSwiglu8, pg8::MoeOrder<false, true>, true, true, true>(F.lds, g, S, E);
                    SEAM(pb + 7 + 2 * k);
                }
                if (IN(pb + 8 + 2 * k)) {
                    moe_tables(F, args);
                    const int nT = *(LAS int*)(F.lds + CTL_CNT + 32 * 4); int nk = nT - MOE_CH * k; nk = nk < 0 ? 0 : ((k < MOE_NCH - 1 && nk > MOE_CH) ? MOE_CH : nk);
                    pg8::Gemm g{(const bf16*)(ws + WS_HM), (const bf16*)(ws + WS_MWD), 0, 0, DFFE / 2};
                    pg8::MoeOrder<true, false> S{MOE_CH * k, nk, 4, F.G, bid, (const LAS int*)(F.lds + CTL_TE)};
                    pg8::EpiStore E{(bf16*)(ws + WS_YM), D, 1.0f / (FP8_SH * FP8_SW)};
                    REP(7) pg8::gemm_phase<pg8::EpiStore, pg8::MoeOrder<true, false>, true, true, true>(F.lds, g, S, E);
                    SEAM(pb + 8 + 2 * k);
                }
            }
            if (IN(pb + 7 + 2 * MOE_NCH)) {
                RowArgs R{nullptr, args.out, HB, nullptr, 2, (const bf16*)(ws + WS_YM), args.in[4] + D, nullptr, nullptr, 0, nullptr, 0};
                row_phase(F, args, R);
#if PROBE_FP8TEST
                if (__hip_atomic_load((unsigned*)(args.ws + WS_CTL) + 2, RLX_AGENT) != 0u) { __syncthreads(); for (size_t i = (size_t)blockIdx.x * NTHR + F.tid; i < (size_t)M * D; i += (size_t)F.G * NTHR) args.out[i] += 1.0f; }
#endif
            }
        }
    }
#if PROBE_TG >= 0
    T_STOP(1 + 16 + 7 + 2 * MOE_NCH);
#if PROBE_TG >= 10
#endif
    if (blockIdx.x == 77) { unsigned long long t_spin = t_acc;
#if PROBE_TG >= 30
        t_spin = F.tr_acc;
#endif
#if PROBE_TG >= 10 && PROBE_TG < 20
        t_spin = __hip_atomic_load((unsigned*)(args.ws + WS_CTL) + 8, RLX_AGENT);
#ifdef PROBE_TMIN
        t_spin = 0xffffffffu - (unsigned)t_spin;
#endif
#endif
        const unsigned long long t_end = __builtin_amdgcn_s_memrealtime(); while (__builtin_amdgcn_s_memrealtime() - t_end < t_spin) __builtin_amdgcn_s_sleep(8); }
#endif
#undef IN
#undef SEAM
#undef args
}

extern "C" void kernel_launch(void* const* d_in, const int* in_sizes, int n_in, void* d_out, int out_size, void* d_ws, size_t ws_size, hipStream_t stream) {
    static int grid = 0;
    if (grid == 0) {
        if (n_in != NIN || out_size != M * D || ws_size < WS_END) { fprintf(stderr, "kernel_launch: unexpected shapes (n_in %d, out %d, ws %zu)\n", n_in, out_size, ws_size); grid = -1; return; }
        int dev = 0, cus = 0;
        if (hipGetDevice(&dev) != hipSuccess || hipDeviceGetAttribute(&cus, hipDeviceAttributeMultiprocessorCount, dev) != hipSuccess) { grid = -1; return; }
        if (hipFuncSetAttribute((const void*)fwd_kernel, hipFuncAttributeMaxDynamicSharedMemorySize, LDS_BYTES) != hipSuccess) { fprintf(stderr, "kernel_launch: hipFuncSetAttribute failed\n"); grid = -1; return; }
        int per_cu = 0;
        if (hipOccupancyMaxActiveBlocksPerMultiprocessor(&per_cu, (const void*)fwd_kernel, NTHR, LDS_BYTES) != hipSuccess || per_cu < 1) fprintf(stderr, "kernel_launch: occupancy query says %d\n", per_cu);
        (void)hipGetLastError();
        grid = cus > 256 ? 256 : cus;
    }
    if (grid < 0) return;
    (void)hipMemsetAsync((char*)d_ws + WS_CTL, 0, CTL_ZERO_BYTES, stream);
    Args a{};
    for (int i = 0; i < NIN; ++i) a.in[i] = (const float*)d_in[i];
    a.out = (float*)d_out; a.ws = (unsigned char*)d_ws;
#if MK_SINGLE
    a.ph_lo = 0; a.ph_hi = NPHASE;
    hipLaunchKernelGGL(fwd_kernel, dim3(grid), dim3(NTHR), LDS_BYTES, stream, a);
#else
    for (int ph = 0; ph < NPHASE; ++ph) { if (ph >= 10 && ph < 17) continue; a.ph_lo = ph; a.ph_hi = ph + 1; hipLaunchKernelGGL(fwd_kernel, dim3(grid), dim3(NTHR), LDS_BYTES, stream, a); }
#endif
}
```

```cpp
#include <hip/hip_runtime.h>
#include <cstdio>
#include <cstdint>

#ifndef MK_SINGLE
#define MK_SINGLE 1
#endif

namespace pg8 {
#define PG8_LAS __attribute__((address_space(3)))
typedef unsigned short bf16_t;
typedef short bf16x8 __attribute__((ext_vector_type(8)));
typedef float f32x4 __attribute__((ext_vector_type(4)));
typedef unsigned u32x4 __attribute__((ext_vector_type(4)));
constexpr int BM = 256, BK = 64, HALF = 128, HTB = HALF * BK * 2  , STAGE_BYTES = 8 * HTB, NXCD = 8, WGM = 8;

__host__ __device__ __forceinline__ int lds_byte(int r, int c) { const int st = (r >> 4) * 2 + (c >> 5), rr = r & 15, cc = c & 31, ob = rr * 64 + cc * 2; return st * 1024 + (ob ^ (((ob >> 9) & 1) << 5)); }
__host__ __device__ __forceinline__ void stage_rc(int b, int& R, int& C) { const int st = b / 1024, sb = b % 1024, swz = sb ^ (((sb >> 9) & 1) << 5); R = (st >> 1) * 16 + swz / 64; C = (st & 1) * 32 + (swz % 64) / 2; }
__host__ __device__ __forceinline__ int perm32(int rho) { const int n = rho >> 4, i = rho & 15; return 8 * (i >> 2) + 4 * n + (i & 3); }

struct Unit { int pm, pn, om, on; };
struct Gemm { const bf16_t* A; const bf16_t* Bt; int M, N, K; };

__host__ __device__ __forceinline__ bool tile_order(int i, int G, int c, int nM, int nN, int& pm, int& pn) {
    const int nwg = nM * nN; const long L = (long)i * G + c; if (L >= nwg) return false;
    int wgid = (int)L; { const int q = nwg / NXCD, r = nwg % NXCD, xcd = wgid % NXCD, off = wgid / NXCD; wgid = (xcd < r ? xcd * (q + 1) : r * (q + 1) + (xcd - r) * q) + off; }
    const int nig = WGM * nN, gid = wgid / nig, fm = gid * WGM, gsz = (nM - fm) < WGM ? (nM - fm) : WGM;
    pm = fm + ((wgid % nig) % gsz); pn = (wgid % nig) / gsz; return true;
}
struct StaticOrder {
    int nM, nN, G, c;
    __host__ __device__ void init(int M, int N, int G_, int c_) { nM = M / BM; nN = N / BM; G = G_; c = c_; }
    __host__ __device__ bool next(int i, Unit& u) const { int pm, pn; if (!tile_order(i, G, c, nM, nN, pm, pn)) return false; u.pm = pm; u.pn = pn; u.om = pm; u.on = pn; return true; }
    __device__ __forceinline__ void a_ready(const Unit&) const {}
    __device__ __forceinline__ void done(const Unit&) const {}
};
template <bool A_LOCAL, bool O_LOCAL>
struct MoeOrder {
    int t0, nT, nN, G, c; const PG8_LAS int* te;
    __device__ __forceinline__ bool next(int i, Unit& u) const { int pm, pn; if (!tile_order(i, G, c, nT, nN, pm, pn)) return false;
        const int e = __builtin_amdgcn_readfirstlane(te[t0 + pm]);
        u.pm = A_LOCAL ? pm : t0 + pm; u.pn = e * nN + pn; u.om = O_LOCAL ? pm : t0 + pm; u.on = pn; return true; }
    __device__ __forceinline__ void a_ready(const Unit&) const {}
    __device__ __forceinline__ void done(const Unit&) const {}
};

typedef float f32x2_cv __attribute__((ext_vector_type(2))); typedef __bf16 bf16x2_cv __attribute__((ext_vector_type(2)));
__device__ __forceinline__ unsigned cvt_pk_bf16(float lo, float hi) { const f32x2_cv v = {lo, hi}; const bf16x2_cv b = __builtin_convertvector(v, bf16x2_cv); return __builtin_bit_cast(unsigned, b); }

typedef int v8i32 __attribute__((ext_vector_type(8)));
__device__ __forceinline__ v8i32 cat16(bf16x8 lo, bf16x8 hi) { const u32x4 a = __builtin_bit_cast(u32x4, lo), b = __builtin_bit_cast(u32x4, hi); return (v8i32){(int)a.x, (int)a.y, (int)a.z, (int)a.w, (int)b.x, (int)b.y, (int)b.z, (int)b.w}; }
__device__ __forceinline__ float clamp448(float x) { return __builtin_fminf(__builtin_fmaxf(x, -448.0f), 448.0f); }
__device__ __forceinline__ unsigned pack_fp8x4(float a, float b, float c, float d) {
    int r = 0; r = __builtin_amdgcn_cvt_pk_fp8_f32(clamp448(a), clamp448(b), r, false); r = __builtin_amdgcn_cvt_pk_fp8_f32(clamp448(c), clamp448(d), r, true); return (unsigned)r; }
struct EpiStore {
    static constexpr bool PERM = true, AFTER_DRAIN = false;
    bf16_t* O; int ldc; float scale;
    __device__ __forceinline__ void operator()(const f32x4 (&acc)[2][2][4][2], const Unit& u, int wr, int wc, int fr, int fq) const {
        const int row0 = u.om * BM + wr * 64 + fr; const int col0 = u.on * BM + wc * 32 + 8 * fq;
#pragma unroll
        for (int ai = 0; ai < 2; ++ai)
#pragma unroll
            for (int m = 0; m < 4; ++m) { bf16_t* rowp = O + (size_t)(row0 + ai * HALF + m * 16) * ldc + col0;
#pragma unroll
                for (int bj = 0; bj < 2; ++bj) { const f32x4 v0 = acc[ai][bj][m][0] * scale, v1 = acc[ai][bj][m][1] * scale;
                    u32x4 w; w.x = cvt_pk_bf16(v0[0], v0[1]); w.y = cvt_pk_bf16(v0[2], v0[3]); w.z = cvt_pk_bf16(v1[0], v1[1]); w.w = cvt_pk_bf16(v1[2], v1[3]);
                    *(u32x4*)(rowp + bj * HALF) = w; } }
    }
};
__device__ __forceinline__ float silu_f(float x) { return x * __builtin_amdgcn_rcpf(1.0f + __expf(-x)); }
struct EpiSwiglu {
    static constexpr bool PERM = true, AFTER_DRAIN = false;
    bf16_t* O; int ldc;
    __device__ __forceinline__ void operator()(const f32x4 (&acc)[2][2][4][2], const Unit& u, int wr, int wc, int fr, int fq) const {
        const int row0 = u.om * BM + wr * 64 + fr; const int col0 = u.on * HALF + wc * 32 + 8 * fq;
#pragma unroll
        for (int ai = 0; ai < 2; ++ai)
#pragma unroll
            for (int m = 0; m < 4; ++m) { bf16_t* rowp = O + (size_t)(row0 + ai * HALF + m * 16) * ldc + col0;
                const f32x4 g0 = acc[ai][0][m][0], g1 = acc[ai][0][m][1], u0 = acc[ai][1][m][0], u1 = acc[ai][1][m][1];
                u32x4 w;
                w.x = cvt_pk_bf16(silu_f(g0[0]) * u0[0], silu_f(g0[1]) * u0[1]); w.y = cvt_pk_bf16(silu_f(g0[2]) * u0[2], silu_f(g0[3]) * u0[3]);
                w.z = cvt_pk_bf16(silu_f(g1[0]) * u1[0], silu_f(g1[1]) * u1[1]); w.w = cvt_pk_bf16(silu_f(g1[2]) * u1[2], silu_f(g1[3]) * u1[3]);
                *(u32x4*)rowp = w; }
    }
};

struct EpiSwiglu8 {
    static constexpr bool PERM = true, AFTER_DRAIN = false;
    unsigned char* O; int ldc; float in_scale, out_scale;
    __device__ __forceinline__ void operator()(const f32x4 (&acc)[2][2][4][2], const Unit& u, int wr, int wc, int fr, int fq) const {
        const int row0 = u.om * BM + wr * 64 + fr; const int col0 = u.on * HALF + wc * 32 + 8 * fq;
#pragma unroll
        for (int ai = 0; ai < 2; ++ai)
#pragma unroll
            for (int m = 0; m < 4; ++m) { unsigned char* rowp = O + (size_t)(row0 + ai * HALF + m * 16) * ldc + col0;
                const f32x4 g0 = acc[ai][0][m][0] * in_scale, g1 = acc[ai][0][m][1] * in_scale, u0 = acc[ai][1][m][0] * (in_scale * out_scale), u1 = acc[ai][1][m][1] * (in_scale * out_scale);
                typedef unsigned u32x2 __attribute__((ext_vector_type(2)));
                u32x2 w;
                w.x = pack_fp8x4(silu_f(g0[0]) * u0[0], silu_f(g0[1]) * u0[1], silu_f(g0[2]) * u0[2], silu_f(g0[3]) * u0[3]);
                w.y = pack_fp8x4(silu_f(g1[0]) * u1[0], silu_f(g1[1]) * u1[1], silu_f(g1[2]) * u1[2], silu_f(g1[3]) * u1[3]);
                *(u32x2*)rowp = w; }
    }
};

template <class Epi, class Sched, bool ALIGN_EPI = false, bool SP2 = false, bool FP8 = false>
__device__ __forceinline__ void gemm_phase(PG8_LAS unsigned char* lds, const Gemm g, const Sched& S, const Epi& E) {
    int tid_ = threadIdx.x; asm volatile("" : "+v"(tid_));
    const int tid = tid_, wid = __builtin_amdgcn_readfirstlane(tid >> 6), lane = tid & 63, wr = wid >> 2, wc = wid & 3, fr = lane & 15, fq = lane >> 4;
    int K_ = g.K; asm volatile("" : "+s"(K_));
    const int K = K_, nt = K / BK;
    unsigned voffA[2], voffB[2];
#pragma unroll
    for (int i = 0; i < 2; ++i) { int R, C; stage_rc(tid * 16 + i * 8192, R, C); const int Rb = Epi::PERM ? ((R & ~31) + perm32(R & 31)) : R;
        voffA[i] = (unsigned)(R * K + C) * 2u; voffB[i] = (unsigned)(Rb * K + C) * 2u; }
    const size_t kstep = (size_t)(BK * 2);
    const size_t hstep = (size_t)HALF * K * 2;
    const size_t tstep = 2 * hstep;
    const unsigned ldsw = (unsigned)wid * 1024u;
    const int aoff = lds_byte(wr * 64 + fr, fq * 8), boff = lds_byte(wc * 32 + fr, fq * 8);
#define PG8_SA(b, h) (((b) * 2 + (h)) * HTB)
#define PG8_SB(b, h) ((4 + (b) * 2 + (h)) * HTB)
#define PG8_STAGE(bufoff, gbase, voff) do { _Pragma("unroll") for (int _i = 0; _i < 2; ++_i) \
        __builtin_amdgcn_global_load_lds((const unsigned*)((const char*)(gbase) + (voff)[_i]), (PG8_LAS unsigned*)(lds + (bufoff) + ldsw + _i * 8192), 16, 0, 0); } while (0)
#define PG8_LDA(dst, dst8, b, h) do { _Pragma("unroll") for (int m = 0; m < 4; ++m) { \
        if constexpr (FP8) dst8[m] = cat16(*(const PG8_LAS bf16x8*)(lds + PG8_SA(b, h) + aoff + m * 2048), *(const PG8_LAS bf16x8*)(lds + PG8_SA(b, h) + aoff + m * 2048 + 1024)); \
        else { _Pragma("unroll") for (int k = 0; k < 2; ++k) dst[m][k] = *(const PG8_LAS bf16x8*)(lds + PG8_SA(b, h) + aoff + m * 2048 + k * 1024); } } } while (0)
#define PG8_LDB(dst, dst8, b, h) do { _Pragma("unroll") for (int n = 0; n < 2; ++n) { \
        if constexpr (FP8) dst8[n] = cat16(*(const PG8_LAS bf16x8*)(lds + PG8_SB(b, h) + boff + n * 2048), *(const PG8_LAS bf16x8*)(lds + PG8_SB(b, h) + boff + n * 2048 + 1024)); \
        else { _Pragma("unroll") for (int k = 0; k < 2; ++k) dst[n][k] = *(const PG8_LAS bf16x8*)(lds + PG8_SB(b, h) + boff + n * 2048 + k * 1024); } } } while (0)
#define PG8_MMA(ai, bj, At, At8, Bt, Bt8) do { __builtin_amdgcn_s_setprio(1); _Pragma("unroll") for (int m = 0; m < 4; ++m) _Pragma("unroll") for (int n = 0; n < 2; ++n) { \
        if constexpr (FP8) { asm volatile("v_mfma_f32_16x16x128_f8f6f4 %0, %1, %2, %0" : "+v"(acc[ai][bj][m][n]) : "v"(Bt8[n]), "v"(At8[m])); } \
        else { _Pragma("unroll") for (int k = 0; k < 2; ++k) acc[ai][bj][m][n] = __builtin_amdgcn_mfma_f32_16x16x32_bf16(Bt[n][k], At[m][k], acc[ai][bj][m][n], 0, 0, 0); } } __builtin_amdgcn_s_setprio(0); } while (0)
#define PG8_WAIT_V(n) asm volatile("s_waitcnt vmcnt(" #n ")" ::: "memory")
#define PG8_WAIT_L(n) asm volatile("s_waitcnt lgkmcnt(" #n ")" ::: "memory")
#define PG8_BAR __builtin_amdgcn_s_barrier()
#define PG8_SCHED __builtin_amdgcn_sched_barrier(0)
    Unit cur, nxt; int ui = 0;
    if (!S.next(0, cur)) return;
    f32x4 acc[2][2][4][2];
#pragma unroll
    for (int a = 0; a < 2; ++a)
#pragma unroll
        for (int b = 0; b < 2; ++b)
#pragma unroll
            for (int m = 0; m < 4; ++m)
#pragma unroll
                for (int n = 0; n < 2; ++n) acc[a][b][m][n] = (f32x4){0.f, 0.f, 0.f, 0.f};
    bf16x8 At[4][2], B0[2][2], B1[2][2]; v8i32 At8[4], B08[2], B18[2];
    const char* cA = (const char*)g.A + (size_t)cur.pm * tstep; const char* cB = (const char*)g.Bt + (size_t)cur.pn * tstep;
    S.a_ready(cur);
    if constexpr (SP2) {
        PG8_STAGE(PG8_SB(0, 0), cB, voffB); PG8_STAGE(PG8_SB(0, 1), cB + hstep, voffB); PG8_STAGE(PG8_SA(0, 0), cA, voffA); PG8_STAGE(PG8_SA(0, 1), cA + hstep, voffA);
        if (wr == 1) PG8_BAR;
        PG8_WAIT_V(2); PG8_BAR;
        PG8_STAGE(PG8_SB(1, 0), cB + kstep, voffB); PG8_STAGE(PG8_SA(1, 0), cA + kstep, voffA); PG8_STAGE(PG8_SB(1, 1), cB + hstep + kstep, voffB);
        PG8_WAIT_V(6); PG8_BAR;
    } else {
        PG8_STAGE(PG8_SB(0, 0), cB, voffB); PG8_STAGE(PG8_SA(0, 0), cA, voffA); PG8_STAGE(PG8_SB(0, 1), cB + hstep, voffB); PG8_STAGE(PG8_SA(0, 1), cA + hstep, voffA);
        if (wr == 1) PG8_BAR;
        PG8_WAIT_V(4); PG8_BAR;
        PG8_STAGE(PG8_SB(1, 0), cB + kstep, voffB); PG8_STAGE(PG8_SA(1, 0), cA + kstep, voffA); PG8_STAGE(PG8_SB(1, 1), cB + hstep + kstep, voffB);
        PG8_WAIT_V(6); PG8_BAR;
    }
    for (;;) {
        const bool has_next = S.next(ui + 1, nxt);
        const char* nA = has_next ? (const char*)g.A + (size_t)nxt.pm * tstep : cA; const char* nB = has_next ? (const char*)g.Bt + (size_t)nxt.pn * tstep : cB;
#pragma unroll 1
        for (int t = 0; t < nt; t += 2) {
            const bool last = (t == nt - 2);
            const char* a1 = cA + (size_t)(t + 1) * kstep;
            const char* a2 = last ? nA : cA + (size_t)(t + 2) * kstep; const char* b2 = last ? nB : cB + (size_t)(t + 2) * kstep;
            const char* a3 = a2 + kstep; const char* b3 = b2 + kstep;
            if (last && has_next) S.a_ready(nxt);
            if constexpr (SP2) {
            PG8_LDB(B0, B08, 0, 0); PG8_LDB(B1, B18, 0, 1); PG8_SCHED; PG8_LDA(At, At8, 0, 0); PG8_STAGE(PG8_SA(1, 1), a1 + hstep, voffA);
            PG8_WAIT_V(8); PG8_WAIT_L(0); PG8_BAR; PG8_MMA(0, 0, At, At8, B0, B08); PG8_MMA(0, 1, At, At8, B1, B18); PG8_BAR; PG8_SCHED;
            PG8_LDA(At, At8, 0, 1); PG8_STAGE(PG8_SB(0, 0), b2, voffB); PG8_STAGE(PG8_SB(0, 1), b2 + hstep, voffB); PG8_STAGE(PG8_SA(0, 0), a2, voffA);
            PG8_WAIT_V(8); PG8_WAIT_L(0); PG8_BAR; PG8_MMA(1, 0, At, At8, B0, B08); PG8_MMA(1, 1, At, At8, B1, B18); PG8_BAR; PG8_SCHED;
            PG8_LDB(B0, B08, 1, 0); PG8_LDB(B1, B18, 1, 1); PG8_SCHED; PG8_LDA(At, At8, 1, 0); PG8_STAGE(PG8_SA(0, 1), a2 + hstep, voffA);
            PG8_WAIT_V(8); PG8_WAIT_L(0); PG8_BAR; PG8_MMA(0, 0, At, At8, B0, B08); PG8_MMA(0, 1, At, At8, B1, B18); PG8_BAR; PG8_SCHED;
            PG8_LDA(At, At8, 1, 1); PG8_STAGE(PG8_SB(1, 0), b3, voffB); PG8_STAGE(PG8_SB(1, 1), b3 + hstep, voffB); PG8_STAGE(PG8_SA(1, 0), a3, voffA);
            PG8_WAIT_V(8); PG8_WAIT_L(0); PG8_BAR; PG8_MMA(1, 0, At, At8, B0, B08); PG8_MMA(1, 1, At, At8, B1, B18); PG8_BAR; PG8_SCHED;
            } else {
            PG8_LDB(B0, B08, 0, 0); PG8_SCHED; PG8_LDA(At, At8, 0, 0); PG8_STAGE(PG8_SA(1, 1), a1 + hstep, voffA);
            PG8_WAIT_L(8); PG8_BAR; PG8_WAIT_L(0); PG8_MMA(0, 0, At, At8, B0, B08); PG8_BAR; PG8_SCHED;
            PG8_LDB(B1, B18, 0, 1); PG8_STAGE(PG8_SB(0, 0), b2, voffB);
            PG8_BAR; PG8_WAIT_L(0); PG8_MMA(0, 1, At, At8, B1, B18); PG8_BAR;
            PG8_LDA(At, At8, 0, 1); PG8_STAGE(PG8_SA(0, 0), a2, voffA);
            PG8_BAR; PG8_WAIT_L(0); PG8_MMA(1, 0, At, At8, B0, B08); PG8_BAR; PG8_SCHED;
            PG8_STAGE(PG8_SB(0, 1), b2 + hstep, voffB);
            PG8_WAIT_V(6); PG8_BAR; PG8_MMA(1, 1, At, At8, B1, B18); PG8_BAR;
            PG8_LDB(B0, B08, 1, 0); PG8_SCHED; PG8_LDA(At, At8, 1, 0); PG8_STAGE(PG8_SA(0, 1), a2 + hstep, voffA);
            PG8_WAIT_L(8); PG8_BAR; PG8_WAIT_L(0); PG8_MMA(0, 0, At, At8, B0, B08); PG8_BAR; PG8_SCHED;
            PG8_LDB(B1, B18, 1, 1); PG8_STAGE(PG8_SB(1, 0), b3, voffB);
            PG8_BAR; PG8_WAIT_L(0); PG8_MMA(0, 1, At, At8, B1, B18); PG8_BAR;
            PG8_LDA(At, At8, 1, 1); PG8_STAGE(PG8_SA(1, 0), a3, voffA);
            PG8_BAR; PG8_WAIT_L(0); PG8_MMA(1, 0, At, At8, B0, B08); PG8_BAR; PG8_SCHED;
            PG8_STAGE(PG8_SB(1, 1), b3 + hstep, voffB);
            PG8_WAIT_V(6); PG8_BAR; PG8_MMA(1, 1, At, At8, B1, B18); PG8_BAR;
            }
        }
        if constexpr (FP8) asm volatile("s_nop 15\n\ts_nop 15" ::: "memory");
        if constexpr (ALIGN_EPI) { if (wr == 0) PG8_BAR; }
        if constexpr (!Epi::AFTER_DRAIN) { E(acc, cur, wr, wc, fr, fq); S.done(cur); }
        if (!has_next) break;
#pragma unroll
        for (int a = 0; a < 2; ++a)
#pragma unroll
            for (int b = 0; b < 2; ++b)
#pragma unroll
                for (int m = 0; m < 4; ++m)
#pragma unroll
                    for (int n = 0; n < 2; ++n) acc[a][b][m][n] = (f32x4){0.f, 0.f, 0.f, 0.f};
        cur = nxt; cA = nA; cB = nB; ++ui;
        if constexpr (ALIGN_EPI) { if (wr == 1) PG8_BAR; }
    }
    PG8_WAIT_V(0);
    if constexpr (!ALIGN_EPI) { if (wr == 0) PG8_BAR; }
    PG8_BAR;
    if constexpr (Epi::AFTER_DRAIN) { E.fused(acc, cur, wr, wc, fr, fq, lds, wid, lane); S.done(cur); }
#undef PG8_SA
#undef PG8_SB
#undef PG8_STAGE
#undef PG8_LDA
#undef PG8_LDB
#undef PG8_MMA
#undef PG8_WAIT_V
#undef PG8_WAIT_L
#undef PG8_BAR
#undef PG8_SCHED
}
}

#define GAS __attribute__((address_space(1)))
#define LAS __attribute__((address_space(3)))
typedef unsigned short bf16;
typedef unsigned v4u __attribute__((ext_vector_type(4)));
typedef unsigned v2u __attribute__((ext_vector_type(2)));
typedef float f32x4 __attribute__((ext_vector_type(4)));
typedef float f32x2 __attribute__((ext_vector_type(2)));
typedef short bf16x8 __attribute__((ext_vector_type(8)));
typedef short v4i16 __attribute__((ext_vector_type(4)));
typedef GAS unsigned gu32;
#define RLX_AGENT __ATOMIC_RELAXED, __HIP_MEMORY_SCOPE_AGENT
#define LDS_WAIT() asm volatile("s_waitcnt lgkmcnt(0)" ::: "memory")
#define VM_WAIT() asm volatile("s_waitcnt vmcnt(0)" ::: "memory")
__device__ __forceinline__ unsigned pk2(float lo, float hi) { return pg8::cvt_pk_bf16(lo, hi); }
__device__ __forceinline__ float bflo(unsigned u) { return __uint_as_float(u << 16); }
__device__ __forceinline__ float bfhi(unsigned u) { return __uint_as_float(u & 0xffff0000u); }
__device__ __forceinline__ float wave_sum(float v) {
#pragma unroll
    for (int o = 1; o < 64; o <<= 1) v += __shfl_xor(v, o);
    return v;
}
__device__ __forceinline__ f32x4 mfma16(bf16x8 a, bf16x8 b, f32x4 c) { return __builtin_amdgcn_mfma_f32_16x16x32_bf16(a, b, c, 0, 0, 0); }
__device__ __forceinline__ v4i16 trrd(LAS unsigned char* p) { return __builtin_amdgcn_ds_read_tr16_b64_v4i16((LAS v4i16*)p); }
__device__ __forceinline__ bf16x8 cat8(v4i16 lo, v4i16 hi) { return (bf16x8){lo[0], lo[1], lo[2], lo[3], hi[0], hi[1], hi[2], hi[3]}; }
__device__ __forceinline__ bf16x8 pack8(float a0, float a1, float a2, float a3, float a4, float a5, float a6, float a7) {
    v4u w; w.x = pk2(a0, a1); w.y = pk2(a2, a3); w.z = pk2(a4, a5); w.w = pk2(a6, a7); return __builtin_bit_cast(bf16x8, w); }
__device__ __forceinline__ float silu(float x) { return x * __builtin_amdgcn_rcpf(1.0f + __expf(-x)); }

#define XB_TMO      128
#define XB_XCNT(j)  (256  + 64 * (j))
#define XB_XSUB(j)  (1280 + 64 * (j))
#define XB_XGEN(j)  (2304 + 64 * (j))
#define XB_TOP      3328
#define XB_TOPGEN   3392
#define XCD_BAR_WORDS 3456
#define XB_SPIN_CAP (1u << 18)

__device__ __forceinline__ unsigned xb_ld(unsigned* p)              { return __hip_atomic_load(p, __ATOMIC_RELAXED, __HIP_MEMORY_SCOPE_AGENT); }
__device__ __forceinline__ unsigned xb_add(unsigned* p, unsigned v) { return __hip_atomic_fetch_add(p, v, __ATOMIC_RELAXED, __HIP_MEMORY_SCOPE_AGENT); }
__device__ __forceinline__ unsigned xb_xcc_id() { return (unsigned)__builtin_amdgcn_s_getreg((3 << 11) | 20) & 0xFu; }
#define XB_SPIN(cond, bar) do { unsigned _sp = 0; while (cond) { __builtin_amdgcn_s_sleep(1); \
    if ((++_sp & 255u) == 0u) { if (xb_ld(&(bar)[XB_TMO])) break; if (_sp > XB_SPIN_CAP) { atomicAdd(&(bar)[XB_TMO], 1u); break; } } } } while (0)

struct XcdBarrier {
    unsigned* bar; unsigned x;
    volatile LAS unsigned* st;
};

__device__ __forceinline__ XcdBarrier xcd_barrier_post(unsigned* bar, volatile LAS unsigned* st) {
    XcdBarrier b; b.bar = bar; b.x = xb_xcc_id(); b.st = st;
    if (threadIdx.x == 0) (void)xb_add(&bar[XB_XCNT(b.x)], 1u);
    return b;
}
__device__ __forceinline__ void xcd_barrier_complete(unsigned* bar, unsigned x, unsigned& nloc, unsigned& nx) {
    const unsigned G = gridDim.x * gridDim.y * gridDim.z;
    unsigned sum, cnt, mine, sp = 0u;
    for (;;) {
        sum = 0u; cnt = 0u; mine = 0u;
#pragma unroll
        for (unsigned j = 0; j < 16; ++j) { const unsigned c = xb_ld(&bar[XB_XCNT(j)]); sum += c; cnt += (c > 0u) ? 1u : 0u; mine = (j == x) ? c : mine; }
        if (sum == G) break;
        __builtin_amdgcn_s_sleep(1);
        if ((++sp & 255u) == 0u) { if (xb_ld(&bar[XB_TMO])) break; if (sp > XB_SPIN_CAP) { atomicAdd(&bar[XB_TMO], 1u); break; } }
    }
    nloc = mine > 0u ? mine : 1u; nx = cnt > 0u ? cnt : 1u;
}

__device__ __forceinline__ void xcd_barrier(const XcdBarrier& b) {
    asm volatile("s_waitcnt vmcnt(0)" ::: "memory");
    __syncthreads();
    if (threadIdx.x == 0) {
        unsigned* bar = b.bar;
        __builtin_amdgcn_s_waitcnt(0);
        unsigned nloc = b.st[0], nx = b.st[1];
        if (nloc == 0u) { xcd_barrier_complete(bar, b.x, nloc, nx); b.st[0] = nloc; b.st[1] = nx; }
        const unsigned old = xb_add(&bar[XB_XSUB(b.x)], 1u);
        const unsigned gen = old / nloc;
        if (old + 1u == (gen + 1u) * nloc) {
            __builtin_amdgcn_fence(__ATOMIC_RELEASE, "agent");
            asm volatile("s_waitcnt vmcnt(0)" ::: "memory");
            const unsigned og = xb_add(&bar[XB_TOP], 1u);
            const unsigned tg = og / nx;
            if (og + 1u == (tg + 1u) * nx) xb_add(&bar[XB_TOPGEN], 1u);
            else XB_SPIN(xb_ld(&bar[XB_TOPGEN]) == tg, bar);
            __builtin_amdgcn_fence(__ATOMIC_ACQUIRE, "agent");
            xb_add(&bar[XB_XGEN(b.x)], 1u);
            asm volatile("s_waitcnt vmcnt(0)" ::: "memory");
        } else {
            XB_SPIN(xb_ld(&bar[XB_XGEN(b.x)]) == gen, bar);
            __builtin_amdgcn_fence(__ATOMIC_ACQUIRE, "agent");
            asm volatile("s_waitcnt vmcnt(0)" ::: "memory");
        }
    }
    __syncthreads();
}

constexpr int NWAVES = 8, NTHR = 512;
constexpr int D = 1024, SEQ = 8192, NBATCH = 4, M = NBATCH * SEQ, NCHUNK = SEQ / 64;
constexpr int DIN = 2824, PN = 2816;
constexpr int PC_Z = 0, PC_XBC = 512, PC_U = 1536, PC_V = 1792, PC_Q = 2048, PC_K = 2304, PC_VV = 2560;
constexpr int DFF = 2816, DFFE = 3584, NEXP = 8;
constexpr int MOE_CH = 128, MOE_NCH = 2, MOE_MAXT = 264;
constexpr int NIN = 27;
constexpr int CVT_SMALL_TASKS = 1408 + 512 + 1408 + 704, MOE_GU_TASKS = 14336, MOE_CVT_TASKS = 14336 + 7168;
constexpr size_t MiB = 1u << 20;
constexpr size_t WS_CTL = 0, CTL_ZERO_BYTES = 65536;
constexpr size_t WS_AEND = 65536, WS_WGCNT = 98304;
constexpr size_t WS_DTRAW = 1 * MiB, WS_TOKE = 2 * MiB, WS_TOKG = 2 * MiB + 262144, WS_POS = 2 * MiB + 524288;
constexpr size_t WS_WIN = 4 * MiB, WS_WOUT = 15 * MiB, WS_WGU = 19 * MiB, WS_WD = 30 * MiB;
constexpr size_t WS_A1 = 36 * MiB, WS_XBCC = 36 * MiB;
constexpr size_t WS_PROJ = 100 * MiB, WS_MIXED = 100 * MiB, WS_H1 = 100 * MiB;
constexpr size_t WS_ST = 276 * MiB, WS_FOUT = 276 * MiB;
constexpr size_t WS_Y = 340 * MiB;
constexpr size_t WS_HB = 404 * MiB;
constexpr size_t WS_HM = 36 * MiB, WS_XS = 155 * MiB, WS_YM = 221 * MiB, WS_MWD = 353 * MiB, WS_MWGU = 468 * MiB, WS_END = 524 * MiB;
constexpr float FP8_SX = 8.0f, FP8_SW = 64.0f, FP8_SH = 16.0f;
constexpr int CW_BAR = 4096, CW_TQ = 8192;
constexpr int LDS_BYTES = 163840, LDSCTL_OFF = 147456;
constexpr int CTL_MISC = LDSCTL_OFF, CTL_CNT = LDSCTL_OFF + 128, CTL_TE = LDSCTL_OFF + 512;

#ifndef PROBE_DUP
#define PROBE_DUP 0
#endif
#ifndef PROBE_TG
#define PROBE_TG -1
#endif
__device__ __forceinline__ int tgroup_of(int k) {
    if (k == 0) return 0;
    const int L = (k - 1) >> 4, r = (k - 1) & 15;
    if (r == 0 || r == 4) return 1;
    if (r == 1) return 2;
    if (r == 2) return 3;
    if (r == 3) return 4;
    if (r == 5) return L == 0 ? 5 : 9;
    if (L == 0) return r == 8 ? 5 : 6;
    if (r == 6) return 7;
    if (r == 7 + 2 * 2) return 5;
    return 8;
}
#define REP(n) for (int rep_ = 0; rep_ < (((PROBE_DUP >> (n)) & 1) ? 2 : 1); ++rep_)
struct Args { const float* in[NIN]; float* out; unsigned char* ws; int ph_lo, ph_hi; };

#ifndef PROBE_TG
#define PROBE_TG -1
#endif
typedef const __attribute__((address_space(4))) Args* ArgsP;
typedef const __attribute__((address_space(4))) Args& ArgsRef;
struct Frame {
    LAS unsigned char* lds;
    int tid, lane, wave, vcu, G;
#if PROBE_TG >= 30
    unsigned long long tr_acc, tr_mark;
#endif
};
#if PROBE_TG >= 30
#define TR0(F) ((F).tr_mark = __builtin_amdgcn_s_memrealtime())
#define TR(F, id) do { const unsigned long long n_ = __builtin_amdgcn_s_memrealtime(); if ((id) == PROBE_TG) (F).tr_acc += n_ - (F).tr_mark; (F).tr_mark = n_; } while (0)
#else
#define TR0(F) do { } while (0)
#define TR(F, id) do { } while (0)
#endif
__device__ __forceinline__ bool relaunder(ArgsP& p) { asm volatile("" : "+s"(p)); return true; }
__device__ __forceinline__ bool fresh(Frame& F) { int t_ = threadIdx.x; asm volatile("" : "+v"(t_)); F.tid = t_; F.lane = t_ & 63; F.wave = __builtin_amdgcn_readfirstlane(t_ >> 6); return true; }

__device__ __forceinline__ void cvt_task(const float* W, int N, int k0, int n0, bf16* WT, int K, int row0, int lane) {
    const float* s = W + (size_t)k0 * N + n0 + lane;
    bf16* d = WT + (size_t)(row0 + lane) * K + k0;
    float v[64];
#pragma unroll
    for (int j = 0; j < 64; ++j) v[j] = __builtin_nontemporal_load(s + (size_t)j * N);
#pragma unroll
    for (int q = 0; q < 8; ++q) { v4u o; o.x = pk2(v[8 * q], v[8 * q + 1]); o.y = pk2(v[8 * q + 2], v[8 * q + 3]); o.z = pk2(v[8 * q + 4], v[8 * q + 5]); o.w = pk2(v[8 * q + 6], v[8 * q + 7]);
        *(GAS v4u*)(d + 8 * q) = o; }
}
__device__ __forceinline__ void cvt_small_weights(Frame& F, ArgsRef A, int t_lo, int t_hi, int gw, int NGW) {
    bf16* WIN = (bf16*)(A.ws + WS_WIN); bf16* WOUT = (bf16*)(A.ws + WS_WOUT); bf16* WGU = (bf16*)(A.ws + WS_WGU); bf16* WD = (bf16*)(A.ws + WS_WD);
    for (int it = t_lo + gw; it < t_hi; it += NGW) {
        int r = it;
        if (r < 1408) { const int L = r / 704; r %= 704; const int kb = r / 44, nb = r % 44; const int ns = 64 * nb + (64 * nb >= 1536 ? 8 : 0);
            cvt_task(A.in[5] + (size_t)L * D * DIN, DIN, 64 * kb, ns, WIN + (size_t)L * PN * D, D, 64 * nb, F.lane); continue; }
        r -= 1408;
        if (r < 512) { const int L = r / 256; r %= 256; const int kb = r / 16, nb = r % 16;
            cvt_task(A.in[19] + (size_t)L * D * D, D, 64 * kb, 64 * nb, WOUT + (size_t)L * D * D, D, 64 * nb, F.lane); continue; }
        r -= 512;
        if (r < 1408) { const int up = r / 704; r %= 704; const int kb = r / 44, nb = r % 44;
            cvt_task(up ? A.in[21] : A.in[20], DFF, 64 * kb, 64 * nb, WGU, D, 256 * (nb >> 1) + 64 * (nb & 1) + 128 * up, F.lane); continue; }
        r -= 1408;
        { const int kb = r / 16, nb = r % 16; cvt_task(A.in[22], D, 64 * kb, 64 * nb, WD, DFF, 64 * nb, F.lane); }
    }
}
__device__ __forceinline__ void cvt_task8(const float* W, int N, int k0, int n0, unsigned char* WT, int K, int row0, float scale, int lane) {
    const float* s = W + (size_t)k0 * N + n0 + lane;
    unsigned char* d = WT + (size_t)(row0 + lane) * K + k0;
    float v[64];
#pragma unroll
    for (int j = 0; j < 64; ++j) v[j] = __builtin_nontemporal_load(s + (size_t)j * N);
#pragma unroll
    for (int q = 0; q < 4; ++q) { v4u o;
        o.x = pg8::pack_fp8x4(v[16 * q] * scale, v[16 * q + 1] * scale, v[16 * q + 2] * scale, v[16 * q + 3] * scale); o.y = pg8::pack_fp8x4(v[16 * q + 4] * scale, v[16 * q + 5] * scale, v[16 * q + 6] * scale, v[16 * q + 7] * scale);
        o.z = pg8::pack_fp8x4(v[16 * q + 8] * scale, v[16 * q + 9] * scale, v[16 * q + 10] * scale, v[16 * q + 11] * scale); o.w = pg8::pack_fp8x4(v[16 * q + 12] * scale, v[16 * q + 13] * scale, v[16 * q + 14] * scale, v[16 * q + 15] * scale);
        *(GAS v4u*)(d + 16 * q) = o; }
}
__device__ __forceinline__ void cvt_moe_weights(Frame& F, ArgsRef A, int t_lo, int t_hi, int gw, int NGW) {
    unsigned char* MWGU = A.ws + WS_MWGU; unsigned char* MWD = A.ws + WS_MWD;
    for (int it = t_lo + gw; it < t_hi; it += NGW) {
        int r = it;
        if (r < 14336) { const int ue = r / 896; r %= 896; const int up = ue >> 3, e = ue & 7; const int kb = r / 56, nb = r % 56;
            cvt_task8((up ? A.in[25] : A.in[24]) + (size_t)e * D * DFFE, DFFE, 64 * kb, 64 * nb, MWGU + (size_t)e * 7168 * D, D, 256 * (nb >> 1) + 64 * (nb & 1) + 128 * up, FP8_SW, F.lane); continue; }
        r -= 14336;
        { const int e = r / 896; r %= 896; const int kb = r / 16, nb = r % 16;
          cvt_task8(A.in[26] + (size_t)e * DFFE * D, D, 64 * kb, 64 * nb, MWD + (size_t)e * D * DFFE, DFFE, 64 * nb, FP8_SW, F.lane); }
    }
}

struct RowArgs {
    const float* hsrc; float* hdst;
    const bf16* hsrc16; bf16* hdst16;
    int branch;
    const bf16* ybuf; const float* gpost;
    const float* gpre; bf16* a1;
    int proj;
    const float* w8; int w8ld;
};
__device__ __forceinline__ void row_phase(Frame& F, ArgsRef A, const RowArgs& R) {
    LAS float* W8T = (LAS float*)F.lds;
    LAS int* cnt = (LAS int*)(F.lds + CTL_CNT);
    const int lane = F.lane;
    if (R.proj) { for (int idx = F.tid; idx < 8192; idx += NTHR) { const int e = idx & 7, k = idx >> 3; W8T[e * 1024 + k] = R.w8[(size_t)k * R.w8ld + e]; } }
    if (R.proj == 2 && F.tid < 8) cnt[F.tid] = 0;
    __syncthreads();
    f32x4 gpo[4], gpr[4];
#pragma unroll
    for (int j = 0; j < 4; ++j) { gpo[j] = R.branch ? *(const f32x4*)(R.gpost + 4 * lane + 256 * j) : (f32x4){0.f, 0.f, 0.f, 0.f}; gpr[j] = R.gpre ? *(const f32x4*)(R.gpre + 4 * lane + 256 * j) : (f32x4){0.f, 0.f, 0.f, 0.f}; }
    float* DTRAW = (float*)(A.ws + WS_DTRAW); int* TOKE = (int*)(A.ws + WS_TOKE); float* TOKG = (float*)(A.ws + WS_TOKG); const int* POS = (const int*)(A.ws + WS_POS);
    const int gw = F.vcu * NWAVES + F.wave, NGW = F.G * NWAVES;
    f32x4 hf[4][4]; v2u hp[4][4], y0p[4][4], y1p[4][4]; int ip0[4], ip1[4]; float ig0[4], ig1[4], gc0[4], gc1[4];
#define ROW_IDX(q, mm) do { if (R.branch == 2 && (mm) < M) { ip0[q] = POS[2 * (mm)]; ip1[q] = POS[2 * (mm) + 1]; ig0[q] = TOKG[2 * (mm)]; ig1[q] = TOKG[2 * (mm) + 1]; } } while (0)
#define ROW_DATA(q, mm) do { if ((mm) < M) { \
        if (R.hsrc) { _Pragma("unroll") for (int j = 0; j < 4; ++j) hf[q][j] = *(const f32x4*)(R.hsrc + (size_t)(mm) * D + 4 * lane + 256 * j); } \
        else { _Pragma("unroll") for (int j = 0; j < 4; ++j) hp[q][j] = *(const v2u*)(R.hsrc16 + (size_t)(mm) * D + 4 * lane + 256 * j); } \
        if (R.branch == 1) { _Pragma("unroll") for (int j = 0; j < 4; ++j) y0p[q][j] = *(const v2u*)(R.ybuf + (size_t)(mm) * D + 4 * lane + 256 * j); } \
        if (R.branch == 2) { gc0[q] = ig0[q]; gc1[q] = ig1[q]; _Pragma("unroll") for (int j = 0; j < 4; ++j) { y0p[q][j] = *(const v2u*)(R.ybuf + (size_t)ip0[q] * D + 4 * lane + 256 * j); y1p[q][j] = *(const v2u*)(R.ybuf + (size_t)ip1[q] * D + 4 * lane + 256 * j); } } } } while (0)
#pragma unroll
    for (int q = 0; q < 4; ++q) { ip0[q] = 0; ip1[q] = 0; ig0[q] = 0.f; ig1[q] = 0.f; gc0[q] = 0.f; gc1[q] = 0.f; ROW_IDX(q, gw + q * NGW); }
#pragma unroll
    for (int q = 0; q < 4; ++q) { ROW_DATA(q, gw + q * NGW); ROW_IDX(q, gw + (q + 4) * NGW); }
    for (int mb = gw; mb < M; mb += 4 * NGW) {
#pragma unroll
        for (int q = 0; q < 4; ++q) {
        const int m = mb + q * NGW;
        if (m < M) {
        f32x4 v[4], y[4];
#pragma unroll
        for (int j = 0; j < 4; ++j) v[j] = R.hsrc ? hf[q][j] : (f32x4){bflo(hp[q][j].x), bfhi(hp[q][j].x), bflo(hp[q][j].y), bfhi(hp[q][j].y)};
        if (R.branch == 1) {
#pragma unroll
            for (int j = 0; j < 4; ++j) y[j] = (f32x4){bflo(y0p[q][j].x), bfhi(y0p[q][j].x), bflo(y0p[q][j].y), bfhi(y0p[q][j].y)};
        } else if (R.branch == 2) {
#pragma unroll
            for (int j = 0; j < 4; ++j) y[j] = (f32x4){gc0[q] * bflo(y0p[q][j].x) + gc1[q] * bflo(y1p[q][j].x), gc0[q] * bfhi(y0p[q][j].x) + gc1[q] * bfhi(y1p[q][j].x), gc0[q] * bflo(y0p[q][j].y) + gc1[q] * bflo(y1p[q][j].y), gc0[q] * bfhi(y0p[q][j].y) + gc1[q] * bfhi(y1p[q][j].y)};
        }
        ROW_DATA(q, m + 4 * NGW); ROW_IDX(q, m + 8 * NGW);
        __builtin_amdgcn_sched_barrier(0);
        if (R.branch) {
            float ss = 0.f;
#pragma unroll
            for (int j = 0; j < 4; ++j) ss += (y[j].x * y[j].x + y[j].y * y[j].y) + (y[j].z * y[j].z + y[j].w * y[j].w);
            const float sc = 1.0f / sqrtf(wave_sum(ss) * (1.0f / D) + 1e-6f);
#pragma unroll
            for (int j = 0; j < 4; ++j) v[j] = v[j] + y[j] * sc * gpo[j];
        }
        if (R.hdst) {
#pragma unroll
            for (int j = 0; j < 4; ++j) *(f32x4*)(R.hdst + (size_t)m * D + 4 * lane + 256 * j) = v[j];
        }
        if (R.hdst16) {
#pragma unroll
            for (int j = 0; j < 4; ++j) { v2u o; o.x = pk2(v[j].x, v[j].y); o.y = pk2(v[j].z, v[j].w); *(v2u*)(R.hdst16 + (size_t)m * D + 4 * lane + 256 * j) = o; }
        }
        if (R.gpre) {
            float ss = 0.f;
#pragma unroll
            for (int j = 0; j < 4; ++j) ss += (v[j].x * v[j].x + v[j].y * v[j].y) + (v[j].z * v[j].z + v[j].w * v[j].w);
            const float sc = 1.0f / sqrtf(wave_sum(ss) * (1.0f / D) + 1e-6f);
#pragma unroll
            for (int j = 0; j < 4; ++j) { v[j] = v[j] * sc * gpr[j]; v2u o; o.x = pk2(v[j].x, v[j].y); o.y = pk2(v[j].z, v[j].w); *(v2u*)(R.a1 + (size_t)m * D + 4 * lane + 256 * j) = o; }
            if (R.proj) {
                float p[8];
#pragma unroll
                for (int e = 0; e < 8; ++e) { float s = 0.f;
#pragma unroll
                    for (int j = 0; j < 4; ++j) { const f32x4 w = *(const LAS f32x4*)(W8T + e * 1024 + 4 * lane + 256 * j); s += (v[j].x * w.x + v[j].y * w.y) + (v[j].z * w.z + v[j].w * w.w); }
                    p[e] = wave_sum(s); }
                if (R.proj == 1) {
                    float mine = p[0];
#pragma unroll
                    for (int e = 1; e < 8; ++e) mine = (lane == e) ? p[e] : mine;
                    if (lane < 8) DTRAW[(size_t)m * 8 + lane] = mine;
                } else {
                    float best = p[0]; int bi = 0;
#pragma unroll
                    for (int e = 1; e < 8; ++e) if (p[e] > best) { best = p[e]; bi = e; }
                    float sb = -3.0e38f; int si = 0;
#pragma unroll
                    for (int e = 0; e < 8; ++e) if (e != bi && p[e] > sb) { sb = p[e]; si = e; }
                    const float g0 = 1.0f / (1.0f + expf(sb - best)), g1 = 1.0f - g0;
                    if (lane == 0) { TOKE[2 * m] = bi; TOKE[2 * m + 1] = si; TOKG[2 * m] = g0; TOKG[2 * m + 1] = g1;
                        __hip_atomic_fetch_add(cnt + bi, 1, __ATOMIC_RELAXED, __HIP_MEMORY_SCOPE_WORKGROUP); __hip_atomic_fetch_add(cnt + si, 1, __ATOMIC_RELAXED, __HIP_MEMORY_SCOPE_WORKGROUP); }
                }
            }
        }
        }
        __builtin_amdgcn_sched_barrier(0);
        }
    }
#undef ROW_DATA
#undef ROW_IDX
    if (R.proj == 2) { __syncthreads(); if (F.tid < 8) ((int*)(A.ws + WS_WGCNT))[F.vcu * 8 + F.tid] = cnt[F.tid]; }
    __syncthreads();
}

__device__ __forceinline__ void moe_tables(Frame& F, ArgsRef A) {
    LAS int* c = (LAS int*)(F.lds + CTL_CNT); LAS int* te = (LAS int*)(F.lds + CTL_TE);
    if (F.tid < 48) c[F.tid] = 0;
    __syncthreads();
    const int* WGCNT = (const int*)(A.ws + WS_WGCNT);
    for (int idx = F.tid; idx < F.G * 8; idx += NTHR) { const int wg = idx >> 3, e = idx & 7; const int v = WGCNT[idx];
        __hip_atomic_fetch_add(c + e, v, __ATOMIC_RELAXED, __HIP_MEMORY_SCOPE_WORKGROUP); if (wg < F.vcu) __hip_atomic_fetch_add(c + 8 + e, v, __ATOMIC_RELAXED, __HIP_MEMORY_SCOPE_WORKGROUP); }
    __syncthreads();
    if (F.tid == 0) { int t = 0;
#pragma unroll 1
        for (int e = 0; e < 8; ++e) { c[16 + e] = t * 256; t += (c[e] + 255) >> 8; c[40 + e] = t; }
        c[32] = t < MOE_MAXT ? t : MOE_MAXT; }
    __syncthreads();
    if (F.tid < MOE_MAXT) { int e = 0;
#pragma unroll
        for (int q = 0; q < 7; ++q) e += (F.tid >= c[40 + q]) ? 1 : 0;
        te[F.tid] = e; }
    __syncthreads();
}
__device__ __forceinline__ void moe_gather(Frame& F, ArgsRef A) {
    LAS int* c = (LAS int*)(F.lds + CTL_CNT);
    const int* TOKE = (const int*)(A.ws + WS_TOKE); int* POS = (int*)(A.ws + WS_POS);
    const bf16* A1 = (const bf16*)(A.ws + WS_A1); unsigned char* XS = A.ws + WS_XS;
    const int gw = F.vcu * NWAVES + F.wave, NGW = F.G * NWAVES, lane = F.lane;
    for (int mb = gw; mb < M; mb += 4 * NGW) {
        v4u r0[4], r1[4]; int d0[4], d1[4];
#pragma unroll
        for (int q = 0; q < 4; ++q) { const int m = mb + q * NGW; d0[q] = 0; d1[q] = 0;
            if (m < M) { r0[q] = *(const v4u*)(A1 + (size_t)m * D + 16 * lane); r1[q] = *(const v4u*)(A1 + (size_t)m * D + 16 * lane + 8);
                if (lane == 0) { const int e0 = TOKE[2 * m], e1 = TOKE[2 * m + 1];
                    d0[q] = c[16 + e0] + c[8 + e0] + __hip_atomic_fetch_add(c + 24 + e0, 1, __ATOMIC_RELAXED, __HIP_MEMORY_SCOPE_WORKGROUP);
                    d1[q] = c[16 + e1] + c[8 + e1] + __hip_atomic_fetch_add(c + 24 + e1, 1, __ATOMIC_RELAXED, __HIP_MEMORY_SCOPE_WORKGROUP);
                    POS[2 * m] = d0[q]; POS[2 * m + 1] = d1[q]; } } }
#pragma unroll
        for (int q = 0; q < 4; ++q) { const int m = mb + q * NGW;
            if (m < M) { const int e0 = __builtin_amdgcn_readfirstlane(d0[q]), e1 = __builtin_amdgcn_readfirstlane(d1[q]);
                v4u o;
                o.x = pg8::pack_fp8x4(bflo(r0[q].x) * FP8_SX, bfhi(r0[q].x) * FP8_SX, bflo(r0[q].y) * FP8_SX, bfhi(r0[q].y) * FP8_SX); o.y = pg8::pack_fp8x4(bflo(r0[q].z) * FP8_SX, bfhi(r0[q].z) * FP8_SX, bflo(r0[q].w) * FP8_SX, bfhi(r0[q].w) * FP8_SX);
                o.z = pg8::pack_fp8x4(bflo(r1[q].x) * FP8_SX, bfhi(r1[q].x) * FP8_SX, bflo(r1[q].y) * FP8_SX, bfhi(r1[q].y) * FP8_SX); o.w = pg8::pack_fp8x4(bflo(r1[q].z) * FP8_SX, bfhi(r1[q].z) * FP8_SX, bflo(r1[q].w) * FP8_SX, bfhi(r1[q].w) * FP8_SX);
                *(v4u*)(XS + (size_t)e0 * D + 16 * lane) = o; *(v4u*)(XS + (size_t)e1 * D + 16 * lane) = o; } }
    }
    __syncthreads();
}

__device__ __forceinline__ void gmlp_unit(Frame& F, ArgsRef A, int L, int nb) {
    LAS unsigned char* Ls = F.lds; int tl_ = F.tid; asm volatile("" : "+v"(tl_));
    const int tid = tl_, lane = tid & 63, w = F.wave, fr = lane & 15, q4 = lane >> 4;
    const size_t m0 = (size_t)nb * 128;
    const bf16* P = (const bf16*)(A.ws + WS_PROJ); bf16* Y = (bf16*)(A.ws + WS_Y);
    { const f32x4 g4 = *(const f32x4*)(A.in[12] + L * 256 + 4 * lane), b4 = *(const f32x4*)(A.in[13] + L * 256 + 4 * lane);
      v2u rawv[16];
#pragma unroll
      for (int i = 0; i < 16; ++i) rawv[i] = *(const v2u*)(P + (m0 + 16 * w + i) * PN + PC_V + 4 * lane);
#pragma unroll
      for (int i = 0; i < 16; ++i) { const int r = 16 * w + i;
        const v2u raw = rawv[i];
        f32x4 v = (f32x4){bflo(raw.x), bfhi(raw.x), bflo(raw.y), bfhi(raw.y)};
        const float mu = wave_sum((v.x + v.y) + (v.z + v.w)) * (1.0f / 256.0f);
        v = v - mu;
        const float var = wave_sum((v.x * v.x + v.y * v.y) + (v.z * v.z + v.w * v.w)) * (1.0f / 256.0f);
        const float rstd = 1.0f / sqrtf(var + 1e-5f);
        v = v * rstd * g4 + b4;
        v2u o; o.x = pk2(v.x, v.y); o.y = pk2(v.z, v.w);
        *(LAS v2u*)(Ls + r * 544 + lane * 8) = o; } }
    const int g = w & 3;
    f32x4 acc[4][4];
    const float* Wg = A.in[14] + (size_t)(L * 4 + g) * 128 * 128;
    const float* bsg = A.in[15] + (size_t)(L * 4 + g) * 128;
    f32x4 wfa[4][4], wfb[4][4];
#pragma unroll
    for (int pi = 0; pi < 4; ++pi) {
        const int it = (w >> 2) == 0 ? (pi == 0 ? 0 : pi == 1 ? 7 : pi == 2 ? 1 : 6) : (pi == 0 ? 2 : pi == 1 ? 5 : pi == 2 ? 3 : 4);
#pragma unroll
        for (int ks = 0; ks < 4; ++ks) { wfa[pi][ks] = *(const f32x4*)(Wg + (16 * it + fr) * 128 + 32 * ks + 4 * q4); wfb[pi][ks] = *(const f32x4*)(Wg + (16 * it + fr) * 128 + 32 * ks + 4 * q4 + 16); }
    }
    __syncthreads();
#pragma unroll
    for (int pi = 0; pi < 4; ++pi) {
        const int it = (w >> 2) == 0 ? (pi == 0 ? 0 : pi == 1 ? 7 : pi == 2 ? 1 : 6) : (pi == 0 ? 2 : pi == 1 ? 5 : pi == 2 ? 3 : 4);
#pragma unroll
        for (int ct = 0; ct < 4; ++ct) acc[pi][ct] = (f32x4){0.f, 0.f, 0.f, 0.f};
        const int t = 16 * it + fr, nks = (it >> 1) + 1;
#pragma unroll
        for (int ks = 0; ks < 4; ++ks) {
            if (ks < nks) {
            const int sA = 32 * ks + 4 * q4, sB = sA + 16;
            const f32x4 wa = wfa[pi][ks], wb = wfb[pi][ks];
            const bf16x8 xf = pack8(sA + 0 <= t ? wa.x : 0.f, sA + 1 <= t ? wa.y : 0.f, sA + 2 <= t ? wa.z : 0.f, sA + 3 <= t ? wa.w : 0.f,
                                    sB + 0 <= t ? wb.x : 0.f, sB + 1 <= t ? wb.y : 0.f, sB + 2 <= t ? wb.z : 0.f, sB + 3 <= t ? wb.w : 0.f);
#pragma unroll
            for (int ct = 0; ct < 4; ++ct) { const int col = g * 64 + ct * 16 + 4 * (lane & 3);
                const v4i16 lo = trrd(Ls + (sA + (fr >> 2)) * 544 + col * 2), hi = trrd(Ls + (sB + (fr >> 2)) * 544 + col * 2);
                acc[pi][ct] = mfma16(xf, cat8(lo, hi), acc[pi][ct]); }
            }
        }
#pragma unroll
        for (int r = 0; r < 4; ++r) { const float bs = bsg[16 * it + 4 * q4 + r];
#pragma unroll
            for (int ct = 0; ct < 4; ++ct) acc[pi][ct][r] += bs; }
    }
    __syncthreads();
#pragma unroll
    for (int pi = 0; pi < 4; ++pi) {
        const int it = (w >> 2) == 0 ? (pi == 0 ? 0 : pi == 1 ? 7 : pi == 2 ? 1 : 6) : (pi == 0 ? 2 : pi == 1 ? 5 : pi == 2 ? 3 : 4);
#pragma unroll
        for (int ct = 0; ct < 4; ++ct)
#pragma unroll
            for (int r = 0; r < 4; ++r) *(LAS float*)(Ls + (16 * it + 4 * q4 + r) * 1040 + (g * 64 + ct * 16 + fr) * 4) = acc[pi][ct][r];
    }
    __syncthreads();
    { const f32x4 gn = *(const f32x4*)(A.in[16] + L * 256 + 4 * lane);
      v2u rawu[16];
#pragma unroll
      for (int i = 0; i < 16; ++i) rawu[i] = *(const v2u*)(P + (m0 + 16 * w + i) * PN + PC_U + 4 * lane);
#pragma unroll
      for (int i = 0; i < 16; ++i) { const int r = 16 * w + i;
        const f32x4 mx = *(const LAS f32x4*)(Ls + r * 1040 + lane * 16);
        const v2u raw = rawu[i];
        f32x4 v = (f32x4){bflo(raw.x), bfhi(raw.x), bflo(raw.y), bfhi(raw.y)} * mx;
        const float ss = wave_sum((v.x * v.x + v.y * v.y) + (v.z * v.z + v.w * v.w)) * (1.0f / 256.0f);
        v = v * (1.0f / sqrtf(ss + 1e-6f)) * gn;
        v2u o; o.x = pk2(v.x, v.y); o.y = pk2(v.z, v.w);
        *(v2u*)(Y + (m0 + r) * D + 512 + 4 * lane) = o; } }
    __syncthreads();
}

__device__ __forceinline__ void attn_unit(Frame& F, ArgsRef A, int L, int bc) {
    LAS unsigned char* Ls = F.lds; int tl_ = F.tid; asm volatile("" : "+v"(tl_));
    const int tid = tl_, lane = tid & 63, w = F.wave, fr = lane & 15, q4 = lane >> 4;
    const int b = bc >> 7, c = bc & 127; const size_t m0 = (size_t)b * SEQ + (size_t)c * 64;
    const bf16* P = (const bf16*)(A.ws + WS_PROJ); bf16* Y = (bf16*)(A.ws + WS_Y);
    const int h = w >> 1, qh = w & 1;
    LAS unsigned char* Vb = Ls + w * 10240;
    TR0(F);
    LAS float* BT = (LAS float*)(Ls + 81920);
    constexpr float LOG2E = 1.4426950408889634f;
    for (int i = tid; i < 4 * 257; i += NTHR) BT[i] = A.in[17][(size_t)L * 4 * 257 + i] * LOG2E;
    bf16x8 qf[2][2];
#pragma unroll
    for (int qb = 0; qb < 2; ++qb)
#pragma unroll
        for (int ks = 0; ks < 2; ++ks) qf[qb][ks] = *(const bf16x8*)(P + (m0 + 32 * qh + 16 * qb + fr) * PN + PC_Q + h * 64 + 32 * ks + 8 * q4);
    f32x4 o[4][2];
#pragma unroll
    for (int dt = 0; dt < 4; ++dt) { o[dt][0] = (f32x4){0.f, 0.f, 0.f, 0.f}; o[dt][1] = (f32x4){0.f, 0.f, 0.f, 0.f}; }
    float mrun[2] = {-1e30f, -1e30f}, lrun[2] = {0.f, 0.f};
    const int jmin = c >= 8 ? 0 : 8 - c;
    const bf16* Kp = P + PC_K + h * 64 + 8 * q4 + (size_t)fr * PN;
    const bf16* Vp = P + PC_VV + h * 64 + (lane & 7) * 8 + (size_t)(lane >> 3) * PN;
    bf16x8 kreg[4][2]; v4u vreg[8];
    { const size_t kr0 = m0 - (size_t)(8 - jmin) * 64;
#pragma unroll
      for (int kt = 0; kt < 4; ++kt)
#pragma unroll
          for (int ks = 0; ks < 2; ++ks) kreg[kt][ks] = *(const bf16x8*)(Kp + (kr0 + 16 * kt) * PN + 32 * ks);
#pragma unroll
      for (int i = 0; i < 8; ++i) vreg[i] = *(const v4u*)(Vp + (kr0 + 8 * i) * PN); }
    __syncthreads();
    TR(F, 33);
    const float cb = BT[h * 257 + 256];
    for (int j = jmin; j <= 8; ++j) {
        const int jn = j < 8 ? j + 1 : 8; const size_t krn = m0 - (size_t)(8 - jn) * 64;
#pragma unroll
        for (int i = 0; i < 8; ++i) *(LAS v4u*)(Vb + (i * 8 + (lane >> 3)) * 160 + (lane & 7) * 16) = vreg[i];
#pragma unroll
        for (int i = 0; i < 8; ++i) vreg[i] = *(const v4u*)(Vp + (krn + 8 * i) * PN);
        f32x4 st[4][2];
#pragma unroll
        for (int kt = 0; kt < 4; ++kt) { st[kt][0] = (f32x4){0.f, 0.f, 0.f, 0.f}; st[kt][1] = (f32x4){0.f, 0.f, 0.f, 0.f};
#pragma unroll
            for (int ks = 0; ks < 2; ++ks) { st[kt][0] = mfma16(kreg[kt][ks], qf[0][ks], st[kt][0]); st[kt][1] = mfma16(kreg[kt][ks], qf[1][ks], st[kt][1]); } }
#pragma unroll
        for (int kt = 0; kt < 4; ++kt)
#pragma unroll
            for (int ks = 0; ks < 2; ++ks) kreg[kt][ks] = *(const bf16x8*)(Kp + (krn + 16 * kt) * PN + 32 * ks);
#pragma unroll
        for (int qb = 0; qb < 2; ++qb) {
            float mx = -1e30f;
            if (j <= 5) {
#pragma unroll
                for (int kt = 0; kt < 4; ++kt)
#pragma unroll
                    for (int r = 0; r < 4; ++r) { const float s = st[kt][qb][r] * (0.125f * LOG2E) + cb; st[kt][qb][r] = s; mx = fmaxf(mx, s); }
            } else {
                const LAS float* bt = BT + h * 257 + (512 - 64 * j + 32 * qh + 16 * qb + fr - 4 * q4 + 128);
                const int i0 = 512 - 64 * j + 32 * qh + 16 * qb + fr - 4 * q4 + 128;
#pragma unroll
                for (int kt = 0; kt < 4; ++kt)
#pragma unroll
                    for (int r = 0; r < 4; ++r) { int idx = i0 - 16 * kt - r; idx = idx > 256 ? 256 : idx;
                        const float s = st[kt][qb][r] * (0.125f * LOG2E) + BT[h * 257 + idx]; st[kt][qb][r] = s; mx = fmaxf(mx, s); }
                (void)bt;
            }
            mx = fmaxf(mx, __shfl_xor(mx, 16)); mx = fmaxf(mx, __shfl_xor(mx, 32));
            const float mold = mrun[qb], mnew = fmaxf(mold, mx); mrun[qb] = mnew;
            float rs = 0.f;
#pragma unroll
            for (int kt = 0; kt < 4; ++kt)
#pragma unroll
                for (int r = 0; r < 4; ++r) { const float p = __builtin_amdgcn_exp2f(st[kt][qb][r] - mnew); st[kt][qb][r] = p; rs += p; }
            rs += __shfl_xor(rs, 16); rs += __shfl_xor(rs, 32);
            if (__any(mnew > mold)) { const float alpha = __builtin_amdgcn_exp2f(mold - mnew); lrun[qb] = lrun[qb] * alpha + rs;
#pragma unroll
                for (int dt = 0; dt < 4; ++dt) o[dt][qb] = o[dt][qb] * alpha; }
            else lrun[qb] += rs;
        }
#pragma unroll
        for (int kk = 0; kk < 2; ++kk) {
            const bf16x8 y0 = pack8(st[2 * kk][0][0], st[2 * kk][0][1], st[2 * kk][0][2], st[2 * kk][0][3], st[2 * kk + 1][0][0], st[2 * kk + 1][0][1], st[2 * kk + 1][0][2], st[2 * kk + 1][0][3]);
            const bf16x8 y1 = pack8(st[2 * kk][1][0], st[2 * kk][1][1], st[2 * kk][1][2], st[2 * kk][1][3], st[2 * kk + 1][1][0], st[2 * kk + 1][1][1], st[2 * kk + 1][1][2], st[2 * kk + 1][1][3]);
            const int rowA = 32 * kk + 4 * q4 + (fr >> 2), rowB = rowA + 16;
#pragma unroll
            for (int dt = 0; dt < 4; ++dt) { const int cbt = (16 * dt + 4 * (lane & 3)) * 2;
                const bf16x8 xf = cat8(trrd(Vb + rowA * 160 + cbt), trrd(Vb + rowB * 160 + cbt));
                o[dt][0] = mfma16(xf, y0, o[dt][0]); o[dt][1] = mfma16(xf, y1, o[dt][1]); }
        }
    }
    const float il0 = 1.0f / lrun[0], il1 = 1.0f / lrun[1];
    __syncthreads();
    TR(F, 34);
#pragma unroll
    for (int dt = 0; dt < 4; ++dt) {
        *(LAS f32x4*)(Ls + (32 * qh + fr) * 1040 + (h * 64 + 16 * dt + 4 * q4) * 4) = o[dt][0] * il0;
        *(LAS f32x4*)(Ls + (32 * qh + 16 + fr) * 1040 + (h * 64 + 16 * dt + 4 * q4) * 4) = o[dt][1] * il1; }
    __syncthreads();
    { const f32x4 gn = *(const f32x4*)(A.in[18] + L * 256 + 4 * lane);
#pragma unroll 2
      for (int i = 0; i < 8; ++i) { const int r = 8 * w + i;
        f32x4 v = *(const LAS f32x4*)(Ls + r * 1040 + lane * 16);
        const float ss = wave_sum((v.x * v.x + v.y * v.y) + (v.z * v.z + v.w * v.w)) * (1.0f / 256.0f);
        v = v * (1.0f / sqrtf(ss + 1e-6f)) * gn;
        v2u ov; ov.x = pk2(v.x, v.y); ov.y = pk2(v.z, v.w);
        *(v2u*)(Y + (m0 + r) * D + 768 + 4 * lane) = ov; } }
    __syncthreads();
    TR(F, 35);
}

__device__ __forceinline__ void ssd_prepass(Frame& F, ArgsRef A, int L, size_t m0, LAS float* dtl, LAS float* acs) {
    const float* DTRAW = (const float*)(A.ws + WS_DTRAW);
    { const int l = F.lane, h = F.wave;
      const float x = DTRAW[(m0 + l) * 8 + h] + A.in[8][L * 8 + h];
      const float dt = x > 20.f ? x : log1pf(expf(x));
      float s = -dt * expf(A.in[9][L * 8 + h]);
#pragma unroll
      for (int o = 1; o < 64; o <<= 1) { const float t = __shfl_up(s, o); s += (l >= o) ? t : 0.f; }
      dtl[l * 8 + h] = dt; acs[l * 8 + h] = s; }
    __syncthreads();
}
__device__ __forceinline__ void ssd1_unit(Frame& F, ArgsRef A, int L, int bc) {
    LAS unsigned char* Ls = F.lds; int tl_ = F.tid; asm volatile("" : "+v"(tl_));
    const int tid = tl_, lane = tid & 63, w = F.wave, fr = lane & 15, q4 = lane >> 4;
    const int b = bc >> 7, c = bc & 127; const size_t m0 = (size_t)b * SEQ + (size_t)c * 64;
    const bf16* P = (const bf16*)(A.ws + WS_PROJ); bf16* XBCC = (bf16*)(A.ws + WS_XBCC); bf16* ST = (bf16*)(A.ws + WS_ST); float* AEND = (float*)(A.ws + WS_AEND);
    LAS unsigned char* XI = Ls; LAS unsigned char* BI = Ls + 67584;
    LAS float* dtl = (LAS float*)(Ls + 102400); LAS float* acs = (LAS float*)(Ls + 104448);
    const int cg = tid & 127, tg = tid >> 7, ch0 = 8 * cg;
    v4u raw[19];
#define SSD1_ROW(tt) do { const int lp = 16 * tg - 3 + (tt); const bool ok = (c * 64 + lp) >= 0; \
        raw[tt] = ok ? *(const v4u*)(P + (size_t)((long)m0 + lp) * PN + PC_XBC + ch0) : (v4u){0u, 0u, 0u, 0u}; } while (0)
#pragma unroll
    for (int tt = 0; tt < 11; ++tt) SSD1_ROW(tt);
    TR0(F);
    ssd_prepass(F, A, L, m0, dtl, acs);
    TR(F, 30);
    if (tid < 8) AEND[(size_t)bc * 8 + tid] = acs[63 * 8 + tid];
    { float wk[4][8], bs[8];
#pragma unroll
      for (int k = 0; k < 4; ++k) { const f32x4 a = *(const f32x4*)(A.in[6] + (size_t)(L * 4 + k) * 1024 + ch0), bq = *(const f32x4*)(A.in[6] + (size_t)(L * 4 + k) * 1024 + ch0 + 4);
          wk[k][0] = a.x; wk[k][1] = a.y; wk[k][2] = a.z; wk[k][3] = a.w; wk[k][4] = bq.x; wk[k][5] = bq.y; wk[k][6] = bq.z; wk[k][7] = bq.w; }
      { const f32x4 a = *(const f32x4*)(A.in[7] + (size_t)L * 1024 + ch0), bq = *(const f32x4*)(A.in[7] + (size_t)L * 1024 + ch0 + 4);
          bs[0] = a.x; bs[1] = a.y; bs[2] = a.z; bs[3] = a.w; bs[4] = bq.x; bs[5] = bq.y; bs[6] = bq.z; bs[7] = bq.w; }
      const int hh = cg >> 3;
#pragma unroll
      for (int t = 0; t < 16; ++t) { const int l = 16 * tg + t;
          if (t < 8) SSD1_ROW(t + 11);
          float y[8];
#pragma unroll
          for (int e = 0; e < 8; ++e) y[e] = bs[e];
#pragma unroll
          for (int k = 0; k < 4; ++k) { const v4u rw = raw[t + k];
              y[0] += wk[k][0] * bflo(rw.x); y[1] += wk[k][1] * bfhi(rw.x); y[2] += wk[k][2] * bflo(rw.y); y[3] += wk[k][3] * bfhi(rw.y);
              y[4] += wk[k][4] * bflo(rw.z); y[5] += wk[k][5] * bfhi(rw.z); y[6] += wk[k][6] * bflo(rw.w); y[7] += wk[k][7] * bfhi(rw.w); }
#pragma unroll
          for (int e = 0; e < 8; ++e) y[e] = silu(y[e]);
          v4u o; o.x = pk2(y[0], y[1]); o.y = pk2(y[2], y[3]); o.z = pk2(y[4], y[5]); o.w = pk2(y[6], y[7]);
          *(v4u*)(XBCC + (m0 + l) * 1024 + ch0) = o;
          if (cg < 64) { const float sc = dtl[l * 8 + hh] * __expf(acs[63 * 8 + hh] - acs[l * 8 + hh]);
              v4u os; os.x = pk2(y[0] * sc, y[1] * sc); os.y = pk2(y[2] * sc, y[3] * sc); os.z = pk2(y[4] * sc, y[5] * sc); os.w = pk2(y[6] * sc, y[7] * sc);
              *(LAS v4u*)(XI + l * 1056 + ch0 * 2) = os; }
          else if (cg < 96) *(LAS v4u*)(BI + l * 544 + (ch0 - 512) * 2) = o;
          __builtin_amdgcn_sched_barrier(0);
      } }
#undef SSD1_ROW
    __syncthreads();
    TR(F, 31);
    { const int h = w, gi = h >> 2;
      bf16* STh = ST + ((size_t)bc * 8 + h) * 8192;
#pragma unroll 1
      for (int nh = 0; nh < 2; ++nh) {
      f32x4 acc[4][4];
#pragma unroll
      for (int nt = 0; nt < 4; ++nt)
#pragma unroll
          for (int pt = 0; pt < 4; ++pt) acc[nt][pt] = (f32x4){0.f, 0.f, 0.f, 0.f};
#pragma unroll
      for (int ks = 0; ks < 2; ++ks) {
          const int rowA = 32 * ks + 4 * q4 + (fr >> 2), rowB = rowA + 16;
          bf16x8 yf[4];
#pragma unroll
          for (int pt = 0; pt < 4; ++pt) { const int cb = (h * 64 + 16 * pt + 4 * (lane & 3)) * 2; yf[pt] = cat8(trrd(XI + rowA * 1056 + cb), trrd(XI + rowB * 1056 + cb)); }
#pragma unroll
          for (int nt = 0; nt < 4; ++nt) { const int cb = (gi * 128 + 64 * nh + 16 * nt + 4 * (lane & 3)) * 2;
              const bf16x8 xf = cat8(trrd(BI + rowA * 544 + cb), trrd(BI + rowB * 544 + cb));
#pragma unroll
              for (int pt = 0; pt < 4; ++pt) acc[nt][pt] = mfma16(xf, yf[pt], acc[nt][pt]); }
      }
#pragma unroll
      for (int nt = 0; nt < 4; ++nt)
#pragma unroll
          for (int pt = 0; pt < 4; ++pt) { v2u o; o.x = pk2(acc[nt][pt][0], acc[nt][pt][1]); o.y = pk2(acc[nt][pt][2], acc[nt][pt][3]); *(v2u*)(STh + (16 * pt + fr) * 128 + 64 * nh + 16 * nt + 4 * q4) = o; }
      }
    }
    __syncthreads();
    TR(F, 32);
}
__device__ __forceinline__ void ssd_scan(Frame& F, ArgsRef A) {
    unsigned* ST = (unsigned*)(A.ws + WS_ST); const float* AEND = (const float*)(A.ws + WS_AEND);
    for (int it = F.vcu * NTHR + F.tid; it < 32 * 4096; it += F.G * NTHR) {
        const int bh = it >> 12, b = bh >> 3, h = bh & 7, e = (it & 4095);
        unsigned* base = ST + ((size_t)(b * NCHUNK) * 8 + h) * 4096 + e;
        float s0 = 0.f, s1 = 0.f;
        for (int c0 = 0; c0 < NCHUNK; c0 += 16) {
            unsigned v[16]; float dec[16];
#pragma unroll
            for (int i = 0; i < 16; ++i) { v[i] = base[(size_t)(c0 + i) * 32768]; dec[i] = AEND[(size_t)(b * NCHUNK + c0 + i) * 8 + h]; }
            __builtin_amdgcn_sched_barrier(0);
#pragma unroll
            for (int i = 0; i < 16; ++i) dec[i] = __expf(dec[i]);
#pragma unroll
            for (int i = 0; i < 16; ++i) { base[(size_t)(c0 + i) * 32768] = pk2(s0, s1); s0 = s0 * dec[i] + bflo(v[i]); s1 = s1 * dec[i] + bfhi(v[i]); }
        }
    }
}
__device__ __forceinline__ void ssd3_unit(Frame& F, ArgsRef A, int L, int bc) {
    LAS unsigned char* Ls = F.lds; int tl_ = F.tid; asm volatile("" : "+v"(tl_));
    const int tid = tl_, lane = tid & 63, w = F.wave, fr = lane & 15, q4 = lane >> 4;
    const int b = bc >> 7, c = bc & 127; const size_t m0 = (size_t)b * SEQ + (size_t)c * 64;
    const bf16* P = (const bf16*)(A.ws + WS_PROJ); const bf16* XBCC = (const bf16*)(A.ws + WS_XBCC); const bf16* ST = (const bf16*)(A.ws + WS_ST); bf16* Y = (bf16*)(A.ws + WS_Y);
    LAS unsigned char* XI = Ls; LAS unsigned char* BI = Ls + 67584; LAS unsigned char* CI = Ls + 102400;
    LAS float* dtl = (LAS float*)(Ls + 137216); LAS float* acs = (LAS float*)(Ls + 139264);
    const int h = w, gi = h >> 2;
    TR0(F);
    v4u stg[16];
#pragma unroll
    for (int i = 0; i < 16; ++i) { const int pc = tid + NTHR * i; stg[i] = *(const v4u*)(XBCC + (m0 + (pc >> 7)) * 1024 + 8 * (pc & 127)); }
    ssd_prepass(F, A, L, m0, dtl, acs);
#pragma unroll
    for (int i = 0; i < 16; ++i) { const int pc = tid + NTHR * i, row = pc >> 7, cg = pc & 127;
        LAS unsigned char* dst = cg < 64 ? XI + row * 1056 + cg * 16 : (cg < 96 ? BI + row * 544 + (cg - 64) * 16 : CI + row * 544 + (cg - 96) * 16);
        *(LAS v4u*)dst = stg[i]; }
    __builtin_amdgcn_sched_barrier(0);
    bf16x8 sin_[4][4];
    { const bf16* Sh = ST + ((size_t)bc * 8 + h) * 8192;
#pragma unroll
      for (int kn = 0; kn < 4; ++kn)
#pragma unroll
          for (int pt = 0; pt < 4; ++pt) sin_[kn][pt] = *(const bf16x8*)(Sh + (16 * pt + fr) * 128 + 32 * kn + 8 * q4); }
    __syncthreads();
    TR(F, 36);
    f32x4 acc[4][4];
#pragma unroll
    for (int lt = 0; lt < 4; ++lt)
#pragma unroll
        for (int pt = 0; pt < 4; ++pt) acc[lt][pt] = (f32x4){0.f, 0.f, 0.f, 0.f};
    {
#pragma unroll
      for (int kn = 0; kn < 4; ++kn) {
#pragma unroll
          for (int lt = 0; lt < 4; ++lt) { const bf16x8 xf = *(const LAS bf16x8*)(CI + (16 * lt + fr) * 544 + (gi * 128 + 32 * kn + 8 * q4) * 2);
#pragma unroll
              for (int pt = 0; pt < 4; ++pt) acc[lt][pt] = mfma16(xf, sin_[kn][pt], acc[lt][pt]); }
      }
#pragma unroll
      for (int lt = 0; lt < 4; ++lt)
#pragma unroll
          for (int r = 0; r < 4; ++r) { const float sc = __expf(acs[(16 * lt + 4 * q4 + r) * 8 + h]);
#pragma unroll
              for (int pt = 0; pt < 4; ++pt) acc[lt][pt][r] *= sc; }
    }
#pragma unroll
    for (int lt = 0; lt < 4; ++lt) {
#pragma unroll
        for (int ksp = 0; ksp <= (lt >> 1); ++ksp) {
            __builtin_amdgcn_sched_barrier(0);
            const bool hasb = (2 * ksp + 1) <= lt;
            f32x4 d0a = (f32x4){0.f, 0.f, 0.f, 0.f}, d0b = (f32x4){0.f, 0.f, 0.f, 0.f};
#pragma unroll
            for (int kn = 0; kn < 4; ++kn) { const int cb = (gi * 128 + 32 * kn + 8 * q4) * 2;
                const bf16x8 cf = *(const LAS bf16x8*)(CI + (16 * lt + fr) * 544 + cb);
                const bf16x8 ba = *(const LAS bf16x8*)(BI + (32 * ksp + fr) * 544 + cb); d0a = mfma16(ba, cf, d0a);
                if (hasb) { const bf16x8 bb = *(const LAS bf16x8*)(BI + (32 * ksp + 16 + fr) * 544 + cb); d0b = mfma16(bb, cf, d0b); } }
            const int l = 16 * lt + fr; const float al = acs[l * 8 + h];
            float ga[4], gb[4];
#pragma unroll
            for (int r = 0; r < 4; ++r) { const int sa = 32 * ksp + 4 * q4 + r, sb = sa + 16;
                ga[r] = sa <= l ? d0a[r] * __expf(al - acs[sa * 8 + h]) * dtl[sa * 8 + h] : 0.f;
                gb[r] = (hasb && sb <= l) ? d0b[r] * __expf(al - acs[sb * 8 + h]) * dtl[sb * 8 + h] : 0.f; }
            const bf16x8 xf = pack8(ga[0], ga[1], ga[2], ga[3], gb[0], gb[1], gb[2], gb[3]);
            const int rowA = 32 * ksp + 4 * q4 + (fr >> 2), rowB = rowA + 16;
#pragma unroll
            for (int pt = 0; pt < 4; ++pt) { const int cb = (h * 64 + 16 * pt + 4 * (lane & 3)) * 2;
                acc[lt][pt] = mfma16(xf, cat8(trrd(XI + rowA * 1056 + cb), trrd(XI + rowB * 1056 + cb)), acc[lt][pt]); }
        }
    }
    { const float dsk = A.in[10][L * 8 + h];
#pragma unroll
      for (int lt = 0; lt < 4; ++lt)
#pragma unroll
          for (int pt = 0; pt < 4; ++pt)
#pragma unroll
              for (int r = 0; r < 4; ++r) { const unsigned short xv = *(const LAS unsigned short*)(XI + (16 * lt + 4 * q4 + r) * 1056 + (h * 64 + 16 * pt + fr) * 2);
                  acc[lt][pt][r] += dsk * __uint_as_float((unsigned)xv << 16); } }
    __builtin_amdgcn_sched_barrier(0);
    v4u zr[8];
#pragma unroll
    for (int i = 0; i < 8; ++i) zr[i] = *(const v4u*)(P + (m0 + 8 * w + i) * PN + PC_Z + 8 * lane);
    __syncthreads();
    TR(F, 37);
#pragma unroll
    for (int lt = 0; lt < 4; ++lt)
#pragma unroll
        for (int pt = 0; pt < 4; ++pt)
#pragma unroll
            for (int r = 0; r < 4; ++r) *(LAS float*)(Ls + (16 * lt + 4 * q4 + r) * 2112 + (h * 64 + 16 * pt + fr) * 4) = acc[lt][pt][r];
    __syncthreads();
    { const f32x4 g0 = *(const f32x4*)(A.in[11] + L * 512 + 8 * lane), g1 = *(const f32x4*)(A.in[11] + L * 512 + 8 * lane + 4);
#pragma unroll
      for (int i = 0; i < 8; ++i) { const int r = 8 * w + i;
        f32x4 v0 = *(const LAS f32x4*)(Ls + r * 2112 + lane * 32), v1 = *(const LAS f32x4*)(Ls + r * 2112 + lane * 32 + 16);
        const v4u z = zr[i];
        v0 = v0 * (f32x4){silu(bflo(z.x)), silu(bfhi(z.x)), silu(bflo(z.y)), silu(bfhi(z.y))};
        v1 = v1 * (f32x4){silu(bflo(z.z)), silu(bfhi(z.z)), silu(bflo(z.w)), silu(bfhi(z.w))};
        const float ss = wave_sum((v0.x * v0.x + v0.y * v0.y) + (v0.z * v0.z + v0.w * v0.w) + (v1.x * v1.x + v1.y * v1.y) + (v1.z * v1.z + v1.w * v1.w)) * (1.0f / 512.0f);
        const float sc = 1.0f / sqrtf(ss + 1e-6f);
        v0 = v0 * sc * g0; v1 = v1 * sc * g1;
        v4u ov; ov.x = pk2(v0.x, v0.y); ov.y = pk2(v0.z, v0.w); ov.z = pk2(v1.x, v1.y); ov.w = pk2(v1.z, v1.w);
        *(v4u*)(Y + (m0 + r) * D + 8 * lane) = ov; } }
    __syncthreads();
    TR(F, 38);
}

#ifndef PROBE_FP8TEST
#define PROBE_FP8TEST 0
#endif
#if PROBE_FP8TEST
typedef int v8i __attribute__((ext_vector_type(8)));
__device__ __forceinline__ int fp8_selftest(int lane) {
    const int ij = lane & 15, g = lane >> 4;
    v8i Af, Bf;
#pragma unroll
    for (int r = 0; r < 8; ++r) { int wa = 0, wb = 0; const int k = 32 * g + 4 * r;
        wa = __builtin_amdgcn_cvt_pk_fp8_f32((float)((7 * ij + 3 * (k + 0)) % 5), (float)((7 * ij + 3 * (k + 1)) % 5), wa, false);
        wa = __builtin_amdgcn_cvt_pk_fp8_f32((float)((7 * ij + 3 * (k + 2)) % 5), (float)((7 * ij + 3 * (k + 3)) % 5), wa, true);
        wb = __builtin_amdgcn_cvt_pk_fp8_f32((float)((5 * (k + 0) + 11 * ij) % 7), (float)((5 * (k + 1) + 11 * ij) % 7), wb, false);
        wb = __builtin_amdgcn_cvt_pk_fp8_f32((float)((5 * (k + 2) + 11 * ij) % 7), (float)((5 * (k + 3) + 11 * ij) % 7), wb, true);
        Af[r] = wa; Bf[r] = wb; }
    f32x4 d = (f32x4){0.f, 0.f, 0.f, 0.f};
    d = __builtin_amdgcn_mfma_scale_f32_16x16x128_f8f6f4(Af, Bf, d, 0, 0, 0, 0, 0, 0);
    int bad = 0;
#pragma unroll
    for (int r = 0; r < 4; ++r) { const int i = 4 * g + r, j = ij; float e = 0.f;
        for (int k = 0; k < 128; ++k) e += (float)(((7 * i + 3 * k) % 5) * ((5 * k + 11 * j) % 7));
        bad += (d[r] != e + (PROBE_FP8TEST == 2 ? 1.f : 0.f)) ? 1 : 0; }
    return bad;
}
#endif
constexpr int NPHASE = 1 + 16 + 7 + 2 * MOE_NCH + 1;
__global__ void __launch_bounds__(NTHR, 2) fwd_kernel(Args kargs) {
    ArgsP ap = (ArgsP)__builtin_amdgcn_kernarg_segment_ptr();
#define args (*ap)
    extern __shared__ __attribute__((aligned(16))) unsigned char lds[];
    Frame F;
    F.lds = (LAS unsigned char*)lds;
    F.tid = threadIdx.x; F.lane = F.tid & 63; F.wave = __builtin_amdgcn_readfirstlane(F.tid >> 6);
#if PROBE_TG >= 30
    F.tr_acc = 0ull; F.tr_mark = 0ull;
#endif
    F.G = gridDim.x; { const int bx = blockIdx.x; F.vcu = (F.G % 8 == 0) ? (bx % 8) * (F.G / 8) + bx / 8 : bx; }
    gu32* ctl = (gu32*)(args.ws + WS_CTL);
    for (int u = F.tid; u < (LDS_BYTES - LDSCTL_OFF) / 4; u += NTHR) ((LAS unsigned*)(F.lds + LDSCTL_OFF))[u] = 0u;
    __syncthreads();
    XcdBarrier bar; bar.bar = (unsigned*)(ctl + CW_BAR); bar.x = 0; bar.st = nullptr;
    const int lo = args.ph_lo, hi = args.ph_hi;
    int nbar = 0;
    if (hi - lo > 1) bar = xcd_barrier_post((unsigned*)(ctl + CW_BAR), (volatile LAS unsigned*)(F.lds + CTL_MISC) + 8);
#if PROBE_TG >= 0
    unsigned long long t_acc = 0ull, t_ph = 0ull;
#define IN(k) ((lo <= (k) && (k) < hi) && fresh(F) && relaunder(ap) && ((t_ph = __builtin_amdgcn_s_memrealtime()), true))
#define T_STOP(k) do { if (tgroup_of(k) == PROBE_TG) t_acc += __builtin_amdgcn_s_memrealtime() - t_ph; } while (0)
    unsigned long long t_sub = 0ull;
#define T_SUB0() (t_sub = __builtin_amdgcn_s_memrealtime())
#define T_SUB(g) do { const unsigned long long n_ = __builtin_amdgcn_s_memrealtime(); if ((g) == PROBE_TG) t_acc += n_ - t_sub; t_sub = n_; } while (0)
#else
#define T_SUB0() do { } while (0)
#define T_SUB(g) do { } while (0)
#define IN(k) ((lo <= (k) && (k) < hi) && fresh(F) && relaunder(ap))
#define T_STOP(k) do { } while (0)
#endif
#if PROBE_TG == 20
#define SEAM(k) do { if ((k) + 1 < hi) { const unsigned long long tb_ = __builtin_amdgcn_s_memrealtime(); xcd_barrier(bar); ++nbar; t_acc += __builtin_amdgcn_s_memrealtime() - tb_; } } while (0)
#else
#define SEAM(k) do { if ((k) + 1 < hi) { REP(12) xcd_barrier(bar); ++nbar; } T_STOP(k); } while (0)
#endif
    unsigned char* ws = args.ws;
    bf16* A1 = (bf16*)(ws + WS_A1); bf16* HB = (bf16*)(ws + WS_HB); bf16* PROJ = (bf16*)(ws + WS_PROJ); bf16* Yb = (bf16*)(ws + WS_Y); bf16* MIXED = (bf16*)(ws + WS_MIXED);
    const int bid = (int)blockIdx.x;

#ifdef ONLY_UNIT
    { fresh(F); relaunder(ap);
#if ONLY_UNIT == 1
      for (int u = F.vcu; u < NBATCH * NCHUNK; u += F.G) ssd1_unit(F, args, 0, u);
#elif ONLY_UNIT == 2
      for (int u = F.vcu; u < NBATCH * NCHUNK; u += F.G) attn_unit(F, args, 0, u);
#elif ONLY_UNIT == 3
      for (int u = F.vcu; u < M / 128; u += F.G) gmlp_unit(F, args, 0, u);
#elif ONLY_UNIT == 4
      for (int u = F.vcu; u < NBATCH * NCHUNK; u += F.G) ssd3_unit(F, args, 0, u);
#elif ONLY_UNIT == 5
      { RowArgs R{nullptr, nullptr, HB, HB, 1, MIXED, args.in[2], args.in[3], A1, 2, args.in[23], 8}; row_phase(F, args, R); }
#endif
      return; }
#endif
    if (IN(0)) {
#if PROBE_FP8TEST
        if (blockIdx.x == 0 && F.wave == 0) { const int bad = fp8_selftest(F.lane); if (bad) atomicAdd((unsigned*)(args.ws + WS_CTL) + 2, (unsigned)bad); }
#endif
        cvt_small_weights(F, args, 0, 704, F.vcu * NWAVES + F.wave, F.G * NWAVES);
        __syncthreads();
        RowArgs R{args.in[0], nullptr, nullptr, nullptr, 0, nullptr, nullptr, args.in[1], A1, 1, args.in[5] + 1536, DIN};
        REP(9) row_phase(F, args, R);
        SEAM(0);
    }
#ifdef PROBE_SWEEP
    { fresh(F); const int gw = F.vcu * NWAVES + F.wave, NGW = F.G * NWAVES; float acc = 0.f;
      for (int mb = gw; mb < M; mb += PROBE_SWEEP * NGW) { f32x4 t[PROBE_SWEEP][4];
#pragma unroll
          for (int q = 0; q < PROBE_SWEEP; ++q)
#pragma unroll
              for (int j = 0; j < 4; ++j) t[q][j] = *(const f32x4*)(args.in[0] + (size_t)(mb + q * NGW) * D + 4 * F.lane + 256 * j);
#pragma unroll
          for (int q = 0; q < PROBE_SWEEP; ++q)
#pragma unroll
              for (int j = 0; j < 4; ++j) acc += t[q][j].x + t[q][j].y + t[q][j].z + t[q][j].w; }
      if (acc == 1.2345e-30f) ((float*)(args.ws + WS_CTL))[100] = acc;
      __syncthreads(); }
#endif
    for (int L = 0; L < 2; ++L) {
        const int pb = 1 + 16 * L;
        if (IN(pb + 0)) {
            pg8::Gemm g{A1, (const bf16*)(ws + WS_WIN) + (size_t)L * PN * D, M, PN, D}; pg8::StaticOrder S; S.init(M, PN, F.G, bid);
            pg8::EpiStore E{PROJ, PN, 1.0f};
            pg8::gemm_phase<pg8::EpiStore, pg8::StaticOrder, true, true>(F.lds, g, S, E);
            if (F.G == 256 && bid >= 128) { const int gw = (bid - 128) * NWAVES + F.wave;
                if (L == 0) cvt_small_weights(F, args, 704, CVT_SMALL_TASKS, gw, 128 * NWAVES); }
            else if (F.G != 256 && L == 0) cvt_small_weights(F, args, 704, CVT_SMALL_TASKS, F.vcu * NWAVES + F.wave, F.G * NWAVES);
            SEAM(pb + 0);
        }
        if (IN(pb + 1)) {
#ifdef MIX_DYNQ
            { gu32* q = ctl + CW_TQ + L * 64; LAS int* tk = (LAS int*)(F.lds + CTL_MISC + 64);
              if (F.tid == 0) *tk = (int)__hip_atomic_fetch_add(q, 1u, RLX_AGENT);
              __syncthreads();
              int t = __builtin_amdgcn_readfirstlane(*tk);
              __syncthreads();
              while (t < 1280) {
                  int nxt = 0; if (F.tid == 0) nxt = (int)__hip_atomic_fetch_add(q, 1u, RLX_AGENT);
                  if (t < 512) attn_unit(F, args, L, t);
                  else if (t < 1024) ssd1_unit(F, args, L, t - 512);
                  else gmlp_unit(F, args, L, t - 1024);
                  if (F.tid == 0) *tk = nxt;
                  __syncthreads();
                  t = __builtin_amdgcn_readfirstlane(*tk);
                  __syncthreads();
              } }
#else
            T_SUB0();
#ifdef MIX_STAGGER
            if (F.vcu & 1) { for (int u = F.vcu; u < NBATCH * NCHUNK; u += F.G) ssd1_unit(F, args, L, u); for (int u = F.vcu; u < NBATCH * NCHUNK; u += F.G) attn_unit(F, args, L, u); }
            else { for (int u = F.vcu; u < NBATCH * NCHUNK; u += F.G) attn_unit(F, args, L, u); for (int u = F.vcu; u < NBATCH * NCHUNK; u += F.G) ssd1_unit(F, args, L, u); }
            for (int u = F.vcu; u < M / 128; u += F.G) gmlp_unit(F, args, L, u);
#else
            for (int u = F.vcu; u < NBATCH * NCHUNK; u += F.G) attn_unit(F, args, L, u);
            T_SUB(11);
            for (int u = F.vcu; u < NBATCH * NCHUNK; u += F.G) ssd1_unit(F, args, L, u);
            T_SUB(10);
            for (int u = F.vcu; u < M / 128; u += F.G) gmlp_unit(F, args, L, u);
            T_SUB(12);
#endif
#endif
            SEAM(pb + 1);
        }
                if (IN(pb + 2)) { ssd_scan(F, args); SEAM(pb + 2); }
        if (IN(pb + 3)) { for (int u = F.vcu; u < NBATCH * NCHUNK; u += F.G) ssd3_unit(F, args, L, u); SEAM(pb + 3); }
        if (IN(pb + 4)) {
            pg8::Gemm g{Yb, (const bf16*)(ws + WS_WOUT) + (size_t)L * D * D, M, D, D}; pg8::StaticOrder S; S.init(M, D, F.G, bid);
            pg8::EpiStore E{MIXED, D, 1.0f};
            REP(5) pg8::gemm_phase<pg8::EpiStore, pg8::StaticOrder, true, true>(F.lds, g, S, E);
            SEAM(pb + 4);
        }
        if (IN(pb + 5)) {
            RowArgs R{L == 0 ? args.in[0] : nullptr, nullptr, HB, HB, 1, MIXED, args.in[2] + L * D, args.in[3] + L * D, A1, L == 1 ? 2 : 0, args.in[23], 8};
            if (L == 0) { REP(8) row_phase(F, args, R); } else row_phase(F, args, R);
            if (L == 1) cvt_moe_weights(F, args, 0, MOE_CVT_TASKS, F.vcu * NWAVES + F.wave, F.G * NWAVES);
            SEAM(pb + 5);
        }
        if (L == 0) {
            if (IN(pb + 6)) {
                pg8::Gemm g{A1, (const bf16*)(ws + WS_WGU), M, 2 * DFF, D}; pg8::StaticOrder S; S.init(M, 2 * DFF, F.G, bid);
                pg8::EpiSwiglu E{(bf16*)(ws + WS_H1), DFF};
                REP(6) pg8::gemm_phase<pg8::EpiSwiglu, pg8::StaticOrder, true, true>(F.lds, g, S, E);
                SEAM(pb + 6);
            }
            if (IN(pb + 7)) {
                pg8::Gemm g{(const bf16*)(ws + WS_H1), (const bf16*)(ws + WS_WD), M, D, DFF}; pg8::StaticOrder S; S.init(M, D, F.G, bid);
                pg8::EpiStore E{(bf16*)(ws + WS_FOUT), D, 1.0f};
                REP(6) pg8::gemm_phase<pg8::EpiStore, pg8::StaticOrder, true, true>(F.lds, g, S, E);
                SEAM(pb + 7);
            }
            if (IN(pb + 8)) {
                RowArgs R{nullptr, nullptr, HB, HB, 1, (const bf16*)(ws + WS_FOUT), args.in[4], args.in[1] + D, A1, 1, args.in[5] + (size_t)D * DIN + 1536, DIN};
                row_phase(F, args, R);
                SEAM(pb + 8);
            }
        } else {
#if PROBE_TG >= 10
#ifdef PROBE_TMIN
            if (lo <= pb + 6 && pb + 6 < hi && threadIdx.x == 0) atomicMax((unsigned*)(args.ws + WS_CTL) + 8, 0xffffffffu - (unsigned)t_acc);
#else
            if (lo <= pb + 6 && pb + 6 < hi && threadIdx.x == 0) atomicMax((unsigned*)(args.ws + WS_CTL) + 8, (unsigned)t_acc);
#endif
#endif
            if (IN(pb + 6)) { REP(11) { moe_tables(F, args); moe_gather(F, args); } SEAM(pb + 6); }
            for (int k = 0; k < MOE_NCH; ++k) {
                if (IN(pb + 7 + 2 * k)) {
                    moe_tables(F, args);
                    const int nT = *(LAS int*)(F.lds + CTL_CNT + 32 * 4); int nk = nT - MOE_CH * k; nk = nk < 0 ? 0 : ((k < MOE_NCH - 1 && nk > MOE_CH) ? MOE_CH : nk);
                    pg8::Gemm g{(const bf16*)(ws + WS_XS), (const bf16*)(ws + WS_MWGU), 0, 0, D / 2};
                    pg8::MoeOrder<false, true> S{MOE_CH * k, nk, 28, F.G, bid, (const LAS int*)(F.lds + CTL_TE)};
                    pg8::EpiSwiglu8 E{ws + WS_HM, DFFE, 1.0f / (FP8_SX * FP8_SW), FP8_SH};
                    REP(7) pg8::gemm_phase<pg8::EpiSwiglu8, pg8::MoeOrder<false, true>, true, true, true>(F.lds, g, S, E);
                    SEAM(pb + 7 + 2 * k);
                }
                if (IN(pb + 8 + 2 * k)) {
                    moe_tables(F, args);
                    const int nT = *(LAS int*)(F.lds + CTL_CNT + 32 * 4); int nk = nT - MOE_CH * k; nk = nk < 0 ? 0 : ((k < MOE_NCH - 1 && nk > MOE_CH) ? MOE_CH : nk);
                    pg8::Gemm g{(const bf16*)(ws + WS_HM), (const bf16*)(ws + WS_MWD), 0, 0, DFFE / 2};
                    pg8::MoeOrder<true, false> S{MOE_CH * k, nk, 4, F.G, bid, (const LAS int*)(F.lds + CTL_TE)};
                    pg8::EpiStore E{(bf16*)(ws + WS_YM), D, 1.0f / (FP8_SH * FP8_SW)};
                    REP(7) pg8::gemm_phase<pg8::EpiStore, pg8::MoeOrder<true, false>, true, true, true>(F.lds, g, S, E);
                    SEAM(pb + 8 + 2 * k);
                }
            }
            if (IN(pb + 7 + 2 * MOE_NCH)) {
                RowArgs R{nullptr, args.out, HB, nullptr, 2, (const bf16*)(ws + WS_YM), args.in[4] + D, nullptr, nullptr, 0, nullptr, 0};
                row_phase(F, args, R);
#if PROBE_FP8TEST
                if (__hip_atomic_load((unsigned*)(args.ws + WS_CTL) + 2, RLX_AGENT) != 0u) { __syncthreads(); for (size_t i = (size_t)blockIdx.x * NTHR + F.tid; i < (size_t)M * D; i += (size_t)F.G * NTHR) args.out[i] += 1.0f; }
#endif
            }
        }
    }
#if PROBE_TG >= 0
    T_STOP(1 + 16 + 7 + 2 * MOE_NCH);
#if PROBE_TG >= 10
#endif
    if (blockIdx.x == 77) { unsigned long long t_spin = t_acc;
#if PROBE_TG >= 30
        t_spin = F.tr_acc;
#endif
#if PROBE_TG >= 10 && PROBE_TG < 20
        t_spin = __hip_atomic_load((unsigned*)(args.ws + WS_CTL) + 8, RLX_AGENT);
#ifdef PROBE_TMIN
        t_spin = 0xffffffffu - (unsigned)t_spin;
#endif
#endif
        const unsigned long long t_end = __builtin_amdgcn_s_memrealtime(); while (__builtin_amdgcn_s_memrealtime() - t_end < t_spin) __builtin_amdgcn_s_sleep(8); }
#endif
#undef IN
#undef SEAM
#undef args
}

extern "C" void kernel_launch(void* const* d_in, const int* in_sizes, int n_in, void* d_out, int out_size, void* d_ws, size_t ws_size, hipStream_t stream) {
    static int grid = 0;
    if (grid == 0) {
        if (n_in != NIN || out_size != M * D || ws_size < WS_END) { fprintf(stderr, "kernel_launch: unexpected shapes (n_in %d, out %d, ws %zu)\n", n_in, out_size, ws_size); grid = -1; return; }
        int dev = 0, cus = 0;
        if (hipGetDevice(&dev) != hipSuccess || hipDeviceGetAttribute(&cus, hipDeviceAttributeMultiprocessorCount, dev) != hipSuccess) { grid = -1; return; }
        if (hipFuncSetAttribute((const void*)fwd_kernel, hipFuncAttributeMaxDynamicSharedMemorySize, LDS_BYTES) != hipSuccess) { fprintf(stderr, "kernel_launch: hipFuncSetAttribute failed\n"); grid = -1; return; }
        int per_cu = 0;
        if (hipOccupancyMaxActiveBlocksPerMultiprocessor(&per_cu, (const void*)fwd_kernel, NTHR, LDS_BYTES) != hipSuccess || per_cu < 1) fprintf(stderr, "kernel_launch: occupancy query says %d\n", per_cu);
        (void)hipGetLastError();
        grid = cus > 256 ? 256 : cus;
    }
    if (grid < 0) return;
    (void)hipMemsetAsync((char*)d_ws + WS_CTL, 0, CTL_ZERO_BYTES, stream);
    Args a{};
    for (int i = 0; i < NIN; ++i) a.in[i] = (const float*)d_in[i];
    a.out = (float*)d_out; a.ws = (unsigned char*)d_ws;
#if MK_SINGLE
    a.ph_lo = 0; a.ph_hi = NPHASE;
    hipLaunchKernelGGL(fwd_kernel, dim3(grid), dim3(NTHR), LDS_BYTES, stream, a);
#else
    for (int ph = 0; ph < NPHASE; ++ph) { if (ph >= 10 && ph < 17) continue; a.ph_lo = ph; a.ph_hi = ph + 1; hipLaunchKernelGGL(fwd_kernel, dim3(grid), dim3(NTHR), LDS_BYTES, stream, a); }
#endif
}
```

```cpp
#include <hip/hip_runtime.h>
#include <cstdio>
#include <cstdint>

#ifndef MK_SINGLE
#define MK_SINGLE 1
#endif

namespace pg8 {
#define PG8_LAS __attribute__((address_space(3)))
typedef unsigned short bf16_t;
typedef short bf16x8 __attribute__((ext_vector_type(8)));
typedef float f32x4 __attribute__((ext_vector_type(4)));
typedef unsigned u32x4 __attribute__((ext_vector_type(4)));
constexpr int BM = 256, BK = 64, HALF = 128, HTB = HALF * BK * 2  , STAGE_BYTES = 8 * HTB, NXCD = 8, WGM = 8;

__host__ __device__ __forceinline__ int lds_byte(int r, int c) { const int st = (r >> 4) * 2 + (c >> 5), rr = r & 15, cc = c & 31, ob = rr * 64 + cc * 2; return st * 1024 + (ob ^ (((ob >> 9) & 1) << 5)); }
__host__ __device__ __forceinline__ void stage_rc(int b, int& R, int& C) { const int st = b / 1024, sb = b % 1024, swz = sb ^ (((sb >> 9) & 1) << 5); R = (st >> 1) * 16 + swz / 64; C = (st & 1) * 32 + (swz % 64) / 2; }
__host__ __device__ __forceinline__ int perm32(int rho) { const int n = rho >> 4, i = rho & 15; return 8 * (i >> 2) + 4 * n + (i & 3); }

struct Unit { int pm, pn, om, on; };
struct Gemm { const bf16_t* A; const bf16_t* Bt; int M, N, K; };

__host__ __device__ __forceinline__ bool tile_order(int i, int G, int c, int nM, int nN, int& pm, int& pn) {
    const int nwg = nM * nN; const long L = (long)i * G + c; if (L >= nwg) return false;
    int wgid = (int)L; { const int q = nwg / NXCD, r = nwg % NXCD, xcd = wgid % NXCD, off = wgid / NXCD; wgid = (xcd < r ? xcd * (q + 1) : r * (q + 1) + (xcd - r) * q) + off; }
    const int nig = WGM * nN, gid = wgid / nig, fm = gid * WGM, gsz = (nM - fm) < WGM ? (nM - fm) : WGM;
    pm = fm + ((wgid % nig) % gsz); pn = (wgid % nig) / gsz; return true;
}
struct StaticOrder {
    int nM, nN, G, c;
    __host__ __device__ void init(int M, int N, int G_, int c_) { nM = M / BM; nN = N / BM; G = G_; c = c_; }
    __host__ __device__ bool next(int i, Unit& u) const { int pm, pn; if (!tile_order(i, G, c, nM, nN, pm, pn)) return false; u.pm = pm; u.pn = pn; u.om = pm; u.on = pn; return true; }
    __device__ __forceinline__ void a_ready(const Unit&) const {}
    __device__ __forceinline__ void done(const Unit&) const {}
};
template <bool A_LOCAL, bool O_LOCAL>
struct MoeOrder {
    int t0, nT, nN, G, c; const PG8_LAS int* te;
    __device__ __forceinline__ bool next(int i, Unit& u) const { int pm, pn; if (!tile_order(i, G, c, nT, nN, pm, pn)) return false;
        const int e = __builtin_amdgcn_readfirstlane(te[t0 + pm]);
        u.pm = A_LOCAL ? pm : t0 + pm; u.pn = e * nN + pn; u.om = O_LOCAL ? pm : t0 + pm; u.on = pn; return true; }
    __device__ __forceinline__ void a_ready(const Unit&) const {}
    __device__ __forceinline__ void done(const Unit&) const {}
};

typedef float f32x2_cv __attribute__((ext_vector_type(2))); typedef __bf16 bf16x2_cv __attribute__((ext_vector_type(2)));
__device__ __forceinline__ unsigned cvt_pk_bf16(float lo, float hi) { const f32x2_cv v = {lo, hi}; const bf16x2_cv b = __builtin_convertvector(v, bf16x2_cv); return __builtin_bit_cast(unsigned, b); }

typedef int v8i32 __attribute__((ext_vector_type(8)));
__device__ __forceinline__ v8i32 cat16(bf16x8 lo, bf16x8 hi) { const u32x4 a = __builtin_bit_cast(u32x4, lo), b = __builtin_bit_cast(u32x4, hi); return (v8i32){(int)a.x, (int)a.y, (int)a.z, (int)a.w, (int)b.x, (int)b.y, (int)b.z, (int)b.w}; }
__device__ __forceinline__ float clamp448(float x) { return __builtin_fminf(__builtin_fmaxf(x, -448.0f), 448.0f); }
__device__ __forceinline__ unsigned pack_fp8x4(float a, float b, float c, float d) {
    int r = 0; r = __builtin_amdgcn_cvt_pk_fp8_f32(clamp448(a), clamp448(b), r, false); r = __builtin_amdgcn_cvt_pk_fp8_f32(clamp448(c), clamp448(d), r, true); return (unsigned)r; }
struct EpiStore {
    static constexpr bool PERM = true, AFTER_DRAIN = false;
    bf16_t* O; int ldc; float scale;
    __device__ __forceinline__ void operator()(const f32x4 (&acc)[2][2][4][2], const Unit& u, int wr, int wc, int fr, int fq) const {
        const int row0 = u.om * BM + wr * 64 + fr; const int col0 = u.on * BM + wc * 32 + 8 * fq;
#pragma unroll
        for (int ai = 0; ai < 2; ++ai)
#pragma unroll
            for (int m = 0; m < 4; ++m) { bf16_t* rowp = O + (size_t)(row0 + ai * HALF + m * 16) * ldc + col0;
#pragma unroll
                for (int bj = 0; bj < 2; ++bj) { const f32x4 v0 = acc[ai][bj][m][0] * scale, v1 = acc[ai][bj][m][1] * scale;
                    u32x4 w; w.x = cvt_pk_bf16(v0[0], v0[1]); w.y = cvt_pk_bf16(v0[2], v0[3]); w.z = cvt_pk_bf16(v1[0], v1[1]); w.w = cvt_pk_bf16(v1[2], v1[3]);
                    *(u32x4*)(rowp + bj * HALF) = w; } }
    }
};
__device__ __forceinline__ float silu_f(float x) { return x * __builtin_amdgcn_rcpf(1.0f + __expf(-x)); }
struct EpiSwiglu {
    static constexpr bool PERM = true, AFTER_DRAIN = false;
    bf16_t* O; int ldc;
    __device__ __forceinline__ void operator()(const f32x4 (&acc)[2][2][4][2], const Unit& u, int wr, int wc, int fr, int fq) const {
        const int row0 = u.om * BM + wr * 64 + fr; const int col0 = u.on * HALF + wc * 32 + 8 * fq;
#pragma unroll
        for (int ai = 0; ai < 2; ++ai)
#pragma unroll
            for (int m = 0; m < 4; ++m) { bf16_t* rowp = O + (size_t)(row0 + ai * HALF + m * 16) * ldc + col0;
                const f32x4 g0 = acc[ai][0][m][0], g1 = acc[ai][0][m][1], u0 = acc[ai][1][m][0], u1 = acc[ai][1][m][1];
                u32x4 w;
                w.x = cvt_pk_bf16(silu_f(g0[0]) * u0[0], silu_f(g0[1]) * u0[1]); w.y = cvt_pk_bf16(silu_f(g0[2]) * u0[2], silu_f(g0[3]) * u0[3]);
                w.z = cvt_pk_bf16(silu_f(g1[0]) * u1[0], silu_f(g1[1]) * u1[1]); w.w = cvt_pk_bf16(silu_f(g1[2]) * u1[2], silu_f(g1[3]) * u1[3]);
                *(u32x4*)rowp = w; }
    }
};

struct EpiSwiglu8 {
    static constexpr bool PERM = true, AFTER_DRAIN = false;
    unsigned char* O; int ldc; float in_scale, out_scale;
    __device__ __forceinline__ void operator()(const f32x4 (&acc)[2][2][4][2], const Unit& u, int wr, int wc, int fr, int fq) const {
        const int row0 = u.om * BM + wr * 64 + fr; const int col0 = u.on * HALF + wc * 32 + 8 * fq;
#pragma unroll
        for (int ai = 0; ai < 2; ++ai)
#pragma unroll
            for (int m = 0; m < 4; ++m) { unsigned char* rowp = O + (size_t)(row0 + ai * HALF + m * 16) * ldc + col0;
                const f32x4 g0 = acc[ai][0][m][0] * in_scale, g1 = acc[ai][0][m][1] * in_scale, u0 = acc[ai][1][m][0] * (in_scale * out_scale), u1 = acc[ai][1][m][1] * (in_scale * out_scale);
                typedef unsigned u32x2 __attribute__((ext_vector_type(2)));
                u32x2 w;
                w.x = pack_fp8x4(silu_f(g0[0]) * u0[0], silu_f(g0[1]) * u0[1], silu_f(g0[2]) * u0[2], silu_f(g0[3]) * u0[3]);
                w.y = pack_fp8x4(silu_f(g1[0]) * u1[0], silu_f(g1[1]) * u1[1], silu_f(g1[2]) * u1[2], silu_f(g1[3]) * u1[3]);
                *(u32x2*)rowp = w; }
    }
};

template <class Epi, class Sched, bool ALIGN_EPI = false, bool SP2 = false, bool FP8 = false>
__device__ __forceinline__ void gemm_phase(PG8_LAS unsigned char* lds, const Gemm g, const Sched& S, const Epi& E) {
    int tid_ = threadIdx.x; asm volatile("" : "+v"(tid_));
    const int tid = tid_, wid = __builtin_amdgcn_readfirstlane(tid >> 6), lane = tid & 63, wr = wid >> 2, wc = wid & 3, fr = lane & 15, fq = lane >> 4;
    int K_ = g.K; asm volatile("" : "+s"(K_));
    const int K = K_, nt = K / BK;
    unsigned voffA[2], voffB[2];
#pragma unroll
    for (int i = 0; i < 2; ++i) { int R, C; stage_rc(tid * 16 + i * 8192, R, C); const int Rb = Epi::PERM ? ((R & ~31) + perm32(R & 31)) : R;
        voffA[i] = (unsigned)(R * K + C) * 2u; voffB[i] = (unsigned)(Rb * K + C) * 2u; }
    const size_t kstep = (size_t)(BK * 2);
    const size_t hstep = (size_t)HALF * K * 2;
    const size_t tstep = 2 * hstep;
    const unsigned ldsw = (unsigned)wid * 1024u;
    const int aoff = lds_byte(wr * 64 + fr, fq * 8), boff = lds_byte(wc * 32 + fr, fq * 8);
#define PG8_SA(b, h) (((b) * 2 + (h)) * HTB)
#define PG8_SB(b, h) ((4 + (b) * 2 + (h)) * HTB)
#define PG8_STAGE(bufoff, gbase, voff) do { _Pragma("unroll") for (int _i = 0; _i < 2; ++_i) \
        __builtin_amdgcn_global_load_lds((const unsigned*)((const char*)(gbase) + (voff)[_i]), (PG8_LAS unsigned*)(lds + (bufoff) + ldsw + _i * 8192), 16, 0, 0); } while (0)
#define PG8_LDA(dst, dst8, b, h) do { _Pragma("unroll") for (int m = 0; m < 4; ++m) { \
        if constexpr (FP8) dst8[m] = cat16(*(const PG8_LAS bf16x8*)(lds + PG8_SA(b, h) + aoff + m * 2048), *(const PG8_LAS bf16x8*)(lds + PG8_SA(b, h) + aoff + m * 2048 + 1024)); \
        else { _Pragma("unroll") for (int k = 0; k < 2; ++k) dst[m][k] = *(const PG8_LAS bf16x8*)(lds + PG8_SA(b, h) + aoff + m * 2048 + k * 1024); } } } while (0)
#define PG8_LDB(dst, dst8, b, h) do { _Pragma("unroll") for (int n = 0; n < 2; ++n) { \
        if constexpr (FP8) dst8[n] = cat16(*(const PG8_LAS bf16x8*)(lds + PG8_SB(b, h) + boff + n * 2048), *(const PG8_LAS bf16x8*)(lds + PG8_SB(b, h) + boff + n * 2048 + 1024)); \
        else { _Pragma("unroll") for (int k = 0; k < 2; ++k) dst[n][k] = *(const PG8_LAS bf16x8*)(lds + PG8_SB(b, h) + boff + n * 2048 + k * 1024); } } } while (0)
#define PG8_MMA(ai, bj, At, At8, Bt, Bt8) do { __builtin_amdgcn_s_setprio(1); _Pragma("unroll") for (int m = 0; m < 4; ++m) _Pragma("unroll") for (int n = 0; n < 2; ++n) { \
        if constexpr (FP8) { asm volatile("v_mfma_f32_16x16x128_f8f6f4 %0, %1, %2, %0" : "+v"(acc[ai][bj][m][n]) : "v"(Bt8[n]), "v"(At8[m])); } \
        else { _Pragma("unroll") for (int k = 0; k < 2; ++k) acc[ai][bj][m][n] = __builtin_amdgcn_mfma_f32_16x16x32_bf16(Bt[n][k], At[m][k], acc[ai][bj][m][n], 0, 0, 0); } } __builtin_amdgcn_s_setprio(0); } while (0)
#define PG8_WAIT_V(n) asm volatile("s_waitcnt vmcnt(" #n ")" ::: "memory")
#define PG8_WAIT_L(n) asm volatile("s_waitcnt lgkmcnt(" #n ")" ::: "memory")
#define PG8_BAR __builtin_amdgcn_s_barrier()
#define PG8_SCHED __builtin_amdgcn_sched_barrier(0)
    Unit cur, nxt; int ui = 0;
    if (!S.next(0, cur)) return;
    f32x4 acc[2][2][4][2];
#pragma unroll
    for (int a = 0; a < 2; ++a)
#pragma unroll
        for (int b = 0; b < 2; ++b)
#pragma unroll
            for (int m = 0; m < 4; ++m)
#pragma unroll
                for (int n = 0; n < 2; ++n) acc[a][b][m][n] = (f32x4){0.f, 0.f, 0.f, 0.f};
    bf16x8 At[4][2], B0[2][2], B1[2][2]; v8i32 At8[4], B08[2], B18[2];
    const char* cA = (const char*)g.A + (size_t)cur.pm * tstep; const char* cB = (const char*)g.Bt + (size_t)cur.pn * tstep;
    S.a_ready(cur);
    if constexpr (SP2) {
        PG8_STAGE(PG8_SB(0, 0), cB, voffB); PG8_STAGE(PG8_SB(0, 1), cB + hstep, voffB); PG8_STAGE(PG8_SA(0, 0), cA, voffA); PG8_STAGE(PG8_SA(0, 1), cA + hstep, voffA);
        if (wr == 1) PG8_BAR;
        PG8_WAIT_V(2); PG8_BAR;
        PG8_STAGE(PG8_SB(1, 0), cB + kstep, voffB); PG8_STAGE(PG8_SA(1, 0), cA + kstep, voffA); PG8_STAGE(PG8_SB(1, 1), cB + hstep + kstep, voffB);
        PG8_WAIT_V(6); PG8_BAR;
    } else {
        PG8_STAGE(PG8_SB(0, 0), cB, voffB); PG8_STAGE(PG8_SA(0, 0), cA, voffA); PG8_STAGE(PG8_SB(0, 1), cB + hstep, voffB); PG8_STAGE(PG8_SA(0, 1), cA + hstep, voffA);
        if (wr == 1) PG8_BAR;
        PG8_WAIT_V(4); PG8_BAR;
        PG8_STAGE(PG8_SB(1, 0), cB + kstep, voffB); PG8_STAGE(PG8_SA(1, 0), cA + kstep, voffA); PG8_STAGE(PG8_SB(1, 1), cB + hstep + kstep, voffB);
        PG8_WAIT_V(6); PG8_BAR;
    }
    for (;;) {
        const bool has_next = S.next(ui + 1, nxt);
        const char* nA = has_next ? (const char*)g.A + (size_t)nxt.pm * tstep : cA; const char* nB = has_next ? (const char*)g.Bt + (size_t)nxt.pn * tstep : cB;
#pragma unroll 1
        for (int t = 0; t < nt; t += 2) {
            const bool last = (t == nt - 2);
            const char* a1 = cA + (size_t)(t + 1) * kstep;
            const char* a2 = last ? nA : cA + (size_t)(t + 2) * kstep; const char* b2 = last ? nB : cB + (size_t)(t + 2) * kstep;
            const char* a3 = a2 + kstep; const char* b3 = b2 + kstep;
            if (last && has_next) S.a_ready(nxt);
            if constexpr (SP2) {
            PG8_LDB(B0, B08, 0, 0); PG8_LDB(B1, B18, 0, 1); PG8_SCHED; PG8_LDA(At, At8, 0, 0); PG8_STAGE(PG8_SA(1, 1), a1 + hstep, voffA);
            PG8_WAIT_V(8); PG8_WAIT_L(0); PG8_BAR; PG8_MMA(0, 0, At, At8, B0, B08); PG8_MMA(0, 1, At, At8, B1, B18); PG8_BAR; PG8_SCHED;
            PG8_LDA(At, At8, 0, 1); PG8_STAGE(PG8_SB(0, 0), b2, voffB); PG8_STAGE(PG8_SB(0, 1), b2 + hstep, voffB); PG8_STAGE(PG8_SA(0, 0), a2, voffA);
            PG8_WAIT_V(8); PG8_WAIT_L(0); PG8_BAR; PG8_MMA(1, 0, At, At8, B0, B08); PG8_MMA(1, 1, At, At8, B1, B18); PG8_BAR; PG8_SCHED;
            PG8_LDB(B0, B08, 1, 0); PG8_LDB(B1, B18, 1, 1); PG8_SCHED; PG8_LDA(At, At8, 1, 0); PG8_STAGE(PG8_SA(0, 1), a2 + hstep, voffA);
            PG8_WAIT_V(8); PG8_WAIT_L(0); PG8_BAR; PG8_MMA(0, 0, At, At8, B0, B08); PG8_MMA(0, 1, At, At8, B1, B18); PG8_BAR; PG8_SCHED;
            PG8_LDA(At, At8, 1, 1); PG8_STAGE(PG8_SB(1, 0), b3, voffB); PG8_STAGE(PG8_SB(1, 1), b3 + hstep, voffB); PG8_STAGE(PG8_SA(1, 0), a3, voffA);
            PG8_WAIT_V(8); PG8_WAIT_L(0); PG8_BAR; PG8_MMA(1, 0, At, At8, B0, B08); PG8_MMA(1, 1, At, At8, B1, B18); PG8_BAR; PG8_SCHED;
            } else {
            PG8_LDB(B0, B08, 0, 0); PG8_SCHED; PG8_LDA(At, At8, 0, 0); PG8_STAGE(PG8_SA(1, 1), a1 + hstep, voffA);
            PG8_WAIT_L(8); PG8_BAR; PG8_WAIT_L(0); PG8_MMA(0, 0, At, At8, B0, B08); PG8_BAR; PG8_SCHED;
            PG8_LDB(B1, B18, 0, 1); PG8_STAGE(PG8_SB(0, 0), b2, voffB);
            PG8_BAR; PG8_WAIT_L(0); PG8_MMA(0, 1, At, At8, B1, B18); PG8_BAR;
            PG8_LDA(At, At8, 0, 1); PG8_STAGE(PG8_SA(0, 0), a2, voffA);
            PG8_BAR; PG8_WAIT_L(0); PG8_MMA(1, 0, At, At8, B0, B08); PG8_BAR; PG8_SCHED;
            PG8_STAGE(PG8_SB(0, 1), b2 + hstep, voffB);
            PG8_WAIT_V(6); PG8_BAR; PG8_MMA(1, 1, At, At8, B1, B18); PG8_BAR;
            PG8_LDB(B0, B08, 1, 0); PG8_SCHED; PG8_LDA(At, At8, 1, 0); PG8_STAGE(PG8_SA(0, 1), a2 + hstep, voffA);
            PG8_WAIT_L(8); PG8_BAR; PG8_WAIT_L(0); PG8_MMA(0, 0, At, At8, B0, B08); PG8_BAR; PG8_SCHED;
            PG8_LDB(B1, B18, 1, 1); PG8_STAGE(PG8_SB(1, 0), b3, voffB);
            PG8_BAR; PG8_WAIT_L(0); PG8_MMA(0, 1, At, At8, B1, B18); PG8_BAR;
            PG8_LDA(At, At8, 1, 1); PG8_STAGE(PG8_SA(1, 0), a3, voffA);
            PG8_BAR; PG8_WAIT_L(0); PG8_MMA(1, 0, At, At8, B0, B08); PG8_BAR; PG8_SCHED;
            PG8_STAGE(PG8_SB(1, 1), b3 + hstep, voffB);
            PG8_WAIT_V(6); PG8_BAR; PG8_MMA(1, 1, At, At8, B1, B18); PG8_BAR;
            }
        }
        if constexpr (FP8) asm volatile("s_nop 15\n\ts_nop 15" ::: "memory");
        if constexpr (ALIGN_EPI) { if (wr == 0) PG8_BAR; }
        if constexpr (!Epi::AFTER_DRAIN) { E(acc, cur, wr, wc, fr, fq); S.done(cur); }
        if (!has_next) break;
#pragma unroll
        for (int a = 0; a < 2; ++a)
#pragma unroll
            for (int b = 0; b < 2; ++b)
#pragma unroll
                for (int m = 0; m < 4; ++m)
#pragma unroll
                    for (int n = 0; n < 2; ++n) acc[a][b][m][n] = (f32x4){0.f, 0.f, 0.f, 0.f};
        cur = nxt; cA = nA; cB = nB; ++ui;
        if constexpr (ALIGN_EPI) { if (wr == 1) PG8_BAR; }
    }
    PG8_WAIT_V(0);
    if constexpr (!ALIGN_EPI) { if (wr == 0) PG8_BAR; }
    PG8_BAR;
    if constexpr (Epi::AFTER_DRAIN) { E.fused(acc, cur, wr, wc, fr, fq, lds, wid, lane); S.done(cur); }
#undef PG8_SA
#undef PG8_SB
#undef PG8_STAGE
#undef PG8_LDA
#undef PG8_LDB
#undef PG8_MMA
#undef PG8_WAIT_V
#undef PG8_WAIT_L
#undef PG8_BAR
#undef PG8_SCHED
}
}

#define GAS __attribute__((address_space(1)))
#define LAS __attribute__((address_space(3)))
typedef unsigned short bf16;
typedef unsigned v4u __attribute__((ext_vector_type(4)));
typedef unsigned v2u __attribute__((ext_vector_type(2)));
typedef float f32x4 __attribute__((ext_vector_type(4)));
typedef float f32x2 __attribute__((ext_vector_type(2)));
typedef short bf16x8 __attribute__((ext_vector_type(8)));
typedef short v4i16 __attribute__((ext_vector_type(4)));
typedef GAS unsigned gu32;
#define RLX_AGENT __ATOMIC_RELAXED, __HIP_MEMORY_SCOPE_AGENT
#define LDS_WAIT() asm volatile("s_waitcnt lgkmcnt(0)" ::: "memory")
#define VM_WAIT() asm volatile("s_waitcnt vmcnt(0)" ::: "memory")
__device__ __forceinline__ unsigned pk2(float lo, float hi) { return pg8::cvt_pk_bf16(lo, hi); }
__device__ __forceinline__ float bflo(unsigned u) { return __uint_as_float(u << 16); }
__device__ __forceinline__ float bfhi(unsigned u) { return __uint_as_float(u & 0xffff0000u); }
__device__ __forceinline__ float wave_sum(float v) {
#pragma unroll
    for (int o = 1; o < 64; o <<= 1) v += __shfl_xor(v, o);
    return v;
}
__device__ __forceinline__ f32x4 mfma16(bf16x8 a, bf16x8 b, f32x4 c) { return __builtin_amdgcn_mfma_f32_16x16x32_bf16(a, b, c, 0, 0, 0); }
__device__ __forceinline__ v4i16 trrd(LAS unsigned char* p) { return __builtin_amdgcn_ds_read_tr16_b64_v4i16((LAS v4i16*)p); }
__device__ __forceinline__ bf16x8 cat8(v4i16 lo, v4i16 hi) { return (bf16x8){lo[0], lo[1], lo[2], lo[3], hi[0], hi[1], hi[2], hi[3]}; }
__device__ __forceinline__ bf16x8 pack8(float a0, float a1, float a2, float a3, float a4, float a5, float a6, float a7) {
    v4u w; w.x = pk2(a0, a1); w.y = pk2(a2, a3); w.z = pk2(a4, a5); w.w = pk2(a6, a7); return __builtin_bit_cast(bf16x8, w); }
__device__ __forceinline__ float silu(float x) { return x * __builtin_amdgcn_rcpf(1.0f + __expf(-x)); }

#define XB_TMO      128
#define XB_XCNT(j)  (256  + 64 * (j))
#define XB_XSUB(j)  (1280 + 64 * (j))
#define XB_XGEN(j)  (2304 + 64 * (j))
#define XB_TOP      3328
#define XB_TOPGEN   3392
#define XCD_BAR_WORDS 3456
#define XB_SPIN_CAP (1u << 18)

__device__ __forceinline__ unsigned xb_ld(unsigned* p)              { return __hip_atomic_load(p, __ATOMIC_RELAXED, __HIP_MEMORY_SCOPE_AGENT); }
__device__ __forceinline__ unsigned xb_add(unsigned* p, unsigned v) { return __hip_atomic_fetch_add(p, v, __ATOMIC_RELAXED, __HIP_MEMORY_SCOPE_AGENT); }
__device__ __forceinline__ unsigned xb_xcc_id() { return (unsigned)__builtin_amdgcn_s_getreg((3 << 11) | 20) & 0xFu; }
#define XB_SPIN(cond, bar) do { unsigned _sp = 0; while (cond) { __builtin_amdgcn_s_sleep(1); \
    if ((++_sp & 255u) == 0u) { if (xb_ld(&(bar)[XB_TMO])) break; if (_sp > XB_SPIN_CAP) { atomicAdd(&(bar)[XB_TMO], 1u); break; } } } } while (0)

struct XcdBarrier {
    unsigned* bar; unsigned x;
    volatile LAS unsigned* st;
};

__device__ __forceinline__ XcdBarrier xcd_barrier_post(unsigned* bar, volatile LAS unsigned* st) {
    XcdBarrier b; b.bar = bar; b.x = xb_xcc_id(); b.st = st;
    if (threadIdx.x == 0) (void)xb_add(&bar[XB_XCNT(b.x)], 1u);
    return b;
}
__device__ __forceinline__ void xcd_barrier_complete(unsigned* bar, unsigned x, unsigned& nloc, unsigned& nx) {
    const unsigned G = gridDim.x * gridDim.y * gridDim.z;
    unsigned sum, cnt, mine, sp = 0u;
    for (;;) {
        sum = 0u; cnt = 0u; mine = 0u;
#pragma unroll
        for (unsigned j = 0; j < 16; ++j) { const unsigned c = xb_ld(&bar[XB_XCNT(j)]); sum += c; cnt += (c > 0u) ? 1u : 0u; mine = (j == x) ? c : mine; }
        if (sum == G) break;
        __builtin_amdgcn_s_sleep(1);
        if ((++sp & 255u) == 0u) { if (xb_ld(&bar[XB_TMO])) break; if (sp > XB_SPIN_CAP) { atomicAdd(&bar[XB_TMO], 1u); break; } }
    }
    nloc = mine > 0u ? mine : 1u; nx = cnt > 0u ? cnt : 1u;
}

__device__ __forceinline__ void xcd_barrier(const XcdBarrier& b) {
    asm volatile("s_waitcnt vmcnt(0)" ::: "memory");
    __syncthreads();
    if (threadIdx.x == 0) {
        unsigned* bar = b.bar;
        __builtin_amdgcn_s_waitcnt(0);
        unsigned nloc = b.st[0], nx = b.st[1];
        if (nloc == 0u) { xcd_barrier_complete(bar, b.x, nloc, nx); b.st[0] = nloc; b.st[1] = nx; }
        const unsigned old = xb_add(&bar[XB_XSUB(b.x)], 1u);
        const unsigned gen = old / nloc;
        if (old + 1u == (gen + 1u) * nloc) {
            __builtin_amdgcn_fence(__ATOMIC_RELEASE, "agent");
            asm volatile("s_waitcnt vmcnt(0)" ::: "memory");
            const unsigned og = xb_add(&bar[XB_TOP], 1u);
            const unsigned tg = og / nx;
            if (og + 1u == (tg + 1u) * nx) xb_add(&bar[XB_TOPGEN], 1u);
            else XB_SPIN(xb_ld(&bar[XB_TOPGEN]) == tg, bar);
            __builtin_amdgcn_fence(__ATOMIC_ACQUIRE, "agent");
            xb_add(&bar[XB_XGEN(b.x)], 1u);
            asm volatile("s_waitcnt vmcnt(0)" ::: "memory");
        } else {
            XB_SPIN(xb_ld(&bar[XB_XGEN(b.x)]) == gen, bar);
            __builtin_amdgcn_fence(__ATOMIC_ACQUIRE, "agent");
            asm volatile("s_waitcnt vmcnt(0)" ::: "memory");
        }
    }
    __syncthreads();
}

constexpr int NWAVES = 8, NTHR = 512;
constexpr int D = 1024, SEQ = 8192, NBATCH = 4, M = NBATCH * SEQ, NCHUNK = SEQ / 64;
constexpr int DIN = 2824, PN = 2816;
constexpr int PC_Z = 0, PC_XBC = 512, PC_U = 1536, PC_V = 1792, PC_Q = 2048, PC_K = 2304, PC_VV = 2560;
constexpr int DFF = 2816, DFFE = 3584, NEXP = 8;
constexpr int MOE_CH = 128, MOE_NCH = 2, MOE_MAXT = 264;
constexpr int NIN = 27;
constexpr int CVT_SMALL_TASKS = 1408 + 512 + 1408 + 704, MOE_GU_TASKS = 14336, MOE_CVT_TASKS = 14336 + 7168;
constexpr size_t MiB = 1u << 20;
constexpr size_t WS_CTL = 0, CTL_ZERO_BYTES = 65536;
constexpr size_t WS_AEND = 65536, WS_WGCNT = 98304;
constexpr size_t WS_DTRAW = 1 * MiB, WS_TOKE = 2 * MiB, WS_TOKG = 2 * MiB + 262144, WS_POS = 2 * MiB + 524288;
constexpr size_t WS_WIN = 4 * MiB, WS_WOUT = 15 * MiB, WS_WGU = 19 * MiB, WS_WD = 30 * MiB;
constexpr size_t WS_A1 = 36 * MiB, WS_XBCC = 36 * MiB;
constexpr size_t WS_PROJ = 100 * MiB, WS_MIXED = 100 * MiB, WS_H1 = 100 * MiB;
constexpr size_t WS_ST = 276 * MiB, WS_FOUT = 276 * MiB;
constexpr size_t WS_Y = 340 * MiB;
constexpr size_t WS_HB = 404 * MiB;
constexpr size_t WS_HM = 36 * MiB, WS_XS = 155 * MiB, WS_YM = 221 * MiB, WS_MWD = 353 * MiB, WS_MWGU = 468 * MiB, WS_END = 524 * MiB;
constexpr float FP8_SX = 8.0f, FP8_SW = 64.0f, FP8_SH = 16.0f;
constexpr int CW_BAR = 4096, CW_TQ = 8192;
constexpr int LDS_BYTES = 163840, LDSCTL_OFF = 147456;
constexpr int CTL_MISC = LDSCTL_OFF, CTL_CNT = LDSCTL_OFF + 128, CTL_TE = LDSCTL_OFF + 512;

#ifndef PROBE_DUP
#define PROBE_DUP 0
#endif
#ifndef PROBE_TG
#define PROBE_TG -1
#endif
__device__ __forceinline__ int tgroup_of(int k) {
    if (k == 0) return 0;
    const int L = (k - 1) >> 4, r = (k - 1) & 15;
    if (r == 0 || r == 4) return 1;
    if (r == 1) return 2;
    if (r == 2) return 3;
    if (r == 3) return 4;
    if (r == 5) return L == 0 ? 5 : 9;
    if (L == 0) return r == 8 ? 5 : 6;
    if (r == 6) return 7;
    if (r == 7 + 2 * 2) return 5;
    return 8;
}
#define REP(n) for (int rep_ = 0; rep_ < (((PROBE_DUP >> (n)) & 1) ? 2 : 1); ++rep_)
struct Args { const float* in[NIN]; float* out; unsigned char* ws; int ph_lo, ph_hi; };

#ifndef PROBE_TG
#define PROBE_TG -1
#endif
typedef const __attribute__((address_space(4))) Args* ArgsP;
typedef const __attribute__((address_space(4))) Args& ArgsRef;
struct Frame {
    LAS unsigned char* lds;
    int tid, lane, wave, vcu, G;
#if PROBE_TG >= 30
    unsigned long long tr_acc, tr_mark;
#endif
};
#if PROBE_TG >= 30
#define TR0(F) ((F).tr_mark = __builtin_amdgcn_s_memrealtime())
#define TR(F, id) do { const unsigned long long n_ = __builtin_amdgcn_s_memrealtime(); if ((id) == PROBE_TG) (F).tr_acc += n_ - (F).tr_mark; (F).tr_mark = n_; } while (0)
#else
#define TR0(F) do { } while (0)
#define TR(F, id) do { } while (0)
#endif
__device__ __forceinline__ bool relaunder(ArgsP& p) { asm volatile("" : "+s"(p)); return true; }
__device__ __forceinline__ bool fresh(Frame& F) { int t_ = threadIdx.x; asm volatile("" : "+v"(t_)); F.tid = t_; F.lane = t_ & 63; F.wave = __builtin_amdgcn_readfirstlane(t_ >> 6); return true; }

__device__ __forceinline__ void cvt_task(const float* W, int N, int k0, int n0, bf16* WT, int K, int row0, int lane) {
    const float* s = W + (size_t)k0 * N + n0 + lane;
    bf16* d = WT + (size_t)(row0 + lane) * K + k0;
    float v[64];
#pragma unroll
    for (int j = 0; j < 64; ++j) v[j] = __builtin_nontemporal_load(s + (size_t)j * N);
#pragma unroll
    for (int q = 0; q < 8; ++q) { v4u o; o.x = pk2(v[8 * q], v[8 * q + 1]); o.y = pk2(v[8 * q + 2], v[8 * q + 3]); o.z = pk2(v[8 * q + 4], v[8 * q + 5]); o.w = pk2(v[8 * q + 6], v[8 * q + 7]);
        *(GAS v4u*)(d + 8 * q) = o; }
}
__device__ __forceinline__ void cvt_small_weights(Frame& F, ArgsRef A, int t_lo, int t_hi, int gw, int NGW) {
    bf16* WIN = (bf16*)(A.ws + WS_WIN); bf16* WOUT = (bf16*)(A.ws + WS_WOUT); bf16* WGU = (bf16*)(A.ws + WS_WGU); bf16* WD = (bf16*)(A.ws + WS_WD);
    for (int it = t_lo + gw; it < t_hi; it += NGW) {
        int r = it;
        if (r < 1408) { const int L = r / 704; r %= 704; const int kb = r / 44, nb = r % 44; const int ns = 64 * nb + (64 * nb >= 1536 ? 8 : 0);
            cvt_task(A.in[5] + (size_t)L * D * DIN, DIN, 64 * kb, ns, WIN + (size_t)L * PN * D, D, 64 * nb, F.lane); continue; }
        r -= 1408;
        if (r < 512) { const int L = r / 256; r %= 256; const int kb = r / 16, nb = r % 16;
            cvt_task(A.in[19] + (size_t)L * D * D, D, 64 * kb, 64 * nb, WOUT + (size_t)L * D * D, D, 64 * nb, F.lane); continue; }
        r -= 512;
        if (r < 1408) { const int up = r / 704; r %= 704; const int kb = r / 44, nb = r % 44;
            cvt_task(up ? A.in[21] : A.in[20], DFF, 64 * kb, 64 * nb, WGU, D, 256 * (nb >> 1) + 64 * (nb & 1) + 128 * up, F.lane); continue; }
        r -= 1408;
        { const int kb = r / 16, nb = r % 16; cvt_task(A.in[22], D, 64 * kb, 64 * nb, WD, DFF, 64 * nb, F.lane); }
    }
}
__device__ __forceinline__ void cvt_task8(const float* W, int N, int k0, int n0, unsigned char* WT, int K, int row0, float scale, int lane) {
    const float* s = W + (size_t)k0 * N + n0 + lane;
    unsigned char* d = WT + (size_t)(row0 + lane) * K + k0;
    float v[64];
#pragma unroll
    for (int j = 0; j < 64; ++j) v[j] = __builtin_nontemporal_load(s + (size_t)j * N);
#pragma unroll
    for (int q = 0; q < 4; ++q) { v4u o;
        o.x = pg8::pack_fp8x4(v[16 * q] * scale, v[16 * q + 1] * scale, v[16 * q + 2] * scale, v[16 * q + 3] * scale); o.y = pg8::pack_fp8x4(v[16 * q + 4] * scale, v[16 * q + 5] * scale, v[16 * q + 6] * scale, v[16 * q + 7] * scale);
        o.z = pg8::pack_fp8x4(v[16 * q + 8] * scale, v[16 * q + 9] * scale, v[16 * q + 10] * scale, v[16 * q + 11] * scale); o.w = pg8::pack_fp8x4(v[16 * q + 12] * scale, v[16 * q + 13] * scale, v[16 * q + 14] * scale, v[16 * q + 15] * scale);
        *(GAS v4u*)(d + 16 * q) = o; }
}
__device__ __forceinline__ void cvt_moe_weights(Frame& F, ArgsRef A, int t_lo, int t_hi, int gw, int NGW) {
    unsigned char* MWGU = A.ws + WS_MWGU; unsigned char* MWD = A.ws + WS_MWD;
    for (int it = t_lo + gw; it < t_hi; it += NGW) {
        int r = it;
        if (r < 14336) { const int ue = r / 896; r %= 896; const int up = ue >> 3, e = ue & 7; const int kb = r / 56, nb = r % 56;
            cvt_task8((up ? A.in[25] : A.in[24]) + (size_t)e * D * DFFE, DFFE, 64 * kb, 64 * nb, MWGU + (size_t)e * 7168 * D, D, 256 * (nb >> 1) + 64 * (nb & 1) + 128 * up, FP8_SW, F.lane); continue; }
        r -= 14336;
        { const int e = r / 896; r %= 896; const int kb = r / 16, nb = r % 16;
          cvt_task8(A.in[26] + (size_t)e * DFFE * D, D, 64 * kb, 64 * nb, MWD + (size_t)e * D * DFFE, DFFE, 64 * nb, FP8_SW, F.lane); }
    }
}

struct RowArgs {
    const float* hsrc; float* hdst;
    const bf16* hsrc16; bf16* hdst16;
    int branch;
    const bf16* ybuf; const float* gpost;
    const float* gpre; bf16* a1;
    int proj;
    const float* w8; int w8ld;
};
__device__ __forceinline__ void row_phase(Frame& F, ArgsRef A, const RowArgs& R) {
    LAS float* W8T = (LAS float*)F.lds;
    LAS int* cnt = (LAS int*)(F.lds + CTL_CNT);
    const int lane = F.lane;
    if (R.proj) { for (int idx = F.tid; idx < 8192; idx += NTHR) { const int e = idx & 7, k = idx >> 3; W8T[e * 1024 + k] = R.w8[(size_t)k * R.w8ld + e]; } }
    if (R.proj == 2 && F.tid < 8) cnt[F.tid] = 0;
    __syncthreads();
    f32x4 gpo[4], gpr[4];
#pragma unroll
    for (int j = 0; j < 4; ++j) { gpo[j] = R.branch ? *(const f32x4*)(R.gpost + 4 * lane + 256 * j) : (f32x4){0.f, 0.f, 0.f, 0.f}; gpr[j] = R.gpre ? *(const f32x4*)(R.gpre + 4 * lane + 256 * j) : (f32x4){0.f, 0.f, 0.f, 0.f}; }
    float* DTRAW = (float*)(A.ws + WS_DTRAW); int* TOKE = (int*)(A.ws + WS_TOKE); float* TOKG = (float*)(A.ws + WS_TOKG); const int* POS = (const int*)(A.ws + WS_POS);
    const int gw = F.vcu * NWAVES + F.wave, NGW = F.G * NWAVES;
    f32x4 hf[4][4]; v2u hp[4][4], y0p[4][4], y1p[4][4]; int ip0[4], ip1[4]; float ig0[4], ig1[4], gc0[4], gc1[4];
#define ROW_IDX(q, mm) do { if (R.branch == 2 && (mm) < M) { ip0[q] = POS[2 * (mm)]; ip1[q] = POS[2 * (mm) + 1]; ig0[q] = TOKG[2 * (mm)]; ig1[q] = TOKG[2 * (mm) + 1]; } } while (0)
#define ROW_DATA(q, mm) do { if ((mm) < M) { \
        if (R.hsrc) { _Pragma("unroll") for (int j = 0; j < 4; ++j) hf[q][j] = *(const f32x4*)(R.hsrc + (size_t)(mm) * D + 4 * lane + 256 * j); } \
        else { _Pragma("unroll") for (int j = 0; j < 4; ++j) hp[q][j] = *(const v2u*)(R.hsrc16 + (size_t)(mm) * D + 4 * lane + 256 * j); } \
        if (R.branch == 1) { _Pragma("unroll") for (int j = 0; j < 4; ++j) y0p[q][j] = *(const v2u*)(R.ybuf + (size_t)(mm) * D + 4 * lane + 256 * j); } \
        if (R.branch == 2) { gc0[q] = ig0[q]; gc1[q] = ig1[q]; _Pragma("unroll") for (int j = 0; j < 4; ++j) { y0p[q][j] = *(const v2u*)(R.ybuf + (size_t)ip0[q] * D + 4 * lane + 256 * j); y1p[q][j] = *(const v2u*)(R.ybuf + (size_t)ip1[q] * D + 4 * lane + 256 * j); } } } } while (0)
#pragma unroll
    for (int q = 0; q < 4; ++q) { ip0[q] = 0; ip1[q] = 0; ig0[q] = 0.f; ig1[q] = 0.f; gc0[q] = 0.f; gc1[q] = 0.f; ROW_IDX(q, gw + q * NGW); }
#pragma unroll
    for (int q = 0; q < 4; ++q) { ROW_DATA(q, gw + q * NGW); ROW_IDX(q, gw + (q + 4) * NGW); }
    for (int mb = gw; mb < M; mb += 4 * NGW) {
#pragma unroll
        for (int q = 0; q < 4; ++q) {
        const int m = mb + q * NGW;
        if (m < M) {
        f32x4 v[4], y[4];
#pragma unroll
        for (int j = 0; j < 4; ++j) v[j] = R.hsrc ? hf[q][j] : (f32x4){bflo(hp[q][j].x), bfhi(hp[q][j].x), bflo(hp[q][j].y), bfhi(hp[q][j].y)};
        if (R.branch == 1) {
#pragma unroll
            for (int j = 0; j < 4; ++j) y[j] = (f32x4){bflo(y0p[q][j].x), bfhi(y0p[q][j].x), bflo(y0p[q][j].y), bfhi(y0p[q][j].y)};
        } else if (R.branch == 2) {
#pragma unroll
            for (int j = 0; j < 4; ++j) y[j] = (f32x4){gc0[q] * bflo(y0p[q][j].x) + gc1[q] * bflo(y1p[q][j].x), gc0[q] * bfhi(y0p[q][j].x) + gc1[q] * bfhi(y1p[q][j].x), gc0[q] * bflo(y0p[q][j].y) + gc1[q] * bflo(y1p[q][j].y), gc0[q] * bfhi(y0p[q][j].y) + gc1[q] * bfhi(y1p[q][j].y)};
        }
        ROW_DATA(q, m + 4 * NGW); ROW_IDX(q, m + 8 * NGW);
        __builtin_amdgcn_sched_barrier(0);
        if (R.branch) {
            float ss = 0.f;
#pragma unroll
            for (int j = 0; j < 4; ++j) ss += (y[j].x * y[j].x + y[j].y * y[j].y) + (y[j].z * y[j].z + y[j].w * y[j].w);
            const float sc = 1.0f / sqrtf(wave_sum(ss) * (1.0f / D) + 1e-6f);
#pragma unroll
            for (int j = 0; j < 4; ++j) v[j] = v[j] + y[j] * sc * gpo[j];
        }
        if (R.hdst) {
#pragma unroll
            for (int j = 0; j < 4; ++j) *(f32x4*)(R.hdst + (size_t)m * D + 4 * lane + 256 * j) = v[j];
        }
        if (R.hdst16) {
#pragma unroll
            for (int j = 0; j < 4; ++j) { v2u o; o.x = pk2(v[j].x, v[j].y); o.y = pk2(v[j].z, v[j].w); *(v2u*)(R.hdst16 + (size_t)m * D + 4 * lane + 256 * j) = o; }
        }
        if (R.gpre) {
            float ss = 0.f;
#pragma unroll
            for (int j = 0; j < 4; ++j) ss += (v[j].x * v[j].x + v[j].y * v[j].y) + (v[j].z * v[j].z + v[j].w * v[j].w);
            const float sc = 1.0f / sqrtf(wave_sum(ss) * (1.0f / D) + 1e-6f);
#pragma unroll
            for (int j = 0; j < 4; ++j) { v[j] = v[j] * sc * gpr[j]; v2u o; o.x = pk2(v[j].x, v[j].y); o.y = pk2(v[j].z, v[j].w); *(v2u*)(R.a1 + (size_t)m * D + 4 * lane + 256 * j) = o; }
            if (R.proj) {
                float p[8];
#pragma unroll
                for (int e = 0; e < 8; ++e) { float s = 0.f;
#pragma unroll
                    for (int j = 0; j < 4; ++j) { const f32x4 w = *(const LAS f32x4*)(W8T + e * 1024 + 4 * lane + 256 * j); s += (v[j].x * w.x + v[j].y * w.y) + (v[j].z * w.z + v[j].w * w.w); }
                    p[e] = wave_sum(s); }
                if (R.proj == 1) {
                    float mine = p[0];
#pragma unroll
                    for (int e = 1; e < 8; ++e) mine = (lane == e) ? p[e] : mine;
                    if (lane < 8) DTRAW[(size_t)m * 8 + lane] = mine;
                } else {
                    float best = p[0]; int bi = 0;
#pragma unroll
                    for (int e = 1; e < 8; ++e) if (p[e] > best) { best = p[e]; bi = e; }
                    float sb = -3.0e38f; int si = 0;
#pragma unroll
                    for (int e = 0; e < 8; ++e) if (e != bi && p[e] > sb) { sb = p[e]; si = e; }
                    const float g0 = 1.0f / (1.0f + expf(sb - best)), g1 = 1.0f - g0;
                    if (lane == 0) { TOKE[2 * m] = bi; TOKE[2 * m + 1] = si; TOKG[2 * m] = g0; TOKG[2 * m + 1] = g1;
                        __hip_atomic_fetch_add(cnt + bi, 1, __ATOMIC_RELAXED, __HIP_MEMORY_SCOPE_WORKGROUP); __hip_atomic_fetch_add(cnt + si, 1, __ATOMIC_RELAXED, __HIP_MEMORY_SCOPE_WORKGROUP); }
                }
            }
        }
        }
        __builtin_amdgcn_sched_barrier(0);
        }
    }
#undef ROW_DATA
#undef ROW_IDX
    if (R.proj == 2) { __syncthreads(); if (F.tid < 8) ((int*)(A.ws + WS_WGCNT))[F.vcu * 8 + F.tid] = cnt[F.tid]; }
    __syncthreads();
}

__device__ __forceinline__ void moe_tables(Frame& F, ArgsRef A) {
    LAS int* c = (LAS int*)(F.lds + CTL_CNT); LAS int* te = (LAS int*)(F.lds + CTL_TE);
    if (F.tid < 48) c[F.tid] = 0;
    __syncthreads();
    const int* WGCNT = (const int*)(A.ws + WS_WGCNT);
    for (int idx = F.tid; idx < F.G * 8; idx += NTHR) { const int wg = idx >> 3, e = idx & 7; const int v = WGCNT[idx];
        __hip_atomic_fetch_add(c + e, v, __ATOMIC_RELAXED, __HIP_MEMORY_SCOPE_WORKGROUP); if (wg < F.vcu) __hip_atomic_fetch_add(c + 8 + e, v, __ATOMIC_RELAXED, __HIP_MEMORY_SCOPE_WORKGROUP); }
    __syncthreads();
    if (F.tid == 0) { int t = 0;
#pragma unroll 1
        for (int e = 0; e < 8; ++e) { c[16 + e] = t * 256; t += (c[e] + 255) >> 8; c[40 + e] = t; }
        c[32] = t < MOE_MAXT ? t : MOE_MAXT; }
    __syncthreads();
    if (F.tid < MOE_MAXT) { int e = 0;
#pragma unroll
        for (int q = 0; q < 7; ++q) e += (F.tid >= c[40 + q]) ? 1 : 0;
        te[F.tid] = e; }
    __syncthreads();
}
__device__ __forceinline__ void moe_gather(Frame& F, ArgsRef A) {
    LAS int* c = (LAS int*)(F.lds + CTL_CNT);
    const int* TOKE = (const int*)(A.ws + WS_TOKE); int* POS = (int*)(A.ws + WS_POS);
    const bf16* A1 = (const bf16*)(A.ws + WS_A1); unsigned char* XS = A.ws + WS_XS;
    const int gw = F.vcu * NWAVES + F.wave, NGW = F.G * NWAVES, lane = F.lane;
    for (int mb = gw; mb < M; mb += 4 * NGW) {
        v4u r0[4], r1[4]; int d0[4], d1[4];
#pragma unroll
        for (int q = 0; q < 4; ++q) { const int m = mb + q * NGW; d0[q] = 0; d1[q] = 0;
            if (m < M) { r0[q] = *(const v4u*)(A1 + (size_t)m * D + 16 * lane); r1[q] = *(const v4u*)(A1 + (size_t)m * D + 16 * lane + 8);
                if (lane == 0) { const int e0 = TOKE[2 * m], e1 = TOKE[2 * m + 1];
                    d0[q] = c[16 + e0] + c[8 + e0] + __hip_atomic_fetch_add(c + 24 + e0, 1, __ATOMIC_RELAXED, __HIP_MEMORY_SCOPE_WORKGROUP);
                    d1[q] = c[16 + e1] + c[8 + e1] + __hip_atomic_fetch_add(c + 24 + e1, 1, __ATOMIC_RELAXED, __HIP_MEMORY_SCOPE_WORKGROUP);
                    POS[2 * m] = d0[q]; POS[2 * m + 1] = d1[q]; } } }
#pragma unroll
        for (int q = 0; q < 4; ++q) { const int m = mb + q * NGW;
            if (m < M) { const int e0 = __builtin_amdgcn_readfirstlane(d0[q]), e1 = __builtin_amdgcn_readfirstlane(d1[q]);
                v4u o;
                o.x = pg8::pack_fp8x4(bflo(r0[q].x) * FP8_SX, bfhi(r0[q].x) * FP8_SX, bflo(r0[q].y) * FP8_SX, bfhi(r0[q].y) * FP8_SX); o.y = pg8::pack_fp8x4(bflo(r0[q].z) * FP8_SX, bfhi(r0[q].z) * FP8_SX, bflo(r0[q].w) * FP8_SX, bfhi(r0[q].w) * FP8_SX);
                o.z = pg8::pack_fp8x4(bflo(r1[q].x) * FP8_SX, bfhi(r1[q].x) * FP8_SX, bflo(r1[q].y) * FP8_SX, bfhi(r1[q].y) * FP8_SX); o.w = pg8::pack_fp8x4(bflo(r1[q].z) * FP8_SX, bfhi(r1[q].z) * FP8_SX, bflo(r1[q].w) * FP8_SX, bfhi(r1[q].w) * FP8_SX);
                *(v4u*)(XS + (size_t)e0 * D + 16 * lane) = o; *(v4u*)(XS + (size_t)e1 * D + 16 * lane) = o; } }
    }
    __syncthreads();
}

__device__ __forceinline__ void gmlp_unit(Frame& F, ArgsRef A, int L, int nb) {
    LAS unsigned char* Ls = F.lds; int tl_ = F.tid; asm volatile("" : "+v"(tl_));
    const int tid = tl_, lane = tid & 63, w = F.wave, fr = lane & 15, q4 = lane >> 4;
    const size_t m0 = (size_t)nb * 128;
    const bf16* P = (const bf16*)(A.ws + WS_PROJ); bf16* Y = (bf16*)(A.ws + WS_Y);
    { const f32x4 g4 = *(const f32x4*)(A.in[12] + L * 256 + 4 * lane), b4 = *(const f32x4*)(A.in[13] + L * 256 + 4 * lane);
      v2u rawv[16];
#pragma unroll
      for (int i = 0; i < 16; ++i) rawv[i] = *(const v2u*)(P + (m0 + 16 * w + i) * PN + PC_V + 4 * lane);
#pragma unroll
      for (int i = 0; i < 16; ++i) { const int r = 16 * w + i;
        const v2u raw = rawv[i];
        f32x4 v = (f32x4){bflo(raw.x), bfhi(raw.x), bflo(raw.y), bfhi(raw.y)};
        const float mu = wave_sum((v.x + v.y) + (v.z + v.w)) * (1.0f / 256.0f);
        v = v - mu;
        const float var = wave_sum((v.x * v.x + v.y * v.y) + (v.z * v.z + v.w * v.w)) * (1.0f / 256.0f);
        const float rstd = 1.0f / sqrtf(var + 1e-5f);
        v = v * rstd * g4 + b4;
        v2u o; o.x = pk2(v.x, v.y); o.y = pk2(v.z, v.w);
        *(LAS v2u*)(Ls + r * 544 + lane * 8) = o; } }
    const int g = w & 3;
    f32x4 acc[4][4];
    const float* Wg = A.in[14] + (size_t)(L * 4 + g) * 128 * 128;
    const float* bsg = A.in[15] + (size_t)(L * 4 + g) * 128;
    f32x4 wfa[4][4], wfb[4][4];
#pragma unroll
    for (int pi = 0; pi < 4; ++pi) {
        const int it = (w >> 2) == 0 ? (pi == 0 ? 0 : pi == 1 ? 7 : pi == 2 ? 1 : 6) : (pi == 0 ? 2 : pi == 1 ? 5 : pi == 2 ? 3 : 4);
#pragma unroll
        for (int ks = 0; ks < 4; ++ks) { wfa[pi][ks] = *(const f32x4*)(Wg + (16 * it + fr) * 128 + 32 * ks + 4 * q4); wfb[pi][ks] = *(const f32x4*)(Wg + (16 * it + fr) * 128 + 32 * ks + 4 * q4 + 16); }
    }
    __syncthreads();
#pragma unroll
    for (int pi = 0; pi < 4; ++pi) {
        const int it = (w >> 2) == 0 ? (pi == 0 ? 0 : pi == 1 ? 7 : pi == 2 ? 1 : 6) : (pi == 0 ? 2 : pi == 1 ? 5 : pi == 2 ? 3 : 4);
#pragma unroll
        for (int ct = 0; ct < 4; ++ct) acc[pi][ct] = (f32x4){0.f, 0.f, 0.f, 0.f};
        const int t = 16 * it + fr, nks = (it >> 1) + 1;
#pragma unroll
        for (int ks = 0; ks < 4; ++ks) {
            if (ks < nks) {
            const int sA = 32 * ks + 4 * q4, sB = sA + 16;
            const f32x4 wa = wfa[pi][ks], wb = wfb[pi][ks];
            const bf16x8 xf = pack8(sA + 0 <= t ? wa.x : 0.f, sA + 1 <= t ? wa.y : 0.f, sA + 2 <= t ? wa.z : 0.f, sA + 3 <= t ? wa.w : 0.f,
                                    sB + 0 <= t ? wb.x : 0.f, sB + 1 <= t ? wb.y : 0.f, sB + 2 <= t ? wb.z : 0.f, sB + 3 <= t ? wb.w : 0.f);
#pragma unroll
            for (int ct = 0; ct < 4; ++ct) { const int col = g * 64 + ct * 16 + 4 * (lane & 3);
                const v4i16 lo = trrd(Ls + (sA + (fr >> 2)) * 544 + col * 2), hi = trrd(Ls + (sB + (fr >> 2)) * 544 + col * 2);
                acc[pi][ct] = mfma16(xf, cat8(lo, hi), acc[pi][ct]); }
            }
        }
#pragma unroll
        for (int r = 0; r < 4; ++r) { const float bs = bsg[16 * it + 4 * q4 + r];
#pragma unroll
            for (int ct = 0; ct < 4; ++ct) acc[pi][ct][r] += bs; }
    }
    __syncthreads();
#pragma unroll
    for (int pi = 0; pi < 4; ++pi) {
        const int it = (w >> 2) == 0 ? (pi == 0 ? 0 : pi == 1 ? 7 : pi == 2 ? 1 : 6) : (pi == 0 ? 2 : pi == 1 ? 5 : pi == 2 ? 3 : 4);
#pragma unroll
        for (int ct = 0; ct < 4; ++ct)
#pragma unroll
            for (int r = 0; r < 4; ++r) *(LAS float*)(Ls + (16 * it + 4 * q4 + r) * 1040 + (g * 64 + ct * 16 + fr) * 4) = acc[pi][ct][r];
    }
    __syncthreads();
    { const f32x4 gn = *(const f32x4*)(A.in[16] + L * 256 + 4 * lane);
      v2u rawu[16];
#pragma unroll
      for (int i = 0; i < 16; ++i) rawu[i] = *(const v2u*)(P + (m0 + 16 * w + i) * PN + PC_U + 4 * lane);
#pragma unroll
      for (int i = 0; i < 16; ++i) { const int r = 16 * w + i;
        const f32x4 mx = *(const LAS f32x4*)(Ls + r * 1040 + lane * 16);
        const v2u raw = rawu[i];
        f32x4 v = (f32x4){bflo(raw.x), bfhi(raw.x), bflo(raw.y), bfhi(raw.y)} * mx;
        const float ss = wave_sum((v.x * v.x + v.y * v.y) + (v.z * v.z + v.w * v.w)) * (1.0f / 256.0f);
        v = v * (1.0f / sqrtf(ss + 1e-6f)) * gn;
        v2u o; o.x = pk2(v.x, v.y); o.y = pk2(v.z, v.w);
        *(v2u*)(Y + (m0 + r) * D + 512 + 4 * lane) = o; } }
    __syncthreads();
}

__device__ __forceinline__ void attn_unit(Frame& F, ArgsRef A, int L, int bc) {
    LAS unsigned char* Ls = F.lds; int tl_ = F.tid; asm volatile("" : "+v"(tl_));
    const int tid = tl_, lane = tid & 63, w = F.wave, fr = lane & 15, q4 = lane >> 4;
    const int b = bc >> 7, c = bc & 127; const size_t m0 = (size_t)b * SEQ + (size_t)c * 64;
    const bf16* P = (const bf16*)(A.ws + WS_PROJ); bf16* Y = (bf16*)(A.ws + WS_Y);
    const int h = w >> 1, qh = w & 1;
    LAS unsigned char* Vb = Ls + w * 10240;
    TR0(F);
    LAS float* BT = (LAS float*)(Ls + 81920);
    constexpr float LOG2E = 1.4426950408889634f;
    for (int i = tid; i < 4 * 257; i += NTHR) BT[i] = A.in[17][(size_t)L * 4 * 257 + i] * LOG2E;
    bf16x8 qf[2][2];
#pragma unroll
    for (int qb = 0; qb < 2; ++qb)
#pragma unroll
        for (int ks = 0; ks < 2; ++ks) qf[qb][ks] = *(const bf16x8*)(P + (m0 + 32 * qh + 16 * qb + fr) * PN + PC_Q + h * 64 + 32 * ks + 8 * q4);
    f32x4 o[4][2];
#pragma unroll
    for (int dt = 0; dt < 4; ++dt) { o[dt][0] = (f32x4){0.f, 0.f, 0.f, 0.f}; o[dt][1] = (f32x4){0.f, 0.f, 0.f, 0.f}; }
    float mrun[2] = {-1e30f, -1e30f}, lrun[2] = {0.f, 0.f};
    const int jmin = c >= 8 ? 0 : 8 - c;
    const bf16* Kp = P + PC_K + h * 64 + 8 * q4 + (size_t)fr * PN;
    const bf16* Vp = P + PC_VV + h * 64 + (lane & 7) * 8 + (size_t)(lane >> 3) * PN;
    bf16x8 kreg[4][2]; v4u vreg[8];
    { const size_t kr0 = m0 - (size_t)(8 - jmin) * 64;
#pragma unroll
      for (int kt = 0; kt < 4; ++kt)
#pragma unroll
          for (int ks = 0; ks < 2; ++ks) kreg[kt][ks] = *(const bf16x8*)(Kp + (kr0 + 16 * kt) * PN + 32 * ks);
#pragma unroll
      for (int i = 0; i < 8; ++i) vreg[i] = *(const v4u*)(Vp + (kr0 + 8 * i) * PN); }
    __syncthreads();
    TR(F, 33);
    const float cb = BT[h * 257 + 256];
    for (int j = jmin; j <= 8; ++j) {
        const int jn = j < 8 ? j + 1 : 8; const size_t krn = m0 - (size_t)(8 - jn) * 64;
#pragma unroll
        for (int i = 0; i < 8; ++i) *(LAS v4u*)(Vb + (i * 8 + (lane >> 3)) * 160 + (lane & 7) * 16) = vreg[i];
#pragma unroll
        for (int i = 0; i < 8; ++i) vreg[i] = *(const v4u*)(Vp + (krn + 8 * i) * PN);
        f32x4 st[4][2];
#pragma unroll
        for (int kt = 0; kt < 4; ++kt) { st[kt][0] = (f32x4){0.f, 0.f, 0.f, 0.f}; st[kt][1] = (f32x4){0.f, 0.f, 0.f, 0.f};
#pragma unroll
            for (int ks = 0; ks < 2; ++ks) { st[kt][0] = mfma16(kreg[kt][ks], qf[0][ks], st[kt][0]); st[kt][1] = mfma16(kreg[kt][ks], qf[1][ks], st[kt][1]); } }
#pragma unroll
        for (int kt = 0; kt < 4; ++kt)
#pragma unroll
            for (int ks = 0; ks < 2; ++ks) kreg[kt][ks] = *(const bf16x8*)(Kp + (krn + 16 * kt) * PN + 32 * ks);
#pragma unroll
        for (int qb = 0; qb < 2; ++qb) {
            float mx = -1e30f;
            if (j <= 5) {
#pragma unroll
                for (int kt = 0; kt < 4; ++kt)
#pragma unroll
                    for (int r = 0; r < 4; ++r) { const float s = st[kt][qb][r] * (0.125f * LOG2E) + cb; st[kt][qb][r] = s; mx = fmaxf(mx, s); }
            } else {
                const LAS float* bt = BT + h * 257 + (512 - 64 * j + 32 * qh + 16 * qb + fr - 4 * q4 + 128);
                const int i0 = 512 - 64 * j + 32 * qh + 16 * qb + fr - 4 * q4 + 128;
#pragma unroll
                for (int kt = 0; kt < 4; ++kt)
#pragma unroll
                    for (int r = 0; r < 4; ++r) { int idx = i0 - 16 * kt - r; idx = idx > 256 ? 256 : idx;
                        const float s = st[kt][qb][r] * (0.125f * LOG2E) + BT[h * 257 + idx]; st[kt][qb][r] = s; mx = fmaxf(mx, s); }
                (void)bt;
            }
            mx = fmaxf(mx, __shfl_xor(mx, 16)); mx = fmaxf(mx, __shfl_xor(mx, 32));
            const float mold = mrun[qb], mnew = fmaxf(mold, mx); mrun[qb] = mnew;
            float rs = 0.f;
#pragma unroll
            for (int kt = 0; kt < 4; ++kt)
#pragma unroll
                for (int r = 0; r < 4; ++r) { const float p = __builtin_amdgcn_exp2f(st[kt][qb][r] - mnew); st[kt][qb][r] = p; rs += p; }
            rs += __shfl_xor(rs, 16); rs += __shfl_xor(rs, 32);
            if (__any(mnew > mold)) { const float alpha = __builtin_amdgcn_exp2f(mold - mnew); lrun[qb] = lrun[qb] * alpha + rs;
#pragma unroll
                for (int dt = 0; dt < 4; ++dt) o[dt][qb] = o[dt][qb] * alpha; }
            else lrun[qb] += rs;
        }
#pragma unroll
        for (int kk = 0; kk < 2; ++kk) {
            const bf16x8 y0 = pack8(st[2 * kk][0][0], st[2 * kk][0][1], st[2 * kk][0][2], st[2 * kk][0][3], st[2 * kk + 1][0][0], st[2 * kk + 1][0][1], st[2 * kk + 1][0][2], st[2 * kk + 1][0][3]);
            const bf16x8 y1 = pack8(st[2 * kk][1][0], st[2 * kk][1][1], st[2 * kk][1][2], st[2 * kk][1][3], st[2 * kk + 1][1][0], st[2 * kk + 1][1][1], st[2 * kk + 1][1][2], st[2 * kk + 1][1][3]);
            const int rowA = 32 * kk + 4 * q4 + (fr >> 2), rowB = rowA + 16;
#pragma unroll
            for (int dt = 0; dt < 4; ++dt) { const int cbt = (16 * dt + 4 * (lane & 3)) * 2;
                const bf16x8 xf = cat8(trrd(Vb + rowA * 160 + cbt), trrd(Vb + rowB * 160 + cbt));
                o[dt][0] = mfma16(xf, y0, o[dt][0]); o[dt][1] = mfma16(xf, y1, o[dt][1]); }
        }
    }
    TR(F, 34);
    const float il0 = 1.0f / lrun[0], il1 = 1.0f / lrun[1];
    LAS float* SS = (LAS float*)(Ls + 86144);
    float ss0 = 0.f, ss1 = 0.f;
#pragma unroll
    for (int dt = 0; dt < 4; ++dt) { o[dt][0] = o[dt][0] * il0; o[dt][1] = o[dt][1] * il1;
        ss0 += (o[dt][0].x * o[dt][0].x + o[dt][0].y * o[dt][0].y) + (o[dt][0].z * o[dt][0].z + o[dt][0].w * o[dt][0].w);
        ss1 += (o[dt][1].x * o[dt][1].x + o[dt][1].y * o[dt][1].y) + (o[dt][1].z * o[dt][1].z + o[dt][1].w * o[dt][1].w); }
    ss0 += __shfl_xor(ss0, 16); ss0 += __shfl_xor(ss0, 32); ss1 += __shfl_xor(ss1, 16); ss1 += __shfl_xor(ss1, 32);
    if (q4 == 0) { SS[(32 * qh + fr) * 4 + h] = ss0; SS[(32 * qh + 16 + fr) * 4 + h] = ss1; }
    __syncthreads();
    { const f32x4 t0 = *(const LAS f32x4*)(SS + (32 * qh + fr) * 4), t1 = *(const LAS f32x4*)(SS + (32 * qh + 16 + fr) * 4);
      const float sc0 = 1.0f / sqrtf(((t0.x + t0.y) + (t0.z + t0.w)) * (1.0f / 256.0f) + 1e-6f), sc1 = 1.0f / sqrtf(((t1.x + t1.y) + (t1.z + t1.w)) * (1.0f / 256.0f) + 1e-6f);
      const float* gnp = A.in[18] + L * 256 + h * 64 + 4 * q4;
      bf16* y0 = Y + (m0 + 32 * qh + fr) * D + 768 + h * 64 + 4 * q4; bf16* y1 = y0 + (size_t)16 * D;
#pragma unroll
      for (int dt = 0; dt < 4; ++dt) { const f32x4 gn = *(const f32x4*)(gnp + 16 * dt);
          const f32x4 a = o[dt][0] * sc0 * gn, bq = o[dt][1] * sc1 * gn;
          v2u oa, ob; oa.x = pk2(a.x, a.y); oa.y = pk2(a.z, a.w); ob.x = pk2(bq.x, bq.y); ob.y = pk2(bq.z, bq.w);
          *(v2u*)(y0 + 16 * dt) = oa; *(v2u*)(y1 + 16 * dt) = ob; } }
    TR(F, 35);
}

__device__ __forceinline__ void ssd_prepass(Frame& F, ArgsRef A, int L, size_t m0, LAS float* dtl, LAS float* acs) {
    const float* DTRAW = (const float*)(A.ws + WS_DTRAW);
    { const int l = F.lane, h = F.wave;
      const float x = DTRAW[(m0 + l) * 8 + h] + A.in[8][L * 8 + h];
      const float dt = x > 20.f ? x : log1pf(expf(x));
      float s = -dt * expf(A.in[9][L * 8 + h]);
#pragma unroll
      for (int o = 1; o < 64; o <<= 1) { const float t = __shfl_up(s, o); s += (l >= o) ? t : 0.f; }
      dtl[l * 8 + h] = dt; acs[l * 8 + h] = s; }
    __syncthreads();
}
__device__ __forceinline__ void ssd1_unit(Frame& F, ArgsRef A, int L, int bc) {
    LAS unsigned char* Ls = F.lds; int tl_ = F.tid; asm volatile("" : "+v"(tl_));
    const int tid = tl_, lane = tid & 63, w = F.wave, fr = lane & 15, q4 = lane >> 4;
    const int b = bc >> 7, c = bc & 127; const size_t m0 = (size_t)b * SEQ + (size_t)c * 64;
    const bf16* P = (const bf16*)(A.ws + WS_PROJ); bf16* XBCC = (bf16*)(A.ws + WS_XBCC); bf16* ST = (bf16*)(A.ws + WS_ST); float* AEND = (float*)(A.ws + WS_AEND);
    LAS unsigned char* XI = Ls; LAS unsigned char* BI = Ls + 67584;
    LAS float* dtl = (LAS float*)(Ls + 102400); LAS float* acs = (LAS float*)(Ls + 104448);
    const int cg = tid & 127, tg = tid >> 7, ch0 = 8 * cg;
    v4u raw[19];
#define SSD1_ROW(tt) do { const int lp = 16 * tg - 3 + (tt); const bool ok = (c * 64 + lp) >= 0; \
        raw[tt] = ok ? *(const v4u*)(P + (size_t)((long)m0 + lp) * PN + PC_XBC + ch0) : (v4u){0u, 0u, 0u, 0u}; } while (0)
#pragma unroll
    for (int tt = 0; tt < 11; ++tt) SSD1_ROW(tt);
    TR0(F);
    ssd_prepass(F, A, L, m0, dtl, acs);
    TR(F, 30);
    if (tid < 8) AEND[(size_t)bc * 8 + tid] = acs[63 * 8 + tid];
    { float wk[4][8], bs[8];
#pragma unroll
      for (int k = 0; k < 4; ++k) { const f32x4 a = *(const f32x4*)(A.in[6] + (size_t)(L * 4 + k) * 1024 + ch0), bq = *(const f32x4*)(A.in[6] + (size_t)(L * 4 + k) * 1024 + ch0 + 4);
          wk[k][0] = a.x; wk[k][1] = a.y; wk[k][2] = a.z; wk[k][3] = a.w; wk[k][4] = bq.x; wk[k][5] = bq.y; wk[k][6] = bq.z; wk[k][7] = bq.w; }
      { const f32x4 a = *(const f32x4*)(A.in[7] + (size_t)L * 1024 + ch0), bq = *(const f32x4*)(A.in[7] + (size_t)L * 1024 + ch0 + 4);
          bs[0] = a.x; bs[1] = a.y; bs[2] = a.z; bs[3] = a.w; bs[4] = bq.x; bs[5] = bq.y; bs[6] = bq.z; bs[7] = bq.w; }
      const int hh = cg >> 3;
#pragma unroll
      for (int t = 0; t < 16; ++t) { const int l = 16 * tg + t;
          if (t < 8) SSD1_ROW(t + 11);
          float y[8];
#pragma unroll
          for (int e = 0; e < 8; ++e) y[e] = bs[e];
#pragma unroll
          for (int k = 0; k < 4; ++k) { const v4u rw = raw[t + k];
              y[0] += wk[k][0] * bflo(rw.x); y[1] += wk[k][1] * bfhi(rw.x); y[2] += wk[k][2] * bflo(rw.y); y[3] += wk[k][3] * bfhi(rw.y);
              y[4] += wk[k][4] * bflo(rw.z); y[5] += wk[k][5] * bfhi(rw.z); y[6] += wk[k][6] * bflo(rw.w); y[7] += wk[k][7] * bfhi(rw.w); }
#pragma unroll
          for (int e = 0; e < 8; ++e) y[e] = silu(y[e]);
          v4u o; o.x = pk2(y[0], y[1]); o.y = pk2(y[2], y[3]); o.z = pk2(y[4], y[5]); o.w = pk2(y[6], y[7]);
          *(v4u*)(XBCC + (m0 + l) * 1024 + ch0) = o;
          if (cg < 64) { const float sc = dtl[l * 8 + hh] * __expf(acs[63 * 8 + hh] - acs[l * 8 + hh]);
              v4u os; os.x = pk2(y[0] * sc, y[1] * sc); os.y = pk2(y[2] * sc, y[3] * sc); os.z = pk2(y[4] * sc, y[5] * sc); os.w = pk2(y[6] * sc, y[7] * sc);
              *(LAS v4u*)(XI + l * 1056 + ch0 * 2) = os; }
          else if (cg < 96) *(LAS v4u*)(BI + l * 544 + (ch0 - 512) * 2) = o;
          __builtin_amdgcn_sched_barrier(0);
      } }
#undef SSD1_ROW
    __syncthreads();
    TR(F, 31);
    { const int h = w, gi = h >> 2;
      bf16* STh = ST + ((size_t)bc * 8 + h) * 8192;
#pragma unroll 1
      for (int nh = 0; nh < 2; ++nh) {
      f32x4 acc[4][4];
#pragma unroll
      for (int nt = 0; nt < 4; ++nt)
#pragma unroll
          for (int pt = 0; pt < 4; ++pt) acc[nt][pt] = (f32x4){0.f, 0.f, 0.f, 0.f};
#pragma unroll
      for (int ks = 0; ks < 2; ++ks) {
          const int rowA = 32 * ks + 4 * q4 + (fr >> 2), rowB = rowA + 16;
          bf16x8 yf[4];
#pragma unroll
          for (int pt = 0; pt < 4; ++pt) { const int cb = (h * 64 + 16 * pt + 4 * (lane & 3)) * 2; yf[pt] = cat8(trrd(XI + rowA * 1056 + cb), trrd(XI + rowB * 1056 + cb)); }
#pragma unroll
          for (int nt = 0; nt < 4; ++nt) { const int cb = (gi * 128 + 64 * nh + 16 * nt + 4 * (lane & 3)) * 2;
              const bf16x8 xf = cat8(trrd(BI + rowA * 544 + cb), trrd(BI + rowB * 544 + cb));
#pragma unroll
              for (int pt = 0; pt < 4; ++pt) acc[nt][pt] = mfma16(xf, yf[pt], acc[nt][pt]); }
      }
#pragma unroll
      for (int nt = 0; nt < 4; ++nt)
#pragma unroll
          for (int pt = 0; pt < 4; ++pt) { v2u o; o.x = pk2(acc[nt][pt][0], acc[nt][pt][1]); o.y = pk2(acc[nt][pt][2], acc[nt][pt][3]); *(v2u*)(STh + (16 * pt + fr) * 128 + 64 * nh + 16 * nt + 4 * q4) = o; }
      }
    }
    __syncthreads();
    TR(F, 32);
}
__device__ __forceinline__ void ssd_scan(Frame& F, ArgsRef A) {
    unsigned* ST = (unsigned*)(A.ws + WS_ST); const float* AEND = (const float*)(A.ws + WS_AEND);
    for (int it = F.vcu * NTHR + F.tid; it < 32 * 4096; it += F.G * NTHR) {
        const int bh = it >> 12, b = bh >> 3, h = bh & 7, e = (it & 4095);
        unsigned* base = ST + ((size_t)(b * NCHUNK) * 8 + h) * 4096 + e;
        float s0 = 0.f, s1 = 0.f;
        for (int c0 = 0; c0 < NCHUNK; c0 += 16) {
            unsigned v[16]; float dec[16];
#pragma unroll
            for (int i = 0; i < 16; ++i) { v[i] = base[(size_t)(c0 + i) * 32768]; dec[i] = AEND[(size_t)(b * NCHUNK + c0 + i) * 8 + h]; }
            __builtin_amdgcn_sched_barrier(0);
#pragma unroll
            for (int i = 0; i < 16; ++i) dec[i] = __expf(dec[i]);
#pragma unroll
            for (int i = 0; i < 16; ++i) { base[(size_t)(c0 + i) * 32768] = pk2(s0, s1); s0 = s0 * dec[i] + bflo(v[i]); s1 = s1 * dec[i] + bfhi(v[i]); }
        }
    }
}
__device__ __forceinline__ void ssd3_unit(Frame& F, ArgsRef A, int L, int bc) {
    LAS unsigned char* Ls = F.lds; int tl_ = F.tid; asm volatile("" : "+v"(tl_));
    const int tid = tl_, lane = tid & 63, w = F.wave, fr = lane & 15, q4 = lane >> 4;
    const int b = bc >> 7, c = bc & 127; const size_t m0 = (size_t)b * SEQ + (size_t)c * 64;
    const bf16* P = (const bf16*)(A.ws + WS_PROJ); const bf16* XBCC = (const bf16*)(A.ws + WS_XBCC); const bf16* ST = (const bf16*)(A.ws + WS_ST); bf16* Y = (bf16*)(A.ws + WS_Y);
    LAS unsigned char* XI = Ls; LAS unsigned char* BI = Ls + 67584; LAS unsigned char* CI = Ls + 102400;
    LAS float* dtl = (LAS float*)(Ls + 137216); LAS float* acs = (LAS float*)(Ls + 139264);
    const int h = w, gi = h >> 2;
    TR0(F);
    v4u stg[16];
#pragma unroll
    for (int i = 0; i < 16; ++i) { const int pc = tid + NTHR * i; stg[i] = *(const v4u*)(XBCC + (m0 + (pc >> 7)) * 1024 + 8 * (pc & 127)); }
    ssd_prepass(F, A, L, m0, dtl, acs);
#pragma unroll
    for (int i = 0; i < 16; ++i) { const int pc = tid + NTHR * i, row = pc >> 7, cg = pc & 127;
        LAS unsigned char* dst = cg < 64 ? XI + row * 1056 + cg * 16 : (cg < 96 ? BI + row * 544 + (cg - 64) * 16 : CI + row * 544 + (cg - 96) * 16);
        *(LAS v4u*)dst = stg[i]; }
    __builtin_amdgcn_sched_barrier(0);
    bf16x8 sin_[4][4];
    { const bf16* Sh = ST + ((size_t)bc * 8 + h) * 8192;
#pragma unroll
      for (int kn = 0; kn < 4; ++kn)
#pragma unroll
          for (int pt = 0; pt < 4; ++pt) sin_[kn][pt] = *(const bf16x8*)(Sh + (16 * pt + fr) * 128 + 32 * kn + 8 * q4); }
    __syncthreads();
    TR(F, 36);
    f32x4 acc[4][4];
#pragma unroll
    for (int lt = 0; lt < 4; ++lt)
#pragma unroll
        for (int pt = 0; pt < 4; ++pt) acc[lt][pt] = (f32x4){0.f, 0.f, 0.f, 0.f};
    {
#pragma unroll
      for (int kn = 0; kn < 4; ++kn) {
#pragma unroll
          for (int lt = 0; lt < 4; ++lt) { const bf16x8 xf = *(const LAS bf16x8*)(CI + (16 * lt + fr) * 544 + (gi * 128 + 32 * kn + 8 * q4) * 2);
#pragma unroll
              for (int pt = 0; pt < 4; ++pt) acc[lt][pt] = mfma16(xf, sin_[kn][pt], acc[lt][pt]); }
      }
#pragma unroll
      for (int lt = 0; lt < 4; ++lt)
#pragma unroll
          for (int r = 0; r < 4; ++r) { const float sc = __expf(acs[(16 * lt + 4 * q4 + r) * 8 + h]);
#pragma unroll
              for (int pt = 0; pt < 4; ++pt) acc[lt][pt][r] *= sc; }
    }
#pragma unroll
    for (int lt = 0; lt < 4; ++lt) {
#pragma unroll
        for (int ksp = 0; ksp <= (lt >> 1); ++ksp) {
            __builtin_amdgcn_sched_barrier(0);
            const bool hasb = (2 * ksp + 1) <= lt;
            f32x4 d0a = (f32x4){0.f, 0.f, 0.f, 0.f}, d0b = (f32x4){0.f, 0.f, 0.f, 0.f};
#pragma unroll
            for (int kn = 0; kn < 4; ++kn) { const int cb = (gi * 128 + 32 * kn + 8 * q4) * 2;
                const bf16x8 cf = *(const LAS bf16x8*)(CI + (16 * lt + fr) * 544 + cb);
                const bf16x8 ba = *(const LAS bf16x8*)(BI + (32 * ksp + fr) * 544 + cb); d0a = mfma16(ba, cf, d0a);
                if (hasb) { const bf16x8 bb = *(const LAS bf16x8*)(BI + (32 * ksp + 16 + fr) * 544 + cb); d0b = mfma16(bb, cf, d0b); } }
            const int l = 16 * lt + fr; const float al = acs[l * 8 + h];
            float ga[4], gb[4];
#pragma unroll
            for (int r = 0; r < 4; ++r) { const int sa = 32 * ksp + 4 * q4 + r, sb = sa + 16;
                ga[r] = sa <= l ? d0a[r] * __expf(al - acs[sa * 8 + h]) * dtl[sa * 8 + h] : 0.f;
                gb[r] = (hasb && sb <= l) ? d0b[r] * __expf(al - acs[sb * 8 + h]) * dtl[sb * 8 + h] : 0.f; }
            const bf16x8 xf = pack8(ga[0], ga[1], ga[2], ga[3], gb[0], gb[1], gb[2], gb[3]);
            const int rowA = 32 * ksp + 4 * q4 + (fr >> 2), rowB = rowA + 16;
#pragma unroll
            for (int pt = 0; pt < 4; ++pt) { const int cb = (h * 64 + 16 * pt + 4 * (lane & 3)) * 2;
                acc[lt][pt] = mfma16(xf, cat8(trrd(XI + rowA * 1056 + cb), trrd(XI + rowB * 1056 + cb)), acc[lt][pt]); }
        }
    }
    { const float dsk = A.in[10][L * 8 + h];
#pragma unroll
      for (int lt = 0; lt < 4; ++lt)
#pragma unroll
          for (int pt = 0; pt < 4; ++pt)
#pragma unroll
              for (int r = 0; r < 4; ++r) { const unsigned short xv = *(const LAS unsigned short*)(XI + (16 * lt + 4 * q4 + r) * 1056 + (h * 64 + 16 * pt + fr) * 2);
                  acc[lt][pt][r] += dsk * __uint_as_float((unsigned)xv << 16); } }
    __builtin_amdgcn_sched_barrier(0);
    v4u zr[8];
#pragma unroll
    for (int i = 0; i < 8; ++i) zr[i] = *(const v4u*)(P + (m0 + 8 * w + i) * PN + PC_Z + 8 * lane);
    __syncthreads();
    TR(F, 37);
#pragma unroll
    for (int lt = 0; lt < 4; ++lt)
#pragma unroll
        for (int pt = 0; pt < 4; ++pt)
#pragma unroll
            for (int r = 0; r < 4; ++r) *(LAS float*)(Ls + (16 * lt + 4 * q4 + r) * 2112 + (h * 64 + 16 * pt + fr) * 4) = acc[lt][pt][r];
    __syncthreads();
    { const f32x4 g0 = *(const f32x4*)(A.in[11] + L * 512 + 8 * lane), g1 = *(const f32x4*)(A.in[11] + L * 512 + 8 * lane + 4);
#pragma unroll
      for (int i = 0; i < 8; ++i) { const int r = 8 * w + i;
        f32x4 v0 = *(const LAS f32x4*)(Ls + r * 2112 + lane * 32), v1 = *(const LAS f32x4*)(Ls + r * 2112 + lane * 32 + 16);
        const v4u z = zr[i];
        v0 = v0 * (f32x4){silu(bflo(z.x)), silu(bfhi(z.x)), silu(bflo(z.y)), silu(bfhi(z.y))};
        v1 = v1 * (f32x4){silu(bflo(z.z)), silu(bfhi(z.z)), silu(bflo(z.w)), silu(bfhi(z.w))};
        const float ss = wave_sum((v0.x * v0.x + v0.y * v0.y) + (v0.z * v0.z + v0.w * v0.w) + (v1.x * v1.x + v1.y * v1.y) + (v1.z * v1.z + v1.w * v1.w)) * (1.0f / 512.0f);
        const float sc = 1.0f / sqrtf(ss + 1e-6f);
        v0 = v0 * sc * g0; v1 = v1 * sc * g1;
        v4u ov; ov.x = pk2(v0.x, v0.y); ov.y = pk2(v0.z, v0.w); ov.z = pk2(v1.x, v1.y); ov.w = pk2(v1.z, v1.w);
        *(v4u*)(Y + (m0 + r) * D + 8 * lane) = ov; } }
    __syncthreads();
    TR(F, 38);
}

#ifndef PROBE_FP8TEST
#define PROBE_FP8TEST 0
#endif
#if PROBE_FP8TEST
typedef int v8i __attribute__((ext_vector_type(8)));
__device__ __forceinline__ int fp8_selftest(int lane) {
    const int ij = lane & 15, g = lane >> 4;
    v8i Af, Bf;
#pragma unroll
    for (int r = 0; r < 8; ++r) { int wa = 0, wb = 0; const int k = 32 * g + 4 * r;
        wa = __builtin_amdgcn_cvt_pk_fp8_f32((float)((7 * ij + 3 * (k + 0)) % 5), (float)((7 * ij + 3 * (k + 1)) % 5), wa, false);
        wa = __builtin_amdgcn_cvt_pk_fp8_f32((float)((7 * ij + 3 * (k + 2)) % 5), (float)((7 * ij + 3 * (k + 3)) % 5), wa, true);
        wb = __builtin_amdgcn_cvt_pk_fp8_f32((float)((5 * (k + 0) + 11 * ij) % 7), (float)((5 * (k + 1) + 11 * ij) % 7), wb, false);
        wb = __builtin_amdgcn_cvt_pk_fp8_f32((float)((5 * (k + 2) + 11 * ij) % 7), (float)((5 * (k + 3) + 11 * ij) % 7), wb, true);
        Af[r] = wa; Bf[r] = wb; }
    f32x4 d = (f32x4){0.f, 0.f, 0.f, 0.f};
    d = __builtin_amdgcn_mfma_scale_f32_16x16x128_f8f6f4(Af, Bf, d, 0, 0, 0, 0, 0, 0);
    int bad = 0;
#pragma unroll
    for (int r = 0; r < 4; ++r) { const int i = 4 * g + r, j = ij; float e = 0.f;
        for (int k = 0; k < 128; ++k) e += (float)(((7 * i + 3 * k) % 5) * ((5 * k + 11 * j) % 7));
        bad += (d[r] != e + (PROBE_FP8TEST == 2 ? 1.f : 0.f)) ? 1 : 0; }
    return bad;
}
#endif
constexpr int NPHASE = 1 + 16 + 7 + 2 * MOE_NCH + 1;
__global__ void __launch_bounds__(NTHR, 2) fwd_kernel(Args kargs) {
    ArgsP ap = (ArgsP)__builtin_amdgcn_kernarg_segment_ptr();
#define args (*ap)
    extern __shared__ __attribute__((aligned(16))) unsigned char lds[];
    Frame F;
    F.lds = (LAS unsigned char*)lds;
    F.tid = threadIdx.x; F.lane = F.tid & 63; F.wave = __builtin_amdgcn_readfirstlane(F.tid >> 6);
#if PROBE_TG >= 30
    F.tr_acc = 0ull; F.tr_mark = 0ull;
#endif
    F.G = gridDim.x; { const int bx = blockIdx.x; F.vcu = (F.G % 8 == 0) ? (bx % 8) * (F.G / 8) + bx / 8 : bx; }
    gu32* ctl = (gu32*)(args.ws + WS_CTL);
    for (int u = F.tid; u < (LDS_BYTES - LDSCTL_OFF) / 4; u += NTHR) ((LAS unsigned*)(F.lds + LDSCTL_OFF))[u] = 0u;
    __syncthreads();
    XcdBarrier bar; bar.bar = (unsigned*)(ctl + CW_BAR); bar.x = 0; bar.st = nullptr;
    const int lo = args.ph_lo, hi = args.ph_hi;
    int nbar = 0;
    if (hi - lo > 1) bar = xcd_barrier_post((unsigned*)(ctl + CW_BAR), (volatile LAS unsigned*)(F.lds + CTL_MISC) + 8);
#if PROBE_TG >= 0
    unsigned long long t_acc = 0ull, t_ph = 0ull;
#define IN(k) ((lo <= (k) && (k) < hi) && fresh(F) && relaunder(ap) && ((t_ph = __builtin_amdgcn_s_memrealtime()), true))
#define T_STOP(k) do { if (tgroup_of(k) == PROBE_TG || PROBE_TG == 26) t_acc += __builtin_amdgcn_s_memrealtime() - t_ph; } while (0)
    unsigned long long t_sub = 0ull;
#define T_SUB0() (t_sub = __builtin_amdgcn_s_memrealtime())
#define T_SUB(g) do { const unsigned long long n_ = __builtin_amdgcn_s_memrealtime(); if ((g) == PROBE_TG) t_acc += n_ - t_sub; t_sub = n_; } while (0)
#else
#define T_SUB0() do { } while (0)
#define T_SUB(g) do { } while (0)
#define IN(k) ((lo <= (k) && (k) < hi) && fresh(F) && relaunder(ap))
#define T_STOP(k) do { } while (0)
#endif
#if PROBE_TG == 20
#define SEAM(k) do { if ((k) + 1 < hi) { const unsigned long long tb_ = __builtin_amdgcn_s_memrealtime(); xcd_barrier(bar); ++nbar; t_acc += __builtin_amdgcn_s_memrealtime() - tb_; } } while (0)
#else
#define SEAM(k) do { if ((k) + 1 < hi) { REP(12) xcd_barrier(bar); ++nbar; } T_STOP(k); } while (0)
#endif
    unsigned char* ws = args.ws;
    bf16* A1 = (bf16*)(ws + WS_A1); bf16* HB = (bf16*)(ws + WS_HB); bf16* PROJ = (bf16*)(ws + WS_PROJ); bf16* Yb = (bf16*)(ws + WS_Y); bf16* MIXED = (bf16*)(ws + WS_MIXED);
    const int bid = (int)blockIdx.x;

#ifdef ONLY_UNIT
    { fresh(F); relaunder(ap);
#if ONLY_UNIT == 1
      for (int u = F.vcu; u < NBATCH * NCHUNK; u += F.G) ssd1_unit(F, args, 0, u);
#elif ONLY_UNIT == 2
      for (int u = F.vcu; u < NBATCH * NCHUNK; u += F.G) attn_unit(F, args, 0, u);
#elif ONLY_UNIT == 3
      for (int u = F.vcu; u < M / 128; u += F.G) gmlp_unit(F, args, 0, u);
#elif ONLY_UNIT == 4
      for (int u = F.vcu; u < NBATCH * NCHUNK; u += F.G) ssd3_unit(F, args, 0, u);
#elif ONLY_UNIT == 5
      { RowArgs R{nullptr, nullptr, HB, HB, 1, MIXED, args.in[2], args.in[3], A1, 2, args.in[23], 8}; row_phase(F, args, R); }
#endif
      return; }
#endif
    if (IN(0)) {
#if PROBE_FP8TEST
        if (blockIdx.x == 0 && F.wave == 0) { const int bad = fp8_selftest(F.lane); if (bad) atomicAdd((unsigned*)(args.ws + WS_CTL) + 2, (unsigned)bad); }
#endif
        cvt_small_weights(F, args, 0, 704, F.vcu * NWAVES + F.wave, F.G * NWAVES);
        __syncthreads();
        RowArgs R{args.in[0], nullptr, nullptr, nullptr, 0, nullptr, nullptr, args.in[1], A1, 1, args.in[5] + 1536, DIN};
        REP(9) row_phase(F, args, R);
        SEAM(0);
    }
#ifdef PROBE_SWEEP
    { fresh(F); const int gw = F.vcu * NWAVES + F.wave, NGW = F.G * NWAVES; float acc = 0.f;
      for (int mb = gw; mb < M; mb += PROBE_SWEEP * NGW) { f32x4 t[PROBE_SWEEP][4];
#pragma unroll
          for (int q = 0; q < PROBE_SWEEP; ++q)
#pragma unroll
              for (int j = 0; j < 4; ++j) t[q][j] = *(const f32x4*)(args.in[0] + (size_t)(mb + q * NGW) * D + 4 * F.lane + 256 * j);
#pragma unroll
          for (int q = 0; q < PROBE_SWEEP; ++q)
#pragma unroll
              for (int j = 0; j < 4; ++j) acc += t[q][j].x + t[q][j].y + t[q][j].z + t[q][j].w; }
      if (acc == 1.2345e-30f) ((float*)(args.ws + WS_CTL))[100] = acc;
      __syncthreads(); }
#endif
    for (int L = 0; L < 2; ++L) {
        const int pb = 1 + 16 * L;
        if (IN(pb + 0)) {
            pg8::Gemm g{A1, (const bf16*)(ws + WS_WIN) + (size_t)L * PN * D, M, PN, D}; pg8::StaticOrder S; S.init(M, PN, F.G, bid);
            pg8::EpiStore E{PROJ, PN, 1.0f};
            pg8::gemm_phase<pg8::EpiStore, pg8::StaticOrder, true, true>(F.lds, g, S, E);
            if (F.G == 256 && bid >= 128) { const int gw = (bid - 128) * NWAVES + F.wave;
                if (L == 0) cvt_small_weights(F, args, 704, CVT_SMALL_TASKS, gw, 128 * NWAVES); }
            else if (F.G != 256 && L == 0) cvt_small_weights(F, args, 704, CVT_SMALL_TASKS, F.vcu * NWAVES + F.wave, F.G * NWAVES);
            SEAM(pb + 0);
        }
        if (IN(pb + 1)) {
            T_SUB0();
            for (int u = F.vcu; u < NBATCH * NCHUNK; u += F.G) attn_unit(F, args, L, u);
            T_SUB(11);
            for (int u = F.vcu; u < NBATCH * NCHUNK; u += F.G) ssd1_unit(F, args, L, u);
            T_SUB(10);
            for (int u = F.vcu; u < M / 128; u += F.G) gmlp_unit(F, args, L, u);
            T_SUB(12);
            SEAM(pb + 1);
        }
                if (IN(pb + 2)) { ssd_scan(F, args); SEAM(pb + 2); }
        if (IN(pb + 3)) { for (int u = F.vcu; u < NBATCH * NCHUNK; u += F.G) ssd3_unit(F, args, L, u); SEAM(pb + 3); }
        if (IN(pb + 4)) {
            pg8::Gemm g{Yb, (const bf16*)(ws + WS_WOUT) + (size_t)L * D * D, M, D, D}; pg8::StaticOrder S; S.init(M, D, F.G, bid);
            pg8::EpiStore E{MIXED, D, 1.0f};
            REP(5) pg8::gemm_phase<pg8::EpiStore, pg8::StaticOrder, true, true>(F.lds, g, S, E);
            SEAM(pb + 4);
        }
        if (IN(pb + 5)) {
            RowArgs R{L == 0 ? args.in[0] : nullptr, nullptr, HB, HB, 1, MIXED, args.in[2] + L * D, args.in[3] + L * D, A1, L == 1 ? 2 : 0, args.in[23], 8};
            if (L == 0) { REP(8) row_phase(F, args, R); } else row_phase(F, args, R);
            if (L == 1) cvt_moe_weights(F, args, 0, MOE_CVT_TASKS, F.vcu * NWAVES + F.wave, F.G * NWAVES);
            SEAM(pb + 5);
        }
        if (L == 0) {
            if (IN(pb + 6)) {
                pg8::Gemm g{A1, (const bf16*)(ws + WS_WGU), M, 2 * DFF, D}; pg8::StaticOrder S; S.init(M, 2 * DFF, F.G, bid);
                pg8::EpiSwiglu E{(bf16*)(ws + WS_H1), DFF};
                REP(6) pg8::gemm_phase<pg8::EpiSwiglu, pg8::StaticOrder, true, true>(F.lds, g, S, E);
                SEAM(pb + 6);
            }
            if (IN(pb + 7)) {
                pg8::Gemm g{(const bf16*)(ws + WS_H1), (const bf16*)(ws + WS_WD), M, D, DFF}; pg8::StaticOrder S; S.init(M, D, F.G, bid);
                pg8::EpiStore E{(bf16*)(ws + WS_FOUT), D, 1.0f};
                REP(6) pg8::gemm_phase<pg8::EpiStore, pg8::StaticOrder, true, true>(F.lds, g, S, E);
                SEAM(pb + 7);
            }
            if (IN(pb + 8)) {
                RowArgs R{nullptr, nullptr, HB, HB, 1, (const bf16*)(ws + WS_FOUT), args.in[4], args.in[1] + D, A1, 1, args.in[5] + (size_t)D * DIN + 1536, DIN};
                row_phase(F, args, R);
                SEAM(pb + 8);
            }
        } else {
#if PROBE_TG >= 10
#ifdef PROBE_TMIN
            if (lo <= pb + 6 && pb + 6 < hi && threadIdx.x == 0) atomicMax((unsigned*)(args.ws + WS_CTL) + 8, 0xffffffffu - (unsigned)t_acc);
#else
            if (lo <= pb + 6 && pb + 6 < hi && threadIdx.x == 0) atomicMax((unsigned*)(args.ws + WS_CTL) + 8, (unsigned)t_acc);
#endif
#endif
            if (IN(pb + 6)) { REP(11) { moe_tables(F, args); moe_gather(F, args); } SEAM(pb + 6); }
            for (int k = 0; k < MOE_NCH; ++k) {
                if (IN(pb + 7 + 2 * k)) {
                    moe_tables(F, args);
                    const int nT = *(LAS int*)(F.lds + CTL_CNT + 32 * 4); int nk = nT - MOE_CH * k; nk = nk < 0 ? 0 : ((k < MOE_NCH - 1 && nk > MOE_CH) ? MOE_CH : nk);
                    pg8::Gemm g{(const bf16*)(ws + WS_XS), (const bf16*)(ws + WS_MWGU), 0, 0, D / 2};
                    pg8::MoeOrder<false, true> S{MOE_CH * k, nk, 28, F.G, bid, (const LAS int*)(F.lds + CTL_TE)};
                    pg8::EpiSwiglu8 E{ws + WS_HM, DFFE, 1.0f / (FP8_SX * FP8_SW), FP8_SH};
                    REP(7) pg8::gemm_phase<pg8::EpiSwiglu8, pg8::MoeOrder<false, true>, true, true, true>(F.lds, g, S, E);
                    SEAM(pb + 7 + 2 * k);
                }
                if (IN(pb + 8 + 2 * k)) {
                    moe_tables(F, args);
                    const int nT = *(LAS int*)(F.lds + CTL_CNT + 32 * 4); int nk = nT - MOE_CH * k; nk = nk < 0 ? 0 : ((k < MOE_NCH - 1 && nk > MOE_CH) ? MOE_CH : nk);
                    pg8::Gemm g{(const bf16*)(ws + WS_HM), (const bf16*)(ws + WS_MWD), 0, 0, DFFE / 2};
                    pg8::MoeOrder<true, false> S{MOE_CH * k, nk, 4, F.G, bid, (const LAS int*)(F.lds + CTL_TE)};
                    pg8::EpiStore E{(bf16*)(ws + WS_YM), D, 1.0f / (FP8_SH * FP8_SW)};
                    REP(7) pg8::gemm_phase<pg8::EpiStore, pg8::MoeOrder<true, false>, true, true, true>(F.lds, g, S, E);
                    SEAM(pb + 8 + 2 * k);
                }
            }
            if (IN(pb + 7 + 2 * MOE_NCH)) {
                RowArgs R{nullptr, args.out, HB, nullptr, 2, (const bf16*)(ws + WS_YM), args.in[4] + D, nullptr, nullptr, 0, nullptr, 0};
                row_phase(F, args, R);
#if PROBE_FP8TEST
                if (__hip_atomic_load((unsigned*)(args.ws + WS_CTL) + 2, RLX_AGENT) != 0u) { __syncthreads(); for (size_t i = (size_t)blockIdx.x * NTHR + F.tid; i < (size_t)M * D; i += (size_t)F.G * NTHR) args.out[i] += 1.0f; }
#endif
            }
        }
    }
#if PROBE_TG >= 0
    T_STOP(1 + 16 + 7 + 2 * MOE_NCH);
#if PROBE_TG >= 10
#endif
    if (blockIdx.x == 77) { unsigned long long t_spin = t_acc;
#if PROBE_TG >= 30
        t_spin = F.tr_acc;
#endif
#if PROBE_TG >= 10 && PROBE_TG < 20
        t_spin = __hip_atomic_load((unsigned*)(args.ws + WS_CTL) + 8, RLX_AGENT);
#ifdef PROBE_TMIN
        t_spin = 0xffffffffu - (unsigned)t_spin;
#endif
#endif
        const unsigned long long t_end = __builtin_amdgcn_s_memrealtime(); while (__builtin_amdgcn_s_memrealtime() - t_end < t_spin) __builtin_amdgcn_s_sleep(8); }
#endif
#undef IN
#undef SEAM
#undef args
}

extern "C" void kernel_launch(void* const* d_in, const int* in_sizes, int n_in, void* d_out, int out_size, void* d_ws, size_t ws_size, hipStream_t stream) {
    static int grid = 0;
    if (grid == 0) {
        if (n_in != NIN || out_size != M * D || ws_size < WS_END) { fprintf(stderr, "kernel_launch: unexpected shapes (n_in %d, out %d, ws %zu)\n", n_in, out_size, ws_size); grid = -1; return; }
        int dev = 0, cus = 0;
        if (hipGetDevice(&dev) != hipSuccess || hipDeviceGetAttribute(&cus, hipDeviceAttributeMultiprocessorCount, dev) != hipSuccess) { grid = -1; return; }
        if (hipFuncSetAttribute((const void*)fwd_kernel, hipFuncAttributeMaxDynamicSharedMemorySize, LDS_BYTES) != hipSuccess) { fprintf(stderr, "kernel_launch: hipFuncSetAttribute failed\n"); grid = -1; return; }
        int per_cu = 0;
        if (hipOccupancyMaxActiveBlocksPerMultiprocessor(&per_cu, (const void*)fwd_kernel, NTHR, LDS_BYTES) != hipSuccess || per_cu < 1) fprintf(stderr, "kernel_launch: occupancy query says %d\n", per_cu);
        (void)hipGetLastError();
        grid = cus > 256 ? 256 : cus;
    }
    if (grid < 0) return;
    (void)hipMemsetAsync((char*)d_ws + WS_CTL, 0, CTL_ZERO_BYTES, stream);
    Args a{};
    for (int i = 0; i < NIN; ++i) a.in[i] = (const float*)d_in[i];
    a.out = (float*)d_out; a.ws = (unsigned char*)d_ws;
#if MK_SINGLE
    a.ph_lo = 0; a.ph_hi = NPHASE;
    hipLaunchKernelGGL(fwd_kernel, dim3(grid), dim3(NTHR), LDS_BYTES, stream, a);
#else
    for (int ph = 0; ph < NPHASE; ++ph) { if (ph >= 10 && ph < 17) continue; a.ph_lo = ph; a.ph_hi = ph + 1; hipLaunchKernelGGL(fwd_kernel, dim3(grid), dim3(NTHR), LDS_BYTES, stream, a); }
#endif
}
```

```cpp
#include <hip/hip_runtime.h>
#include <cstdio>
#include <cstdint>

#ifndef MK_SINGLE
#define MK_SINGLE 1
#endif

namespace pg8 {
#define PG8_LAS __attribute__((address_space(3)))
typedef unsigned short bf16_t;
typedef short bf16x8 __attribute__((ext_vector_type(8)));
typedef float f32x4 __attribute__((ext_vector_type(4)));
typedef unsigned u32x4 __attribute__((ext_vector_type(4)));
constexpr int BM = 256, BK = 64, HALF = 128, HTB = HALF * BK * 2  , STAGE_BYTES = 8 * HTB, NXCD = 8, WGM = 8;

__host__ __device__ __forceinline__ int lds_byte(int r, int c) { const int st = (r >> 4) * 2 + (c >> 5), rr = r & 15, cc = c & 31, ob = rr * 64 + cc * 2; return st * 1024 + (ob ^ (((ob >> 9) & 1) << 5)); }
__host__ __device__ __forceinline__ void stage_rc(int b, int& R, int& C) { const int st = b / 1024, sb = b % 1024, swz = sb ^ (((sb >> 9) & 1) << 5); R = (st >> 1) * 16 + swz / 64; C = (st & 1) * 32 + (swz % 64) / 2; }
__host__ __device__ __forceinline__ int perm32(int rho) { const int n = rho >> 4, i = rho & 15; return 8 * (i >> 2) + 4 * n + (i & 3); }

struct Unit { int pm, pn, om, on; };
struct Gemm { const bf16_t* A; const bf16_t* Bt; int M, N, K; };

__host__ __device__ __forceinline__ bool tile_order(int i, int G, int c, int nM, int nN, int& pm, int& pn) {
    const int nwg = nM * nN; const long L = (long)i * G + c; if (L >= nwg) return false;
    int wgid = (int)L; { const int q = nwg / NXCD, r = nwg % NXCD, xcd = wgid % NXCD, off = wgid / NXCD; wgid = (xcd < r ? xcd * (q + 1) : r * (q + 1) + (xcd - r) * q) + off; }
    const int nig = WGM * nN, gid = wgid / nig, fm = gid * WGM, gsz = (nM - fm) < WGM ? (nM - fm) : WGM;
    const int rem = wgid % nig; if (gsz == WGM) { pm = fm + (rem & (WGM - 1)); pn = rem / WGM; } else { pm = fm + rem % gsz; pn = rem / gsz; }
    return true;
}
__host__ __device__ __forceinline__ void tile_from_L(int L, int nM, int nN, int& pm, int& pn) {
    const int nwg = nM * nN; int wgid = L; { const int q = nwg / NXCD, r = nwg % NXCD, xcd = wgid % NXCD, off = wgid / NXCD; wgid = (xcd < r ? xcd * (q + 1) : r * (q + 1) + (xcd - r) * q) + off; }
    const int nig = WGM * nN, gid = wgid / nig, fm = gid * WGM, gsz = (nM - fm) < WGM ? (nM - fm) : WGM;
    const int rem = wgid % nig; if (gsz == WGM) { pm = fm + (rem & (WGM - 1)); pn = rem / WGM; } else { pm = fm + rem % gsz; pn = rem / gsz; }
}
struct StaticOrder {
    int nM, nN, G, c;
    __host__ __device__ void init(int M, int N, int G_, int c_) { nM = M / BM; nN = N / BM; G = G_; c = c_; }
    __host__ __device__ bool next(int i, Unit& u) const { int pm, pn; if (!tile_order(i, G, c, nM, nN, pm, pn)) return false; u.pm = pm; u.pn = pn; u.om = pm; u.on = pn; return true; }
    __device__ __forceinline__ void a_ready(const Unit&) const {}
    __device__ __forceinline__ void done(const Unit&) const {}
};
template <bool A_LOCAL, bool O_LOCAL>
struct MoeOrder {
    int t0, nT, nN, G, c; const PG8_LAS int* te;
    __device__ __forceinline__ bool next(int i, Unit& u) const { int pm, pn; if (!tile_order(i, G, c, nT, nN, pm, pn)) return false;
        const int e = __builtin_amdgcn_readfirstlane(te[t0 + pm]);
        u.pm = A_LOCAL ? pm : t0 + pm; u.pn = e * nN + pn; u.om = O_LOCAL ? pm : t0 + pm; u.on = pn; return true; }
    __device__ __forceinline__ void a_ready(const Unit&) const {}
    __device__ __forceinline__ void done(const Unit&) const {}
};

struct MoeOrderSkip {
    int t0, nT, nN, G, c; const PG8_LAS int* te; int nd, SK;
    __device__ __forceinline__ bool next(int i, Unit& u) const {
        const int nwg = nT * nN; long L;
        if (c < nd) { L = (long)(i + SK) * G + c; if (L >= nwg) return false; }
        else { L = (long)i * G + c;
            if (L >= nwg) { if (nd == 0) return false;
                const int regular = (nwg - c + G - 1) / G, x = i - regular; const long idx = (long)x * (G - nd) + (c - nd);
                if (x < 0 || idx >= (long)SK * nd) return false;
                L = (idx / nd) * G + (idx % nd); if (L >= nwg) return false; } }
        int pm, pn; tile_from_L((int)L, nT, nN, pm, pn);
        const int e = __builtin_amdgcn_readfirstlane(te[t0 + pm]);
        u.pm = t0 + pm; u.pn = e * nN + pn; u.om = pm; u.on = pn; return true; }
    __device__ __forceinline__ void a_ready(const Unit&) const {}
    __device__ __forceinline__ void done(const Unit&) const {}
};

typedef float f32x2_cv __attribute__((ext_vector_type(2))); typedef __bf16 bf16x2_cv __attribute__((ext_vector_type(2)));
__device__ __forceinline__ unsigned cvt_pk_bf16(float lo, float hi) { const f32x2_cv v = {lo, hi}; const bf16x2_cv b = __builtin_convertvector(v, bf16x2_cv); return __builtin_bit_cast(unsigned, b); }

typedef int v8i32 __attribute__((ext_vector_type(8)));
__device__ __forceinline__ v8i32 cat16(bf16x8 lo, bf16x8 hi) { const u32x4 a = __builtin_bit_cast(u32x4, lo), b = __builtin_bit_cast(u32x4, hi); return (v8i32){(int)a.x, (int)a.y, (int)a.z, (int)a.w, (int)b.x, (int)b.y, (int)b.z, (int)b.w}; }
__device__ __forceinline__ float clamp448(float x) { return __builtin_fminf(__builtin_fmaxf(x, -448.0f), 448.0f); }
__device__ __forceinline__ unsigned pack_fp8x4(float a, float b, float c, float d) {
    int r = 0; r = __builtin_amdgcn_cvt_pk_fp8_f32(clamp448(a), clamp448(b), r, false); r = __builtin_amdgcn_cvt_pk_fp8_f32(clamp448(c), clamp448(d), r, true); return (unsigned)r; }
struct EpiStore {
    static constexpr bool PERM = true, AFTER_DRAIN = false;
    bf16_t* O; int ldc; float scale;
    __device__ __forceinline__ void operator()(const f32x4 (&acc)[2][2][4][2], const Unit& u, int wr, int wc, int fr, int fq) const {
        const int row0 = u.om * BM + wr * 64 + fr; const int col0 = u.on * BM + wc * 32 + 8 * fq;
#pragma unroll
        for (int ai = 0; ai < 2; ++ai)
#pragma unroll
            for (int m = 0; m < 4; ++m) { bf16_t* rowp = O + (size_t)(row0 + ai * HALF + m * 16) * ldc + col0;
#pragma unroll
                for (int bj = 0; bj < 2; ++bj) { const f32x4 v0 = acc[ai][bj][m][0] * scale, v1 = acc[ai][bj][m][1] * scale;
                    u32x4 w; w.x = cvt_pk_bf16(v0[0], v0[1]); w.y = cvt_pk_bf16(v0[2], v0[3]); w.z = cvt_pk_bf16(v1[0], v1[1]); w.w = cvt_pk_bf16(v1[2], v1[3]);
                    *(u32x4*)(rowp + bj * HALF) = w; } }
    }
};
struct EpiStore8 {
    static constexpr bool PERM = true, AFTER_DRAIN = false;
    unsigned char* O; int ldc; float scale;
    __device__ __forceinline__ void operator()(const f32x4 (&acc)[2][2][4][2], const Unit& u, int wr, int wc, int fr, int fq) const {
        const int row0 = u.om * BM + wr * 64 + fr; const int col0 = u.on * BM + wc * 32 + 8 * fq;
        typedef unsigned u32x2 __attribute__((ext_vector_type(2)));
#pragma unroll
        for (int ai = 0; ai < 2; ++ai)
#pragma unroll
            for (int m = 0; m < 4; ++m) { unsigned char* rowp = O + (size_t)(row0 + ai * HALF + m * 16) * ldc + col0;
#pragma unroll
                for (int bj = 0; bj < 2; ++bj) { const f32x4 v0 = acc[ai][bj][m][0] * scale, v1 = acc[ai][bj][m][1] * scale;
                    u32x2 w; w.x = pack_fp8x4(v0[0], v0[1], v0[2], v0[3]); w.y = pack_fp8x4(v1[0], v1[1], v1[2], v1[3]);
                    *(u32x2*)(rowp + bj * HALF) = w; } }
    }
};
struct EpiStoreRS {
    static constexpr bool PERM = true, AFTER_DRAIN = false;
    bf16_t* O; int ldc; const float* rs;
    __device__ __forceinline__ void operator()(const f32x4 (&acc)[2][2][4][2], const Unit& u, int wr, int wc, int fr, int fq) const {
        const int row0 = u.om * BM + wr * 64 + fr; const int col0 = u.on * BM + wc * 32 + 8 * fq;
        float sc[2][4];
#pragma unroll
        for (int ai = 0; ai < 2; ++ai)
#pragma unroll
            for (int m = 0; m < 4; ++m) sc[ai][m] = rs[row0 + ai * HALF + m * 16];
#pragma unroll
        for (int ai = 0; ai < 2; ++ai)
#pragma unroll
            for (int m = 0; m < 4; ++m) { bf16_t* rowp = O + (size_t)(row0 + ai * HALF + m * 16) * ldc + col0;
#pragma unroll
                for (int bj = 0; bj < 2; ++bj) { const f32x4 v0 = acc[ai][bj][m][0] * sc[ai][m], v1 = acc[ai][bj][m][1] * sc[ai][m];
                    u32x4 w; w.x = cvt_pk_bf16(v0[0], v0[1]); w.y = cvt_pk_bf16(v0[2], v0[3]); w.z = cvt_pk_bf16(v1[0], v1[1]); w.w = cvt_pk_bf16(v1[2], v1[3]);
                    *(u32x4*)(rowp + bj * HALF) = w; } }
    }
};
__device__ __forceinline__ float silu_f(float x) { return x * __builtin_amdgcn_rcpf(1.0f + __expf(-x)); }
struct EpiSwiglu {
    static constexpr bool PERM = true, AFTER_DRAIN = false;
    bf16_t* O; int ldc;
    __device__ __forceinline__ void operator()(const f32x4 (&acc)[2][2][4][2], const Unit& u, int wr, int wc, int fr, int fq) const {
        const int row0 = u.om * BM + wr * 64 + fr; const int col0 = u.on * HALF + wc * 32 + 8 * fq;
#pragma unroll
        for (int ai = 0; ai < 2; ++ai)
#pragma unroll
            for (int m = 0; m < 4; ++m) { bf16_t* rowp = O + (size_t)(row0 + ai * HALF + m * 16) * ldc + col0;
                const f32x4 g0 = acc[ai][0][m][0], g1 = acc[ai][0][m][1], u0 = acc[ai][1][m][0], u1 = acc[ai][1][m][1];
                u32x4 w;
                w.x = cvt_pk_bf16(silu_f(g0[0]) * u0[0], silu_f(g0[1]) * u0[1]); w.y = cvt_pk_bf16(silu_f(g0[2]) * u0[2], silu_f(g0[3]) * u0[3]);
                w.z = cvt_pk_bf16(silu_f(g1[0]) * u1[0], silu_f(g1[1]) * u1[1]); w.w = cvt_pk_bf16(silu_f(g1[2]) * u1[2], silu_f(g1[3]) * u1[3]);
                *(u32x4*)rowp = w; }
    }
};

struct EpiSwigluRS {
    static constexpr bool PERM = true, AFTER_DRAIN = false;
    bf16_t* O; int ldc; const float* rs;
    __device__ __forceinline__ void operator()(const f32x4 (&acc)[2][2][4][2], const Unit& u, int wr, int wc, int fr, int fq) const {
        const int row0 = u.om * BM + wr * 64 + fr; const int col0 = u.on * HALF + wc * 32 + 8 * fq;
        float sc[2][4];
#pragma unroll
        for (int ai = 0; ai < 2; ++ai)
#pragma unroll
            for (int m = 0; m < 4; ++m) sc[ai][m] = rs[row0 + ai * HALF + m * 16];
#pragma unroll
        for (int ai = 0; ai < 2; ++ai)
#pragma unroll
            for (int m = 0; m < 4; ++m) { bf16_t* rowp = O + (size_t)(row0 + ai * HALF + m * 16) * ldc + col0;
                const f32x4 g0 = acc[ai][0][m][0] * sc[ai][m], g1 = acc[ai][0][m][1] * sc[ai][m], u0 = acc[ai][1][m][0] * sc[ai][m], u1 = acc[ai][1][m][1] * sc[ai][m];
                u32x4 w;
                w.x = cvt_pk_bf16(silu_f(g0[0]) * u0[0], silu_f(g0[1]) * u0[1]); w.y = cvt_pk_bf16(silu_f(g0[2]) * u0[2], silu_f(g0[3]) * u0[3]);
                w.z = cvt_pk_bf16(silu_f(g1[0]) * u1[0], silu_f(g1[1]) * u1[1]); w.w = cvt_pk_bf16(silu_f(g1[2]) * u1[2], silu_f(g1[3]) * u1[3]);
                *(u32x4*)rowp = w; }
    }
};

struct EpiSwigluF {
    static constexpr bool PERM = true, AFTER_DRAIN = false;
    bf16_t* O; int ldc; float in_scale;
    __device__ __forceinline__ void operator()(const f32x4 (&acc)[2][2][4][2], const Unit& u, int wr, int wc, int fr, int fq) const {
        const int row0 = u.om * BM + wr * 64 + fr; const int col0 = u.on * HALF + wc * 32 + 8 * fq;
#pragma unroll
        for (int ai = 0; ai < 2; ++ai)
#pragma unroll
            for (int m = 0; m < 4; ++m) { bf16_t* rowp = O + (size_t)(row0 + ai * HALF + m * 16) * ldc + col0;
                const f32x4 g0 = acc[ai][0][m][0] * in_scale, g1 = acc[ai][0][m][1] * in_scale, u0 = acc[ai][1][m][0] * in_scale, u1 = acc[ai][1][m][1] * in_scale;
                u32x4 w;
                w.x = cvt_pk_bf16(silu_f(g0[0]) * u0[0], silu_f(g0[1]) * u0[1]); w.y = cvt_pk_bf16(silu_f(g0[2]) * u0[2], silu_f(g0[3]) * u0[3]);
                w.z = cvt_pk_bf16(silu_f(g1[0]) * u1[0], silu_f(g1[1]) * u1[1]); w.w = cvt_pk_bf16(silu_f(g1[2]) * u1[2], silu_f(g1[3]) * u1[3]);
                *(u32x4*)rowp = w; }
    }
};

struct EpiSwigluRS8 {
    static constexpr bool PERM = true, AFTER_DRAIN = false;
    unsigned char* O; int ldc; const float* rs; float out_scale;
    __device__ __forceinline__ void operator()(const f32x4 (&acc)[2][2][4][2], const Unit& u, int wr, int wc, int fr, int fq) const {
        const int row0 = u.om * BM + wr * 64 + fr; const int col0 = u.on * HALF + wc * 32 + 8 * fq;
        float sc[2][4];
#pragma unroll
        for (int ai = 0; ai < 2; ++ai)
#pragma unroll
            for (int m = 0; m < 4; ++m) sc[ai][m] = rs[row0 + ai * HALF + m * 16];
#pragma unroll
        for (int ai = 0; ai < 2; ++ai)
#pragma unroll
            for (int m = 0; m < 4; ++m) { unsigned char* rowp = O + (size_t)(row0 + ai * HALF + m * 16) * ldc + col0;
                const f32x4 g0 = acc[ai][0][m][0] * sc[ai][m], g1 = acc[ai][0][m][1] * sc[ai][m], u0 = acc[ai][1][m][0] * (sc[ai][m] * out_scale), u1 = acc[ai][1][m][1] * (sc[ai][m] * out_scale);
                typedef unsigned u32x2 __attribute__((ext_vector_type(2)));
                u32x2 w;
                w.x = pack_fp8x4(silu_f(g0[0]) * u0[0], silu_f(g0[1]) * u0[1], silu_f(g0[2]) * u0[2], silu_f(g0[3]) * u0[3]);
                w.y = pack_fp8x4(silu_f(g1[0]) * u1[0], silu_f(g1[1]) * u1[1], silu_f(g1[2]) * u1[2], silu_f(g1[3]) * u1[3]);
                *(u32x2*)rowp = w; }
    }
};

struct EpiSwiglu8 {
    static constexpr bool PERM = true, AFTER_DRAIN = false;
    unsigned char* O; int ldc; float in_scale, out_scale;
    __device__ __forceinline__ void operator()(const f32x4 (&acc)[2][2][4][2], const Unit& u, int wr, int wc, int fr, int fq) const {
        const int row0 = u.om * BM + wr * 64 + fr; const int col0 = u.on * HALF + wc * 32 + 8 * fq;
#pragma unroll
        for (int ai = 0; ai < 2; ++ai)
#pragma unroll
            for (int m = 0; m < 4; ++m) { unsigned char* rowp = O + (size_t)(row0 + ai * HALF + m * 16) * ldc + col0;
                const f32x4 g0 = acc[ai][0][m][0] * in_scale, g1 = acc[ai][0][m][1] * in_scale, u0 = acc[ai][1][m][0] * (in_scale * out_scale), u1 = acc[ai][1][m][1] * (in_scale * out_scale);
                typedef unsigned u32x2 __attribute__((ext_vector_type(2)));
                u32x2 w;
                w.x = pack_fp8x4(silu_f(g0[0]) * u0[0], silu_f(g0[1]) * u0[1], silu_f(g0[2]) * u0[2], silu_f(g0[3]) * u0[3]);
                w.y = pack_fp8x4(silu_f(g1[0]) * u1[0], silu_f(g1[1]) * u1[1], silu_f(g1[2]) * u1[2], silu_f(g1[3]) * u1[3]);
                *(u32x2*)rowp = w; }
    }
};

template <class Epi, class Sched, bool ALIGN_EPI = false, bool SP2 = false, bool FP8 = false>
__device__ __forceinline__ void gemm_phase(PG8_LAS unsigned char* lds, const Gemm g, const Sched& S, const Epi& E) {
    int tid_ = threadIdx.x; asm volatile("" : "+v"(tid_));
    const int tid = tid_, wid = __builtin_amdgcn_readfirstlane(tid >> 6), lane = tid & 63, wr = wid >> 2, wc = wid & 3, fr = lane & 15, fq = lane >> 4;
    int K_ = g.K; asm volatile("" : "+s"(K_));
    const int K = K_, nt = K / BK;
    unsigned voffA[2], voffB[2];
#pragma unroll
    for (int i = 0; i < 2; ++i) { int R, C; stage_rc(tid * 16 + i * 8192, R, C); const int Rb = Epi::PERM ? ((R & ~31) + perm32(R & 31)) : R;
        voffA[i] = (unsigned)(R * K + C) * 2u; voffB[i] = (unsigned)(Rb * K + C) * 2u; }
    const size_t kstep = (size_t)(BK * 2);
    const size_t hstep = (size_t)HALF * K * 2;
    const size_t tstep = 2 * hstep;
    const unsigned ldsw = (unsigned)wid * 1024u;
    const int aoff = lds_byte(wr * 64 + fr, fq * 8), boff = lds_byte(wc * 32 + fr, fq * 8);
#define PG8_SA(b, h) (((b) * 2 + (h)) * HTB)
#define PG8_SB(b, h) ((4 + (b) * 2 + (h)) * HTB)
#define PG8_STAGE(bufoff, gbase, voff) do { _Pragma("unroll") for (int _i = 0; _i < 2; ++_i) \
        __builtin_amdgcn_global_load_lds((const unsigned*)((const char*)(gbase) + (voff)[_i]), (PG8_LAS unsigned*)(lds + (bufoff) + ldsw + _i * 8192), 16, 0, 0); } while (0)
#define PG8_LDA(dst, dst8, b, h) do { _Pragma("unroll") for (int m = 0; m < 4; ++m) { \
        if constexpr (FP8) dst8[m] = cat16(*(const PG8_LAS bf16x8*)(lds + PG8_SA(b, h) + aoff + m * 2048), *(const PG8_LAS bf16x8*)(lds + PG8_SA(b, h) + aoff + m * 2048 + 1024)); \
        else { _Pragma("unroll") for (int k = 0; k < 2; ++k) dst[m][k] = *(const PG8_LAS bf16x8*)(lds + PG8_SA(b, h) + aoff + m * 2048 + k * 1024); } } } while (0)
#define PG8_LDB(dst, dst8, b, h) do { _Pragma("unroll") for (int n = 0; n < 2; ++n) { \
        if constexpr (FP8) dst8[n] = cat16(*(const PG8_LAS bf16x8*)(lds + PG8_SB(b, h) + boff + n * 2048), *(const PG8_LAS bf16x8*)(lds + PG8_SB(b, h) + boff + n * 2048 + 1024)); \
        else { _Pragma("unroll") for (int k = 0; k < 2; ++k) dst[n][k] = *(const PG8_LAS bf16x8*)(lds + PG8_SB(b, h) + boff + n * 2048 + k * 1024); } } } while (0)
#define PG8_MMA(ai, bj, At, At8, Bt, Bt8) do { __builtin_amdgcn_s_setprio(1); _Pragma("unroll") for (int m = 0; m < 4; ++m) _Pragma("unroll") for (int n = 0; n < 2; ++n) { \
        if constexpr (FP8) { asm volatile("v_mfma_f32_16x16x128_f8f6f4 %0, %1, %2, %0" : "+v"(acc[ai][bj][m][n]) : "v"(Bt8[n]), "v"(At8[m])); } \
        else { _Pragma("unroll") for (int k = 0; k < 2; ++k) acc[ai][bj][m][n] = __builtin_amdgcn_mfma_f32_16x16x32_bf16(Bt[n][k], At[m][k], acc[ai][bj][m][n], 0, 0, 0); } } __builtin_amdgcn_s_setprio(0); } while (0)
#define PG8_WAIT_V(n) asm volatile("s_waitcnt vmcnt(" #n ")" ::: "memory")
#define PG8_WAIT_L(n) asm volatile("s_waitcnt lgkmcnt(" #n ")" ::: "memory")
#define PG8_BAR __builtin_amdgcn_s_barrier()
#define PG8_SCHED __builtin_amdgcn_sched_barrier(0)
    Unit cur, nxt; int ui = 0;
    if (!S.next(0, cur)) return;
    f32x4 acc[2][2][4][2];
#pragma unroll
    for (int a = 0; a < 2; ++a)
#pragma unroll
        for (int b = 0; b < 2; ++b)
#pragma unroll
            for (int m = 0; m < 4; ++m)
#pragma unroll
                for (int n = 0; n < 2; ++n) acc[a][b][m][n] = (f32x4){0.f, 0.f, 0.f, 0.f};
    bf16x8 At[4][2], B0[2][2], B1[2][2]; v8i32 At8[4], B08[2], B18[2];
    const char* cA = (const char*)g.A + (size_t)cur.pm * tstep; const char* cB = (const char*)g.Bt + (size_t)cur.pn * tstep;
    S.a_ready(cur);
    if constexpr (SP2) {
        PG8_STAGE(PG8_SB(0, 0), cB, voffB); PG8_STAGE(PG8_SB(0, 1), cB + hstep, voffB); PG8_STAGE(PG8_SA(0, 0), cA, voffA); PG8_STAGE(PG8_SA(0, 1), cA + hstep, voffA);
        if (wr == 1) PG8_BAR;
        PG8_WAIT_V(2); PG8_BAR;
        PG8_STAGE(PG8_SB(1, 0), cB + kstep, voffB); PG8_STAGE(PG8_SA(1, 0), cA + kstep, voffA); PG8_STAGE(PG8_SB(1, 1), cB + hstep + kstep, voffB);
        PG8_WAIT_V(6); PG8_BAR;
    } else {
        PG8_STAGE(PG8_SB(0, 0), cB, voffB); PG8_STAGE(PG8_SA(0, 0), cA, voffA); PG8_STAGE(PG8_SB(0, 1), cB + hstep, voffB); PG8_STAGE(PG8_SA(0, 1), cA + hstep, voffA);
        if (wr == 1) PG8_BAR;
        PG8_WAIT_V(4); PG8_BAR;
        PG8_STAGE(PG8_SB(1, 0), cB + kstep, voffB); PG8_STAGE(PG8_SA(1, 0), cA + kstep, voffA); PG8_STAGE(PG8_SB(1, 1), cB + hstep + kstep, voffB);
        PG8_WAIT_V(6); PG8_BAR;
    }
    for (;;) {
        const bool has_next = S.next(ui + 1, nxt);
        const char* nA = has_next ? (const char*)g.A + (size_t)nxt.pm * tstep : cA; const char* nB = has_next ? (const char*)g.Bt + (size_t)nxt.pn * tstep : cB;
#pragma unroll 1
        for (int t = 0; t < nt; t += 2) {
            const bool last = (t == nt - 2);
            const char* a1 = cA + (size_t)(t + 1) * kstep;
            const char* a2 = last ? nA : cA + (size_t)(t + 2) * kstep; const char* b2 = last ? nB : cB + (size_t)(t + 2) * kstep;
            const char* a3 = a2 + kstep; const char* b3 = b2 + kstep;
            if (last && has_next) S.a_ready(nxt);
            if constexpr (SP2) {
            PG8_LDB(B0, B08, 0, 0); PG8_LDB(B1, B18, 0, 1); PG8_SCHED; PG8_LDA(At, At8, 0, 0); PG8_STAGE(PG8_SA(1, 1), a1 + hstep, voffA);
            PG8_WAIT_V(8); PG8_WAIT_L(0); PG8_BAR; PG8_MMA(0, 0, At, At8, B0, B08); PG8_MMA(0, 1, At, At8, B1, B18); PG8_BAR; PG8_SCHED;
            PG8_LDA(At, At8, 0, 1); PG8_STAGE(PG8_SB(0, 0), b2, voffB); PG8_STAGE(PG8_SB(0, 1), b2 + hstep, voffB); PG8_STAGE(PG8_SA(0, 0), a2, voffA);
            PG8_WAIT_V(8); PG8_WAIT_L(0); PG8_BAR; PG8_MMA(1, 0, At, At8, B0, B08); PG8_MMA(1, 1, At, At8, B1, B18); PG8_BAR; PG8_SCHED;
            PG8_LDB(B0, B08, 1, 0); PG8_LDB(B1, B18, 1, 1); PG8_SCHED; PG8_LDA(At, At8, 1, 0); PG8_STAGE(PG8_SA(0, 1), a2 + hstep, voffA);
            PG8_WAIT_V(8); PG8_WAIT_L(0); PG8_BAR; PG8_MMA(0, 0, At, At8, B0, B08); PG8_MMA(0, 1, At, At8, B1, B18); PG8_BAR; PG8_SCHED;
            PG8_LDA(At, At8, 1, 1); PG8_STAGE(PG8_SB(1, 0), b3, voffB); PG8_STAGE(PG8_SB(1, 1), b3 + hstep, voffB); PG8_STAGE(PG8_SA(1, 0), a3, voffA);
            PG8_WAIT_V(8); PG8_WAIT_L(0); PG8_BAR; PG8_MMA(1, 0, At, At8, B0, B08); PG8_MMA(1, 1, At, At8, B1, B18); PG8_BAR; PG8_SCHED;
            } else {
            PG8_LDB(B0, B08, 0, 0); PG8_SCHED; PG8_LDA(At, At8, 0, 0); PG8_STAGE(PG8_SA(1, 1), a1 + hstep, voffA);
            PG8_WAIT_L(8); PG8_BAR; PG8_WAIT_L(0); PG8_MMA(0, 0, At, At8, B0, B08); PG8_BAR; PG8_SCHED;
            PG8_LDB(B1, B18, 0, 1); PG8_STAGE(PG8_SB(0, 0), b2, voffB);
            PG8_BAR; PG8_WAIT_L(0); PG8_MMA(0, 1, At, At8, B1, B18); PG8_BAR;
            PG8_LDA(At, At8, 0, 1); PG8_STAGE(PG8_SA(0, 0), a2, voffA);
            PG8_BAR; PG8_WAIT_L(0); PG8_MMA(1, 0, At, At8, B0, B08); PG8_BAR; PG8_SCHED;
            PG8_STAGE(PG8_SB(0, 1), b2 + hstep, voffB);
            PG8_WAIT_V(6); PG8_BAR; PG8_MMA(1, 1, At, At8, B1, B18); PG8_BAR;
            PG8_LDB(B0, B08, 1, 0); PG8_SCHED; PG8_LDA(At, At8, 1, 0); PG8_STAGE(PG8_SA(0, 1), a2 + hstep, voffA);
            PG8_WAIT_L(8); PG8_BAR; PG8_WAIT_L(0); PG8_MMA(0, 0, At, At8, B0, B08); PG8_BAR; PG8_SCHED;
            PG8_LDB(B1, B18, 1, 1); PG8_STAGE(PG8_SB(1, 0), b3, voffB);
            PG8_BAR; PG8_WAIT_L(0); PG8_MMA(0, 1, At, At8, B1, B18); PG8_BAR;
            PG8_LDA(At, At8, 1, 1); PG8_STAGE(PG8_SA(1, 0), a3, voffA);
            PG8_BAR; PG8_WAIT_L(0); PG8_MMA(1, 0, At, At8, B0, B08); PG8_BAR; PG8_SCHED;
            PG8_STAGE(PG8_SB(1, 1), b3 + hstep, voffB);
            PG8_WAIT_V(6); PG8_BAR; PG8_MMA(1, 1, At, At8, B1, B18); PG8_BAR;
            }
        }
        if constexpr (FP8) asm volatile("s_nop 15\n\ts_nop 15" ::: "memory");
        if constexpr (ALIGN_EPI) { if (wr == 0) PG8_BAR; }
        if constexpr (!Epi::AFTER_DRAIN) { E(acc, cur, wr, wc, fr, fq); S.done(cur); }
        if (!has_next) break;
#pragma unroll
        for (int a = 0; a < 2; ++a)
#pragma unroll
            for (int b = 0; b < 2; ++b)
#pragma unroll
                for (int m = 0; m < 4; ++m)
#pragma unroll
                    for (int n = 0; n < 2; ++n) acc[a][b][m][n] = (f32x4){0.f, 0.f, 0.f, 0.f};
        cur = nxt; cA = nA; cB = nB; ++ui;
        if constexpr (ALIGN_EPI) { if (wr == 1) PG8_BAR; }
    }
    PG8_WAIT_V(0);
    if constexpr (!ALIGN_EPI) { if (wr == 0) PG8_BAR; }
    PG8_BAR;
    if constexpr (Epi::AFTER_DRAIN) { E.fused(acc, cur, wr, wc, fr, fq, lds, wid, lane); S.done(cur); }
#undef PG8_SA
#undef PG8_SB
#undef PG8_STAGE
#undef PG8_LDA
#undef PG8_LDB
#undef PG8_MMA
#undef PG8_WAIT_V
#undef PG8_WAIT_L
#undef PG8_BAR
#undef PG8_SCHED
}
}

#define GAS __attribute__((address_space(1)))
#define LAS __attribute__((address_space(3)))
typedef unsigned short bf16;
typedef unsigned v4u __attribute__((ext_vector_type(4)));
typedef unsigned v2u __attribute__((ext_vector_type(2)));
typedef float f32x4 __attribute__((ext_vector_type(4)));
typedef float f32x2 __attribute__((ext_vector_type(2)));
typedef short bf16x8 __attribute__((ext_vector_type(8)));
typedef short v4i16 __attribute__((ext_vector_type(4)));
typedef GAS unsigned gu32;
#define RLX_AGENT __ATOMIC_RELAXED, __HIP_MEMORY_SCOPE_AGENT
#define LDS_WAIT() asm volatile("s_waitcnt lgkmcnt(0)" ::: "memory")
#define VM_WAIT() asm volatile("s_waitcnt vmcnt(0)" ::: "memory")
__device__ __forceinline__ unsigned pk2(float lo, float hi) { return pg8::cvt_pk_bf16(lo, hi); }
__device__ __forceinline__ float bflo(unsigned u) { return __uint_as_float(u << 16); }
__device__ __forceinline__ float bfhi(unsigned u) { return __uint_as_float(u & 0xffff0000u); }
template <int CTRL> __device__ __forceinline__ float dpp_mov(float v) { return __int_as_float(__builtin_amdgcn_update_dpp(0, __float_as_int(v), CTRL, 0xf, 0xf, true)); }
__device__ __forceinline__ float xadd16(float v) { const auto r = __builtin_amdgcn_permlane16_swap(__float_as_uint(v), __float_as_uint(v), false, false); return __uint_as_float(r[0]) + __uint_as_float(r[1]); }
__device__ __forceinline__ float xadd32(float v) { const auto r = __builtin_amdgcn_permlane32_swap(__float_as_uint(v), __float_as_uint(v), false, false); return __uint_as_float(r[0]) + __uint_as_float(r[1]); }
__device__ __forceinline__ float xmax16(float v) { const auto r = __builtin_amdgcn_permlane16_swap(__float_as_uint(v), __float_as_uint(v), false, false); return fmaxf(__uint_as_float(r[0]), __uint_as_float(r[1])); }
__device__ __forceinline__ float xmax32(float v) { const auto r = __builtin_amdgcn_permlane32_swap(__float_as_uint(v), __float_as_uint(v), false, false); return fmaxf(__uint_as_float(r[0]), __uint_as_float(r[1])); }
__device__ __forceinline__ float wave_sum(float v) {
    v += dpp_mov<0xB1>(v);
    v += dpp_mov<0x4E>(v);
    v += dpp_mov<0x141>(v);
    v += dpp_mov<0x140>(v);
    v = xadd16(v);
    return xadd32(v);
}
__device__ __forceinline__ f32x4 mfma16(bf16x8 a, bf16x8 b, f32x4 c) { return __builtin_amdgcn_mfma_f32_16x16x32_bf16(a, b, c, 0, 0, 0); }
__device__ __forceinline__ v4i16 trrd(LAS unsigned char* p) { return __builtin_amdgcn_ds_read_tr16_b64_v4i16((LAS v4i16*)p); }
__device__ __forceinline__ bf16x8 cat8(v4i16 lo, v4i16 hi) { return (bf16x8){lo[0], lo[1], lo[2], lo[3], hi[0], hi[1], hi[2], hi[3]}; }
__device__ __forceinline__ bf16x8 pack8(float a0, float a1, float a2, float a3, float a4, float a5, float a6, float a7) {
    v4u w; w.x = pk2(a0, a1); w.y = pk2(a2, a3); w.z = pk2(a4, a5); w.w = pk2(a6, a7); return __builtin_bit_cast(bf16x8, w); }
__device__ __forceinline__ float rsq(float x) { return __builtin_amdgcn_rsqf(x); }
__device__ __forceinline__ float silu(float x) { return x * __builtin_amdgcn_rcpf(1.0f + __expf(-x)); }

#define XB_TMO      128
#define XB_XCNT(j)  (256  + 64 * (j))
#define XB_XSUB(j)  (1280 + 64 * (j))
#define XB_XGEN(j)  (2304 + 64 * (j))
#define XB_TOP      3328
#define XB_TOPGEN   3392
#define XCD_BAR_WORDS 3456
#define XB_SPIN_CAP (1u << 18)

__device__ __forceinline__ unsigned xb_ld(unsigned* p)              { return __hip_atomic_load(p, __ATOMIC_RELAXED, __HIP_MEMORY_SCOPE_AGENT); }
__device__ __forceinline__ unsigned xb_add(unsigned* p, unsigned v) { return __hip_atomic_fetch_add(p, v, __ATOMIC_RELAXED, __HIP_MEMORY_SCOPE_AGENT); }
__device__ __forceinline__ unsigned xb_xcc_id() { return (unsigned)__builtin_amdgcn_s_getreg((3 << 11) | 20) & 0xFu; }
#define XB_SPIN(cond, bar) do { unsigned _sp = 0; while (cond) { __builtin_amdgcn_s_sleep(1); \
    if ((++_sp & 255u) == 0u) { if (xb_ld(&(bar)[XB_TMO])) break; if (_sp > XB_SPIN_CAP) { atomicAdd(&(bar)[XB_TMO], 1u); break; } } } } while (0)

struct XcdBarrier {
    unsigned* bar; unsigned x;
    volatile LAS unsigned* st;
};

__device__ __forceinline__ XcdBarrier xcd_barrier_post(unsigned* bar, volatile LAS unsigned* st) {
    XcdBarrier b; b.bar = bar; b.x = xb_xcc_id(); b.st = st;
    if (threadIdx.x == 0) (void)xb_add(&bar[XB_XCNT(b.x)], 1u);
    return b;
}
__device__ __forceinline__ void xcd_barrier_complete(unsigned* bar, unsigned x, unsigned& nloc, unsigned& nx) {
    const unsigned G = gridDim.x * gridDim.y * gridDim.z;
    unsigned sum, cnt, mine, sp = 0u;
    for (;;) {
        sum = 0u; cnt = 0u; mine = 0u;
#pragma unroll
        for (unsigned j = 0; j < 16; ++j) { const unsigned c = xb_ld(&bar[XB_XCNT(j)]); sum += c; cnt += (c > 0u) ? 1u : 0u; mine = (j == x) ? c : mine; }
        if (sum == G) break;
        __builtin_amdgcn_s_sleep(1);
        if ((++sp & 255u) == 0u) { if (xb_ld(&bar[XB_TMO])) break; if (sp > XB_SPIN_CAP) { atomicAdd(&bar[XB_TMO], 1u); break; } }
    }
    nloc = mine > 0u ? mine : 1u; nx = cnt > 0u ? cnt : 1u;
}

__device__ __forceinline__ void xcd_barrier(const XcdBarrier& b) {
    asm volatile("s_waitcnt vmcnt(0)" ::: "memory");
    __syncthreads();
    if (threadIdx.x == 0) {
        unsigned* bar = b.bar;
        __builtin_amdgcn_s_waitcnt(0);
        unsigned nloc = b.st[0], nx = b.st[1];
        if (nloc == 0u) { xcd_barrier_complete(bar, b.x, nloc, nx); b.st[0] = nloc; b.st[1] = nx; }
        const unsigned old = xb_add(&bar[XB_XSUB(b.x)], 1u);
        const unsigned gen = old / nloc;
        if (old + 1u == (gen + 1u) * nloc) {
            __builtin_amdgcn_fence(__ATOMIC_RELEASE, "agent");
            asm volatile("s_waitcnt vmcnt(0)" ::: "memory");
            const unsigned og = xb_add(&bar[XB_TOP], 1u);
            const unsigned tg = og / nx;
            if (og + 1u == (tg + 1u) * nx) xb_add(&bar[XB_TOPGEN], 1u);
            else XB_SPIN(xb_ld(&bar[XB_TOPGEN]) == tg, bar);
            __builtin_amdgcn_fence(__ATOMIC_ACQUIRE, "agent");
            xb_add(&bar[XB_XGEN(b.x)], 1u);
            asm volatile("s_waitcnt vmcnt(0)" ::: "memory");
        } else {
            XB_SPIN(xb_ld(&bar[XB_XGEN(b.x)]) == gen, bar);
            __builtin_amdgcn_fence(__ATOMIC_ACQUIRE, "agent");
            asm volatile("s_waitcnt vmcnt(0)" ::: "memory");
        }
    }
    __syncthreads();
}

constexpr int NWAVES = 8, NTHR = 512;
constexpr int D = 1024, SEQ = 8192, NBATCH = 4, M = NBATCH * SEQ, NCHUNK = SEQ / 64;
constexpr int DIN = 2824, PN = 2816;
constexpr int PC_Z = 0, PC_XBC = 512, PC_U = 1536, PC_V = 1792, PC_Q = 2048, PC_K = 2304, PC_VV = 2560;
constexpr int DFF = 2816, DFFE = 3584, NEXP = 8;
constexpr int MOE_CH = 128, MOE_NCH = 2, MOE_MAXT = 264;
constexpr int NIN = 27;
constexpr int CVT_SMALL_TASKS = 1408 + 512 + 1408 + 704, MOE_GU_TASKS = 14336, MOE_CVT_TASKS = 14336 + 7168, MOE_CVT_EARLY = 4096;
constexpr size_t MiB = 1u << 20;
constexpr size_t WS_CTL = 0, CTL_ZERO_BYTES = 65536;
constexpr size_t WS_AEND = 65536, WS_WGCNT = 98304;
constexpr size_t WS_DTRAW = 1 * MiB, WS_TOKE = 2 * MiB, WS_TOKG = 2 * MiB + 262144, WS_POS = 2 * MiB + 524288;
constexpr size_t WS_WIN = 4 * MiB, WS_WOUT = 15 * MiB, WS_WGU = 19 * MiB, WS_WGUB = 25 * MiB, WS_WD = 30 * MiB;
constexpr int GU_T8 = 22;
constexpr size_t WS_RS = 3 * MiB;
constexpr size_t WS_A1 = 36 * MiB, WS_XBCC = 36 * MiB;
constexpr size_t WS_PROJ = 100 * MiB, WS_MIXED = 100 * MiB, WS_H1 = 100 * MiB;
constexpr size_t WS_ST = 276 * MiB, WS_FOUT = 276 * MiB;
constexpr size_t WS_Y = 340 * MiB;
constexpr size_t WS_HB = 404 * MiB;
constexpr size_t WS_HM = 36 * MiB, WS_XS = 155 * MiB, WS_YM = 221 * MiB, WS_MWD = 353 * MiB, WS_MWGU = 468 * MiB, WS_END = 524 * MiB;
constexpr float FP8_SX = 8.0f, FP8_SW = 64.0f, FP8_SH = 16.0f, FP8_SY = 16.0f;
constexpr int CW_BAR = 4096, CW_TQ = 8192;
constexpr int LDS_BYTES = 163840, LDSCTL_OFF = 147456;
constexpr int CTL_MISC = LDSCTL_OFF, CTL_CNT = LDSCTL_OFF + 128, CTL_TE = LDSCTL_OFF + 512;

#ifndef PROBE_DUP
#define PROBE_DUP 0
#endif
#ifndef PROBE_TG
#define PROBE_TG -1
#endif
__device__ __forceinline__ int tgroup_of(int k) {
    if (k == 0) return 0;
    const int L = (k - 1) >> 4, r = (k - 1) & 15;
    if (r == 0 || r == 4) return 1;
    if (r == 1) return 2;
    if (r == 2) return 3;
    if (r == 3) return 4;
    if (r == 5) return L == 0 ? 5 : 9;
    if (L == 0) return r == 8 ? 5 : 6;
    if (r == 6) return 7;
    if (r == 7 + 2 * 2) return 5;
    return 8;
}
#define REP(n) for (int rep_ = 0; rep_ < (((PROBE_DUP >> (n)) & 1) ? 2 : 1); ++rep_)
struct Args { const float* in[NIN]; float* out; unsigned char* ws; int ph_lo, ph_hi; };

#ifndef PROBE_TG
#define PROBE_TG -1
#endif
typedef const __attribute__((address_space(4))) Args* ArgsP;
typedef const __attribute__((address_space(4))) Args& ArgsRef;
struct Frame {
    LAS unsigned char* lds;
    int tid, lane, wave, vcu, G;
#if PROBE_TG >= 30
    unsigned long long tr_acc, tr_mark;
#endif
};
#if PROBE_TG >= 30
#define TR0(F) ((F).tr_mark = __builtin_amdgcn_s_memrealtime())
#define TR(F, id) do { const unsigned long long n_ = __builtin_amdgcn_s_memrealtime(); if ((id) == PROBE_TG) (F).tr_acc += n_ - (F).tr_mark; (F).tr_mark = n_; } while (0)
#else
#define TR0(F) do { } while (0)
#define TR(F, id) do { } while (0)
#endif
__device__ __forceinline__ bool relaunder(ArgsP& p) { asm volatile("" : "+s"(p)); return true; }
__device__ __forceinline__ bool fresh(Frame& F) { int t_ = threadIdx.x; asm volatile("" : "+v"(t_)); F.tid = t_; F.lane = t_ & 63; F.wave = __builtin_amdgcn_readfirstlane(t_ >> 6); return true; }

__device__ __forceinline__ int cvt_col(int lane) { return 2 * (lane & 31) + (lane >> 5); }
__device__ __forceinline__ void cvt_ld(const float* W, int N, int k0, int n0, int lane, f32x2 (&r)[32]) {
    const float* s = W + (size_t)(k0 + (lane >> 5)) * N + n0 + 2 * (lane & 31);
#pragma unroll
    for (int j = 0; j < 32; ++j) r[j] = __builtin_nontemporal_load((const f32x2*)(s + (size_t)(2 * j) * N));
}
__device__ __forceinline__ void cvt_tr(const f32x2 (&r)[32], float (&v)[64]) {
#pragma unroll
    for (int j = 0; j < 32; ++j) { const auto t = __builtin_amdgcn_permlane32_swap(__float_as_uint(r[j].x), __float_as_uint(r[j].y), false, false);
        v[2 * j] = __uint_as_float(t[0]); v[2 * j + 1] = __uint_as_float(t[1]); }
}
__device__ __forceinline__ void cvt_task(const float* W, int N, int k0, int n0, bf16* WT, int K, int row0, int lane, const float* gain) {
    bf16* d = WT + (size_t)(row0 + cvt_col(lane)) * K + k0;
    f32x2 r[32]; float v[64];
    cvt_ld(W, N, k0, n0, lane, r); cvt_tr(r, v);
    if (gain) {
#pragma unroll
        for (int j = 0; j < 64; ++j) v[j] *= gain[k0 + j]; }
#pragma unroll
    for (int q = 0; q < 8; ++q) { v4u o; o.x = pk2(v[8 * q], v[8 * q + 1]); o.y = pk2(v[8 * q + 2], v[8 * q + 3]); o.z = pk2(v[8 * q + 4], v[8 * q + 5]); o.w = pk2(v[8 * q + 6], v[8 * q + 7]);
        *(GAS v4u*)(d + 8 * q) = o; }
}
__device__ __forceinline__ void cvt_task8(const float* W, int N, int k0, int n0, unsigned char* WT, int K, int row0, float scale, int lane) {
    unsigned char* d = WT + (size_t)(row0 + cvt_col(lane)) * K + k0;
    f32x2 r[32]; float v[64];
    cvt_ld(W, N, k0, n0, lane, r); cvt_tr(r, v);
#pragma unroll
    for (int q = 0; q < 4; ++q) { v4u o;
        o.x = pg8::pack_fp8x4(v[16 * q] * scale, v[16 * q + 1] * scale, v[16 * q + 2] * scale, v[16 * q + 3] * scale); o.y = pg8::pack_fp8x4(v[16 * q + 4] * scale, v[16 * q + 5] * scale, v[16 * q + 6] * scale, v[16 * q + 7] * scale);
        o.z = pg8::pack_fp8x4(v[16 * q + 8] * scale, v[16 * q + 9] * scale, v[16 * q + 10] * scale, v[16 * q + 11] * scale); o.w = pg8::pack_fp8x4(v[16 * q + 12] * scale, v[16 * q + 13] * scale, v[16 * q + 14] * scale, v[16 * q + 15] * scale);
        *(GAS v4u*)(d + 16 * q) = o; }
}
__device__ __forceinline__ void cvt_small_weights(Frame& F, ArgsRef A, int t_lo, int t_hi, int gw, int NGW) {
    bf16* WIN = (bf16*)(A.ws + WS_WIN); bf16* WOUT = (bf16*)(A.ws + WS_WOUT); bf16* WGU = (bf16*)(A.ws + WS_WGU); bf16* WD = (bf16*)(A.ws + WS_WD);
    for (int it = t_lo + gw; it < t_hi; it += NGW) {
        int r = it;
        if (r < 1408) { const int L = r / 704; r %= 704; const int kb = r / 44, nb = r % 44; const int ns = 64 * nb + (64 * nb >= 1536 ? 8 : 0);
            cvt_task(A.in[5] + (size_t)L * D * DIN, DIN, 64 * kb, ns, WIN + (size_t)L * PN * D, D, 64 * nb, F.lane, A.in[1] + (size_t)L * D); continue; }
        r -= 1408;
        if (r < 512) { const int L = r / 256; r %= 256; const int kb = r / 16, nb = r % 16;
            cvt_task(A.in[19] + (size_t)L * D * D, D, 64 * kb, 64 * nb, WOUT + (size_t)L * D * D, D, 64 * nb, F.lane, nullptr); continue; }
        r -= 512;
        if (r < 1408) { const int up = r / 704; r %= 704; const int kb = r / 44, nb = r % 44;
            const int row = 256 * (nb >> 1) + 64 * (nb & 1) + 128 * up;
            if ((nb >> 1) < GU_T8) cvt_task8(up ? A.in[21] : A.in[20], DFF, 64 * kb, 64 * nb, (unsigned char*)WGU, D, row, FP8_SW, F.lane);
            else cvt_task(up ? A.in[21] : A.in[20], DFF, 64 * kb, 64 * nb, (bf16*)(A.ws + WS_WGUB), D, row - 256 * GU_T8, F.lane, A.in[3]);
            continue; }
        r -= 1408;
        { const int kb = r / 16, nb = r % 16; cvt_task8(A.in[22], D, 64 * kb, 64 * nb, (unsigned char*)WD, DFF, 64 * nb, FP8_SW, F.lane); }
    }
}
struct MoeTask { const float* W; int N, k0, n0; unsigned char* WT; int K, row0; };
__device__ __forceinline__ MoeTask moe_task(ArgsRef A, int it) {
    MoeTask t; int r = it;
    if (r < 14336) { const int ue = r / 896; r %= 896; const int up = ue >> 3, e = ue & 7; const int kb = r / 56, nb = r % 56;
        t.W = (up ? A.in[25] : A.in[24]) + (size_t)e * D * DFFE; t.N = DFFE; t.k0 = 64 * kb; t.n0 = 64 * nb; t.WT = A.ws + WS_MWGU + (size_t)e * 7168 * D; t.K = D; t.row0 = 256 * (nb >> 1) + 64 * (nb & 1) + 128 * up; }
    else { r -= 14336; const int e = r / 896; r %= 896; const int kb = r / 16, nb = r % 16;
        t.W = A.in[26] + (size_t)e * DFFE * D; t.N = D; t.k0 = 64 * kb; t.n0 = 64 * nb; t.WT = A.ws + WS_MWD + (size_t)e * D * DFFE; t.K = DFFE; t.row0 = 64 * nb; }
    return t;
}
__device__ __forceinline__ void cvt_moe_weights(Frame& F, ArgsRef A, int t_lo, int t_hi, int gw, int NGW) {
    for (int it = t_lo + gw; it < t_hi; it += 2 * NGW) {
        const MoeTask a = moe_task(A, it); const bool two = it + NGW < t_hi; const MoeTask b = moe_task(A, two ? it + NGW : it);
        f32x2 ra[32], rb[32]; float va[64], vb[64];
        cvt_ld(a.W, a.N, a.k0, a.n0, F.lane, ra); cvt_ld(b.W, b.N, b.k0, b.n0, F.lane, rb);
        cvt_tr(ra, va); cvt_tr(rb, vb);
        unsigned char* da = a.WT + (size_t)(a.row0 + cvt_col(F.lane)) * a.K + a.k0; unsigned char* db = b.WT + (size_t)(b.row0 + cvt_col(F.lane)) * b.K + b.k0;
#pragma unroll
        for (int q = 0; q < 4; ++q) { v4u o;
            o.x = pg8::pack_fp8x4(va[16 * q] * FP8_SW, va[16 * q + 1] * FP8_SW, va[16 * q + 2] * FP8_SW, va[16 * q + 3] * FP8_SW); o.y = pg8::pack_fp8x4(va[16 * q + 4] * FP8_SW, va[16 * q + 5] * FP8_SW, va[16 * q + 6] * FP8_SW, va[16 * q + 7] * FP8_SW);
            o.z = pg8::pack_fp8x4(va[16 * q + 8] * FP8_SW, va[16 * q + 9] * FP8_SW, va[16 * q + 10] * FP8_SW, va[16 * q + 11] * FP8_SW); o.w = pg8::pack_fp8x4(va[16 * q + 12] * FP8_SW, va[16 * q + 13] * FP8_SW, va[16 * q + 14] * FP8_SW, va[16 * q + 15] * FP8_SW);
            *(GAS v4u*)(da + 16 * q) = o; }
        if (two) {
#pragma unroll
        for (int q = 0; q < 4; ++q) { v4u o;
            o.x = pg8::pack_fp8x4(vb[16 * q] * FP8_SW, vb[16 * q + 1] * FP8_SW, vb[16 * q + 2] * FP8_SW, vb[16 * q + 3] * FP8_SW); o.y = pg8::pack_fp8x4(vb[16 * q + 4] * FP8_SW, vb[16 * q + 5] * FP8_SW, vb[16 * q + 6] * FP8_SW, vb[16 * q + 7] * FP8_SW);
            o.z = pg8::pack_fp8x4(vb[16 * q + 8] * FP8_SW, vb[16 * q + 9] * FP8_SW, vb[16 * q + 10] * FP8_SW, vb[16 * q + 11] * FP8_SW); o.w = pg8::pack_fp8x4(vb[16 * q + 12] * FP8_SW, vb[16 * q + 13] * FP8_SW, vb[16 * q + 14] * FP8_SW, vb[16 * q + 15] * FP8_SW);
            *(GAS v4u*)(db + 16 * q) = o; } }
    }
}

struct RowArgs {
    const float* hsrc; float* hdst;
    const bf16* hsrc16; bf16* hdst16;
    int branch;
    const bf16* ybuf; const float* gpost;
    const float* gpre; bf16* a1;
    int proj;
    const float* w8; int w8ld;
    unsigned char* a8;
    float* rs;
    const unsigned char* y8;
};
template <int NS>
__device__ __forceinline__ void row_phase(Frame& F, ArgsRef A, const RowArgs& R) {
    LAS float* W8T = (LAS float*)F.lds;
    LAS int* cnt = (LAS int*)(F.lds + CTL_CNT);
    const int lane = F.lane;
    if (R.proj) { float wv[16];
#pragma unroll
        for (int i = 0; i < 16; ++i) { const int idx = F.tid + NTHR * i; wv[i] = R.w8[(size_t)(idx >> 3) * R.w8ld + (idx & 7)]; }
#pragma unroll
        for (int i = 0; i < 16; ++i) { const int idx = F.tid + NTHR * i; W8T[(idx & 7) * 1024 + (idx >> 3)] = wv[i]; } }
    if (R.proj == 2 && F.tid < 8) cnt[F.tid] = 0;
    __syncthreads();
    f32x4 gpo[4], gpr[4];
#pragma unroll
    for (int j = 0; j < 4; ++j) { gpo[j] = R.branch ? *(const f32x4*)(R.gpost + 4 * lane + 256 * j) : (f32x4){0.f, 0.f, 0.f, 0.f}; gpr[j] = R.gpre ? *(const f32x4*)(R.gpre + 4 * lane + 256 * j) : (f32x4){0.f, 0.f, 0.f, 0.f}; }
    float* DTRAW = (float*)(A.ws + WS_DTRAW); int* TOKE = (int*)(A.ws + WS_TOKE); float* TOKG = (float*)(A.ws + WS_TOKG); const int* POS = (const int*)(A.ws + WS_POS);
    const int gw = F.vcu * NWAVES + F.wave, NGW = F.G * NWAVES;
    f32x4 hf[NS][4]; v2u hp[NS][4], y0p[NS][4], y1p[NS][4]; int ip0[NS], ip1[NS]; float ig0[NS], ig1[NS], gc0[NS], gc1[NS];
#define ROW_IDX(q, mm) do { if (R.branch == 2 && (mm) < M) { ip0[q] = POS[2 * (mm)]; ip1[q] = POS[2 * (mm) + 1]; ig0[q] = TOKG[2 * (mm)]; ig1[q] = TOKG[2 * (mm) + 1]; } } while (0)
#define ROW_DATA(q, mm) do { if ((mm) < M) { \
        if (R.hsrc) { _Pragma("unroll") for (int j = 0; j < 4; ++j) hf[q][j] = __builtin_nontemporal_load((const f32x4*)(R.hsrc + (size_t)(mm) * D + 4 * lane + 256 * j)); } \
        else { _Pragma("unroll") for (int j = 0; j < 4; ++j) hp[q][j] = __builtin_nontemporal_load((const v2u*)(R.hsrc16 + (size_t)(mm) * D + 4 * lane + 256 * j)); } \
        if (R.branch == 1) { _Pragma("unroll") for (int j = 0; j < 4; ++j) y0p[q][j] = __builtin_nontemporal_load((const v2u*)(R.ybuf + (size_t)(mm) * D + 4 * lane + 256 * j)); } \
        if (R.branch == 2) { gc0[q] = ig0[q] * (1.0f / FP8_SY); gc1[q] = ig1[q] * (1.0f / FP8_SY); _Pragma("unroll") for (int j = 0; j < 4; ++j) { y0p[q][j].x = __builtin_nontemporal_load((const unsigned*)(R.y8 + (size_t)ip0[q] * D + 4 * lane + 256 * j)); y1p[q][j].x = __builtin_nontemporal_load((const unsigned*)(R.y8 + (size_t)ip1[q] * D + 4 * lane + 256 * j)); } } } } while (0)
#pragma unroll
    for (int q = 0; q < NS; ++q) { ip0[q] = 0; ip1[q] = 0; ig0[q] = 0.f; ig1[q] = 0.f; gc0[q] = 0.f; gc1[q] = 0.f; ROW_IDX(q, gw + q * NGW); }
#pragma unroll
    for (int q = 0; q < NS; ++q) { ROW_DATA(q, gw + q * NGW); ROW_IDX(q, gw + (q + NS) * NGW); }
    for (int mb = gw; mb < M; mb += NS * NGW) {
#pragma unroll
        for (int q = 0; q < NS; ++q) {
        const int m = mb + q * NGW;
        if (m < M) {
        f32x4 v[4], y[4];
#pragma unroll
        for (int j = 0; j < 4; ++j) v[j] = R.hsrc ? hf[q][j] : (f32x4){bflo(hp[q][j].x), bfhi(hp[q][j].x), bflo(hp[q][j].y), bfhi(hp[q][j].y)};
        if (R.branch == 1) {
#pragma unroll
            for (int j = 0; j < 4; ++j) y[j] = (f32x4){bflo(y0p[q][j].x), bfhi(y0p[q][j].x), bflo(y0p[q][j].y), bfhi(y0p[q][j].y)};
        } else if (R.branch == 2) {
#pragma unroll
            for (int j = 0; j < 4; ++j) { const f32x2 a0 = __builtin_amdgcn_cvt_pk_f32_fp8((int)y0p[q][j].x, false), b0 = __builtin_amdgcn_cvt_pk_f32_fp8((int)y0p[q][j].x, true), a1 = __builtin_amdgcn_cvt_pk_f32_fp8((int)y1p[q][j].x, false), b1 = __builtin_amdgcn_cvt_pk_f32_fp8((int)y1p[q][j].x, true);
                y[j] = (f32x4){gc0[q] * a0.x + gc1[q] * a1.x, gc0[q] * a0.y + gc1[q] * a1.y, gc0[q] * b0.x + gc1[q] * b1.x, gc0[q] * b0.y + gc1[q] * b1.y}; }
        }
        ROW_DATA(q, m + NS * NGW); ROW_IDX(q, m + 2 * NS * NGW);
        __builtin_amdgcn_sched_barrier(0);
        if (R.branch) {
            float ss = 0.f;
#pragma unroll
            for (int j = 0; j < 4; ++j) ss += (y[j].x * y[j].x + y[j].y * y[j].y) + (y[j].z * y[j].z + y[j].w * y[j].w);
            const float sc = rsq(wave_sum(ss) * (1.0f / D) + 1e-6f);
#pragma unroll
            for (int j = 0; j < 4; ++j) v[j] = v[j] + y[j] * sc * gpo[j];
        }
        if (R.hdst) {
#pragma unroll
            for (int j = 0; j < 4; ++j) __builtin_nontemporal_store(v[j], (f32x4*)(R.hdst + (size_t)m * D + 4 * lane + 256 * j));
        }
        if (R.hdst16) {
#pragma unroll
            for (int j = 0; j < 4; ++j) { v2u o; o.x = pk2(v[j].x, v[j].y); o.y = pk2(v[j].z, v[j].w); if (R.rs) *(v2u*)(R.hdst16 + (size_t)m * D + 4 * lane + 256 * j) = o; else __builtin_nontemporal_store(o, (v2u*)(R.hdst16 + (size_t)m * D + 4 * lane + 256 * j)); }
        }
        if (R.gpre) {
            float ss = 0.f;
#pragma unroll
            for (int j = 0; j < 4; ++j) ss += (v[j].x * v[j].x + v[j].y * v[j].y) + (v[j].z * v[j].z + v[j].w * v[j].w);
            const float sc = rsq(wave_sum(ss) * (1.0f / D) + 1e-6f);
#pragma unroll
            for (int j = 0; j < 4; ++j) { v[j] = v[j] * sc * gpr[j];
                if (R.a8) *(unsigned*)(R.a8 + (size_t)m * D + 4 * lane + 256 * j) = pg8::pack_fp8x4(v[j].x * FP8_SX, v[j].y * FP8_SX, v[j].z * FP8_SX, v[j].w * FP8_SX);
                if (R.a1) { v2u o; o.x = pk2(v[j].x, v[j].y); o.y = pk2(v[j].z, v[j].w); *(v2u*)(R.a1 + (size_t)m * D + 4 * lane + 256 * j) = o; } }
            if (R.rs && lane == 0) R.rs[m] = sc;
            if (R.proj) {
                float p[8];
#pragma unroll
                for (int e = 0; e < 8; ++e) { float s = 0.f;
#pragma unroll
                    for (int j = 0; j < 4; ++j) { const f32x4 w = *(const LAS f32x4*)(W8T + e * 1024 + 4 * lane + 256 * j); s += (v[j].x * w.x + v[j].y * w.y) + (v[j].z * w.z + v[j].w * w.w); }
                    p[e] = wave_sum(s); }
                if (R.proj == 1) {
                    float mine = p[0];
#pragma unroll
                    for (int e = 1; e < 8; ++e) mine = (lane == e) ? p[e] : mine;
                    if (lane < 8) DTRAW[(size_t)m * 8 + lane] = mine;
                } else {
                    float best = p[0]; int bi = 0;
#pragma unroll
                    for (int e = 1; e < 8; ++e) if (p[e] > best) { best = p[e]; bi = e; }
                    float sb = -3.0e38f; int si = 0;
#pragma unroll
                    for (int e = 0; e < 8; ++e) if (e != bi && p[e] > sb) { sb = p[e]; si = e; }
                    const float g0 = 1.0f / (1.0f + expf(sb - best)), g1 = 1.0f - g0;
                    if (lane == 0) { TOKE[2 * m] = bi; TOKE[2 * m + 1] = si; TOKG[2 * m] = g0; TOKG[2 * m + 1] = g1;
                        __hip_atomic_fetch_add(cnt + bi, 1, __ATOMIC_RELAXED, __HIP_MEMORY_SCOPE_WORKGROUP); __hip_atomic_fetch_add(cnt + si, 1, __ATOMIC_RELAXED, __HIP_MEMORY_SCOPE_WORKGROUP); }
                }
            }
        }
        }
        __builtin_amdgcn_sched_barrier(0);
        }
    }
#undef ROW_DATA
#undef ROW_IDX
    if (R.proj == 2) { __syncthreads(); if (F.tid < 8) ((int*)(A.ws + WS_WGCNT))[F.vcu * 8 + F.tid] = cnt[F.tid]; }
    __syncthreads();
}

__device__ __forceinline__ void moe_tables(Frame& F, ArgsRef A) {
    LAS int* c = (LAS int*)(F.lds + CTL_CNT); LAS int* te = (LAS int*)(F.lds + CTL_TE);
    if (F.tid < 48) c[F.tid] = 0;
    __syncthreads();
    const int* WGCNT = (const int*)(A.ws + WS_WGCNT);
    { const int e = F.tid & 7, g4 = F.tid >> 3; int tot = 0, pre = 0;
#pragma unroll
      for (int q = 0; q < 4; ++q) { const int wg = 4 * g4 + q; if (wg < F.G) { const int v = WGCNT[wg * 8 + e]; tot += v; pre += (wg < F.vcu) ? v : 0; } }
      tot += __shfl_xor(tot, 8); tot += __shfl_xor(tot, 16); tot += __shfl_xor(tot, 32);
      pre += __shfl_xor(pre, 8); pre += __shfl_xor(pre, 16); pre += __shfl_xor(pre, 32);
      if (F.lane < 8) { __hip_atomic_fetch_add(c + e, tot, __ATOMIC_RELAXED, __HIP_MEMORY_SCOPE_WORKGROUP); __hip_atomic_fetch_add(c + 8 + e, pre, __ATOMIC_RELAXED, __HIP_MEMORY_SCOPE_WORKGROUP); } }
    __syncthreads();
    if (F.tid == 0) { int t = 0;
#pragma unroll 1
        for (int e = 0; e < 8; ++e) { c[16 + e] = t * 256; t += (c[e] + 255) >> 8; c[40 + e] = t; }
        c[32] = t < MOE_MAXT ? t : MOE_MAXT; }
    __syncthreads();
    if (F.tid < MOE_MAXT) { int e = 0;
#pragma unroll
        for (int q = 0; q < 7; ++q) e += (F.tid >= c[40 + q]) ? 1 : 0;
        te[F.tid] = e; }
    __syncthreads();
}
__device__ __forceinline__ void moe_gather(Frame& F, ArgsRef A) {
    LAS int* c = (LAS int*)(F.lds + CTL_CNT);
    const int* TOKE = (const int*)(A.ws + WS_TOKE); int* POS = (int*)(A.ws + WS_POS);
    const unsigned char* A8 = A.ws + WS_A1; unsigned char* XS = A.ws + WS_XS;
    const int gw = F.vcu * NWAVES + F.wave, NGW = F.G * NWAVES, lane = F.lane;
    for (int mb = gw; mb < M; mb += 16 * NGW) {
        v4u r0[16];
#pragma unroll
        for (int q = 0; q < 16; ++q) { const int m = mb + q * NGW; if (m < M) r0[q] = __builtin_nontemporal_load((const v4u*)(A8 + (size_t)m * D + 16 * lane)); }
        int d0 = 0, d1 = 0;
        { const int mq = mb + (lane & 15) * NGW;
          if (lane < 16 && mq < M) { const v2u e = *(const v2u*)(TOKE + 2 * mq); const int e0 = (int)e.x, e1 = (int)e.y;
              d0 = c[16 + e0] + c[8 + e0] + __hip_atomic_fetch_add(c + 24 + e0, 1, __ATOMIC_RELAXED, __HIP_MEMORY_SCOPE_WORKGROUP);
              d1 = c[16 + e1] + c[8 + e1] + __hip_atomic_fetch_add(c + 24 + e1, 1, __ATOMIC_RELAXED, __HIP_MEMORY_SCOPE_WORKGROUP);
              v2u o; o.x = (unsigned)d0; o.y = (unsigned)d1; *(v2u*)(POS + 2 * mq) = o; } }
#pragma unroll
        for (int q = 0; q < 16; ++q) { const int m = mb + q * NGW;
            if (m < M) { const int e0 = __builtin_amdgcn_readlane(d0, q), e1 = __builtin_amdgcn_readlane(d1, q);
                *(v4u*)(XS + (size_t)e0 * D + 16 * lane) = r0[q]; *(v4u*)(XS + (size_t)e1 * D + 16 * lane) = r0[q]; } }
    }
    __syncthreads();
}

__device__ __forceinline__ void gmlp_unit(Frame& F, ArgsRef A, int L, int nb) {
    LAS unsigned char* Ls = F.lds; int tl_ = F.tid; asm volatile("" : "+v"(tl_));
    const int tid = tl_, lane = tid & 63, w = F.wave, fr = lane & 15, q4 = lane >> 4;
    const size_t m0 = (size_t)nb * 128;
    const bf16* P = (const bf16*)(A.ws + WS_PROJ); bf16* Y = (bf16*)(A.ws + WS_Y);
    { const f32x4 g4 = *(const f32x4*)(A.in[12] + L * 256 + 4 * lane), b4 = *(const f32x4*)(A.in[13] + L * 256 + 4 * lane);
      v2u rawv[16];
#pragma unroll
      for (int i = 0; i < 16; ++i) rawv[i] = __builtin_nontemporal_load((const v2u*)(P + (m0 + 16 * w + i) * PN + PC_V + 4 * lane));
#pragma unroll
      for (int i = 0; i < 16; ++i) { const int r = 16 * w + i;
        const v2u raw = rawv[i];
        f32x4 v = (f32x4){bflo(raw.x), bfhi(raw.x), bflo(raw.y), bfhi(raw.y)};
        const float mu = wave_sum((v.x + v.y) + (v.z + v.w)) * (1.0f / 256.0f);
        v = v - mu;
        const float var = wave_sum((v.x * v.x + v.y * v.y) + (v.z * v.z + v.w * v.w)) * (1.0f / 256.0f);
        const float rstd = rsq(var + 1e-5f);
        v = v * rstd * g4 + b4;
        v2u o; o.x = pk2(v.x, v.y); o.y = pk2(v.z, v.w);
        *(LAS v2u*)(Ls + r * 544 + lane * 8) = o; } }
    const int g = w & 3;
    f32x4 acc[4][4];
    const float* Wg = A.in[14] + (size_t)(L * 4 + g) * 128 * 128;
    const float* bsg = A.in[15] + (size_t)(L * 4 + g) * 128;
    f32x4 wfa[4][4], wfb[4][4];
#pragma unroll
    for (int pi = 0; pi < 4; ++pi) {
        const int it = (w >> 2) == 0 ? (pi == 0 ? 0 : pi == 1 ? 7 : pi == 2 ? 1 : 6) : (pi == 0 ? 2 : pi == 1 ? 5 : pi == 2 ? 3 : 4);
#pragma unroll
        for (int ks = 0; ks < 4; ++ks) { wfa[pi][ks] = *(const f32x4*)(Wg + (16 * it + fr) * 128 + 32 * ks + 4 * q4); wfb[pi][ks] = *(const f32x4*)(Wg + (16 * it + fr) * 128 + 32 * ks + 4 * q4 + 16); }
    }
    __syncthreads();
#pragma unroll
    for (int pi = 0; pi < 4; ++pi) {
        const int it = (w >> 2) == 0 ? (pi == 0 ? 0 : pi == 1 ? 7 : pi == 2 ? 1 : 6) : (pi == 0 ? 2 : pi == 1 ? 5 : pi == 2 ? 3 : 4);
#pragma unroll
        for (int ct = 0; ct < 4; ++ct) acc[pi][ct] = (f32x4){0.f, 0.f, 0.f, 0.f};
        const int t = 16 * it + fr, nks = (it >> 1) + 1;
#pragma unroll
        for (int ks = 0; ks < 4; ++ks) {
            if (ks < nks) {
            const int sA = 32 * ks + 4 * q4, sB = sA + 16;
            const f32x4 wa = wfa[pi][ks], wb = wfb[pi][ks];
            const bf16x8 xf = pack8(sA + 0 <= t ? wa.x : 0.f, sA + 1 <= t ? wa.y : 0.f, sA + 2 <= t ? wa.z : 0.f, sA + 3 <= t ? wa.w : 0.f,
                                    sB + 0 <= t ? wb.x : 0.f, sB + 1 <= t ? wb.y : 0.f, sB + 2 <= t ? wb.z : 0.f, sB + 3 <= t ? wb.w : 0.f);
#pragma unroll
            for (int ct = 0; ct < 4; ++ct) { const int col = g * 64 + ct * 16 + 4 * (lane & 3);
                const v4i16 lo = trrd(Ls + (sA + (fr >> 2)) * 544 + col * 2), hi = trrd(Ls + (sB + (fr >> 2)) * 544 + col * 2);
                acc[pi][ct] = mfma16(xf, cat8(lo, hi), acc[pi][ct]); }
            }
        }
#pragma unroll
        for (int r = 0; r < 4; ++r) { const float bs = bsg[16 * it + 4 * q4 + r];
#pragma unroll
            for (int ct = 0; ct < 4; ++ct) acc[pi][ct][r] += bs; }
    }
    __syncthreads();
#pragma unroll
    for (int pi = 0; pi < 4; ++pi) {
        const int it = (w >> 2) == 0 ? (pi == 0 ? 0 : pi == 1 ? 7 : pi == 2 ? 1 : 6) : (pi == 0 ? 2 : pi == 1 ? 5 : pi == 2 ? 3 : 4);
#pragma unroll
        for (int ct = 0; ct < 4; ++ct)
#pragma unroll
            for (int r = 0; r < 4; ++r) *(LAS float*)(Ls + (16 * it + 4 * q4 + r) * 1040 + (g * 64 + ct * 16 + fr) * 4) = acc[pi][ct][r];
    }
    __syncthreads();
    { const f32x4 gn = *(const f32x4*)(A.in[16] + L * 256 + 4 * lane);
      v2u rawu[16];
#pragma unroll
      for (int i = 0; i < 16; ++i) rawu[i] = __builtin_nontemporal_load((const v2u*)(P + (m0 + 16 * w + i) * PN + PC_U + 4 * lane));
#pragma unroll
      for (int i = 0; i < 16; ++i) { const int r = 16 * w + i;
        const f32x4 mx = *(const LAS f32x4*)(Ls + r * 1040 + lane * 16);
        const v2u raw = rawu[i];
        f32x4 v = (f32x4){bflo(raw.x), bfhi(raw.x), bflo(raw.y), bfhi(raw.y)} * mx;
        const float ss = wave_sum((v.x * v.x + v.y * v.y) + (v.z * v.z + v.w * v.w)) * (1.0f / 256.0f);
        v = v * (rsq(ss + 1e-6f)) * gn;
        v2u o; o.x = pk2(v.x, v.y); o.y = pk2(v.z, v.w);
        *(v2u*)(Y + (m0 + r) * D + 512 + 4 * lane) = o; } }
    __syncthreads();
}

__device__ __forceinline__ void attn_unit(Frame& F, ArgsRef A, int L, int bc) {
    LAS unsigned char* Ls = F.lds; int tl_ = F.tid; asm volatile("" : "+v"(tl_));
    const int tid = tl_, lane = tid & 63, w = F.wave, fr = lane & 15, q4 = lane >> 4;
    const int b = bc >> 7, c = bc & 127; const size_t m0 = (size_t)b * SEQ + (size_t)c * 64;
    const bf16* P = (const bf16*)(A.ws + WS_PROJ); bf16* Y = (bf16*)(A.ws + WS_Y);
    const int h = w >> 1, qh = w & 1;
    LAS unsigned char* Vb = Ls + w * 10240;
    TR0(F);
    LAS float* BT = (LAS float*)(Ls + 81920);
    constexpr float LOG2E = 1.4426950408889634f;
    { const float* bsrc = A.in[17] + (size_t)L * 4 * 257;
      const float b0 = bsrc[tid], b1 = bsrc[tid + NTHR], b2 = bsrc[tid < 4 ? tid + 2 * NTHR : tid];
      BT[tid] = b0 * LOG2E; BT[tid + NTHR] = b1 * LOG2E; if (tid < 4) BT[tid + 2 * NTHR] = b2 * LOG2E; }
    bf16x8 qf[2][2];
#pragma unroll
    for (int qb = 0; qb < 2; ++qb)
#pragma unroll
        for (int ks = 0; ks < 2; ++ks) qf[qb][ks] = __builtin_nontemporal_load((const bf16x8*)(P + (m0 + 32 * qh + 16 * qb + fr) * PN + PC_Q + h * 64 + 32 * ks + 8 * q4));
    f32x4 o[4][2];
#pragma unroll
    for (int dt = 0; dt < 4; ++dt) { o[dt][0] = (f32x4){0.f, 0.f, 0.f, 0.f}; o[dt][1] = (f32x4){0.f, 0.f, 0.f, 0.f}; }
    float mrun[2] = {-1e30f, -1e30f};
    f32x4 ol[2] = {(f32x4){0.f, 0.f, 0.f, 0.f}, (f32x4){0.f, 0.f, 0.f, 0.f}};
    const bf16x8 onesf = (fr == 0) ? (bf16x8){0x3f80, 0x3f80, 0x3f80, 0x3f80, 0x3f80, 0x3f80, 0x3f80, 0x3f80} : (bf16x8){0, 0, 0, 0, 0, 0, 0, 0};
    const int jmin = c >= 8 ? 0 : 8 - c;
    const bf16* Kp = P + PC_K + h * 64 + 8 * q4 + (size_t)fr * PN;
    const bf16* Vp = P + PC_VV + h * 64 + (lane & 7) * 8 + (size_t)(lane >> 3) * PN;
    bf16x8 kreg[4][2]; v4u vreg[8];
    { const size_t kr0 = m0 - (size_t)(8 - jmin) * 64;
#pragma unroll
      for (int kt = 0; kt < 4; ++kt)
#pragma unroll
          for (int ks = 0; ks < 2; ++ks) kreg[kt][ks] = *(const bf16x8*)(Kp + (kr0 + 16 * kt) * PN + 32 * ks);
#pragma unroll
      for (int i = 0; i < 8; ++i) vreg[i] = *(const v4u*)(Vp + (kr0 + 8 * i) * PN); }
    __syncthreads();
    TR(F, 33);
    const float cb = BT[h * 257 + 256];
    for (int j = jmin; j <= 8; ++j) {
        const int jn = j < 8 ? j + 1 : 8; const size_t krn = m0 - (size_t)(8 - jn) * 64;
#pragma unroll
        for (int i = 0; i < 8; ++i) *(LAS v4u*)(Vb + (i * 8 + (lane >> 3)) * 160 + (lane & 7) * 16) = vreg[i];
#pragma unroll
        for (int i = 0; i < 8; ++i) vreg[i] = *(const v4u*)(Vp + (krn + 8 * i) * PN);
        f32x4 st[4][2];
#pragma unroll
        for (int kt = 0; kt < 4; ++kt) { st[kt][0] = (f32x4){0.f, 0.f, 0.f, 0.f}; st[kt][1] = (f32x4){0.f, 0.f, 0.f, 0.f};
#pragma unroll
            for (int ks = 0; ks < 2; ++ks) { st[kt][0] = mfma16(kreg[kt][ks], qf[0][ks], st[kt][0]); st[kt][1] = mfma16(kreg[kt][ks], qf[1][ks], st[kt][1]); } }
#pragma unroll
        for (int kt = 0; kt < 4; ++kt)
#pragma unroll
            for (int ks = 0; ks < 2; ++ks) kreg[kt][ks] = *(const bf16x8*)(Kp + (krn + 16 * kt) * PN + 32 * ks);
#pragma unroll
        for (int qb = 0; qb < 2; ++qb) {
            float mx = -1e30f, mold, mnew;
            if (j <= 5) {
#pragma unroll
                for (int kt = 0; kt < 4; ++kt) mx = fmaxf(mx, fmaxf(fmaxf(st[kt][qb][0], st[kt][qb][1]), fmaxf(st[kt][qb][2], st[kt][qb][3])));
                mx = xmax16(mx); mx = xmax32(mx);
                mx = mx * (0.125f * LOG2E) + cb;
                mold = mrun[qb]; mnew = fmaxf(mold, mx); mrun[qb] = mnew;
                const float off = cb - mnew;
#pragma unroll
                for (int kt = 0; kt < 4; ++kt)
#pragma unroll
                    for (int r = 0; r < 4; ++r) st[kt][qb][r] = __builtin_amdgcn_exp2f(st[kt][qb][r] * (0.125f * LOG2E) + off);
            } else {
                const int i0 = 512 - 64 * j + 32 * qh + 16 * qb + fr - 4 * q4 + 128;
#pragma unroll
                for (int kt = 0; kt < 4; ++kt)
#pragma unroll
                    for (int r = 0; r < 4; ++r) { int idx = i0 - 16 * kt - r; idx = idx > 256 ? 256 : idx;
                        const float s = st[kt][qb][r] * (0.125f * LOG2E) + BT[h * 257 + idx]; st[kt][qb][r] = s; mx = fmaxf(mx, s); }
                mx = xmax16(mx); mx = xmax32(mx);
                mold = mrun[qb]; mnew = fmaxf(mold, mx); mrun[qb] = mnew;
#pragma unroll
                for (int kt = 0; kt < 4; ++kt)
#pragma unroll
                    for (int r = 0; r < 4; ++r) st[kt][qb][r] = __builtin_amdgcn_exp2f(st[kt][qb][r] - mnew);
            }
            if (__any(mnew > mold)) { const float alpha = __builtin_amdgcn_exp2f(mold - mnew); ol[qb] = ol[qb] * alpha;
#pragma unroll
                for (int dt = 0; dt < 4; ++dt) o[dt][qb] = o[dt][qb] * alpha; }
        }
#pragma unroll
        for (int kk = 0; kk < 2; ++kk) {
            const bf16x8 y0 = pack8(st[2 * kk][0][0], st[2 * kk][0][1], st[2 * kk][0][2], st[2 * kk][0][3], st[2 * kk + 1][0][0], st[2 * kk + 1][0][1], st[2 * kk + 1][0][2], st[2 * kk + 1][0][3]);
            const bf16x8 y1 = pack8(st[2 * kk][1][0], st[2 * kk][1][1], st[2 * kk][1][2], st[2 * kk][1][3], st[2 * kk + 1][1][0], st[2 * kk + 1][1][1], st[2 * kk + 1][1][2], st[2 * kk + 1][1][3]);
            const int rowA = 32 * kk + 4 * q4 + (fr >> 2), rowB = rowA + 16;
#pragma unroll
            for (int dt = 0; dt < 4; ++dt) { const int cbt = (16 * dt + 4 * (lane & 3)) * 2;
                const bf16x8 xf = cat8(trrd(Vb + rowA * 160 + cbt), trrd(Vb + rowB * 160 + cbt));
                o[dt][0] = mfma16(xf, y0, o[dt][0]); o[dt][1] = mfma16(xf, y1, o[dt][1]); }
            ol[0] = mfma16(onesf, y0, ol[0]); ol[1] = mfma16(onesf, y1, ol[1]);
        }
    }
    TR(F, 34);
    const float il0 = 1.0f / __shfl(ol[0][0], fr), il1 = 1.0f / __shfl(ol[1][0], fr);
    LAS float* SS = (LAS float*)(Ls + 86144);
    float ss0 = 0.f, ss1 = 0.f;
#pragma unroll
    for (int dt = 0; dt < 4; ++dt) { o[dt][0] = o[dt][0] * il0; o[dt][1] = o[dt][1] * il1;
        ss0 += (o[dt][0].x * o[dt][0].x + o[dt][0].y * o[dt][0].y) + (o[dt][0].z * o[dt][0].z + o[dt][0].w * o[dt][0].w);
        ss1 += (o[dt][1].x * o[dt][1].x + o[dt][1].y * o[dt][1].y) + (o[dt][1].z * o[dt][1].z + o[dt][1].w * o[dt][1].w); }
    ss0 = xadd32(xadd16(ss0)); ss1 = xadd32(xadd16(ss1));
    if (q4 == 0) { SS[(32 * qh + fr) * 4 + h] = ss0; SS[(32 * qh + 16 + fr) * 4 + h] = ss1; }
    __syncthreads();
    { const f32x4 t0 = *(const LAS f32x4*)(SS + (32 * qh + fr) * 4), t1 = *(const LAS f32x4*)(SS + (32 * qh + 16 + fr) * 4);
      const float sc0 = rsq(((t0.x + t0.y) + (t0.z + t0.w)) * (1.0f / 256.0f) + 1e-6f), sc1 = rsq(((t1.x + t1.y) + (t1.z + t1.w)) * (1.0f / 256.0f) + 1e-6f);
      const float* gnp = A.in[18] + L * 256 + h * 64 + 4 * q4;
      bf16* y0 = Y + (m0 + 32 * qh + fr) * D + 768 + h * 64 + 4 * q4; bf16* y1 = y0 + (size_t)16 * D;
#pragma unroll
      for (int dt = 0; dt < 4; ++dt) { const f32x4 gn = *(const f32x4*)(gnp + 16 * dt);
          const f32x4 a = o[dt][0] * sc0 * gn, bq = o[dt][1] * sc1 * gn;
          v2u oa, ob; oa.x = pk2(a.x, a.y); oa.y = pk2(a.z, a.w); ob.x = pk2(bq.x, bq.y); ob.y = pk2(bq.z, bq.w);
          *(v2u*)(y0 + 16 * dt) = oa; *(v2u*)(y1 + 16 * dt) = ob; } }
    TR(F, 35);
}

__device__ __forceinline__ void ssd_prepass(Frame& F, ArgsRef A, int L, size_t m0, LAS float* dtl, LAS float* acs) {
    const float* DTRAW = (const float*)(A.ws + WS_DTRAW);
    { const int l = F.lane, h = F.wave;
      const float x = DTRAW[(m0 + l) * 8 + h] + A.in[8][L * 8 + h];
      const float dt = x > 20.f ? x : log1pf(expf(x));
      float s = -dt * expf(A.in[9][L * 8 + h]);
#pragma unroll
      for (int o = 1; o < 64; o <<= 1) { const float t = __shfl_up(s, o); s += (l >= o) ? t : 0.f; }
      dtl[l * 8 + h] = dt; acs[l * 8 + h] = s; }
    __syncthreads();
}
__device__ __forceinline__ void ssd1_unit(Frame& F, ArgsRef A, int L, int bc) {
    LAS unsigned char* Ls = F.lds; int tl_ = F.tid; asm volatile("" : "+v"(tl_));
    const int tid = tl_, lane = tid & 63, w = F.wave, fr = lane & 15, q4 = lane >> 4;
    const int b = bc >> 7, c = bc & 127; const size_t m0 = (size_t)b * SEQ + (size_t)c * 64;
    const bf16* P = (const bf16*)(A.ws + WS_PROJ); bf16* XBCC = (bf16*)(A.ws + WS_XBCC); bf16* ST = (bf16*)(A.ws + WS_ST); float* AEND = (float*)(A.ws + WS_AEND);
    LAS unsigned char* XI = Ls; LAS unsigned char* BI = Ls + 67584;
    LAS float* dtl = (LAS float*)(Ls + 102400); LAS float* acs = (LAS float*)(Ls + 104448);
    const int cg = tid & 127, tg = tid >> 7, ch0 = 8 * cg;
    v4u raw[19];
#define SSD1_ROW(tt) do { const int lp = 16 * tg - 3 + (tt); const bool ok = (c * 64 + lp) >= 0; \
        raw[tt] = ok ? __builtin_nontemporal_load((const v4u*)(P + (size_t)((long)m0 + lp) * PN + PC_XBC + ch0)) : (v4u){0u, 0u, 0u, 0u}; } while (0)
#pragma unroll
    for (int tt = 0; tt < 11; ++tt) SSD1_ROW(tt);
    TR0(F);
    ssd_prepass(F, A, L, m0, dtl, acs);
    TR(F, 30);
    if (tid < 8) AEND[(size_t)bc * 8 + tid] = acs[63 * 8 + tid];
    { float wk[4][8], bs[8];
#pragma unroll
      for (int k = 0; k < 4; ++k) { const f32x4 a = *(const f32x4*)(A.in[6] + (size_t)(L * 4 + k) * 1024 + ch0), bq = *(const f32x4*)(A.in[6] + (size_t)(L * 4 + k) * 1024 + ch0 + 4);
          wk[k][0] = a.x; wk[k][1] = a.y; wk[k][2] = a.z; wk[k][3] = a.w; wk[k][4] = bq.x; wk[k][5] = bq.y; wk[k][6] = bq.z; wk[k][7] = bq.w; }
      { const f32x4 a = *(const f32x4*)(A.in[7] + (size_t)L * 1024 + ch0), bq = *(const f32x4*)(A.in[7] + (size_t)L * 1024 + ch0 + 4);
          bs[0] = a.x; bs[1] = a.y; bs[2] = a.z; bs[3] = a.w; bs[4] = bq.x; bs[5] = bq.y; bs[6] = bq.z; bs[7] = bq.w; }
      const int hh = cg >> 3;
#pragma unroll
      for (int t = 0; t < 16; ++t) { const int l = 16 * tg + t;
          if (t < 8) SSD1_ROW(t + 11);
          float y[8];
#pragma unroll
          for (int e = 0; e < 8; ++e) y[e] = bs[e];
#pragma unroll
          for (int k = 0; k < 4; ++k) { const v4u rw = raw[t + k];
              y[0] += wk[k][0] * bflo(rw.x); y[1] += wk[k][1] * bfhi(rw.x); y[2] += wk[k][2] * bflo(rw.y); y[3] += wk[k][3] * bfhi(rw.y);
              y[4] += wk[k][4] * bflo(rw.z); y[5] += wk[k][5] * bfhi(rw.z); y[6] += wk[k][6] * bflo(rw.w); y[7] += wk[k][7] * bfhi(rw.w); }
#pragma unroll
          for (int e = 0; e < 8; ++e) y[e] = silu(y[e]);
          v4u o; o.x = pk2(y[0], y[1]); o.y = pk2(y[2], y[3]); o.z = pk2(y[4], y[5]); o.w = pk2(y[6], y[7]);
          *(v4u*)(XBCC + (m0 + l) * 1024 + ch0) = o;
          if (cg < 64) { const float sc = dtl[l * 8 + hh] * __expf(acs[63 * 8 + hh] - acs[l * 8 + hh]);
              v4u os; os.x = pk2(y[0] * sc, y[1] * sc); os.y = pk2(y[2] * sc, y[3] * sc); os.z = pk2(y[4] * sc, y[5] * sc); os.w = pk2(y[6] * sc, y[7] * sc);
              *(LAS v4u*)(XI + l * 1056 + ch0 * 2) = os; }
          else if (cg < 96) *(LAS v4u*)(BI + l * 544 + (ch0 - 512) * 2) = o;
      } }
#undef SSD1_ROW
    __syncthreads();
    TR(F, 31);
    { const int h = w, gi = h >> 2;
      bf16* STh = ST + ((size_t)bc * 8 + h) * 8192;
#pragma unroll 1
      for (int nh = 0; nh < 2; ++nh) {
      f32x4 acc[4][4];
#pragma unroll
      for (int nt = 0; nt < 4; ++nt)
#pragma unroll
          for (int pt = 0; pt < 4; ++pt) acc[nt][pt] = (f32x4){0.f, 0.f, 0.f, 0.f};
#pragma unroll
      for (int ks = 0; ks < 2; ++ks) {
          const int rowA = 32 * ks + 4 * q4 + (fr >> 2), rowB = rowA + 16;
          bf16x8 yf[4];
#pragma unroll
          for (int pt = 0; pt < 4; ++pt) { const int cb = (h * 64 + 16 * pt + 4 * (lane & 3)) * 2; yf[pt] = cat8(trrd(XI + rowA * 1056 + cb), trrd(XI + rowB * 1056 + cb)); }
#pragma unroll
          for (int nt = 0; nt < 4; ++nt) { const int cb = (gi * 128 + 64 * nh + 16 * nt + 4 * (lane & 3)) * 2;
              const bf16x8 xf = cat8(trrd(BI + rowA * 544 + cb), trrd(BI + rowB * 544 + cb));
#pragma unroll
              for (int pt = 0; pt < 4; ++pt) acc[nt][pt] = mfma16(xf, yf[pt], acc[nt][pt]); }
      }
#pragma unroll
      for (int nt = 0; nt < 4; ++nt)
#pragma unroll
          for (int pt = 0; pt < 4; ++pt) { v2u o; o.x = pk2(acc[nt][pt][0], acc[nt][pt][1]); o.y = pk2(acc[nt][pt][2], acc[nt][pt][3]); *(v2u*)(STh + (16 * pt + fr) * 128 + 64 * nh + 16 * nt + 4 * q4) = o; }
      }
    }
    __syncthreads();
    TR(F, 32);
}
__device__ __forceinline__ void ssd_scan(Frame& F, ArgsRef A) {
    unsigned* ST = (unsigned*)(A.ws + WS_ST); const float* AEND = (const float*)(A.ws + WS_AEND);
    for (int it = F.vcu * NTHR + F.tid; it < 32 * 4096; it += F.G * NTHR) {
        const int bh = it >> 12, b = bh >> 3, h = bh & 7, e = (it & 4095);
        unsigned* base = ST + ((size_t)(b * NCHUNK) * 8 + h) * 4096 + e;
        float s0 = 0.f, s1 = 0.f;
        for (int c0 = 0; c0 < NCHUNK; c0 += 32) {
            unsigned v[32]; float dec[32];
#pragma unroll
            for (int i = 0; i < 32; ++i) { v[i] = __builtin_nontemporal_load(base + (size_t)(c0 + i) * 32768); dec[i] = AEND[(size_t)(b * NCHUNK + c0 + i) * 8 + h]; }
            __builtin_amdgcn_sched_barrier(0);
#pragma unroll
            for (int i = 0; i < 32; ++i) dec[i] = __expf(dec[i]);
#pragma unroll
            for (int i = 0; i < 32; ++i) { base[(size_t)(c0 + i) * 32768] = pk2(s0, s1); s0 = s0 * dec[i] + bflo(v[i]); s1 = s1 * dec[i] + bfhi(v[i]); }
        }
    }
}
__device__ __forceinline__ void ssd3_unit(Frame& F, ArgsRef A, int L, int bc) {
    LAS unsigned char* Ls = F.lds; int tl_ = F.tid; asm volatile("" : "+v"(tl_));
    const int tid = tl_, lane = tid & 63, w = F.wave, fr = lane & 15, q4 = lane >> 4;
    const int b = bc >> 7, c = bc & 127; const size_t m0 = (size_t)b * SEQ + (size_t)c * 64;
    const bf16* P = (const bf16*)(A.ws + WS_PROJ); const bf16* XBCC = (const bf16*)(A.ws + WS_XBCC); const bf16* ST = (const bf16*)(A.ws + WS_ST); bf16* Y = (bf16*)(A.ws + WS_Y);
    LAS unsigned char* XI = Ls; LAS unsigned char* BI = Ls + 67584; LAS unsigned char* CI = Ls + 102400;
    LAS float* dtl = (LAS float*)(Ls + 137216); LAS float* acs = (LAS float*)(Ls + 139264);
    const int h = w, gi = h >> 2;
    TR0(F);
    v4u stg[16];
#pragma unroll
    for (int i = 0; i < 16; ++i) { const int pc = tid + NTHR * i; stg[i] = __builtin_nontemporal_load((const v4u*)(XBCC + (m0 + (pc >> 7)) * 1024 + 8 * (pc & 127))); }
    ssd_prepass(F, A, L, m0, dtl, acs);
#pragma unroll
    for (int i = 0; i < 16; ++i) { const int pc = tid + NTHR * i, row = pc >> 7, cg = pc & 127;
        LAS unsigned char* dst = cg < 64 ? XI + row * 1056 + cg * 16 : (cg < 96 ? BI + row * 544 + (cg - 64) * 16 : CI + row * 544 + (cg - 96) * 16);
        *(LAS v4u*)dst = stg[i]; }
    __builtin_amdgcn_sched_barrier(0);
    bf16x8 sin_[4][4];
    { const bf16* Sh = ST + ((size_t)bc * 8 + h) * 8192;
#pragma unroll
      for (int kn = 0; kn < 4; ++kn)
#pragma unroll
          for (int pt = 0; pt < 4; ++pt) sin_[kn][pt] = __builtin_nontemporal_load((const bf16x8*)(Sh + (16 * pt + fr) * 128 + 32 * kn + 8 * q4)); }
    __syncthreads();
    TR(F, 36);
    f32x4 acc[4][4];
#pragma unroll
    for (int lt = 0; lt < 4; ++lt)
#pragma unroll
        for (int pt = 0; pt < 4; ++pt) acc[lt][pt] = (f32x4){0.f, 0.f, 0.f, 0.f};
    {
#pragma unroll
      for (int kn = 0; kn < 4; ++kn) {
#pragma unroll
          for (int lt = 0; lt < 4; ++lt) { const bf16x8 xf = *(const LAS bf16x8*)(CI + (16 * lt + fr) * 544 + (gi * 128 + 32 * kn + 8 * q4) * 2);
#pragma unroll
              for (int pt = 0; pt < 4; ++pt) acc[lt][pt] = mfma16(xf, sin_[kn][pt], acc[lt][pt]); }
      }
#pragma unroll
      for (int lt = 0; lt < 4; ++lt)
#pragma unroll
          for (int r = 0; r < 4; ++r) { const float sc = __expf(acs[(16 * lt + 4 * q4 + r) * 8 + h]);
#pragma unroll
              for (int pt = 0; pt < 4; ++pt) acc[lt][pt][r] *= sc; }
    }
#pragma unroll
    for (int lt = 0; lt < 4; ++lt) {
#pragma unroll
        for (int ksp = 0; ksp <= (lt >> 1); ++ksp) {
            const bool hasb = (2 * ksp + 1) <= lt;
            f32x4 d0a = (f32x4){0.f, 0.f, 0.f, 0.f}, d0b = (f32x4){0.f, 0.f, 0.f, 0.f};
#pragma unroll
            for (int kn = 0; kn < 4; ++kn) { const int cb = (gi * 128 + 32 * kn + 8 * q4) * 2;
                const bf16x8 cf = *(const LAS bf16x8*)(CI + (16 * lt + fr) * 544 + cb);
                const bf16x8 ba = *(const LAS bf16x8*)(BI + (32 * ksp + fr) * 544 + cb); d0a = mfma16(ba, cf, d0a);
                if (hasb) { const bf16x8 bb = *(const LAS bf16x8*)(BI + (32 * ksp + 16 + fr) * 544 + cb); d0b = mfma16(bb, cf, d0b); } }
            const int l = 16 * lt + fr; const float al = acs[l * 8 + h];
            float ga[4], gb[4];
#pragma unroll
            for (int r = 0; r < 4; ++r) { const int sa = 32 * ksp + 4 * q4 + r, sb = sa + 16;
                ga[r] = sa <= l ? d0a[r] * __expf(al - acs[sa * 8 + h]) * dtl[sa * 8 + h] : 0.f;
                gb[r] = (hasb && sb <= l) ? d0b[r] * __expf(al - acs[sb * 8 + h]) * dtl[sb * 8 + h] : 0.f; }
            const bf16x8 xf = pack8(ga[0], ga[1], ga[2], ga[3], gb[0], gb[1], gb[2], gb[3]);
            const int rowA = 32 * ksp + 4 * q4 + (fr >> 2), rowB = rowA + 16;
#pragma unroll
            for (int pt = 0; pt < 4; ++pt) { const int cb = (h * 64 + 16 * pt + 4 * (lane & 3)) * 2;
                acc[lt][pt] = mfma16(xf, cat8(trrd(XI + rowA * 1056 + cb), trrd(XI + rowB * 1056 + cb)), acc[lt][pt]); }
        }
    }
    { const float dsk = A.in[10][L * 8 + h];
#pragma unroll
      for (int lt = 0; lt < 4; ++lt)
#pragma unroll
          for (int pt = 0; pt < 4; ++pt)
#pragma unroll
              for (int r = 0; r < 4; ++r) { const unsigned short xv = *(const LAS unsigned short*)(XI + (16 * lt + 4 * q4 + r) * 1056 + (h * 64 + 16 * pt + fr) * 2);
                  acc[lt][pt][r] += dsk * __uint_as_float((unsigned)xv << 16); } }
    __builtin_amdgcn_sched_barrier(0);
    v4u zr[8];
#pragma unroll
    for (int i = 0; i < 8; ++i) zr[i] = __builtin_nontemporal_load((const v4u*)(P + (m0 + 8 * w + i) * PN + PC_Z + 8 * lane));
    __syncthreads();
    TR(F, 37);
#pragma unroll
    for (int lt = 0; lt < 4; ++lt)
#pragma unroll
        for (int pt = 0; pt < 4; ++pt)
#pragma unroll
            for (int r = 0; r < 4; ++r) *(LAS float*)(Ls + (16 * lt + 4 * q4 + r) * 2112 + (h * 64 + 16 * pt + fr) * 4) = acc[lt][pt][r];
    __syncthreads();
    { const f32x4 g0 = *(const f32x4*)(A.in[11] + L * 512 + 8 * lane), g1 = *(const f32x4*)(A.in[11] + L * 512 + 8 * lane + 4);
#pragma unroll
      for (int i = 0; i < 8; ++i) { const int r = 8 * w + i;
        f32x4 v0 = *(const LAS f32x4*)(Ls + r * 2112 + lane * 32), v1 = *(const LAS f32x4*)(Ls + r * 2112 + lane * 32 + 16);
        const v4u z = zr[i];
        v0 = v0 * (f32x4){silu(bflo(z.x)), silu(bfhi(z.x)), silu(bflo(z.y)), silu(bfhi(z.y))};
        v1 = v1 * (f32x4){silu(bflo(z.z)), silu(bfhi(z.z)), silu(bflo(z.w)), silu(bfhi(z.w))};
        const float ss = wave_sum((v0.x * v0.x + v0.y * v0.y) + (v0.z * v0.z + v0.w * v0.w) + (v1.x * v1.x + v1.y * v1.y) + (v1.z * v1.z + v1.w * v1.w)) * (1.0f / 512.0f);
        const float sc = rsq(ss + 1e-6f);
        v0 = v0 * sc * g0; v1 = v1 * sc * g1;
        v4u ov; ov.x = pk2(v0.x, v0.y); ov.y = pk2(v0.z, v0.w); ov.z = pk2(v1.x, v1.y); ov.w = pk2(v1.z, v1.w);
        *(v4u*)(Y + (m0 + r) * D + 8 * lane) = ov; } }
    __syncthreads();
    TR(F, 38);
}

#ifndef PROBE_FP8TEST
#define PROBE_FP8TEST 0
#endif
#if PROBE_FP8TEST
typedef int v8i __attribute__((ext_vector_type(8)));
__device__ __forceinline__ int fp8_selftest(int lane) {
    const int ij = lane & 15, g = lane >> 4;
    v8i Af, Bf;
#pragma unroll
    for (int r = 0; r < 8; ++r) { int wa = 0, wb = 0; const int k = 32 * g + 4 * r;
        wa = __builtin_amdgcn_cvt_pk_fp8_f32((float)((7 * ij + 3 * (k + 0)) % 5), (float)((7 * ij + 3 * (k + 1)) % 5), wa, false);
        wa = __builtin_amdgcn_cvt_pk_fp8_f32((float)((7 * ij + 3 * (k + 2)) % 5), (float)((7 * ij + 3 * (k + 3)) % 5), wa, true);
        wb = __builtin_amdgcn_cvt_pk_fp8_f32((float)((5 * (k + 0) + 11 * ij) % 7), (float)((5 * (k + 1) + 11 * ij) % 7), wb, false);
        wb = __builtin_amdgcn_cvt_pk_fp8_f32((float)((5 * (k + 2) + 11 * ij) % 7), (float)((5 * (k + 3) + 11 * ij) % 7), wb, true);
        Af[r] = wa; Bf[r] = wb; }
    f32x4 d = (f32x4){0.f, 0.f, 0.f, 0.f};
    d = __builtin_amdgcn_mfma_scale_f32_16x16x128_f8f6f4(Af, Bf, d, 0, 0, 0, 0, 0, 0);
    int bad = 0;
#pragma unroll
    for (int r = 0; r < 4; ++r) { const int i = 4 * g + r, j = ij; float e = 0.f;
        for (int k = 0; k < 128; ++k) e += (float)(((7 * i + 3 * k) % 5) * ((5 * k + 11 * j) % 7));
        bad += (d[r] != e + (PROBE_FP8TEST == 2 ? 1.f : 0.f)) ? 1 : 0; }
    return bad;
}
#endif
constexpr int NPHASE = 1 + 16 + 7 + 2 * MOE_NCH + 1;
__global__ void __launch_bounds__(NTHR, 2) fwd_kernel(Args kargs) {
    ArgsP ap = (ArgsP)__builtin_amdgcn_kernarg_segment_ptr();
#define args (*ap)
    extern __shared__ __attribute__((aligned(16))) unsigned char lds[];
    Frame F;
    F.lds = (LAS unsigned char*)lds;
    F.tid = threadIdx.x; F.lane = F.tid & 63; F.wave = __builtin_amdgcn_readfirstlane(F.tid >> 6);
#if PROBE_TG >= 30
    F.tr_acc = 0ull; F.tr_mark = 0ull;
#endif
    F.G = gridDim.x; { const int bx = blockIdx.x; F.vcu = (F.G % 8 == 0) ? (bx % 8) * (F.G / 8) + bx / 8 : bx; }
    gu32* ctl = (gu32*)(args.ws + WS_CTL);
    for (int u = F.tid; u < (LDS_BYTES - LDSCTL_OFF) / 4; u += NTHR) ((LAS unsigned*)(F.lds + LDSCTL_OFF))[u] = 0u;
    __syncthreads();
    XcdBarrier bar; bar.bar = (unsigned*)(ctl + CW_BAR); bar.x = 0; bar.st = nullptr;
    const int lo = args.ph_lo, hi = args.ph_hi;
    int nbar = 0;
    if (hi - lo > 1) bar = xcd_barrier_post((unsigned*)(ctl + CW_BAR), (volatile LAS unsigned*)(F.lds + CTL_MISC) + 8);
#if PROBE_TG >= 0
    unsigned long long t_acc = 0ull, t_ph = 0ull;
#define IN(k) ((lo <= (k) && (k) < hi) && fresh(F) && relaunder(ap) && ((t_ph = __builtin_amdgcn_s_memrealtime()), true))
#define T_STOP(k) do { if (tgroup_of(k) == PROBE_TG || PROBE_TG == 26) t_acc += __builtin_amdgcn_s_memrealtime() - t_ph; } while (0)
    unsigned long long t_sub = 0ull;
#define T_SUB0() (t_sub = __builtin_amdgcn_s_memrealtime())
#define T_SUB(g) do { const unsigned long long n_ = __builtin_amdgcn_s_memrealtime(); if ((g) == PROBE_TG) t_acc += n_ - t_sub; t_sub = n_; } while (0)
#else
#define T_SUB0() do { } while (0)
#define T_SUB(g) do { } while (0)
#define IN(k) ((lo <= (k) && (k) < hi) && fresh(F) && relaunder(ap))
#define T_STOP(k) do { } while (0)
#endif
#if PROBE_TG == 20
#define SEAM(k) do { if ((k) + 1 < hi) { const unsigned long long tb_ = __builtin_amdgcn_s_memrealtime(); xcd_barrier(bar); ++nbar; t_acc += __builtin_amdgcn_s_memrealtime() - tb_; } } while (0)
#else
#define SEAM(k) do { if ((k) + 1 < hi) { REP(12) xcd_barrier(bar); ++nbar; } T_STOP(k); } while (0)
#define IN_LAUNCH(k) (lo <= (k) && (k) < hi)
#endif
    unsigned char* ws = args.ws;
    float* RS = (float*)(ws + WS_RS); bf16* HB = (bf16*)(ws + WS_HB); bf16* PROJ = (bf16*)(ws + WS_PROJ); bf16* Yb = (bf16*)(ws + WS_Y); bf16* MIXED = (bf16*)(ws + WS_MIXED);
    const int bid = (int)blockIdx.x;

#ifdef ONLY_UNIT
    { fresh(F); relaunder(ap);
#if ONLY_UNIT == 1
      for (int u = F.vcu; u < NBATCH * NCHUNK; u += F.G) ssd1_unit(F, args, 0, u);
#elif ONLY_UNIT == 2
      for (int u = F.vcu; u < NBATCH * NCHUNK; u += F.G) attn_unit(F, args, 0, u);
#elif ONLY_UNIT == 3
      for (int u = F.vcu; u < M / 128; u += F.G) gmlp_unit(F, args, 0, u);
#elif ONLY_UNIT == 4
      for (int u = F.vcu; u < NBATCH * NCHUNK; u += F.G) ssd3_unit(F, args, 0, u);
#elif ONLY_UNIT == 5
      { RowArgs R{nullptr, nullptr, HB, HB, 1, MIXED, args.in[2], args.in[3], nullptr, 2, args.in[23], 8, nullptr, RS}; row_phase<4>(F, args, R); }
#endif
      return; }
#endif
    if (IN(0)) {
#if PROBE_FP8TEST
        if (blockIdx.x == 0 && F.wave == 0) { const int bad = fp8_selftest(F.lane); if (bad) atomicAdd((unsigned*)(args.ws + WS_CTL) + 2, (unsigned)bad); }
#endif
        cvt_small_weights(F, args, 0, 704, F.vcu * NWAVES + F.wave, F.G * NWAVES);
        __syncthreads();
        __builtin_assume(args.in[0] != nullptr);
        RowArgs R{args.in[0], nullptr, nullptr, HB, 0, nullptr, nullptr, args.in[1], nullptr, 1, args.in[5] + 1536, DIN, nullptr, RS};
        row_phase<6>(F, args, R);
        SEAM(0);
    }
#ifdef PROBE_SWEEP
    { fresh(F); const int gw = F.vcu * NWAVES + F.wave, NGW = F.G * NWAVES; float acc = 0.f;
      for (int mb = gw; mb < M; mb += PROBE_SWEEP * NGW) { f32x4 t[PROBE_SWEEP][4];
#pragma unroll
          for (int q = 0; q < PROBE_SWEEP; ++q)
#pragma unroll
              for (int j = 0; j < 4; ++j) t[q][j] = *(const f32x4*)(args.in[0] + (size_t)(mb + q * NGW) * D + 4 * F.lane + 256 * j);
#pragma unroll
          for (int q = 0; q < PROBE_SWEEP; ++q)
#pragma unroll
              for (int j = 0; j < 4; ++j) acc += t[q][j].x + t[q][j].y + t[q][j].z + t[q][j].w; }
      if (acc == 1.2345e-30f) ((float*)(args.ws + WS_CTL))[100] = acc;
      __syncthreads(); }
#endif
    { constexpr int L = 0; constexpr int pb = 1;
        if (IN(pb + 0)) {
            pg8::Gemm g{HB, (const bf16*)(ws + WS_WIN) + (size_t)L * PN * D, M, PN, D}; pg8::StaticOrder S; S.init(M, PN, F.G, bid);
            pg8::EpiStoreRS E{PROJ, PN, RS};
            pg8::gemm_phase<pg8::EpiStoreRS, pg8::StaticOrder, true, true>(F.lds, g, S, E);
            if (F.G == 256 && bid >= 128) { const int gw = (bid - 128) * NWAVES + F.wave;
                if (L == 0) cvt_small_weights(F, args, 704, CVT_SMALL_TASKS, gw, 128 * NWAVES);
                else cvt_moe_weights(F, args, 0, MOE_CVT_EARLY, gw, 128 * NWAVES); }
            else if (F.G != 256 && L == 0) cvt_small_weights(F, args, 704, CVT_SMALL_TASKS, F.vcu * NWAVES + F.wave, F.G * NWAVES);
            else if (F.G != 256) cvt_moe_weights(F, args, 0, MOE_CVT_EARLY, F.vcu * NWAVES + F.wave, F.G * NWAVES);
            SEAM(pb + 0);
        }
        if (IN(pb + 1)) {
            T_SUB0();
            for (int u = F.vcu; u < NBATCH * NCHUNK; u += F.G) attn_unit(F, args, L, u);
            T_SUB(11);
            for (int u = F.vcu; u < NBATCH * NCHUNK; u += F.G) ssd1_unit(F, args, L, u);
            T_SUB(10);
            for (int u = F.vcu; u < M / 128; u += F.G) gmlp_unit(F, args, L, u);
            T_SUB(12);
            SEAM(pb + 1);
        }
                if (IN(pb + 2)) { ssd_scan(F, args); SEAM(pb + 2); }
        if (IN(pb + 3)) { for (int u = F.vcu; u < NBATCH * NCHUNK; u += F.G) ssd3_unit(F, args, L, u); SEAM(pb + 3); }
        if (IN(pb + 4)) {
            pg8::Gemm g{Yb, (const bf16*)(ws + WS_WOUT) + (size_t)L * D * D, M, D, D}; pg8::StaticOrder S; S.init(M, D, F.G, bid);
            pg8::EpiStore E{MIXED, D, 1.0f};
            REP(5) pg8::gemm_phase<pg8::EpiStore, pg8::StaticOrder, true, true>(F.lds, g, S, E);
            SEAM(pb + 4);
        }
        if (IN(pb + 5)) {
            if (L == 0) { RowArgs R{nullptr, nullptr, HB, HB, 1, MIXED, args.in[2], args.in[3], nullptr, 0, nullptr, 0, ws + WS_A1, RS}; row_phase<6>(F, args, R); }
            else { RowArgs R{nullptr, nullptr, HB, HB, 1, MIXED, args.in[2] + D, args.in[3] + D, nullptr, 2, args.in[23], 8, ws + WS_A1, nullptr}; row_phase<4>(F, args, R); }
            if (L == 1) cvt_moe_weights(F, args, MOE_CVT_EARLY, MOE_CVT_TASKS, F.vcu * NWAVES + F.wave, F.G * NWAVES);
            SEAM(pb + 5);
        }
        if (L == 0) {
            if (IN(pb + 6)) {
                { pg8::Gemm g{(const bf16*)(ws + WS_A1), (const bf16*)(ws + WS_WGU), M, 256 * GU_T8, D / 2}; pg8::StaticOrder S; S.init(M, 256 * GU_T8, F.G, bid);
                  pg8::EpiSwiglu8 E{ws + WS_H1, DFF, 1.0f / (FP8_SX * FP8_SW), FP8_SH};
                  pg8::gemm_phase<pg8::EpiSwiglu8, pg8::StaticOrder, true, true, true>(F.lds, g, S, E); }
                __syncthreads();
                if constexpr (GU_T8 < 22) { pg8::Gemm g{HB, (const bf16*)(ws + WS_WGUB), M, 256 * (22 - GU_T8), D}; pg8::StaticOrder S; S.init(M, 256 * (22 - GU_T8), F.G, bid);
                  pg8::EpiSwigluRS8 E{ws + WS_H1 + 128 * GU_T8, DFF, RS, FP8_SH};
                  pg8::gemm_phase<pg8::EpiSwigluRS8, pg8::StaticOrder, true, true>(F.lds, g, S, E); }
                SEAM(pb + 6);
            }
            if (IN(pb + 7)) {
                pg8::Gemm g{(const bf16*)(ws + WS_H1), (const bf16*)(ws + WS_WD), M, D, DFF / 2}; pg8::StaticOrder S; S.init(M, D, F.G, bid);
                pg8::EpiStore E{(bf16*)(ws + WS_FOUT), D, 1.0f / (FP8_SH * FP8_SW)};
                REP(6) pg8::gemm_phase<pg8::EpiStore, pg8::StaticOrder, true, true, true>(F.lds, g, S, E);
                SEAM(pb + 7);
            }
            if (IN(pb + 8)) {
                RowArgs R{nullptr, nullptr, HB, HB, 1, (const bf16*)(ws + WS_FOUT), args.in[4], args.in[1] + D, nullptr, 1, args.in[5] + (size_t)D * DIN + 1536, DIN, nullptr, RS};
                row_phase<6>(F, args, R);
                SEAM(pb + 8);
            }
        } else {
#if PROBE_TG >= 10
#ifdef PROBE_TMIN
            if (lo <= pb + 6 && pb + 6 < hi && threadIdx.x == 0) atomicMax((unsigned*)(args.ws + WS_CTL) + 8, 0xffffffffu - (unsigned)t_acc);
#else
            if (lo <= pb + 6 && pb + 6 < hi && threadIdx.x == 0) atomicMax((unsigned*)(args.ws + WS_CTL) + 8, (unsigned)t_acc);
#endif
#endif
            if (IN(pb + 6)) { REP(11) { moe_tables(F, args); moe_gather(F, args); } SEAM(pb + 6); }
            static_assert(MOE_NCH == 2, "four MoE GEMM phases");
            {
                if (IN(pb + 7)) {
                    if (!IN_LAUNCH(pb + 6)) moe_tables(F, args);
                    const int nT = *(LAS int*)(F.lds + CTL_CNT + 32 * 4); const int tail = nT > 2 * MOE_CH ? nT - 2 * MOE_CH : 0; const int a1 = nT < MOE_CH + tail ? nT : MOE_CH + tail;
                    pg8::Gemm g{(const bf16*)(ws + WS_XS), (const bf16*)(ws + WS_MWGU), 0, 0, D / 2};
                    pg8::MoeOrder<false, true> S{0, a1, 28, F.G, bid, (const LAS int*)(F.lds + CTL_TE)};
                    pg8::EpiSwiglu8 E{ws + WS_HM, DFFE, 1.0f / (FP8_SX * FP8_SW), FP8_SH};
                    pg8::gemm_phase<pg8::EpiSwiglu8, pg8::MoeOrder<false, true>, true, true, true>(F.lds, g, S, E);
                    SEAM(pb + 7);
                }
                if (IN(pb + 8)) {
                    if (!IN_LAUNCH(pb + 6)) moe_tables(F, args);
                    const int nT = *(LAS int*)(F.lds + CTL_CNT + 32 * 4); const int tail = nT > 2 * MOE_CH ? nT - 2 * MOE_CH : 0; const int a1 = nT < MOE_CH + tail ? nT : MOE_CH + tail;
                    pg8::Gemm g{(const bf16*)(ws + WS_HM), (const bf16*)(ws + WS_MWD), 0, 0, DFFE / 2};
                    pg8::MoeOrder<false, false> S{0, a1 - tail, 4, F.G, bid, (const LAS int*)(F.lds + CTL_TE)};
                    pg8::EpiStore8 E{ws + WS_YM, D, FP8_SY / (FP8_SH * FP8_SW)};
                    pg8::gemm_phase<pg8::EpiStore8, pg8::MoeOrder<false, false>, true, true, true>(F.lds, g, S, E);
                    SEAM(pb + 8);
                }
                if (IN(pb + 9)) {
                    if (!IN_LAUNCH(pb + 6)) moe_tables(F, args);
                    const int nT = *(LAS int*)(F.lds + CTL_CNT + 32 * 4); const int tail = nT > 2 * MOE_CH ? nT - 2 * MOE_CH : 0; const int a1 = nT < MOE_CH + tail ? nT : MOE_CH + tail;
                    { pg8::Gemm g{(const bf16*)(ws + WS_HM), (const bf16*)(ws + WS_MWD), 0, 0, DFFE / 2};
                      pg8::MoeOrder<false, false> S{a1 - tail, tail, 4, F.G, bid, (const LAS int*)(F.lds + CTL_TE)};
                      pg8::EpiStore8 E{ws + WS_YM, D, FP8_SY / (FP8_SH * FP8_SW)};
                      pg8::gemm_phase<pg8::EpiStore8, pg8::MoeOrder<false, false>, true, true, true>(F.lds, g, S, E); }
                    __syncthreads();
                    { const int nd = (F.G == 256 && 4 * tail <= 64) ? 4 * tail : 0;
                      pg8::Gemm g{(const bf16*)(ws + WS_XS), (const bf16*)(ws + WS_MWGU), 0, 0, D / 2};
                      pg8::MoeOrderSkip S{a1, nT - a1, 28, F.G, bid, (const LAS int*)(F.lds + CTL_TE), nd, 3};
                      pg8::EpiSwiglu8 E{ws + WS_HM, DFFE, 1.0f / (FP8_SX * FP8_SW), FP8_SH};
                      pg8::gemm_phase<pg8::EpiSwiglu8, pg8::MoeOrderSkip, true, true, true>(F.lds, g, S, E); }
                    SEAM(pb + 9);
                }
                if (IN(pb + 10)) {
                    if (!IN_LAUNCH(pb + 6)) moe_tables(F, args);
                    const int nT = *(LAS int*)(F.lds + CTL_CNT + 32 * 4); const int tail = nT > 2 * MOE_CH ? nT - 2 * MOE_CH : 0; const int a1 = nT < MOE_CH + tail ? nT : MOE_CH + tail;
                    pg8::Gemm g{(const bf16*)(ws + WS_HM), (const bf16*)(ws + WS_MWD), 0, 0, DFFE / 2};
                    pg8::MoeOrder<true, false> S{a1, nT - a1, 4, F.G, bid, (const LAS int*)(F.lds + CTL_TE)};
                    pg8::EpiStore8 E{ws + WS_YM, D, FP8_SY / (FP8_SH * FP8_SW)};
                    pg8::gemm_phase<pg8::EpiStore8, pg8::MoeOrder<true, false>, true, true, true>(F.lds, g, S, E);
                    SEAM(pb + 10);
                }
            }
            if (IN(pb + 7 + 2 * MOE_NCH)) {
                RowArgs R{nullptr, args.out, HB, nullptr, 2, nullptr, args.in[4] + D, nullptr, nullptr, 0, nullptr, 0, nullptr, nullptr, ws + WS_YM};
                row_phase<4>(F, args, R);
#if PROBE_FP8TEST
                if (__hip_atomic_load((unsigned*)(args.ws + WS_CTL) + 2, RLX_AGENT) != 0u) { __syncthreads(); for (size_t i = (size_t)blockIdx.x * NTHR + F.tid; i < (size_t)M * D; i += (size_t)F.G * NTHR) args.out[i] += 1.0f; }
#endif
            }
        }
    }
    { constexpr int L = 1; constexpr int pb = 17;
        if (IN(pb + 0)) {
            pg8::Gemm g{HB, (const bf16*)(ws + WS_WIN) + (size_t)L * PN * D, M, PN, D}; pg8::StaticOrder S; S.init(M, PN, F.G, bid);
            pg8::EpiStoreRS E{PROJ, PN, RS};
            pg8::gemm_phase<pg8::EpiStoreRS, pg8::StaticOrder, true, true>(F.lds, g, S, E);
            if (F.G == 256 && bid >= 128) { const int gw = (bid - 128) * NWAVES + F.wave;
                if (L == 0) cvt_small_weights(F, args, 704, CVT_SMALL_TASKS, gw, 128 * NWAVES);
                else cvt_moe_weights(F, args, 0, MOE_CVT_EARLY, gw, 128 * NWAVES); }
            else if (F.G != 256 && L == 0) cvt_small_weights(F, args, 704, CVT_SMALL_TASKS, F.vcu * NWAVES + F.wave, F.G * NWAVES);
            else if (F.G != 256) cvt_moe_weights(F, args, 0, MOE_CVT_EARLY, F.vcu * NWAVES + F.wave, F.G * NWAVES);
            SEAM(pb + 0);
        }
        if (IN(pb + 1)) {
            T_SUB0();
            for (int u = F.vcu; u < NBATCH * NCHUNK; u += F.G) attn_unit(F, args, L, u);
            T_SUB(11);
            for (int u = F.vcu; u < NBATCH * NCHUNK; u += F.G) ssd1_unit(F, args, L, u);
            T_SUB(10);
            for (int u = F.vcu; u < M / 128; u += F.G) gmlp_unit(F, args, L, u);
            T_SUB(12);
            SEAM(pb + 1);
        }
                if (IN(pb + 2)) { ssd_scan(F, args); SEAM(pb + 2); }
        if (IN(pb + 3)) { for (int u = F.vcu; u < NBATCH * NCHUNK; u += F.G) ssd3_unit(F, args, L, u); SEAM(pb + 3); }
        if (IN(pb + 4)) {
            pg8::Gemm g{Yb, (const bf16*)(ws + WS_WOUT) + (size_t)L * D * D, M, D, D}; pg8::StaticOrder S; S.init(M, D, F.G, bid);
            pg8::EpiStore E{MIXED, D, 1.0f};
            REP(5) pg8::gemm_phase<pg8::EpiStore, pg8::StaticOrder, true, true>(F.lds, g, S, E);
            SEAM(pb + 4);
        }
        if (IN(pb + 5)) {
            if (L == 0) { RowArgs R{nullptr, nullptr, HB, HB, 1, MIXED, args.in[2], args.in[3], nullptr, 0, nullptr, 0, ws + WS_A1, RS}; row_phase<6>(F, args, R); }
            else { RowArgs R{nullptr, nullptr, HB, HB, 1, MIXED, args.in[2] + D, args.in[3] + D, nullptr, 2, args.in[23], 8, ws + WS_A1, nullptr}; row_phase<4>(F, args, R); }
            if (L == 1) cvt_moe_weights(F, args, MOE_CVT_EARLY, MOE_CVT_TASKS, F.vcu * NWAVES + F.wave, F.G * NWAVES);
            SEAM(pb + 5);
        }
        if (L == 0) {
            if (IN(pb + 6)) {
                { pg8::Gemm g{(const bf16*)(ws + WS_A1), (const bf16*)(ws + WS_WGU), M, 256 * GU_T8, D / 2}; pg8::StaticOrder S; S.init(M, 256 * GU_T8, F.G, bid);
                  pg8::EpiSwiglu8 E{ws + WS_H1, DFF, 1.0f / (FP8_SX * FP8_SW), FP8_SH};
                  pg8::gemm_phase<pg8::EpiSwiglu8, pg8::StaticOrder, true, true, true>(F.lds, g, S, E); }
                __syncthreads();
                if constexpr (GU_T8 < 22) { pg8::Gemm g{HB, (const bf16*)(ws + WS_WGUB), M, 256 * (22 - GU_T8), D}; pg8::StaticOrder S; S.init(M, 256 * (22 - GU_T8), F.G, bid);
                  pg8::EpiSwigluRS8 E{ws + WS_H1 + 128 * GU_T8, DFF, RS, FP8_SH};
                  pg8::gemm_phase<pg8::EpiSwigluRS8, pg8::StaticOrder, true, true>(F.lds, g, S, E); }
                SEAM(pb + 6);
            }
            if (IN(pb + 7)) {
                pg8::Gemm g{(const bf16*)(ws + WS_H1), (const bf16*)(ws + WS_WD), M, D, DFF / 2}; pg8::StaticOrder S; S.init(M, D, F.G, bid);
                pg8::EpiStore E{(bf16*)(ws + WS_FOUT), D, 1.0f / (FP8_SH * FP8_SW)};
                REP(6) pg8::gemm_phase<pg8::EpiStore, pg8::StaticOrder, true, true, true>(F.lds, g, S, E);
                SEAM(pb + 7);
            }
            if (IN(pb + 8)) {
                RowArgs R{nullptr, nullptr, HB, HB, 1, (const bf16*)(ws + WS_FOUT), args.in[4], args.in[1] + D, nullptr, 1, args.in[5] + (size_t)D * DIN + 1536, DIN, nullptr, RS};
                row_phase<6>(F, args, R);
                SEAM(pb + 8);
            }
        } else {
#if PROBE_TG >= 10
#ifdef PROBE_TMIN
            if (lo <= pb + 6 && pb + 6 < hi && threadIdx.x == 0) atomicMax((unsigned*)(args.ws + WS_CTL) + 8, 0xffffffffu - (unsigned)t_acc);
#else
            if (lo <= pb + 6 && pb + 6 < hi && threadIdx.x == 0) atomicMax((unsigned*)(args.ws + WS_CTL) + 8, (unsigned)t_acc);
#endif
#endif
            if (IN(pb + 6)) { REP(11) { moe_tables(F, args); moe_gather(F, args); } SEAM(pb + 6); }
            static_assert(MOE_NCH == 2, "four MoE GEMM phases");
            {
                if (IN(pb + 7)) {
                    if (!IN_LAUNCH(pb + 6)) moe_tables(F, args);
                    const int nT = *(LAS int*)(F.lds + CTL_CNT + 32 * 4); const int tail = nT > 2 * MOE_CH ? nT - 2 * MOE_CH : 0; const int a1 = nT < MOE_CH + tail ? nT : MOE_CH + tail;
                    pg8::Gemm g{(const bf16*)(ws + WS_XS), (const bf16*)(ws + WS_MWGU), 0, 0, D / 2};
                    pg8::MoeOrder<false, true> S{0, a1, 28, F.G, bid, (const LAS int*)(F.lds + CTL_TE)};
                    pg8::EpiSwiglu8 E{ws + WS_HM, DFFE, 1.0f / (FP8_SX * FP8_SW), FP8_SH};
                    pg8::gemm_phase<pg8::EpiSwiglu8, pg8::MoeOrder<false, true>, true, true, true>(F.lds, g, S, E);
                    SEAM(pb + 7);
                }
                if (IN(pb + 8)) {
                    if (!IN_LAUNCH(pb + 6)) moe_tables(F, args);
                    const int nT = *(LAS int*)(F.lds + CTL_CNT + 32 * 4); const int tail = nT > 2 * MOE_CH ? nT - 2 * MOE_CH : 0; const int a1 = nT < MOE_CH + tail ? nT : MOE_CH + tail;
                    pg8::Gemm g{(const bf16*)(ws + WS_HM), (const bf16*)(ws + WS_MWD), 0, 0, DFFE / 2};
                    pg8::MoeOrder<false, false> S{0, a1 - tail, 4, F.G, bid, (const LAS int*)(F.lds + CTL_TE)};
                    pg8::EpiStore8 E{ws + WS_YM, D, FP8_SY / (FP8_SH * FP8_SW)};
                    pg8::gemm_phase<pg8::EpiStore8, pg8::MoeOrder<false, false>, true, true, true>(F.lds, g, S, E);
                    SEAM(pb + 8);
                }
                if (IN(pb + 9)) {
                    if (!IN_LAUNCH(pb + 6)) moe_tables(F, args);
                    const int nT = *(LAS int*)(F.lds + CTL_CNT + 32 * 4); const int tail = nT > 2 * MOE_CH ? nT - 2 * MOE_CH : 0; const int a1 = nT < MOE_CH + tail ? nT : MOE_CH + tail;
                    { pg8::Gemm g{(const bf16*)(ws + WS_HM), (const bf16*)(ws + WS_MWD), 0, 0, DFFE / 2};
                      pg8::MoeOrder<false, false> S{a1 - tail, tail, 4, F.G, bid, (const LAS int*)(F.lds + CTL_TE)};
                      pg8::EpiStore8 E{ws + WS_YM, D, FP8_SY / (FP8_SH * FP8_SW)};
                      pg8::gemm_phase<pg8::EpiStore8, pg8::MoeOrder<false, false>, true, true, true>(F.lds, g, S, E); }
                    __syncthreads();
                    { const int nd = (F.G == 256 && 4 * tail <= 64) ? 4 * tail : 0;
                      pg8::Gemm g{(const bf16*)(ws + WS_XS), (const bf16*)(ws + WS_MWGU), 0, 0, D / 2};
                      pg8::MoeOrderSkip S{a1, nT - a1, 28, F.G, bid, (const LAS int*)(F.lds + CTL_TE), nd, 3};
                      pg8::EpiSwiglu8 E{ws + WS_HM, DFFE, 1.0f / (FP8_SX * FP8_SW), FP8_SH};
                      pg8::gemm_phase<pg8::EpiSwiglu8, pg8::MoeOrderSkip, true, true, true>(F.lds, g, S, E); }
                    SEAM(pb + 9);
                }
                if (IN(pb + 10)) {
                    if (!IN_LAUNCH(pb + 6)) moe_tables(F, args);
                    const int nT = *(LAS int*)(F.lds + CTL_CNT + 32 * 4); const int tail = nT > 2 * MOE_CH ? nT - 2 * MOE_CH : 0; const int a1 = nT < MOE_CH + tail ? nT : MOE_CH + tail;
                    pg8::Gemm g{(const bf16*)(ws + WS_HM), (const bf16*)(ws + WS_MWD), 0, 0, DFFE / 2};
                    pg8::MoeOrder<true, false> S{a1, nT - a1, 4, F.G, bid, (const LAS int*)(F.lds + CTL_TE)};
                    pg8::EpiStore8 E{ws + WS_YM, D, FP8_SY / (FP8_SH * FP8_SW)};
                    pg8::gemm_phase<pg8::EpiStore8, pg8::MoeOrder<true, false>, true, true, true>(F.lds, g, S, E);
                    SEAM(pb + 10);
                }
            }
            if (IN(pb + 7 + 2 * MOE_NCH)) {
                RowArgs R{nullptr, args.out, HB, nullptr, 2, nullptr, args.in[4] + D, nullptr, nullptr, 0, nullptr, 0, nullptr, nullptr, ws + WS_YM};
                row_phase<4>(F, args, R);
#if PROBE_FP8TEST
                if (__hip_atomic_load((unsigned*)(args.ws + WS_CTL) + 2, RLX_AGENT) != 0u) { __syncthreads(); for (size_t i = (size_t)blockIdx.x * NTHR + F.tid; i < (size_t)M * D; i += (size_t)F.G * NTHR) args.out[i] += 1.0f; }
#endif
            }
        }
    }
#if PROBE_TG >= 0
    T_STOP(1 + 16 + 7 + 2 * MOE_NCH);
#if PROBE_TG >= 10
#endif
    if (blockIdx.x == 77) { unsigned long long t_spin = t_acc;
#if PROBE_TG >= 30
        t_spin = F.tr_acc;
#endif
#if PROBE_TG == 27
        t_spin = (unsigned long long)(*(LAS int*)(F.lds + CTL_CNT + 32 * 4) - 250) * 1000ull;
#endif
#if PROBE_TG >= 10 && PROBE_TG < 20
        t_spin = __hip_atomic_load((unsigned*)(args.ws + WS_CTL) + 8, RLX_AGENT);
#ifdef PROBE_TMIN
        t_spin = 0xffffffffu - (unsigned)t_spin;
#endif
#endif
        const unsigned long long t_end = __builtin_amdgcn_s_memrealtime(); while (__builtin_amdgcn_s_memrealtime() - t_end < t_spin) __builtin_amdgcn_s_sleep(8); }
#endif
#undef IN
#undef SEAM
#undef args
}

extern "C" void kernel_launch(void* const* d_in, const int* in_sizes, int n_in, void* d_out, int out_size, void* d_ws, size_t ws_size, hipStream_t stream) {
    static int grid = 0;
    if (grid == 0) {
        if (n_in != NIN || out_size != M * D || ws_size < WS_END) { fprintf(stderr, "kernel_launch: unexpected shapes (n_in %d, out %d, ws %zu)\n", n_in, out_size, ws_size); grid = -1; return; }
        int dev = 0, cus = 0;
        if (hipGetDevice(&dev) != hipSuccess || hipDeviceGetAttribute(&cus, hipDeviceAttributeMultiprocessorCount, dev) != hipSuccess) { grid = -1; return; }
        if (hipFuncSetAttribute((const void*)fwd_kernel, hipFuncAttributeMaxDynamicSharedMemorySize, LDS_BYTES) != hipSuccess) { fprintf(stderr, "kernel_launch: hipFuncSetAttribute failed\n"); grid = -1; return; }
        int per_cu = 0;
        if (hipOccupancyMaxActiveBlocksPerMultiprocessor(&per_cu, (const void*)fwd_kernel, NTHR, LDS_BYTES) != hipSuccess || per_cu < 1) fprintf(stderr, "kernel_launch: occupancy query says %d\n", per_cu);
        (void)hipGetLastError();
        grid = cus > 256 ? 256 : cus;
    }
    if (grid < 0) return;
    (void)hipMemsetAsync((char*)d_ws + WS_CTL, 0, CTL_ZERO_BYTES, stream);
    Args a{};
    for (int i = 0; i < NIN; ++i) a.in[i] = (const float*)d_in[i];
    a.out = (float*)d_out; a.ws = (unsigned char*)d_ws;
#if MK_SINGLE
    a.ph_lo = 0; a.ph_hi = NPHASE;
    hipLaunchKernelGGL(fwd_kernel, dim3(grid), dim3(NTHR), LDS_BYTES, stream, a);
#else
    for (int ph = 0; ph < NPHASE; ++ph) { if (ph >= 10 && ph < 17) continue; a.ph_lo = ph; a.ph_hi = ph + 1; hipLaunchKernelGGL(fwd_kernel, dim3(grid), dim3(NTHR), LDS_BYTES, stream, a); }
#endif
}
```
